# Optimizing an MI355X kernel written in HIP

```python
import math
import jax
import jax.numpy as jnp
from jax import lax
import numpy as np

D_MODEL = 2048
BATCH = 2
SEQ = 4096
DEPTH = 4

GRID_W = 64
CTX_LEN = 256

HEAD_W = 128
HY_C = 512
HY_ORDER = 2
HY_SHORT = 3
HY_BANDS = 16
HY_EMB = 1 + 2 * HY_BANDS
HY_FFN = 64
HY_FAST_DECAY = 0.3
HY_SLOW_DECAY = 1.5
HY_DECAY_TARGET = 1e-2

LRU_C = 512
LRU_BLOCKS = 4
LRU_BW = LRU_C // LRU_BLOCKS
LRU_CONV = 4
RG_C = 8.0

MLA_H = 8
Q_RANK = 512
KV_RANK = 256
NOPE_D = 128
ROPE_D = 64
V_D = 128
ROPE_BASE = 10000.0
Q_BLOCK = 128
MLA_SCALE = (NOPE_D + ROPE_D) ** -0.5

D_MIX = HY_C + LRU_C + MLA_H * V_D
N_MIX_HEADS = D_MIX // HEAD_W
D_FF = 5632
FFN_CONV = 3
N_MOD = 6
EPS = 1e-6

OFF_HY = 0
OFF_LRU_G = OFF_HY + (HY_ORDER + 1) * HY_C
OFF_MLA_Q = OFF_LRU_G + LRU_C
OFF_LRU_X = OFF_MLA_Q + Q_RANK
OFF_MLA_KV = OFF_LRU_X + LRU_C
OFF_MLA_KR = OFF_MLA_KV + KV_RANK
D_IN = OFF_MLA_KR + ROPE_D

kernel_name = 'hymba_style_hyena_rglru_mla_dit'

F32 = jnp.float32


def rmsnorm(x, g):
    xf = x.astype(F32)
    y = xf * lax.rsqrt(jnp.mean(xf * xf, axis=-1, keepdims=True) + EPS)
    return (y * g.astype(F32)).astype(x.dtype)


def modulate(h, shift, scale):
    return h * (1 + scale) + shift


def dwconv(x, w, left):
    k = w.shape[0]
    length = x.shape[1]
    xp = jnp.pad(x, ((0, 0), (left, k - 1 - left), (0, 0)))
    w = w.astype(x.dtype)
    out = xp[:, 0:length] * w[0]
    for j in range(1, k):
        out = out + xp[:, j:j + length] * w[j]
    return out


def hyena_filter_spectrum(length, w1, b1, w2, b2, w3):
    t = jnp.arange(length, dtype=F32) / length
    ang = 2.0 * math.pi * t[:, None] * jnp.arange(1, HY_BANDS + 1, dtype=F32)
    feats = jnp.concatenate([t[:, None], jnp.sin(ang), jnp.cos(ang)], axis=-1)
    hid = jnp.sin(feats @ w1.astype(F32) + b1.astype(F32))
    hid = jnp.sin(hid @ w2.astype(F32) + b2.astype(F32))
    h = (hid @ w3.astype(F32)).reshape(length, HY_ORDER, 2, HY_C)
    deltas = jnp.abs(jnp.linspace(math.log(HY_DECAY_TARGET) / HY_SLOW_DECAY,
                                  math.log(HY_DECAY_TARGET) / HY_FAST_DECAY, HY_C, dtype=F32))
    h = h * jnp.exp(-t[:, None] * deltas)[:, None, None, :]
    fwd, bwd = h[:, :, 0], h[:, :, 1]
    k = jnp.concatenate([fwd, jnp.zeros((1, HY_ORDER, HY_C), F32), bwd[:0:-1]], axis=0)
    k = k / jnp.sum(jnp.abs(k), axis=0, keepdims=True)
    return jnp.fft.rfft(k, axis=0)


def long_conv(z, spec):
    length = z.shape[1]
    zf = jnp.fft.rfft(z, n=2 * length, axis=1)
    return jnp.fft.irfft(zf * spec, n=2 * length, axis=1)[:, :length]


def hyena_mix(u, conv_w, w1, b1, w2, b2, w3, bias):
    length = u.shape[1]
    parts = jnp.split(dwconv(u, conv_w, HY_SHORT // 2).astype(F32), HY_ORDER + 1, axis=-1)
    spec = hyena_filter_spectrum(length, w1, b1, w2, b2, w3)
    z = parts[0]
    for o in range(HY_ORDER):
        z = parts[o + 1] * (long_conv(z, spec[:, o]) + z * bias[o].astype(F32))
    return z.astype(u.dtype)


def _lru_combine(left, right):
    a1, b1 = left
    a2, b2 = right
    return a1 * a2, a2 * b1 + b2


def rglru_scan(xr, conv_w, wa, ba, wx, bx, lam, h0, reverse):
    bsz, length, _ = xr.shape
    xc = dwconv(xr, conv_w, 0 if reverse else LRU_CONV - 1)
    xb = xc.reshape(bsz, length, LRU_BLOCKS, LRU_BW)
    r = jax.nn.sigmoid(jnp.einsum('blnd,nde->blne', xb, wa).reshape(bsz, length, LRU_C).astype(F32) + ba.astype(F32))
    i = jax.nn.sigmoid(jnp.einsum('blnd,nde->blne', xb, wx).reshape(bsz, length, LRU_C).astype(F32) + bx.astype(F32))
    log_a = -RG_C * r * jax.nn.softplus(-lam.astype(F32))
    a = jnp.exp(log_a)
    b = jnp.sqrt(-jnp.expm1(2.0 * log_a)) * (i * xc.astype(F32))
    if h0 is not None:
        first = length - 1 if reverse else 0
        b = b.at[:, first].add(a[:, first] * h0)
    _, h = lax.associative_scan(_lru_combine, (a, b), reverse=reverse, axis=1)
    return h


def lru_output(gate_pre, h):
    return (jax.nn.gelu(gate_pre.astype(F32), approximate=True) * h).astype(gate_pre.dtype)


def axial_rope_tables(length):
    rows = length // GRID_W
    row = jnp.repeat(jnp.arange(rows, dtype=F32), GRID_W)
    col = jnp.tile(jnp.arange(GRID_W, dtype=F32), rows)
    n_freq = ROPE_D // 4
    inv = ROPE_BASE ** (-jnp.arange(n_freq, dtype=F32) / n_freq)
    ang = jnp.concatenate([row[:, None] * inv, col[:, None] * inv], axis=-1)
    return jnp.cos(ang), jnp.sin(ang)


def apply_rope(x, cos, sin):
    half = x.shape[-1] // 2
    x1 = x[..., :half].astype(F32)
    x2 = x[..., half:].astype(F32)
    return jnp.concatenate([x1 * cos - x2 * sin, x2 * cos + x1 * sin], axis=-1).astype(x.dtype)


def mla_query(uq, gq, wuq, rope):
    bsz, length, _ = uq.shape
    q = (rmsnorm(uq, gq) @ wuq).reshape(bsz, length, MLA_H, NOPE_D + ROPE_D)
    if rope is not None:
        cos, sin = rope
        q = jnp.concatenate([q[..., :NOPE_D], apply_rope(q[..., NOPE_D:], cos[:, None], sin[:, None])], axis=-1)
    return q


def mla_keys_values(ukv, ukr, gkv, wukv, rope):
    bsz, length, _ = ukv.shape
    kv = (rmsnorm(ukv, gkv) @ wukv).reshape(bsz, length, MLA_H, NOPE_D + V_D)
    k_nope, v = kv[..., :NOPE_D], kv[..., NOPE_D:]
    k_rope = ukr if rope is None else apply_rope(ukr, rope[0], rope[1])
    k = jnp.concatenate([k_nope, jnp.broadcast_to(k_rope[:, :, None], (bsz, length, MLA_H, ROPE_D))], axis=-1)
    return k, v


def attend(q, k, v):
    s = jnp.einsum('bqhd,bkhd->bhqk', q, k, preferred_element_type=F32) * MLA_SCALE
    p = jax.nn.softmax(s, axis=-1).astype(v.dtype)
    return jnp.einsum('bhqk,bkhd->bqhd', p, v)


def latent_attention(q, k_lat, v_lat, k_ctx, v_ctx):
    bsz, length = q.shape[:2]
    k = jnp.concatenate([k_ctx, k_lat], axis=1)
    v = jnp.concatenate([v_ctx, v_lat], axis=1)
    nb = length // Q_BLOCK
    qb = q.reshape(bsz, nb, Q_BLOCK, MLA_H, NOPE_D + ROPE_D).swapaxes(0, 1)
    o = lax.map(lambda qi: attend(qi, k, v), qb)
    return o.swapaxes(0, 1).reshape(bsz, length, MLA_H * V_D)


def mix_out(y_hy, y_lru, y_mla, head_g, w_out):
    y = jnp.concatenate([y_hy, y_lru, y_mla], axis=-1)
    bsz, length, _ = y.shape
    y = rmsnorm(y.reshape(bsz, length, N_MIX_HEADS, HEAD_W), head_g.reshape(N_MIX_HEADS, HEAD_W))
    return y.reshape(bsz, length, D_MIX) @ w_out


def conv_ffn(h, w_up, w_conv, w_down):
    up = dwconv(h @ w_up, w_conv, FFN_CONV // 2)
    gate, val = jnp.split(up, 2, axis=-1)
    return (jax.nn.gelu(gate, approximate=True) * val) @ w_down


def setup_inputs(seed: int = 0) -> dict:
    key = jax.random.key(seed)
    ks = iter(jax.random.split(key, 40))

    def nrm(shape, scale):
        return scale * jax.random.normal(next(ks), shape, F32)

    def gain(shape):
        return 1.0 + 0.05 * jax.random.normal(next(ks), shape, F32)

    a0 = jax.random.uniform(next(ks), (DEPTH, 2, LRU_C), F32, 0.9, 0.999) ** (1.0 / RG_C)
    lru_lam = jnp.log(a0) - jnp.log1p(-a0)
    return {
        'x': nrm((BATCH, SEQ, D_MODEL), 1.0),
        'c': nrm((BATCH, D_MODEL), 1.0),
        'ctx': nrm((BATCH, CTX_LEN, D_MODEL), 1.0),
        'c_ctx': nrm((D_MODEL,), 1.0),
        'ada_w': nrm((DEPTH, D_MODEL, N_MOD * D_MODEL), 0.5 * D_MODEL ** -0.5),
        'ada_b': nrm((DEPTH, N_MOD * D_MODEL), 0.02),
        'norm_g': gain((DEPTH, 4, D_MODEL)),
        'w_in': nrm((DEPTH, D_MODEL, D_IN), D_MODEL ** -0.5),
        'hy_conv': nrm((DEPTH, HY_SHORT, (HY_ORDER + 1) * HY_C), HY_SHORT ** -0.5),
        'hy_w1': nrm((DEPTH, HY_EMB, HY_FFN), HY_EMB ** -0.5),
        'hy_b1': nrm((DEPTH, HY_FFN), 0.1),
        'hy_w2': nrm((DEPTH, HY_FFN, HY_FFN), HY_FFN ** -0.5),
        'hy_b2': nrm((DEPTH, HY_FFN), 0.1),
        'hy_w3': nrm((DEPTH, HY_FFN, HY_ORDER * 2 * HY_C), HY_FFN ** -0.5),
        'hy_bias': nrm((DEPTH, HY_ORDER, HY_C), 0.5),
        'lru_conv': nrm((DEPTH, 2, LRU_CONV, LRU_C), LRU_CONV ** -0.5),
        'lru_wa': nrm((DEPTH, 2, LRU_BLOCKS, LRU_BW, LRU_BW), LRU_BW ** -0.5),
        'lru_ba': nrm((DEPTH, 2, LRU_C), 0.02),
        'lru_wx': nrm((DEPTH, 2, LRU_BLOCKS, LRU_BW, LRU_BW), LRU_BW ** -0.5),
        'lru_bx': nrm((DEPTH, 2, LRU_C), 0.02),
        'lru_lam': lru_lam,
        'mla_gq': gain((DEPTH, Q_RANK)),
        'mla_gkv': gain((DEPTH, KV_RANK)),
        'mla_wuq': nrm((DEPTH, Q_RANK, MLA_H * (NOPE_D + ROPE_D)), Q_RANK ** -0.5),
        'mla_wukv': nrm((DEPTH, KV_RANK, MLA_H * (NOPE_D + V_D)), KV_RANK ** -0.5),
        'head_g': gain((DEPTH, D_MIX)),
        'w_out': nrm((DEPTH, D_MIX, D_MODEL), D_MIX ** -0.5),
        'ffn_up': nrm((DEPTH, D_MODEL, 2 * D_FF), D_MODEL ** -0.5),
        'ffn_conv': nrm((DEPTH, FFN_CONV, 2 * D_FF), FFN_CONV ** -0.5),
        'ffn_down': nrm((DEPTH, D_FF, D_MODEL), D_FF ** -0.5),
    }


def reference(x, c, ctx, c_ctx, ada_w, ada_b, norm_g, w_in, hy_conv, hy_w1, hy_b1, hy_w2, hy_b2,
              hy_w3, hy_bias, lru_conv, lru_wa, lru_ba, lru_wx, lru_bx, lru_lam, mla_gq, mla_gkv,
              mla_wuq, mla_wukv, head_g, w_out, ffn_up, ffn_conv, ffn_down):
    bsz, seq, _ = x.shape
    ctx_len = ctx.shape[1]
    rope = axial_rope_tables(seq)
    xc = ctx
    for l in range(DEPTH):
        need_ctx = l < DEPTH - 1
        ng = norm_g[l]
        mod = jax.nn.silu(c) @ ada_w[l] + ada_b[l]
        sh1, sc1, g1, sh2, sc2, g2 = jnp.split(mod[:, None, :], N_MOD, axis=-1)
        mod_c = jax.nn.silu(c_ctx) @ ada_w[l] + ada_b[l]
        csh1, csc1, cg1, csh2, csc2, cg2 = jnp.split(mod_c, N_MOD, axis=-1)
        hy_p = (hy_conv[l], hy_w1[l], hy_b1[l], hy_w2[l], hy_b2[l], hy_w3[l], hy_bias[l])
        lru_f = (lru_conv[l, 0], lru_wa[l, 0], lru_ba[l, 0], lru_wx[l, 0], lru_bx[l, 0], lru_lam[l, 0])
        lru_b = (lru_conv[l, 1], lru_wa[l, 1], lru_ba[l, 1], lru_wx[l, 1], lru_bx[l, 1], lru_lam[l, 1])

        h = modulate(rmsnorm(x, ng[0]), sh1, sc1)
        hc = modulate(rmsnorm(xc, ng[0]), csh1, csc1)
        u = h @ w_in[l]
        uc_s = hc @ w_in[l, :, OFF_LRU_X:]

        xr_c = uc_s[..., :LRU_C]
        hc_f = rglru_scan(xr_c, *lru_f, None, False)
        hc_b = rglru_scan(xr_c, *lru_b, None, True)
        k_c, v_c = mla_keys_values(uc_s[..., OFF_MLA_KV - OFF_LRU_X:OFF_MLA_KR - OFF_LRU_X],
                                   uc_s[..., OFF_MLA_KR - OFF_LRU_X:], mla_gkv[l], mla_wukv[l], None)

        y_hy = hyena_mix(u[..., OFF_HY:OFF_LRU_G], *hy_p)
        xr = u[..., OFF_LRU_X:OFF_MLA_KV]
        h_f = rglru_scan(xr, *lru_f, hc_f[:, -1], False)
        h_b = rglru_scan(xr, *lru_b, hc_b[:, 0], True)
        y_lru = lru_output(u[..., OFF_LRU_G:OFF_MLA_Q], h_f + h_b)
        q = mla_query(u[..., OFF_MLA_Q:OFF_LRU_X], mla_gq[l], mla_wuq[l], rope)
        k, v = mla_keys_values(u[..., OFF_MLA_KV:OFF_MLA_KR], u[..., OFF_MLA_KR:], mla_gkv[l], mla_wukv[l], rope)
        y_mla = latent_attention(q, k, v, k_c, v_c)
        x = x + g1 * rmsnorm(mix_out(y_hy, y_lru, y_mla, head_g[l], w_out[l]), ng[1])

        if need_ctx:
            uc_o = hc @ w_in[l, :, :OFF_LRU_X]
            yc_hy = hyena_mix(uc_o[..., OFF_HY:OFF_LRU_G], *hy_p)
            yc_lru = lru_output(uc_o[..., OFF_LRU_G:OFF_MLA_Q], hc_f + hc_b)
            q_c = mla_query(uc_o[..., OFF_MLA_Q:], mla_gq[l], mla_wuq[l], None)
            yc_mla = attend(q_c, k_c, v_c).reshape(bsz, ctx_len, MLA_H * V_D)
            xc = xc + cg1 * rmsnorm(mix_out(yc_hy, yc_lru, yc_mla, head_g[l], w_out[l]), ng[1])

        h2 = modulate(rmsnorm(x, ng[2]), sh2, sc2)
        x = x + g2 * rmsnorm(conv_ffn(h2, ffn_up[l], ffn_conv[l], ffn_down[l]), ng[3])
        if need_ctx:
            hc2 = modulate(rmsnorm(xc, ng[2]), csh2, csc2)
            xc = xc + cg2 * rmsnorm(conv_ffn(hc2, ffn_up[l], ffn_conv[l], ffn_down[l]), ng[3])
    return x
```

```cpp
#include <hip/hip_runtime.h>
#include <cstdio>
#include <cstdint>

#ifndef MK_MULTI
#define MK_MULTI 1
#endif

constexpr int DM = 2048, NBATCH = 2, SEQ = 4096, CTXL = 256, DEPTH = 4;
constexpr int SEGB = CTXL + SEQ;
constexpr int MR = NBATCH * SEGB;
constexpr int DIN = 3392, DINP = 3584;
constexpr int HYC = 512, LRUC = 512, QRANK = 512, KVRANK = 256, NOPE = 128, ROPED = 64, VD = 128, NH = 8;
constexpr int DQ = NH * (NOPE + ROPED);
constexpr int DKV = NH * (NOPE + VD);
constexpr int DFF = 5632, DMIX = 2048;
constexpr int OFF_LRU_G = 1536, OFF_Q = 2048, OFF_LRU_X = 2560, OFF_KV = 3072, OFF_KR = 3328;
constexpr float EPS = 1e-6f;
constexpr int XR_ROWS = 4364;
constexpr int NCHUNK = MR / 64;
constexpr int HYL = 8192, HYLC = 512;

constexpr size_t MiB = 1u << 20;
constexpr size_t WS_CTL = 0, CTL_ZERO_BYTES = 1 * MiB;
constexpr size_t WS_MOD = 1 * MiB;
constexpr size_t WS_ROPE = 2 * MiB;
constexpr size_t WS_HID = 3 * MiB;
constexpr size_t WS_PART = 8 * MiB;
constexpr size_t WS_RSTD = 9 * MiB;
constexpr size_t WS_SP = 9 * MiB + 256 * 1024;
constexpr size_t WS_CARRY = 10 * MiB;
constexpr size_t WS_G = 16 * MiB;
constexpr size_t WS_GC = 80 * MiB;
constexpr size_t WS_WIN = 96 * MiB;
constexpr size_t WS_WUQ = 152 * MiB;
constexpr size_t WS_WUKV = 158 * MiB;
constexpr size_t WS_WOUT = 162 * MiB;
constexpr size_t WS_WUP = 194 * MiB;
constexpr size_t WS_WDN = 370 * MiB;
constexpr size_t WS_WLRU = 458 * MiB;
constexpr size_t WS_X = 480 * MiB;
constexpr size_t WS_H = 548 * MiB;
constexpr size_t WS_U = 582 * MiB;
constexpr size_t WS_Q = 642 * MiB;
constexpr size_t WS_KV = 668 * MiB;
constexpr size_t WS_KR = 702 * MiB;
constexpr size_t WS_O = 704 * MiB;
constexpr size_t WS_PT = 722 * MiB;
constexpr size_t WS_YT = 748 * MiB;
constexpr size_t WS_XR = 757 * MiB;
constexpr size_t WS_AB = 766 * MiB;
constexpr size_t WS_HF = 834 * MiB;
constexpr size_t WS_YL = 851 * MiB;
constexpr size_t WS_YMIX = 868 * MiB;
constexpr size_t WS_MO = 902 * MiB;
constexpr size_t WS_UP = 936 * MiB;
constexpr size_t WS_ACT = 1123 * MiB;
constexpr size_t WS_END = 1217 * MiB;

constexpr int CW_BAR = 4096;

constexpr int NWAVES = 8, NTHR = 512;
constexpr int RING_BYTES = 131072;
constexpr int LDSCTL_OFF = RING_BYTES, MISC_OFF = LDSCTL_OFF + 320;
constexpr int LDS_BYTES = 147456;

#define GAS __attribute__((address_space(1)))
#define LAS __attribute__((address_space(3)))
typedef unsigned short bf16;
typedef unsigned v4u __attribute__((ext_vector_type(4)));
typedef unsigned v2u __attribute__((ext_vector_type(2)));
typedef float f32x4 __attribute__((ext_vector_type(4)));
typedef float f32x2 __attribute__((ext_vector_type(2)));
typedef float f32x16 __attribute__((ext_vector_type(16)));
typedef short bf16x8 __attribute__((ext_vector_type(8)));
typedef short s16x4 __attribute__((ext_vector_type(4)));
typedef GAS unsigned gu32;
#define RLX_AGENT __ATOMIC_RELAXED, __HIP_MEMORY_SCOPE_AGENT
#define LDS_WAIT() asm volatile("s_waitcnt lgkmcnt(0)" ::: "memory")
#define VM_WAIT() asm volatile("s_waitcnt vmcnt(0)" ::: "memory")

__device__ __forceinline__ unsigned cvt_pk_bf16(float lo, float hi) { unsigned r; asm volatile("v_cvt_pk_bf16_f32 %0, %1, %2" : "=v"(r) : "v"(lo), "v"(hi)); return r; }
__device__ __forceinline__ float bf_lo(unsigned w) { return __uint_as_float(w << 16); }
__device__ __forceinline__ float bf_hi(unsigned w) { return __uint_as_float(w & 0xffff0000u); }
__device__ __forceinline__ float bf2f(bf16 v) { return __uint_as_float(((unsigned)v) << 16); }
__device__ __forceinline__ bf16 f2bf(float f) { return (bf16)(cvt_pk_bf16(f, 0.f) & 0xffffu); }
__device__ __forceinline__ float wave_sum(float v) {
#pragma unroll
    for (int o = 1; o < 64; o <<= 1) v += __shfl_xor(v, o);
    return v;
}
__device__ __forceinline__ float sigmoidf_(float x) { return 1.0f / (1.0f + __expf(-x)); }
__device__ __forceinline__ float gelu_tanh(float x) { const float u = 0.7978845608028654f * (x + 0.044715f * x * x * x); return x / (1.0f + __expf(-2.0f * u)); }

#define XB_TMO      128
#define XB_XCNT(j)  (256  + 64 * (j))
#define XB_XSUB(j)  (1280 + 64 * (j))
#define XB_XGEN(j)  (2304 + 64 * (j))
#define XB_TOP      3328
#define XB_TOPGEN   3392
#define XCD_BAR_WORDS 3456
#define XB_SPIN_CAP (1u << 18)
__device__ __forceinline__ unsigned xb_ld(unsigned* p)              { return __hip_atomic_load(p, __ATOMIC_RELAXED, __HIP_MEMORY_SCOPE_AGENT); }
__device__ __forceinline__ unsigned xb_add(unsigned* p, unsigned v) { return __hip_atomic_fetch_add(p, v, __ATOMIC_RELAXED, __HIP_MEMORY_SCOPE_AGENT); }
__device__ __forceinline__ unsigned xb_xcc_id() { return (unsigned)__builtin_amdgcn_s_getreg((3 << 11) | 20) & 0xFu; }
#define XB_SPIN(cond, bar) do { unsigned _sp = 0; while (cond) { __builtin_amdgcn_s_sleep(1); \
    if ((++_sp & 255u) == 0u) { if (xb_ld(&(bar)[XB_TMO])) break; if (_sp > XB_SPIN_CAP) { atomicAdd(&(bar)[XB_TMO], 1u); break; } } } } while (0)
struct XcdBarrier { unsigned* bar; unsigned x; volatile LAS unsigned* st; };
__device__ __forceinline__ XcdBarrier xcd_barrier_post(unsigned* bar, volatile LAS unsigned* st) {
    XcdBarrier b; b.bar = bar; b.x = xb_xcc_id(); b.st = st;
    if (threadIdx.x == 0) (void)xb_add(&bar[XB_XCNT(b.x)], 1u);
    return b;
}
__device__ __forceinline__ void xcd_barrier_complete(unsigned* bar, unsigned x, unsigned& nloc, unsigned& nx) {
    const unsigned G = gridDim.x * gridDim.y * gridDim.z;
    unsigned sum, cnt, mine, sp = 0u;
    for (;;) {
        sum = 0u; cnt = 0u; mine = 0u;
#pragma unroll
        for (unsigned j = 0; j < 16; ++j) { const unsigned c = xb_ld(&bar[XB_XCNT(j)]); sum += c; cnt += (c > 0u) ? 1u : 0u; mine = (j == x) ? c : mine; }
        if (sum == G) break;
        __builtin_amdgcn_s_sleep(1);
        if ((++sp & 255u) == 0u) { if (xb_ld(&bar[XB_TMO])) break; if (sp > XB_SPIN_CAP) { atomicAdd(&bar[XB_TMO], 1u); break; } }
    }
    nloc = mine > 0u ? mine : 1u; nx = cnt > 0u ? cnt : 1u;
}
__device__ __forceinline__ void xcd_barrier(const XcdBarrier& b) {
    asm volatile("s_waitcnt vmcnt(0)" ::: "memory");
    __syncthreads();
    if (threadIdx.x == 0) {
        unsigned* bar = b.bar;
        __builtin_amdgcn_s_waitcnt(0);
        unsigned nloc = b.st[0], nx = b.st[1];
        if (nloc == 0u) { xcd_barrier_complete(bar, b.x, nloc, nx); b.st[0] = nloc; b.st[1] = nx; }
        const unsigned old = xb_add(&bar[XB_XSUB(b.x)], 1u);
        const unsigned gen = old / nloc;
        if (old + 1u == (gen + 1u) * nloc) {
            __builtin_amdgcn_fence(__ATOMIC_RELEASE, "agent");
            asm volatile("s_waitcnt vmcnt(0)" ::: "memory");
            const unsigned og = xb_add(&bar[XB_TOP], 1u);
            const unsigned tg = og / nx;
            if (og + 1u == (tg + 1u) * nx) xb_add(&bar[XB_TOPGEN], 1u);
            else XB_SPIN(xb_ld(&bar[XB_TOPGEN]) == tg, bar);
            __builtin_amdgcn_fence(__ATOMIC_ACQUIRE, "agent");
            xb_add(&bar[XB_XGEN(b.x)], 1u);
            asm volatile("s_waitcnt vmcnt(0)" ::: "memory");
        } else {
            XB_SPIN(xb_ld(&bar[XB_XGEN(b.x)]) == gen, bar);
            __builtin_amdgcn_fence(__ATOMIC_ACQUIRE, "agent");
            asm volatile("s_waitcnt vmcnt(0)" ::: "memory");
        }
    }
    __syncthreads();
}

struct Args { const float* in[30]; float* out; unsigned char* ws; int ph_lo, ph_hi; };
struct Frame {
    LAS unsigned char* lds;
    unsigned char* ws;
    const float* const* in;
    float* out;
    int tid, lane, wave, vcu, G;
};
#define WSP(T, off) ((T*)(F.ws + (off)))
__device__ __forceinline__ void row_info(int r, int& b, int& isctx, int& t) { b = r >= SEGB ? 1 : 0; const int j = r - b * SEGB; isctx = j < CTXL ? 1 : 0; t = isctx ? j : j - CTXL; }

namespace pg8 {
constexpr int BM = 256, BK = 64, HALF = 128, HTB = HALF * BK * 2, STAGE_BYTES = 8 * HTB, NXCD = 8, WGM = 8;
__host__ __device__ __forceinline__ int lds_byte(int r, int c) { const int st = (r >> 4) * 2 + (c >> 5), rr = r & 15, cc = c & 31, ob = rr * 64 + cc * 2; return st * 1024 + (ob ^ (((ob >> 9) & 1) << 5)); }
__host__ __device__ __forceinline__ void stage_rc(int b, int& R, int& C) { const int st = b / 1024, sb = b % 1024, swz = sb ^ (((sb >> 9) & 1) << 5); R = (st >> 1) * 16 + swz / 64; C = (st & 1) * 32 + (swz % 64) / 2; }
__host__ __device__ __forceinline__ int perm32(int rho) { const int n = rho >> 4, i = rho & 15; return 8 * (i >> 2) + 4 * n + (i & 3); }
struct Unit { int pm, pn; };
struct StaticOrder {
    int nM, nN, nwg, G, c;
    __host__ __device__ void init(int nM_, int nN_, int G_, int c_) { nM = nM_; nN = nN_; nwg = nM * nN; G = G_; c = c_; }
    __host__ __device__ bool next(int i, Unit& u) const {
        const long L = (long)i * G + c; if (L >= nwg) return false;
        int wgid = (int)L; { const int q = nwg / NXCD, r = nwg % NXCD, xcd = wgid % NXCD, off = wgid / NXCD; wgid = (xcd < r ? xcd * (q + 1) : r * (q + 1) + (xcd - r) * q) + off; }
        const int nig = WGM * nN, gid = wgid / nig, fm = gid * WGM, gsz = (nM - fm) < WGM ? (nM - fm) : WGM;
        u.pm = fm + ((wgid % nig) % gsz); u.pn = (wgid % nig) / gsz; return true;
    }
};
struct PlainAB {
    const bf16* A; const bf16* Bt; int lda, ldb;
    __device__ __forceinline__ const char* a_base(const Unit& u) const { return (const char*)(A + (size_t)u.pm * BM * lda); }
    __device__ __forceinline__ const char* b_base(const Unit& u) const { return (const char*)(Bt + (size_t)u.pn * BM * ldb); }
};
struct EpiBf16 {
    static constexpr bool PERM = true;
    bf16* O; int ldc; const float* rowscale;
    __device__ __forceinline__ void operator()(const f32x4 (&acc)[2][2][4][2], const Unit& u, int wr, int wc, int fr, int fq) const {
        const int row0 = u.pm * BM + wr * 64 + fr; const int col0 = u.pn * BM + wc * 32 + 8 * fq;
#pragma unroll
        for (int ai = 0; ai < 2; ++ai)
#pragma unroll
            for (int m = 0; m < 4; ++m) { const int row = row0 + ai * HALF + m * 16; bf16* rowp = O + (size_t)row * ldc + col0; const float sc = rowscale ? rowscale[row] : 1.0f;
#pragma unroll
                for (int bj = 0; bj < 2; ++bj) { const f32x4 v0 = acc[ai][bj][m][0] * sc, v1 = acc[ai][bj][m][1] * sc;
                    v4u w; w.x = cvt_pk_bf16(v0[0], v0[1]); w.y = cvt_pk_bf16(v0[2], v0[3]); w.z = cvt_pk_bf16(v1[0], v1[1]); w.w = cvt_pk_bf16(v1[2], v1[3]);
                    *(v4u*)(rowp + bj * HALF) = w; } }
    }
};

template <class Epi, class AB, bool ALIGN_EPI = true>
__device__ __forceinline__ void gemm_phase(LAS unsigned char* lds, const AB ab, const int K, const StaticOrder& S, const Epi& E) {
    int tid = threadIdx.x; asm volatile("" : "+v"(tid));
    const int wid = __builtin_amdgcn_readfirstlane(tid >> 6), lane = tid & 63, wr = wid >> 2, wc = wid & 3, fr = lane & 15, fq = lane >> 4;
    const int nt = K / BK;
    unsigned voffA[2], voffB[2];
#pragma unroll
    for (int i = 0; i < 2; ++i) { int R, C; stage_rc(tid * 16 + i * 8192, R, C); const int Rb = Epi::PERM ? ((R & ~31) + perm32(R & 31)) : R;
        voffA[i] = (unsigned)(R * ab.lda + C) * 2u; voffB[i] = (unsigned)(Rb * ab.ldb + C) * 2u; }
    const size_t kstep = (size_t)(BK * 2);
    const size_t hstepA = (size_t)HALF * ab.lda * 2, hstepB = (size_t)HALF * ab.ldb * 2;
    const unsigned ldsw = (unsigned)wid * 1024u;
    const int aoff = lds_byte(wr * 64 + fr, fq * 8), boff = lds_byte(wc * 32 + fr, fq * 8);
#define PG8_SA(b, h) (((b) * 2 + (h)) * HTB)
#define PG8_SB(b, h) ((4 + (b) * 2 + (h)) * HTB)
#define PG8_STAGE(bufoff, gbase, voff) do { _Pragma("unroll") for (int _i = 0; _i < 2; ++_i) \
        __builtin_amdgcn_global_load_lds((const unsigned*)((const char*)(gbase) + (voff)[_i]), (LAS unsigned*)(lds + (bufoff) + ldsw + _i * 8192), 16, 0, 0); } while (0)
#define PG8_LDA(dst, b, h) do { _Pragma("unroll") for (int m = 0; m < 4; ++m) _Pragma("unroll") for (int k = 0; k < 2; ++k) dst[m][k] = *(const LAS bf16x8*)(lds + PG8_SA(b, h) + aoff + m * 2048 + k * 1024); } while (0)
#define PG8_LDB(dst, b, h) do { _Pragma("unroll") for (int n = 0; n < 2; ++n) _Pragma("unroll") for (int k = 0; k < 2; ++k) dst[n][k] = *(const LAS bf16x8*)(lds + PG8_SB(b, h) + boff + n * 2048 + k * 1024); } while (0)
#define PG8_MMA(ai, bj, At, Bt) do { __builtin_amdgcn_s_setprio(1); _Pragma("unroll") for (int m = 0; m < 4; ++m) _Pragma("unroll") for (int n = 0; n < 2; ++n) _Pragma("unroll") for (int k = 0; k < 2; ++k) \
        acc[ai][bj][m][n] = __builtin_amdgcn_mfma_f32_16x16x32_bf16(Bt[n][k], At[m][k], acc[ai][bj][m][n], 0, 0, 0); __builtin_amdgcn_s_setprio(0); } while (0)
#define PG8_WAIT_V(n) asm volatile("s_waitcnt vmcnt(" #n ")" ::: "memory")
#define PG8_WAIT_L(n) asm volatile("s_waitcnt lgkmcnt(" #n ")" ::: "memory")
#define PG8_BAR __builtin_amdgcn_s_barrier()
#define PG8_SCHED __builtin_amdgcn_sched_barrier(0)
    Unit cur, nxt; int ui = 0;
    if (!S.next(0, cur)) return;
    f32x4 acc[2][2][4][2];
#pragma unroll
    for (int a = 0; a < 2; ++a)
#pragma unroll
        for (int b = 0; b < 2; ++b)
#pragma unroll
            for (int m = 0; m < 4; ++m)
#pragma unroll
                for (int n = 0; n < 2; ++n) acc[a][b][m][n] = (f32x4){0.f, 0.f, 0.f, 0.f};
    bf16x8 At[4][2], B0[2][2], B1[2][2];
    const char* cA = ab.a_base(cur); const char* cB = ab.b_base(cur);
    PG8_STAGE(PG8_SB(0, 0), cB, voffB); PG8_STAGE(PG8_SB(0, 1), cB + hstepB, voffB); PG8_STAGE(PG8_SA(0, 0), cA, voffA); PG8_STAGE(PG8_SA(0, 1), cA + hstepA, voffA);
    if (wr == 1) PG8_BAR;
    PG8_WAIT_V(2); PG8_BAR;
    PG8_STAGE(PG8_SB(1, 0), cB + kstep, voffB); PG8_STAGE(PG8_SA(1, 0), cA + kstep, voffA); PG8_STAGE(PG8_SB(1, 1), cB + hstepB + kstep, voffB);
    PG8_WAIT_V(6); PG8_BAR;
    for (;;) {
        const bool has_next = S.next(ui + 1, nxt);
        const char* nA = has_next ? ab.a_base(nxt) : cA; const char* nB = has_next ? ab.b_base(nxt) : cB;
        for (int t = 0; t < nt; t += 2) {
            const bool last = (t == nt - 2);
            const char* a1 = cA + (size_t)(t + 1) * kstep;
            const char* a2 = last ? nA : cA + (size_t)(t + 2) * kstep; const char* b2 = last ? nB : cB + (size_t)(t + 2) * kstep;
            const char* a3 = a2 + kstep; const char* b3 = b2 + kstep;
            PG8_LDB(B0, 0, 0); PG8_LDB(B1, 0, 1); PG8_SCHED; PG8_LDA(At, 0, 0); PG8_STAGE(PG8_SA(1, 1), a1 + hstepA, voffA);
            PG8_WAIT_V(8); PG8_WAIT_L(0); PG8_BAR; PG8_MMA(0, 0, At, B0); PG8_MMA(0, 1, At, B1); PG8_BAR; PG8_SCHED;
            PG8_LDA(At, 0, 1); PG8_STAGE(PG8_SB(0, 0), b2, voffB); PG8_STAGE(PG8_SB(0, 1), b2 + hstepB, voffB); PG8_STAGE(PG8_SA(0, 0), a2, voffA);
            PG8_WAIT_V(8); PG8_WAIT_L(0); PG8_BAR; PG8_MMA(1, 0, At, B0); PG8_MMA(1, 1, At, B1); PG8_BAR; PG8_SCHED;
            PG8_LDB(B0, 1, 0); PG8_LDB(B1, 1, 1); PG8_SCHED; PG8_LDA(At, 1, 0); PG8_STAGE(PG8_SA(0, 1), a2 + hstepA, voffA);
            PG8_WAIT_V(8); PG8_WAIT_L(0); PG8_BAR; PG8_MMA(0, 0, At, B0); PG8_MMA(0, 1, At, B1); PG8_BAR; PG8_SCHED;
            PG8_LDA(At, 1, 1); PG8_STAGE(PG8_SB(1, 0), b3, voffB); PG8_STAGE(PG8_SB(1, 1), b3 + hstepB, voffB); PG8_STAGE(PG8_SA(1, 0), a3, voffA);
            PG8_WAIT_V(8); PG8_WAIT_L(0); PG8_BAR; PG8_MMA(1, 0, At, B0); PG8_MMA(1, 1, At, B1); PG8_BAR; PG8_SCHED;
        }
        if constexpr (ALIGN_EPI) { if (wr == 0) PG8_BAR; }
        E(acc, cur, wr, wc, fr, fq);
        if (!has_next) break;
#pragma unroll
        for (int a = 0; a < 2; ++a)
#pragma unroll
            for (int b = 0; b < 2; ++b)
#pragma unroll
                for (int m = 0; m < 4; ++m)
#pragma unroll
                    for (int n = 0; n < 2; ++n) acc[a][b][m][n] = (f32x4){0.f, 0.f, 0.f, 0.f};
        cur = nxt; cA = nA; cB = nB; ++ui;
        if constexpr (ALIGN_EPI) { if (wr == 1) PG8_BAR; }
    }
    PG8_WAIT_V(0);
    if constexpr (!ALIGN_EPI) { if (wr == 0) PG8_BAR; }
    PG8_BAR;
#undef PG8_SA
#undef PG8_SB
#undef PG8_STAGE
#undef PG8_LDA
#undef PG8_LDB
#undef PG8_MMA
#undef PG8_WAIT_V
#undef PG8_WAIT_L
#undef PG8_BAR
#undef PG8_SCHED
}
}

__device__ __forceinline__ void pro_mod(Frame& F) {
    LAS float* sil = (LAS float*)F.lds;
    LAS float* red = (LAS float*)(F.lds + 24576);
    const float* c = F.in[1]; const float* cc = F.in[3];
    for (int i = F.tid; i < 3 * DM; i += NTHR) { const int w = i / DM, k = i - w * DM; const float v = (w < 2) ? c[w * DM + k] : cc[k]; sil[i] = v / (1.0f + expf(-v)); }
    __syncthreads();
    float* MOD = WSP(float, WS_MOD);
    const int k0 = F.wave * 256;
    for (int unit = F.vcu; unit < DEPTH * 192; unit += F.G) {
        const int l = unit / 192, cg = unit - l * 192;
        const float* W = F.in[4] + (size_t)l * DM * (6 * DM) + cg * 64 + F.lane;
        float a0 = 0.f, a1 = 0.f, a2 = 0.f;
#pragma unroll 16
        for (int k = k0; k < k0 + 256; ++k) { const float w = W[(size_t)k * (6 * DM)]; a0 += sil[k] * w; a1 += sil[DM + k] * w; a2 += sil[2 * DM + k] * w; }
        red[(F.wave * 3 + 0) * 64 + F.lane] = a0; red[(F.wave * 3 + 1) * 64 + F.lane] = a1; red[(F.wave * 3 + 2) * 64 + F.lane] = a2;
        __syncthreads();
        if (F.tid < 192) { const int j = F.tid >> 6, ln = F.tid & 63; float s = 0.f;
#pragma unroll
            for (int w = 0; w < 8; ++w) s += red[(w * 3 + j) * 64 + ln];
            MOD[((size_t)l * 3 + j) * (6 * DM) + cg * 64 + ln] = s + F.in[5][(size_t)l * (6 * DM) + cg * 64 + ln]; }
        __syncthreads();
    }
}

__device__ __forceinline__ void tr_tile(const float* __restrict__ W, int K, int N, bf16* __restrict__ WT, const float* kscale, LAS float* scr, int item, int lane) {
    const int nblk = N >> 5, kb = item / nblk, nb = item - kb * nblk, k0 = kb * 64, n0 = nb * 32;
#pragma unroll
    for (int i = 0; i < 8; ++i) { const int kk = 8 * i + (lane >> 3), c4 = (lane & 7) * 4;
        f32x4 v = *(const f32x4*)(W + (size_t)(k0 + kk) * N + n0 + c4); if (kscale) v = v * kscale[k0 + kk];
        scr[kk * 33 + c4 + 0] = v[0]; scr[kk * 33 + c4 + 1] = v[1]; scr[kk * 33 + c4 + 2] = v[2]; scr[kk * 33 + c4 + 3] = v[3]; }
    LDS_WAIT(); asm volatile("" ::: "memory");
    const int c = lane & 7;
#pragma unroll
    for (int j = 0; j < 4; ++j) { const int n = (lane >> 3) + 8 * j; const LAS float* s = scr + (8 * c) * 33 + n;
        v4u o; o.x = cvt_pk_bf16(s[0], s[33]); o.y = cvt_pk_bf16(s[66], s[99]); o.z = cvt_pk_bf16(s[132], s[165]); o.w = cvt_pk_bf16(s[198], s[231]);
        *(v4u*)(WT + (size_t)(n0 + n) * K + k0 + 8 * c) = o; }
    LDS_WAIT(); asm volatile("" ::: "memory");
}
__device__ __forceinline__ void pro_transposes(Frame& F) {
    LAS float* scr = (LAS float*)(F.lds + F.wave * 16384);
    const int gw = F.vcu * NWAVES + F.wave, NGW = F.G * NWAVES;
    constexpr int I0 = 32 * 106, I1 = 8 * 48, I2 = 4 * 64, I3 = 32 * 64, I4 = 32 * 352, I5 = 88 * 64, IL = I0 + I1 + I2 + I3 + I4 + I5;
    for (int it = gw; it < DEPTH * IL; it += NGW) {
        const int l = it / IL; int r = it - l * IL;
        if (r < I0) { tr_tile(F.in[7] + (size_t)l * DM * DIN, DM, DIN, WSP(bf16, WS_WIN) + (size_t)l * DINP * DM, nullptr, scr, r, F.lane); continue; } r -= I0;
        if (r < I1) { tr_tile(F.in[23] + (size_t)l * QRANK * DQ, QRANK, DQ, WSP(bf16, WS_WUQ) + (size_t)l * DQ * QRANK, F.in[21] + l * QRANK, scr, r, F.lane); continue; } r -= I1;
        if (r < I2) { tr_tile(F.in[24] + (size_t)l * KVRANK * DKV, KVRANK, DKV, WSP(bf16, WS_WUKV) + (size_t)l * DKV * KVRANK, F.in[22] + l * KVRANK, scr, r, F.lane); continue; } r -= I2;
        if (r < I3) { tr_tile(F.in[26] + (size_t)l * DMIX * DM, DMIX, DM, WSP(bf16, WS_WOUT) + (size_t)l * DM * DMIX, nullptr, scr, r, F.lane); continue; } r -= I3;
        if (r < I4) { tr_tile(F.in[27] + (size_t)l * DM * 2 * DFF, DM, 2 * DFF, WSP(bf16, WS_WUP) + (size_t)l * 2 * DFF * DM, nullptr, scr, r, F.lane); continue; } r -= I4;
        tr_tile(F.in[29] + (size_t)l * DFF * DM, DFF, DM, WSP(bf16, WS_WDN) + (size_t)l * DM * DFF, nullptr, scr, r, F.lane);
    }
    { const v4u z = {0u, 0u, 0u, 0u}; constexpr int per = (DINP - DIN) * DM / 8;
      for (int i = F.vcu * NTHR + F.tid; i < DEPTH * per; i += F.G * NTHR) { const int l = i / per, j = i - l * per; *(v4u*)(WSP(bf16, WS_WIN) + ((size_t)l * DINP + DIN) * DM + (size_t)j * 8) = z; } }
}
__device__ __forceinline__ void pro_lru_w(Frame& F) {
    bf16* WL = WSP(bf16, WS_WLRU);
    constexpr int total = DEPTH * 2 * 4 * 256 * 64;
    for (int i = F.vcu * NTHR + F.tid; i < total; i += F.G * NTHR) {
        const int ch = i & 63, row = (i >> 6) & 255, blk = (i >> 14) & 3, dir = (i >> 16) & 1, l = i >> 17;
        const int g = row >> 7, e = row & 127, j4 = ch >> 4, d0 = (ch & 15) * 8;
        const float* Wsrc = (g ? F.in[18] : F.in[16]) + ((((size_t)l * 2 + dir) * 4 + blk) * 128) * 128;
        const float* cw = F.in[15] + (((size_t)l * 2 + dir) * 4 + j4) * LRUC + blk * 128 + d0;
        float v[8];
#pragma unroll
        for (int j = 0; j < 8; ++j) v[j] = cw[j] * Wsrc[(size_t)(d0 + j) * 128 + e];
        v4u o; o.x = cvt_pk_bf16(v[0], v[1]); o.y = cvt_pk_bf16(v[2], v[3]); o.z = cvt_pk_bf16(v[4], v[5]); o.w = cvt_pk_bf16(v[6], v[7]);
        *(v4u*)(WL + (size_t)i * 8) = o;
    }
}
__device__ __forceinline__ void pro_rope(Frame& F) {
    { float* SP = WSP(float, WS_SP); for (int i = F.vcu * NTHR + F.tid; i < DEPTH * 2 * LRUC; i += F.G * NTHR) SP[i] = log1pf(expf(-F.in[20][i])); }
    float* R = WSP(float, WS_ROPE);
    for (int i = F.vcu * NTHR + F.tid; i < SEQ * 32; i += F.G * NTHR) { const int t = i >> 5, f = i & 31; const float pos = (f < 16) ? (float)(t >> 6) : (float)(t & 63);
        const float inv = powf(10000.0f, -(float)(f & 15) / 16.0f); const float a = pos * inv; R[t * 64 + f] = cosf(a); R[t * 64 + 32 + f] = sinf(a); }
}
__device__ __forceinline__ void pro_hid(Frame& F) {
    LAS float* h1 = (LAS float*)(F.lds + F.wave * 16384);
    float* HID = WSP(float, WS_HID);
    const int gw = F.vcu * NWAVES + F.wave, NGW = F.G * NWAVES;
    for (int wi = gw; wi < DEPTH * 68; wi += NGW) {
        const int l = __builtin_amdgcn_readfirstlane(wi / 68), tt = (wi - l * 68) * 64 + F.lane;
        const int L = tt < 4096 ? 4096 : 256, t = tt < 4096 ? tt : tt - 4096;
        const float tn = (float)t / (float)L;
        float sb[16], cb[16];
#pragma unroll
        for (int b = 0; b < 16; ++b) { const float ang = (6.2831855f * tn) * (float)(b + 1); sb[b] = sinf(ang); cb[b] = cosf(ang); }
        const float* w1p = F.in[9] + (size_t)l * 33 * 64; const float* b1p = F.in[10] + l * 64;
        const float* w2p = F.in[11] + (size_t)l * 64 * 64; const float* b2p = F.in[12] + l * 64;
        for (int d = 0; d < 64; ++d) { float a = b1p[d] + tn * w1p[d];
#pragma unroll
            for (int b = 0; b < 16; ++b) a += sb[b] * w1p[(1 + b) * 64 + d] + cb[b] * w1p[(17 + b) * 64 + d];
            h1[d * 64 + F.lane] = sinf(a); }
        LDS_WAIT();
        float* dst = HID + ((size_t)l * 4352 + tt) * 64;
        for (int e = 0; e < 64; ++e) { float a = b2p[e];
#pragma unroll 16
            for (int d = 0; d < 64; ++d) a += h1[d * 64 + F.lane] * w2p[d * 64 + e];
            dst[e] = sinf(a); }
        LDS_WAIT();
    }
}
template <bool WRITE> __device__ __forceinline__ void pro_filter(Frame& F) {
    const float* HID = WSP(float, WS_HID); float* PART = WSP(float, WS_PART);
    LAS float* red = (LAS float*)F.lds;
    constexpr float dmin = 3.0701134573253945f, dstep = (15.350567286626973f - 3.0701134573253945f) / 511.0f;
    for (int item = F.vcu; item < DEPTH * 9 * 4 * 8; item += F.G) {
        int r = item; const int cg = r & 7; r >>= 3; const int od = r & 3; r >>= 2; const int tc = r % 9; const int l = r / 9;
        const int kind = tc == 8 ? 1 : 0, L = kind ? 256 : 4096, t = (kind ? 0 : tc * 512) + F.tid; const bool valid = t < L;
        const int o = od >> 1, dir = od & 1;
        const float* hp = HID + ((size_t)l * 4352 + (kind ? 4096 : 0) + (valid ? t : 0)) * 64;
        const float tn = (float)t / (float)L;
        const float* w3 = F.in[13] + (size_t)l * 64 * 2048 + o * 1024 + dir * 512 + cg * 64;
        float acc[64];
#pragma unroll
        for (int j = 0; j < 64; ++j) acc[j] = 0.f;
        for (int e4 = 0; e4 < 64; e4 += 4) {
            const f32x4 h4 = *(const f32x4*)(hp + e4);
#pragma unroll
            for (int ee = 0; ee < 4; ++ee) { const float* wr = w3 + (size_t)(e4 + ee) * 2048; const float h = h4[ee];
#pragma unroll
                for (int j = 0; j < 64; ++j) acc[j] += h * wr[j]; }
        }
        if constexpr (!WRITE) {
#pragma unroll
            for (int j = 0; j < 64; ++j) { const int c = cg * 64 + j; const float delta = dmin + (float)c * dstep; const float v = acc[j] * expf(-tn * delta);
                float a = (valid && (dir == 0 || t >= 1)) ? fabsf(v) : 0.f; a = wave_sum(a); if (F.lane == 0) red[F.wave * 64 + j] = a; }
            __syncthreads();
            if (F.tid < 64) { float s = 0.f;
#pragma unroll
                for (int w = 0; w < 8; ++w) s += red[w * 64 + F.tid];
                PART[((((size_t)l * 2 + kind) * 2 + o) * 2 + dir) * 8 * 512 + (size_t)(kind ? 0 : tc) * 512 + cg * 64 + F.tid] = s; }
            __syncthreads();
        } else {
            const float* pbase = PART + ((((size_t)l * 2 + kind) * 2 + o) * 2) * 8 * 512;
            bf16* gout = kind ? WSP(bf16, WS_GC) + (size_t)l * 512 * 2 * HYLC : WSP(bf16, WS_G) + (size_t)l * 512 * 2 * HYL;
            const int glen = kind ? HYLC : HYL, nch = kind ? 1 : 8;
            const bool zero0 = (dir == 1 && t == 0); const int idx = zero0 ? 0 : (dir == 0 ? L - t : L + t);
#pragma unroll
            for (int j = 0; j < 64; ++j) { const int c = cg * 64 + j; const float delta = dmin + (float)c * dstep; const float v = acc[j] * expf(-tn * delta);
                float nrm = 0.f;
                for (int q = 0; q < 2; ++q) for (int k = 0; k < nch; ++k) nrm += pbase[((size_t)q * 8 + k) * 512 + c];
                if (valid) gout[((size_t)c * 2 + o) * glen + idx] = zero0 ? (bf16)0 : f2bf(v / nrm); }
        }
    }
}

__device__ __forceinline__ void norm_pass(Frame& F, int mode, int l) {
    const float* MOD = WSP(float, WS_MOD); float* X = WSP(float, WS_X); bf16* H = WSP(bf16, WS_H); const bf16* Y = WSP(bf16, WS_MO);
    const float* ng = F.in[6];
    const int gw = F.vcu * NWAVES + F.wave, NGW = F.G * NWAVES;
    const bool last = (mode == 2 && l == DEPTH - 1);
    for (int r = gw; r < MR; r += NGW) {
        int b, isctx, t; row_info(r, b, isctx, t); const int which = isctx ? 2 : b;
        f32x4 xv[8];
        if (mode == 0) { const float* src = isctx ? F.in[2] + ((size_t)b * CTXL + t) * DM : F.in[0] + ((size_t)b * SEQ + t) * DM;
#pragma unroll
            for (int j = 0; j < 8; ++j) xv[j] = *(const f32x4*)(src + 4 * F.lane + 256 * j);
        } else {
            const float* src = X + (size_t)r * DM; const bf16* yp = Y + (size_t)r * DM;
            f32x4 yv[8]; float ss = 0.f;
#pragma unroll
            for (int j = 0; j < 8; ++j) { xv[j] = *(const f32x4*)(src + 4 * F.lane + 256 * j); const v2u w = *(const v2u*)(yp + 4 * F.lane + 256 * j);
                yv[j] = (f32x4){bf_lo(w.x), bf_hi(w.x), bf_lo(w.y), bf_hi(w.y)}; ss += (yv[j][0] * yv[j][0] + yv[j][1] * yv[j][1]) + (yv[j][2] * yv[j][2] + yv[j][3] * yv[j][3]); }
            ss = wave_sum(ss); const float rs = 1.0f / sqrtf(ss * (1.0f / DM) + EPS);
            const float* gpost = ng + ((size_t)l * 4 + (mode == 1 ? 1 : 3)) * DM; const float* gate = MOD + ((size_t)l * 3 + which) * (6 * DM) + (mode == 1 ? 2 : 5) * DM;
#pragma unroll
            for (int j = 0; j < 8; ++j) { const f32x4 gp = *(const f32x4*)(gpost + 4 * F.lane + 256 * j), gt = *(const f32x4*)(gate + 4 * F.lane + 256 * j); xv[j] += gt * (yv[j] * rs * gp); }
        }
        if (!last) {
            float* dst = X + (size_t)r * DM;
#pragma unroll
            for (int j = 0; j < 8; ++j) *(f32x4*)(dst + 4 * F.lane + 256 * j) = xv[j];
        } else { if (!isctx) { float* dst = F.out + ((size_t)b * SEQ + t) * DM;
#pragma unroll
            for (int j = 0; j < 8; ++j) *(f32x4*)(dst + 4 * F.lane + 256 * j) = xv[j]; }
            continue; }
        const int ln = (mode == 2) ? l + 1 : l; const float* gpre = ng + ((size_t)ln * 4 + (mode == 1 ? 2 : 0)) * DM;
        const float* md = MOD + ((size_t)ln * 3 + which) * (6 * DM); const float* sh = md + (mode == 1 ? 3 : 0) * DM; const float* sc = md + (mode == 1 ? 4 : 1) * DM;
        float s2 = 0.f;
#pragma unroll
        for (int j = 0; j < 8; ++j) s2 += (xv[j][0] * xv[j][0] + xv[j][1] * xv[j][1]) + (xv[j][2] * xv[j][2] + xv[j][3] * xv[j][3]);
        s2 = wave_sum(s2); const float rs2 = 1.0f / sqrtf(s2 * (1.0f / DM) + EPS);
        bf16* hp = H + (size_t)r * DM;
#pragma unroll
        for (int j = 0; j < 8; ++j) { const int cidx = 4 * F.lane + 256 * j; const f32x4 gp = *(const f32x4*)(gpre + cidx), s4 = *(const f32x4*)(sc + cidx), h4 = *(const f32x4*)(sh + cidx);
            const f32x4 hv = (xv[j] * rs2 * gp) * (s4 + 1.0f) + h4; v2u w; w.x = cvt_pk_bf16(hv[0], hv[1]); w.y = cvt_pk_bf16(hv[2], hv[3]); *(v2u*)(hp + cidx) = w; }
    }
}

__device__ __forceinline__ bool seg_start(int r) { const int j = r % SEGB; return j == 0 || j == CTXL; }
__device__ __forceinline__ void post_u(Frame& F, int l) {
    const bf16* U = WSP(bf16, WS_U); bf16* PT = WSP(bf16, WS_PT);
    const int gw = F.vcu * NWAVES + F.wave, NGW = F.G * NWAVES;
    LAS bf16* tile = (LAS bf16*)(F.lds + F.wave * 16384);
    const float* hw = F.in[8] + (size_t)l * 3 * 1536;
    for (int wi = gw; wi < (MR / 64) * 24; wi += NGW) {
        const int rt = wi / 24, cgp = wi - rt * 24, r0 = rt * 64, c0 = cgp * 64;
        const bool has_prev = !seg_start(r0), has_next = !seg_start(r0 + 64) && (r0 + 64 < MR);
#pragma unroll
        for (int i = 0; i < 9; ++i) { const int tr = 8 * i + (F.lane >> 3), ch = F.lane & 7;
            if (tr < 66) { const int r = r0 - 1 + tr; const bool ok = (tr == 0) ? has_prev : (tr == 65 ? has_next : true);
                v4u v = {0u, 0u, 0u, 0u}; if (ok) v = *(const v4u*)(U + (size_t)r * DINP + c0 + ch * 8);
                *(LAS v4u*)(tile + tr * 64 + ch * 8) = v; } }
        LDS_WAIT();
        const int c = c0 + F.lane; const float w0 = hw[c], w1 = hw[1536 + c], w2 = hw[2 * 1536 + c];
#pragma unroll
        for (int tb = 0; tb < 8; ++tb) { float v[8];
#pragma unroll
            for (int j = 0; j < 8; ++j) { const int tr = 8 * tb + j; v[j] = w0 * bf2f(tile[tr * 64 + F.lane]) + w1 * bf2f(tile[(tr + 1) * 64 + F.lane]) + w2 * bf2f(tile[(tr + 2) * 64 + F.lane]); }
            v4u o; o.x = cvt_pk_bf16(v[0], v[1]); o.y = cvt_pk_bf16(v[2], v[3]); o.z = cvt_pk_bf16(v[4], v[5]); o.w = cvt_pk_bf16(v[6], v[7]);
            *(v4u*)(PT + (size_t)c * MR + r0 + 8 * tb) = o; }
        LDS_WAIT();
    }
    bf16* XR = WSP(bf16, WS_XR); bf16* KR = WSP(bf16, WS_KR); const float* ROPE = WSP(float, WS_ROPE); float* RSTD = WSP(float, WS_RSTD);
    for (int r = gw; r < MR; r += NGW) {
        int b, isctx, t; row_info(r, b, isctx, t);
        const bf16* ur = U + (size_t)r * DINP;
        { const int blk = F.lane >> 4, k = (F.lane & 15) * 8, prow = isctx ? 3 + t : 265 + t;
          *(v4u*)(XR + (((size_t)b * 4 + blk) * XR_ROWS + prow) * 128 + k) = *(const v4u*)(ur + OFF_LRU_X + 8 * F.lane); }
        if (F.lane < 32) { const float x1 = bf2f(ur[OFF_KR + F.lane]), x2 = bf2f(ur[OFF_KR + 32 + F.lane]); float o1 = x1, o2 = x2;
            if (!isctx) { const float cs = ROPE[t * 64 + F.lane], sn = ROPE[t * 64 + 32 + F.lane]; o1 = x1 * cs - x2 * sn; o2 = x2 * cs + x1 * sn; }
            KR[(size_t)r * 64 + F.lane] = f2bf(o1); KR[(size_t)r * 64 + 32 + F.lane] = f2bf(o2); }
        { const v4u w = *(const v4u*)(ur + OFF_Q + 8 * F.lane); float ss = 0.f;
#pragma unroll
          for (int j = 0; j < 4; ++j) { const float a = bf_lo(w[j]), c2 = bf_hi(w[j]); ss += a * a + c2 * c2; }
          ss = wave_sum(ss); if (F.lane == 0) RSTD[r] = 1.0f / sqrtf(ss * (1.0f / QRANK) + EPS); }
        { float ss = 0.f; if (F.lane < 32) { const v4u w = *(const v4u*)(ur + OFF_KV + 8 * F.lane);
#pragma unroll
            for (int j = 0; j < 4; ++j) { const float a = bf_lo(w[j]), c2 = bf_hi(w[j]); ss += a * a + c2 * c2; } }
          ss = wave_sum(ss); if (F.lane == 0) RSTD[MR + r] = 1.0f / sqrtf(ss * (1.0f / KVRANK) + EPS); }
    }
    for (int i = F.vcu * NTHR + F.tid; i < 2 * 4 * 12 * 16; i += F.G * NTHR) { const int ch = i & 15, pi = (i >> 4) % 12, bb = (i >> 4) / 12;
        const int prow = pi < 3 ? pi : (pi < 9 ? 256 + pi : 4352 + pi);
        unsigned zz = 0u; asm volatile("" : "+v"(zz));
        const v4u z = {zz, zz, zz, zz}; *(v4u*)(XR + ((size_t)bb * XR_ROWS + prow) * 128 + ch * 8) = z; }
}

__device__ __forceinline__ void conv_gelu(Frame& F, int l) {
    const bf16* UP = WSP(bf16, WS_UP); bf16* ACT = WSP(bf16, WS_ACT);
    const float* cw = F.in[28] + (size_t)l * 3 * 2 * DFF;
    const int gw = F.vcu * NWAVES + F.wave, NGW = F.G * NWAVES;
    for (int wi = gw; wi < (MR / 8) * 11; wi += NGW) {
        const int rc = wi / 11, fc = wi - rc * 11, r0 = rc * 8, f0 = fc * 512 + 8 * F.lane;
        const bool has_prev = !seg_start(r0), has_next = !seg_start(r0 + 8) && (r0 + 8 < MR);
        v4u g[10], v[10];
#pragma unroll
        for (int i = 0; i < 10; ++i) { const int r = r0 - 1 + i; const bool ok = (i == 0) ? has_prev : (i == 9 ? has_next : true);
            g[i] = (v4u){0u, 0u, 0u, 0u}; v[i] = (v4u){0u, 0u, 0u, 0u};
            if (ok) { g[i] = *(const v4u*)(UP + (size_t)r * (2 * DFF) + f0); v[i] = *(const v4u*)(UP + (size_t)r * (2 * DFF) + DFF + f0); } }
        float wg[3][8], wv[3][8];
#pragma unroll
        for (int j = 0; j < 3; ++j) { const f32x4 a = *(const f32x4*)(cw + (size_t)j * 2 * DFF + f0), b2 = *(const f32x4*)(cw + (size_t)j * 2 * DFF + f0 + 4);
            const f32x4 c2 = *(const f32x4*)(cw + (size_t)j * 2 * DFF + DFF + f0), d2 = *(const f32x4*)(cw + (size_t)j * 2 * DFF + DFF + f0 + 4);
#pragma unroll
            for (int q = 0; q < 4; ++q) { wg[j][q] = a[q]; wg[j][4 + q] = b2[q]; wv[j][q] = c2[q]; wv[j][4 + q] = d2[q]; } }
#pragma unroll
        for (int i = 0; i < 8; ++i) { float o[8];
#pragma unroll
            for (int q = 0; q < 4; ++q) {
                const float ga = wg[0][2 * q] * bf_lo(g[i][q]) + wg[1][2 * q] * bf_lo(g[i + 1][q]) + wg[2][2 * q] * bf_lo(g[i + 2][q]);
                const float gb = wg[0][2 * q + 1] * bf_hi(g[i][q]) + wg[1][2 * q + 1] * bf_hi(g[i + 1][q]) + wg[2][2 * q + 1] * bf_hi(g[i + 2][q]);
                const float va = wv[0][2 * q] * bf_lo(v[i][q]) + wv[1][2 * q] * bf_lo(v[i + 1][q]) + wv[2][2 * q] * bf_lo(v[i + 2][q]);
                const float vb = wv[0][2 * q + 1] * bf_hi(v[i][q]) + wv[1][2 * q + 1] * bf_hi(v[i + 1][q]) + wv[2][2 * q + 1] * bf_hi(v[i + 2][q]);
                o[2 * q] = gelu_tanh(ga) * va; o[2 * q + 1] = gelu_tanh(gb) * vb; }
            v4u w; w.x = cvt_pk_bf16(o[0], o[1]); w.y = cvt_pk_bf16(o[2], o[3]); w.z = cvt_pk_bf16(o[4], o[5]); w.w = cvt_pk_bf16(o[6], o[7]);
            *(v4u*)(ACT + (size_t)(r0 + i) * DFF + f0) = w; }
    }
}

__device__ __forceinline__ void mix_finalize(Frame& F, int l) {
    const bf16* YT = WSP(bf16, WS_YT); const float* YL = WSP(float, WS_YL); const bf16* O = WSP(bf16, WS_O); bf16* YM = WSP(bf16, WS_YMIX);
    const float* hg = F.in[25] + (size_t)l * DMIX;
    const int gw = F.vcu * NWAVES + F.wave, NGW = F.G * NWAVES;
    LAS bf16* st = (LAS bf16*)(F.lds + F.wave * 16384);
    for (int wi = gw; wi < (MR / 64) * 8; wi += NGW) {
        const int rt = wi >> 3, hp = wi & 7, r0 = rt * 64;
        if (hp < 4) {
            const bf16* src = YT + (size_t)(hp * 128) * MR + r0 + F.lane; float ss = 0.f;
#pragma unroll 16
            for (int c = 0; c < 128; ++c) { const float v = bf2f(src[(size_t)c * MR]); ss += v * v; }
            const float rs = 1.0f / sqrtf(ss * (1.0f / 128.0f) + EPS);
            for (int half = 0; half < 2; ++half) {
#pragma unroll 16
                for (int c = 0; c < 64; ++c) { const int cc = half * 64 + c; const float v = bf2f(src[(size_t)cc * MR]) * rs * hg[hp * 128 + cc]; st[F.lane * 66 + c] = f2bf(v); }
                LDS_WAIT();
#pragma unroll 8
                for (int rr = 0; rr < 32; ++rr) { const int row = 2 * rr + (F.lane >> 5); const unsigned w = *(const LAS unsigned*)(st + row * 66 + 2 * (F.lane & 31));
                    *(unsigned*)(YM + (size_t)(r0 + row) * DMIX + hp * 128 + half * 64 + 2 * (F.lane & 31)) = w; }
                LDS_WAIT();
            }
        } else {
            const int q = F.lane & 3;
            for (int ps = 0; ps < 4; ++ps) { const int row = r0 + ps * 16 + (F.lane >> 2);
                const float* src = YL + (size_t)row * LRUC + (hp - 4) * 128 + q * 32; f32x4 v[8]; float ss = 0.f;
#pragma unroll
                for (int j = 0; j < 8; ++j) { v[j] = *(const f32x4*)(src + 4 * j); ss += (v[j][0] * v[j][0] + v[j][1] * v[j][1]) + (v[j][2] * v[j][2] + v[j][3] * v[j][3]); }
                ss += __shfl_xor(ss, 1); ss += __shfl_xor(ss, 2); const float rs = 1.0f / sqrtf(ss * (1.0f / 128.0f) + EPS);
                const float* g = hg + hp * 128 + q * 32; bf16* dst = YM + (size_t)row * DMIX + hp * 128 + q * 32;
#pragma unroll
                for (int j = 0; j < 4; ++j) { const f32x4 g0 = *(const f32x4*)(g + 8 * j), g1 = *(const f32x4*)(g + 8 * j + 4); const f32x4 a = v[2 * j] * rs * g0, b2 = v[2 * j + 1] * rs * g1;
                    v4u w; w.x = cvt_pk_bf16(a[0], a[1]); w.y = cvt_pk_bf16(a[2], a[3]); w.z = cvt_pk_bf16(b2[0], b2[1]); w.w = cvt_pk_bf16(b2[2], b2[3]); *(v4u*)(dst + 8 * j) = w; } }
        }
        {
            const int q = F.lane & 3;
            for (int ps = 0; ps < 4; ++ps) { const int row = r0 + ps * 16 + (F.lane >> 2);
                const bf16* src = O + (size_t)row * (NH * VD) + hp * 128 + q * 32; v4u v[4]; float ss = 0.f;
#pragma unroll
                for (int j = 0; j < 4; ++j) { v[j] = *(const v4u*)(src + 8 * j);
#pragma unroll
                    for (int k = 0; k < 4; ++k) { const float a = bf_lo(v[j][k]), b2 = bf_hi(v[j][k]); ss += a * a + b2 * b2; } }
                ss += __shfl_xor(ss, 1); ss += __shfl_xor(ss, 2); const float rs = 1.0f / sqrtf(ss * (1.0f / 128.0f) + EPS);
                const float* g = hg + (8 + hp) * 128 + q * 32; bf16* dst = YM + (size_t)row * DMIX + (8 + hp) * 128 + q * 32;
#pragma unroll
                for (int j = 0; j < 4; ++j) { const f32x4 g0 = *(const f32x4*)(g + 8 * j), g1 = *(const f32x4*)(g + 8 * j + 4);
                    v4u w; w.x = cvt_pk_bf16(bf_lo(v[j][0]) * rs * g0[0], bf_hi(v[j][0]) * rs * g0[1]); w.y = cvt_pk_bf16(bf_lo(v[j][1]) * rs * g0[2], bf_hi(v[j][1]) * rs * g0[3]);
                    w.z = cvt_pk_bf16(bf_lo(v[j][2]) * rs * g1[0], bf_hi(v[j][2]) * rs * g1[1]); w.w = cvt_pk_bf16(bf_lo(v[j][3]) * rs * g1[2], bf_hi(v[j][3]) * rs * g1[3]); *(v4u*)(dst + 8 * j) = w; } }
        }
    }
}

namespace att {
constexpr int NW = 8, QBLK = 32, KVBLK = 64;
constexpr float SCALE = 0.07216878364870323f;
constexpr float THR = 8.f;
constexpr int LDQ = DQ, LDK = DKV, LDR = ROPED, LDO = NH * VD;
constexpr int SHM_V = KVBLK * 128 * 2, SHM_K = KVBLK * 128 * 2, SHM_R = KVBLK * 64 * 2;
constexpr int OFF_V = 0, OFF_K = 2 * SHM_V, OFF_R = OFF_K + 2 * SHM_K, OFF_WS = OFF_R + 2 * SHM_R, OFF_QR = OFF_WS + NW * 64 * 4, SHM_ATTN = OFF_QR + NW * 4096;
#define KSWZ(row, colB) ((row) * 256 + ((colB) ^ (((row) & 7) << 4)))
#define RSWZ(row, colB) ((row) * 128 + ((colB) ^ (((row) & 7) << 4)))
#define SBAR() __builtin_amdgcn_sched_barrier(0)
__device__ __forceinline__ int crow(int r, int hi) { return (r & 3) + 8 * (r >> 2) + 4 * hi; }
__device__ __forceinline__ void partialSM(f32x16& p0, f32x16& p1, float& m_reg, float& mn, float& alpha) {
  constexpr float C = SCALE * 1.4426950408889634f;
  float pmax = p0[0]; for (int r = 1; r < 16; ++r) pmax = fmaxf(pmax, p0[r]); for (int r = 0; r < 16; ++r) pmax = fmaxf(pmax, p1[r]);
  { auto rr = __builtin_amdgcn_permlane32_swap(__float_as_uint(pmax), __float_as_uint(pmax), false, false);
    pmax = fmaxf(__uint_as_float(rr[0]), __uint_as_float(rr[1])); }
  if (__builtin_expect(__all(pmax - m_reg <= THR / SCALE), 1)) { mn = m_reg; alpha = 1.f; }
  else { mn = fmaxf(m_reg, pmax); alpha = __builtin_amdgcn_exp2f((m_reg - mn) * C); m_reg = mn; }
  float mnC = -mn * C;
  for (int r = 0; r < 16; ++r) p0[r] = fmaf(p0[r], C, mnC); for (int r = 0; r < 16; ++r) p1[r] = fmaf(p1[r], C, mnC);
  for (int r = 0; r < 16; ++r) p0[r] = __builtin_amdgcn_exp2f(p0[r]);
}
__device__ __forceinline__ void finishSM(f32x16& p0, f32x16& p1, float alpha, float& l_reg, bf16x8& pa0, bf16x8& pa1, bf16x8& pa2, bf16x8& pa3) {
  for (int r = 0; r < 16; ++r) p1[r] = __builtin_amdgcn_exp2f(p1[r]);
  float ps = 0; for (int r = 0; r < 16; ++r) ps += p0[r]; for (int r = 0; r < 16; ++r) ps += p1[r];
  { auto rr = __builtin_amdgcn_permlane32_swap(__float_as_uint(ps), __float_as_uint(ps), false, false);
    ps = __uint_as_float(rr[0]) + __uint_as_float(rr[1]); }
  l_reg = l_reg * alpha + ps;
#define PK4(P, BASE, OUT) do { unsigned a0 = cvt_pk_bf16(P[BASE + 0], P[BASE + 1]), a1 = cvt_pk_bf16(P[BASE + 2], P[BASE + 3]);   \
    unsigned b0 = cvt_pk_bf16(P[BASE + 4], P[BASE + 5]), b1 = cvt_pk_bf16(P[BASE + 6], P[BASE + 7]);                              \
    auto r0 = __builtin_amdgcn_permlane32_swap(a0, b0, false, false); auto r1 = __builtin_amdgcn_permlane32_swap(a1, b1, false, false); \
    v4u w = {r0[0], r1[0], r0[1], r1[1]}; OUT = *reinterpret_cast<bf16x8*>(&w); } while (0)
  PK4(p0, 0, pa0); PK4(p0, 8, pa1); PK4(p1, 0, pa2); PK4(p1, 8, pa3);
#undef PK4
}
__device__ __forceinline__ void qkt(f32x16& p0, f32x16& p1, const LAS char* Ks, const LAS char* Rs, const bf16x8* qr, const LAS char* qrl, int r32, int hi) {
  p0 = f32x16{}; p1 = f32x16{};
#pragma unroll
  for (int d0 = 0; d0 < 8; ++d0) { const int cb = (d0 * 16 + hi * 8) * 2;
    bf16x8 b0 = *(const LAS bf16x8*)(Ks + KSWZ(r32, cb));
    bf16x8 b1 = *(const LAS bf16x8*)(Ks + KSWZ(32 + r32, cb));
    p0 = __builtin_amdgcn_mfma_f32_32x32x16_bf16(b0, qr[d0], p0, 0, 0, 0);
    p1 = __builtin_amdgcn_mfma_f32_32x32x16_bf16(b1, qr[d0], p1, 0, 0, 0); }
#pragma unroll
  for (int d0 = 0; d0 < 4; ++d0) { const int cb = (d0 * 16 + hi * 8) * 2;
    bf16x8 b0 = *(const LAS bf16x8*)(Rs + RSWZ(r32, cb));
    bf16x8 b1 = *(const LAS bf16x8*)(Rs + RSWZ(32 + r32, cb));
    const bf16x8 qf = *(const LAS bf16x8*)(qrl + d0 * 1024);
    p0 = __builtin_amdgcn_mfma_f32_32x32x16_bf16(b0, qf, p0, 0, 0, 0);
    p1 = __builtin_amdgcn_mfma_f32_32x32x16_bf16(b1, qf, p1, 0, 0, 0); }
}
__device__ __forceinline__ int v_st(int k, int c) { const int kk = (k & ~0xC) | ((k & 4) << 1) | ((k & 8) >> 1); return ((kk >> 3) * 4 + (c >> 5)) * 512 + ((kk & 7) * 32 + (c & 31)) * 2; }
__device__ __forceinline__ int v_rd_base(int lane) { return ((lane & 3) << 3) | (((lane >> 2) & 3) << 6) | (((lane >> 4) & 1) << 5) | (((lane >> 5) & 1) << 8); }
constexpr int v_rd_off(int d0, int ks, int half) { return d0 * 512 + ks * 4096 + half * 2048; }
template <int OFF> __device__ __forceinline__ s16x4 tr_read(int vb) {
  s16x4 r; asm volatile("ds_read_b64_tr_b16 %0, %1 offset:%2" : "=&v"(r) : "v"(vb), "i"(OFF) : "memory"); return r;
}
template <int D0> __device__ __forceinline__ void pv_one(f32x16& od, int vb, bf16x8 pa0, bf16x8 pa1, bf16x8 pa2, bf16x8 pa3) {
  const s16x4 l0 = tr_read<v_rd_off(D0, 0, 0)>(vb), h0 = tr_read<v_rd_off(D0, 0, 1)>(vb), l1 = tr_read<v_rd_off(D0, 1, 0)>(vb), h1 = tr_read<v_rd_off(D0, 1, 1)>(vb);
  const s16x4 l2 = tr_read<v_rd_off(D0, 2, 0)>(vb), h2 = tr_read<v_rd_off(D0, 2, 1)>(vb), l3 = tr_read<v_rd_off(D0, 3, 0)>(vb), h3 = tr_read<v_rd_off(D0, 3, 1)>(vb);
  asm volatile("s_waitcnt lgkmcnt(0)" ::: "memory"); SBAR();
#define PK(L, H) (bf16x8){L[0], L[1], L[2], L[3], H[0], H[1], H[2], H[3]}
  od = __builtin_amdgcn_mfma_f32_32x32x16_bf16(pa0, PK(l0, h0), od, 0, 0, 0);
  od = __builtin_amdgcn_mfma_f32_32x32x16_bf16(pa1, PK(l1, h1), od, 0, 0, 0);
  od = __builtin_amdgcn_mfma_f32_32x32x16_bf16(pa2, PK(l2, h2), od, 0, 0, 0);
  od = __builtin_amdgcn_mfma_f32_32x32x16_bf16(pa3, PK(l3, h3), od, 0, 0, 0);
#undef PK
}
__device__ __forceinline__ void pv_d0(f32x16* o, int vb, bf16x8 pa0, bf16x8 pa1, bf16x8 pa2, bf16x8 pa3) {
  pv_one<0>(o[0], vb, pa0, pa1, pa2, pa3); pv_one<1>(o[1], vb, pa0, pa1, pa2, pa3); pv_one<2>(o[2], vb, pa0, pa1, pa2, pa3); pv_one<3>(o[3], vb, pa0, pa1, pa2, pa3);
}
__device__ __forceinline__ void attn_body(const bf16* __restrict__ Qb, const bf16* __restrict__ Kh, const bf16* __restrict__ Vh, const bf16* __restrict__ Rh,
                                          bf16* __restrict__ Ob, int seq, const float* rope_tab, LAS char* lds) {
  int tid = threadIdx.x; asm volatile("" : "+v"(tid));
  const int wid = __builtin_amdgcn_readfirstlane(tid >> 6), lane = tid & 63, r32 = lane & 31, hi = lane >> 5;
  LAS char* V_lds = lds + OFF_V; LAS char* K_lds = lds + OFF_K; LAS char* R_lds = lds + OFF_R;
  LAS float* ws = (LAS float*)(lds + OFF_WS) + wid * 64; LAS float* li_l = ws; LAS float* al_l = ws + 32;
  float m_reg = -1e30f, l_reg = 0; f32x16 o[4] = {}; bf16x8 qr[12];
  LAS char* qrl = lds + OFF_QR + wid * 4096 + lane * 16;
  const bf16* Qw = Qb + (long)(wid * QBLK + r32) * LDQ + hi * 8;
#pragma unroll
  for (int d0 = 0; d0 < 12; ++d0) qr[d0] = *reinterpret_cast<const bf16x8*>(Qw + d0 * 16);
  if (rope_tab) {
    const float* rt = rope_tab + (long)(wid * QBLK + r32) * 64;
#pragma unroll
    for (int p = 0; p < 2; ++p) {
      const float* cs = rt + p * 16 + hi * 8; const f32x4 c0 = *(const f32x4*)cs, c1 = *(const f32x4*)(cs + 4), s0 = *(const f32x4*)(cs + 32), s1 = *(const f32x4*)(cs + 36);
      const v4u x1 = *reinterpret_cast<v4u*>(&qr[8 + p]), x2 = *reinterpret_cast<v4u*>(&qr[10 + p]); v4u y1, y2;
#pragma unroll
      for (int k = 0; k < 4; ++k) { const float ca = k < 2 ? c0[2 * k] : c1[2 * k - 4], cbv = k < 2 ? c0[2 * k + 1] : c1[2 * k - 3], sa = k < 2 ? s0[2 * k] : s1[2 * k - 4], sb = k < 2 ? s0[2 * k + 1] : s1[2 * k - 3];
        const float a1 = bf_lo(x1[k]), b1 = bf_hi(x1[k]), a2 = bf_lo(x2[k]), b2 = bf_hi(x2[k]);
        y1[k] = cvt_pk_bf16(a1 * ca - a2 * sa, b1 * cbv - b2 * sb); y2[k] = cvt_pk_bf16(a2 * ca + a1 * sa, b2 * cbv + b1 * sb); }
      qr[8 + p] = *reinterpret_cast<bf16x8*>(&y1); qr[10 + p] = *reinterpret_cast<bf16x8*>(&y2); }
  }
#pragma unroll
  for (int d0 = 0; d0 < 4; ++d0) *(LAS bf16x8*)(qrl + d0 * 1024) = qr[8 + d0];
  const int sr = tid >> 4, sc = (tid & 15) * 8, vst0 = v_st(sr, sc), vst1 = v_st(32 + sr, sc);
  const int rr_ = tid >> 3, rc_ = (tid & 7) * 8;
  const int vb0 = (int)(uintptr_t)V_lds + v_rd_base(lane);
  constexpr int SDEPTH = 1;
  struct { bf16x8 vs0, vs1, ks0, ks1, rs; } sr_[SDEPTH];
  const unsigned offk0 = (unsigned)(sr * LDK + sc), offk1 = (unsigned)((32 + sr) * LDK + sc), offr = (unsigned)(rr_ * LDR + rc_);
#define SLOAD(i, k0) do { const bf16* vt_ = Vh + (size_t)(k0) * LDK; const bf16* kt_ = Kh + (size_t)(k0) * LDK; const bf16* rt_ = Rh + (size_t)(k0) * LDR; \
    sr_[i].vs0 = *(const bf16x8*)(vt_ + offk0); sr_[i].vs1 = *(const bf16x8*)(vt_ + offk1); \
    sr_[i].ks0 = *(const bf16x8*)(kt_ + offk0); sr_[i].ks1 = *(const bf16x8*)(kt_ + offk1); \
    sr_[i].rs = *(const bf16x8*)(rt_ + offr); } while (0)
#define SWRITE(b, i) do { *(LAS bf16x8*)(V_lds + (b) * SHM_V + vst0) = sr_[i].vs0;          \
    *(LAS bf16x8*)(V_lds + (b) * SHM_V + vst1) = sr_[i].vs1; int kc = sc * 2;               \
    *(LAS bf16x8*)(K_lds + (b) * SHM_K + KSWZ(sr, kc)) = sr_[i].ks0;                       \
    *(LAS bf16x8*)(K_lds + (b) * SHM_K + KSWZ(32 + sr, kc)) = sr_[i].ks1;                  \
    *(LAS bf16x8*)(R_lds + (b) * SHM_R + RSWZ(rr_, rc_ * 2)) = sr_[i].rs; } while (0)
#define SWAIT() do { if constexpr (SDEPTH == 2) asm volatile("s_waitcnt vmcnt(5)" ::: "memory"); else asm volatile("s_waitcnt vmcnt(0)" ::: "memory"); } while (0)
#define RESC(a) do { if (__any((a) < 1.f)) { if (hi == 0) al_l[r32] = (a); asm volatile("s_waitcnt lgkmcnt(0)" ::: "memory"); \
    for (int d = 0; d < 4; ++d) for (int r = 0; r < 16; ++r) o[d][r] *= al_l[crow(r, hi)]; } } while (0)
  f32x16 pA0, pA1, pB0, pB1; float mnA, mnB, alA, alB; bf16x8 pa0, pa1, pa2, pa3; const int NT = seq / KVBLK;
  constexpr int SE = 0, SO = SDEPTH - 1;
  SLOAD(SE, 0); asm volatile("s_waitcnt vmcnt(0)" ::: "memory"); SWRITE(0, SE); __syncthreads();
  qkt(pA0, pA1, K_lds, R_lds, qr, qrl, r32, hi); partialSM(pA0, pA1, m_reg, mnA, alA);
  SLOAD(SO, KVBLK); if constexpr (SDEPTH == 2) { if (2 < NT) SLOAD(SE, 2 * KVBLK); }
  SWAIT(); SWRITE(1, SO); __syncthreads();
  for (int j = 1; j + 1 < NT; j += 2) {
    SBAR(); qkt(pB0, pB1, K_lds + SHM_K, R_lds + SHM_R, qr, qrl, r32, hi);
    finishSM(pA0, pA1, alA, l_reg, pa0, pa1, pa2, pa3); SBAR();
    SLOAD(SO, (j + SDEPTH) * KVBLK); SBAR();
    pv_d0(o, vb0, pa0, pa1, pa2, pa3); partialSM(pB0, pB1, m_reg, mnB, alB);
    __syncthreads(); SWAIT(); SWRITE(0, SE);
    RESC(alB); __syncthreads();
    SBAR(); qkt(pA0, pA1, K_lds, R_lds, qr, qrl, r32, hi);
    finishSM(pB0, pB1, alB, l_reg, pa0, pa1, pa2, pa3); SBAR();
    if (SDEPTH == 1 || j + 3 < NT) SLOAD(SE, (j + 1 + SDEPTH) * KVBLK); SBAR();
    pv_d0(o, vb0 + SHM_V, pa0, pa1, pa2, pa3); partialSM(pA0, pA1, m_reg, mnA, alA);
    __syncthreads(); SWAIT(); SWRITE(1, SO);
    RESC(alA); __syncthreads();
  }
  SBAR(); qkt(pB0, pB1, K_lds + SHM_K, R_lds + SHM_R, qr, qrl, r32, hi);
  finishSM(pA0, pA1, alA, l_reg, pa0, pa1, pa2, pa3); SBAR();
  pv_d0(o, vb0, pa0, pa1, pa2, pa3); partialSM(pB0, pB1, m_reg, mnB, alB);
  __syncthreads(); RESC(alB);
  finishSM(pB0, pB1, alB, l_reg, pa0, pa1, pa2, pa3); SBAR();
  pv_d0(o, vb0 + SHM_V, pa0, pa1, pa2, pa3);
  if (hi == 0) li_l[r32] = l_reg; asm volatile("s_waitcnt lgkmcnt(0)" ::: "memory");
  float rli[16];
#pragma unroll
  for (int r = 0; r < 16; ++r) rli[r] = __builtin_amdgcn_rcpf(li_l[crow(r, hi)]);
  bf16* Ow = Ob + (long)(wid * QBLK) * LDO;
#pragma unroll
  for (int r = 0; r < 16; ++r) { const int orow = crow(r, hi);
#pragma unroll
    for (int d0 = 0; d0 < 4; ++d0) Ow[(long)orow * LDO + d0 * 32 + r32] = f2bf(o[d0][r] * rli[r]); }
  __syncthreads();
#undef SLOAD
#undef SWRITE
#undef SWAIT
#undef RESC
}
}

__device__ __forceinline__ void attn_phase(Frame& F, bool need_ctx) {
    const bf16* Q = WSP(bf16, WS_Q); const bf16* KV = WSP(bf16, WS_KV); const bf16* KR = WSP(bf16, WS_KR); bf16* O = WSP(bf16, WS_O); const float* ROPE = WSP(float, WS_ROPE);
    const int nunits = 256 + (need_ctx ? 16 : 0);
    for (int u = F.vcu; u < nunits; u += F.G) {
        if (u < 256) { const int b = u >> 7, h = (u >> 4) & 7, qb = u & 15; const size_t kb = (size_t)b * SEGB, row0 = kb + CTXL + qb * 256;
            att::attn_body(Q + row0 * DQ + h * 192, KV + kb * DKV + h * 256, KV + kb * DKV + h * 256 + 128, KR + kb * ROPED, O + row0 * (NH * VD) + h * 128, SEGB, ROPE + (size_t)qb * 256 * 64, (LAS char*)F.lds);
        } else { const int b = (u - 256) >> 3, h = (u - 256) & 7; const size_t kb = (size_t)b * SEGB;
            att::attn_body(Q + kb * DQ + h * 192, KV + kb * DKV + h * 256, KV + kb * DKV + h * 256 + 128, KR + kb * ROPED, O + kb * (NH * VD) + h * 128, CTXL, nullptr, (LAS char*)F.lds);
        }
    }
}

struct LruAB {
    const bf16* XR; const bf16* Bt; int lda, ldb;
    __device__ __forceinline__ static int prow0(int pm) { const int jt = pm % 17; return jt == 0 ? 3 : 265 + (jt - 1) * 256; }
    __device__ __forceinline__ const char* a_base(const pg8::Unit& u) const { const int b = u.pm / 17, dir = u.pn >> 2, blk = u.pn & 3;
        return (const char*)(XR + (((size_t)b * 4 + blk) * XR_ROWS + prow0(u.pm) - (dir ? 0 : 3)) * 128); }
    __device__ __forceinline__ const char* b_base(const pg8::Unit& u) const { return (const char*)(Bt + (size_t)u.pn * 256 * 512); }
};
struct EpiGate {
    static constexpr bool PERM = false;
    const bf16* XR; f32x2* AB; const float* ba; const float* bx; const float* sp; const float* cw;
    __device__ __forceinline__ void operator()(const f32x4 (&acc)[2][2][4][2], const pg8::Unit& u, int wr, int wc, int fr, int fq) const {
        asm volatile("" : "+v"(fr), "+v"(fq));
        const int dir = u.pn >> 2, blk = u.pn & 3, b = u.pm / 17, p0 = LruAB::prow0(u.pm);
        const bf16* xb = XR + ((size_t)b * 4 + blk) * XR_ROWS * 128;
        f32x2* abb = AB + (size_t)dir * MR * LRUC;
#pragma unroll 1
        for (int n = 0; n < 2; ++n) { const int cl = wc * 32 + 16 * n + 4 * fq, ch = blk * 128 + cl;
            const f32x4 ba4 = *(const f32x4*)(ba + dir * LRUC + ch), bx4 = *(const f32x4*)(bx + dir * LRUC + ch), sp4 = *(const f32x4*)(sp + dir * LRUC + ch) * -8.0f;
            f32x4 cw4[4];
#pragma unroll
            for (int j = 0; j < 4; ++j) cw4[j] = *(const f32x4*)(cw + ((size_t)dir * 4 + j) * LRUC + ch);
#pragma unroll
            for (int ai = 0; ai < 2; ++ai)
#pragma unroll
                for (int m = 0; m < 4; ++m) { const int rl = ai * 128 + wr * 64 + m * 16 + fr, row = u.pm * 256 + rl, pr = p0 + rl + (dir ? 0 : -3);
                    f32x4 xc = {0.f, 0.f, 0.f, 0.f};
#pragma unroll
                    for (int j = 0; j < 4; ++j) { const v2u w = *(const v2u*)(xb + (unsigned)((pr + j) * 128 + cl)); xc[0] += cw4[j][0] * bf_lo(w.x); xc[1] += cw4[j][1] * bf_hi(w.x); xc[2] += cw4[j][2] * bf_lo(w.y); xc[3] += cw4[j][3] * bf_hi(w.y); }
                    const f32x4 rp = (n == 0 ? acc[ai][0][m][0] : acc[ai][0][m][1]) + ba4, ip = (n == 0 ? acc[ai][1][m][0] : acc[ai][1][m][1]) + bx4;
                    f32x4 o0, o1;
#pragma unroll
                    for (int j = 0; j < 4; ++j) { const float rg = sigmoidf_(rp[j]), ig = sigmoidf_(ip[j]); const float la = rg * sp4[j]; const float a = __expf(la);
                        const float x = 2.0f * la;
                        const float ser = -x * (1.0f + x * (0.5f + x * (0.16666667f + x * (0.041666668f + x * (0.008333334f + x * 0.0013888889f)))));
                        const float om = (x > -0.25f) ? ser : (1.0f - __expf(x));
                        const float bb = sqrtf(om) * (ig * xc[j]); if (j < 2) { o0[2 * j] = a; o0[2 * j + 1] = bb; } else { o1[2 * j - 4] = a; o1[2 * j - 3] = bb; } }
                    f32x2* dst = abb + (unsigned)(row * LRUC + ch); *(f32x4*)dst = o0; *(f32x4*)(dst + 2) = o1;
                    asm volatile("" ::: "memory"); }
        }
    }
};
__device__ __forceinline__ void lru_pass1(Frame& F) {
    const f32x2* AB = WSP(f32x2, WS_AB); f32x2* CARRY = WSP(f32x2, WS_CARRY);
    const int gw = F.vcu * NWAVES + F.wave, NGW = F.G * NWAVES;
    for (int wi = gw; wi < 2 * NCHUNK * 8; wi += NGW) {
        const int chg = wi & 7, cg = (wi >> 3) % NCHUNK, dir = wi / (8 * NCHUNK), ch = chg * 64 + F.lane;
        const f32x2* base = AB + ((size_t)dir * MR + cg * 64) * LRUC + ch;
        float h = 0.f, P = 1.f;
#pragma unroll 16
        for (int i = 0; i < 64; ++i) { const int rr = dir ? 63 - i : i; const f32x2 ab = base[(size_t)rr * LRUC]; h = ab.x * h + ab.y; P *= ab.x; }
        CARRY[((size_t)dir * NCHUNK + cg) * LRUC + ch] = (f32x2){P, h};
    }
}
__device__ __forceinline__ void lru_pass2(Frame& F) {
    const f32x2* AB = WSP(f32x2, WS_AB); const f32x2* CARRY = WSP(f32x2, WS_CARRY); const bf16* U = WSP(bf16, WS_U); float* YL = WSP(float, WS_YL);
    const int gw = F.vcu * NWAVES + F.wave, NGW = F.G * NWAVES;
    for (int wi = gw; wi < NCHUNK * 8; wi += NGW) {
        const int chg = wi & 7, cg = wi >> 3, b = cg / 68, jc = cg - b * 68, ch = chg * 64 + F.lane;
        float hf = 0.f, hb = 0.f;
        const f32x2* cf = CARRY + ((size_t)0 * NCHUNK + b * 68) * LRUC + ch; const f32x2* cbk = CARRY + ((size_t)1 * NCHUNK + b * 68) * LRUC + ch;
        for (int k = 0; k < jc; ++k) { const f32x2 c = cf[(size_t)k * LRUC]; hf = c.x * hf + c.y; }
        if (jc < 4) { for (int k = 3; k > jc; --k) { const f32x2 c = cbk[(size_t)k * LRUC]; hb = c.x * hb + c.y; } }
        else { for (int k = 3; k >= 0; --k) { const f32x2 c = cbk[(size_t)k * LRUC]; hb = c.x * hb + c.y; }
               for (int k = 67; k > jc; --k) { const f32x2 c = cbk[(size_t)k * LRUC]; hb = c.x * hb + c.y; } }
        float hfv[64];
        const f32x2* bf_ = AB + ((size_t)0 * MR + cg * 64) * LRUC + ch; const f32x2* bb_ = AB + ((size_t)1 * MR + cg * 64) * LRUC + ch;
#pragma unroll
        for (int i = 0; i < 64; ++i) { const f32x2 ab = bf_[(size_t)i * LRUC]; hf = ab.x * hf + ab.y; hfv[i] = hf; }
#pragma unroll
        for (int i = 63; i >= 0; --i) { const f32x2 ab = bb_[(size_t)i * LRUC]; hb = ab.x * hb + ab.y; const size_t row = (size_t)cg * 64 + i;
            const float g = bf2f(U[row * DINP + OFF_LRU_G + ch]); YL[row * LRUC + ch] = gelu_tanh(g) * (hfv[i] + hb); }
    }
}

template <int NBLK, int NCH, int WPC>
__device__ __forceinline__ void hyena_item(Frame& F, int l, int item) {
    constexpr int L = 128 * NBLK, GLEN = 2 * L, ZB = NBLK * 136 + 64, ZSZ = 2 * ZB;
    constexpr int CH_BYTES = (GLEN + 2 * ZSZ) * 2 + 64;
    static_assert(CH_BYTES % 16 == 0 && NCH * CH_BYTES <= RING_BYTES && NCH * WPC == NWAVES, "hyena LDS map");
    constexpr int TT = WPC * 64;
    const int cs = F.wave / WPC, q = F.wave % WPC, c = item * NCH + cs, tl = F.tid % TT;
    LAS bf16* Gs = (LAS bf16*)(F.lds + cs * CH_BYTES); LAS bf16* Zc = Gs + GLEN; LAS bf16* Zn = Zc + ZSZ; LAS bf16* zero = Zn + ZSZ;
    const bf16* PT = WSP(bf16, WS_PT); bf16* YT = WSP(bf16, WS_YT);
    const bf16* Gg = (NBLK == 32) ? WSP(bf16, WS_G) + ((size_t)l * 512 + c) * 2 * HYL : WSP(bf16, WS_GC) + ((size_t)l * 512 + c) * 2 * HYLC;
    const int rb0 = (NBLK == 32) ? CTXL : 0;
    for (int i = tl; i < 2 * NBLK * 16; i += TT) { const int b = i / (NBLK * 16), rem = i - b * (NBLK * 16), blk = rem >> 4, e8 = rem & 15;
        *(LAS v4u*)(Zc + b * ZB + blk * 136 + e8 * 8) = *(const v4u*)(PT + (size_t)c * MR + b * SEGB + rb0 + blk * 128 + e8 * 8); }
    if (tl < 16) ((LAS unsigned*)zero)[tl] = 0u;
    const int i16 = F.lane & 15, h4 = F.lane >> 4, nb = i16 >> 3, a = 8 * q + (i16 & 7);
    const int mlo = (8 * q - (NBLK - 1)) > -(NBLK - 1) ? (8 * q - (NBLK - 1)) : -(NBLK - 1), mhi = (8 * q + 7) < (NBLK - 1) ? (8 * q + 7) : (NBLK - 1);
    const float* hb = F.in[14] + (size_t)l * 2 * HYC;
    for (int o = 0; o < 2; ++o) {
        for (int i = tl; i < GLEN / 8; i += TT) *(LAS v4u*)(Gs + 8 * i) = *(const v4u*)(Gg + (size_t)o * GLEN + 8 * i);
        __syncthreads();
        f32x4 acc[8];
#pragma unroll
        for (int r = 0; r < 8; ++r) acc[r] = (f32x4){0.f, 0.f, 0.f, 0.f};
        for (int m = mlo; m <= mhi; ++m) {
            const int blk_in = a - m; const bool valid = (a < NBLK) && blk_in >= 0 && blk_in < NBLK;
            const LAS bf16* zp = valid ? (Zc + nb * ZB + blk_in * 136 + 8 * h4) : zero;
            const int zk = valid ? 1 : 0;
            const LAS bf16* gp = Gs + (L - 128 * m + 8 * (h4 - i16));
#pragma unroll
            for (int k0 = 0; k0 < 128; k0 += 32) {
                const bf16x8 zf = *(const LAS bf16x8*)(zp + zk * k0);
                const v4u lo = *(const LAS v4u*)(gp + k0 - 8), hi = *(const LAS v4u*)(gp + k0);
                const unsigned c0 = lo.x, c1 = lo.y, c2 = lo.z, c3 = lo.w, c4 = hi.x, c5 = hi.y, c6 = hi.z, c7 = hi.w;
                const unsigned s0 = __builtin_amdgcn_alignbit(c1, c0, 16), s1 = __builtin_amdgcn_alignbit(c2, c1, 16), s2 = __builtin_amdgcn_alignbit(c3, c2, 16), s3 = __builtin_amdgcn_alignbit(c4, c3, 16),
                               s4 = __builtin_amdgcn_alignbit(c5, c4, 16), s5 = __builtin_amdgcn_alignbit(c6, c5, 16), s6 = __builtin_amdgcn_alignbit(c7, c6, 16);
#define HYF(x0, x1, x2, x3) __builtin_bit_cast(bf16x8, (v4u){x0, x1, x2, x3})
                acc[0] = __builtin_amdgcn_mfma_f32_16x16x32_bf16(HYF(c4, c5, c6, c7), zf, acc[0], 0, 0, 0);
                acc[1] = __builtin_amdgcn_mfma_f32_16x16x32_bf16(HYF(s3, s4, s5, s6), zf, acc[1], 0, 0, 0);
                acc[2] = __builtin_amdgcn_mfma_f32_16x16x32_bf16(HYF(c3, c4, c5, c6), zf, acc[2], 0, 0, 0);
                acc[3] = __builtin_amdgcn_mfma_f32_16x16x32_bf16(HYF(s2, s3, s4, s5), zf, acc[3], 0, 0, 0);
                acc[4] = __builtin_amdgcn_mfma_f32_16x16x32_bf16(HYF(c2, c3, c4, c5), zf, acc[4], 0, 0, 0);
                acc[5] = __builtin_amdgcn_mfma_f32_16x16x32_bf16(HYF(s1, s2, s3, s4), zf, acc[5], 0, 0, 0);
                acc[6] = __builtin_amdgcn_mfma_f32_16x16x32_bf16(HYF(c1, c2, c3, c4), zf, acc[6], 0, 0, 0);
                acc[7] = __builtin_amdgcn_mfma_f32_16x16x32_bf16(HYF(s0, s1, s2, s3), zf, acc[7], 0, 0, 0);
#undef HYF
            }
        }
        if (a < NBLK) {
            const float bias = hb[o * HYC + c];
            const size_t grow = (size_t)nb * SEGB + rb0 + a * 128 + 32 * h4;
            const bf16* pp = PT + ((size_t)(512 * (o + 1) + c)) * MR + grow;
            const LAS bf16* zz = Zc + nb * ZB + a * 136 + 32 * h4;
#pragma unroll
            for (int jj = 0; jj < 4; ++jj) { const v4u pw = *(const v4u*)(pp + 8 * jj); const v4u zw = *(const LAS v4u*)(zz + 8 * jj); v4u ow;
#pragma unroll
                for (int k = 0; k < 4; ++k) { const float y0 = acc[2 * k][jj], y1 = acc[2 * k + 1][jj];
                    const float r0 = bf_lo(pw[k]) * (y0 + bf_lo(zw[k]) * bias), r1 = bf_hi(pw[k]) * (y1 + bf_hi(zw[k]) * bias); ow[k] = cvt_pk_bf16(r0, r1); }
                if (o == 0) *(LAS v4u*)(Zn + nb * ZB + a * 136 + 32 * h4 + 8 * jj) = ow;
                else *(v4u*)(YT + (size_t)c * MR + grow + 8 * jj) = ow; }
        }
        __syncthreads();
        { LAS bf16* t_ = Zc; Zc = Zn; Zn = t_; }
    }
}
__device__ __forceinline__ void hyena_phase(Frame& F, int l, bool need_ctx) {
    for (int item = F.vcu; item < HYC / 2; item += F.G) hyena_item<32, 2, 4>(F, l, item);
    if (need_ctx) for (int item = F.vcu; item < HYC / 8; item += F.G) hyena_item<2, 8, 1>(F, l, item);
}

constexpr int NSTEPS = 3 + 12 * DEPTH;
__global__ void __launch_bounds__(NTHR, 2) fwd_kernel(Args args) {
    extern __shared__ __attribute__((aligned(16))) unsigned char lds_raw[];
    Frame F;
    F.lds = (LAS unsigned char*)lds_raw; F.ws = args.ws; F.in = args.in; F.out = args.out;
    F.tid = threadIdx.x; F.lane = F.tid & 63; F.wave = __builtin_amdgcn_readfirstlane(F.tid >> 6);
    F.G = gridDim.x; { const int bx = blockIdx.x; F.vcu = (F.G % 8 == 0) ? (bx % 8) * (F.G / 8) + bx / 8 : bx; }
    volatile LAS unsigned* MISC = (volatile LAS unsigned*)(F.lds + MISC_OFF);
    for (int u = F.tid; u < (LDS_BYTES - LDSCTL_OFF) / 4; u += NTHR) ((LAS unsigned*)(F.lds + LDSCTL_OFF))[u] = 0u;
    __syncthreads();
    const int lo = args.ph_lo, hi = args.ph_hi;
    XcdBarrier bar; bar.bar = (unsigned*)(F.ws + WS_CTL) + CW_BAR; bar.x = 0; bar.st = nullptr;
    if (hi - lo > 1) bar = xcd_barrier_post((unsigned*)(F.ws + WS_CTL) + CW_BAR, MISC + 8);
#define LAUNDER() do { asm volatile("" : "+v"(F.tid), "+v"(F.lane)); asm volatile("" : "+s"(F.wave), "+s"(F.vcu)); asm volatile("" : "+s"(l)); } while (0)
#define IN(k) (lo <= (k) && (k) < hi)
#define SEAM(k) do { if (IN(k) && IN((k) + 1)) xcd_barrier(bar); } while (0)

    if (IN(0)) { pro_mod(F); __syncthreads(); pro_transposes(F); pro_lru_w(F); pro_rope(F); __syncthreads(); pro_hid(F); __syncthreads(); }
    SEAM(0);
    if (IN(1)) { pro_filter<false>(F); }
    SEAM(1);
    if (IN(2)) { pro_filter<true>(F); norm_pass(F, 0, 0); }
    SEAM(2);

    for (int li = 0; li < DEPTH; ++li) {
        int l = li; const int sb = 3 + 12 * li; const bool need_ctx = li < DEPTH - 1;
        if (IN(sb + 0)) { LAUNDER(); pg8::PlainAB ab{WSP(bf16, WS_H), WSP(bf16, WS_WIN) + (size_t)l * DINP * DM, DM, DM}; pg8::StaticOrder S; S.init(MR / 256, DINP / 256, F.G, (int)blockIdx.x);
            pg8::EpiBf16 E{WSP(bf16, WS_U), DINP, nullptr}; pg8::gemm_phase<pg8::EpiBf16, pg8::PlainAB>(F.lds, ab, DM, S, E); }
        SEAM(sb + 0);
        if (IN(sb + 1)) { LAUNDER(); post_u(F, l); }
        SEAM(sb + 1);
        if (IN(sb + 2)) { LAUNDER();
            { pg8::PlainAB ab{WSP(bf16, WS_U) + OFF_Q, WSP(bf16, WS_WUQ) + (size_t)l * DQ * QRANK, DINP, QRANK}; pg8::StaticOrder S; S.init(MR / 256, DQ / 256, F.G, (int)blockIdx.x);
              pg8::EpiBf16 E{WSP(bf16, WS_Q), DQ, WSP(float, WS_RSTD)}; pg8::gemm_phase<pg8::EpiBf16, pg8::PlainAB>(F.lds, ab, QRANK, S, E); }
            { pg8::PlainAB ab{WSP(bf16, WS_U) + OFF_KV, WSP(bf16, WS_WUKV) + (size_t)l * DKV * KVRANK, DINP, KVRANK}; pg8::StaticOrder S; S.init(MR / 256, DKV / 256, F.G, (int)blockIdx.x);
              pg8::EpiBf16 E{WSP(bf16, WS_KV), DKV, WSP(float, WS_RSTD) + MR}; pg8::gemm_phase<pg8::EpiBf16, pg8::PlainAB>(F.lds, ab, KVRANK, S, E); }
            { LruAB ab{WSP(bf16, WS_XR), WSP(bf16, WS_WLRU) + (size_t)l * 2 * 4 * 256 * 512, 128, 512}; pg8::StaticOrder S; S.init(MR / 256, 8, F.G, (int)blockIdx.x);
              EpiGate E{WSP(bf16, WS_XR), WSP(f32x2, WS_AB), F.in[17] + (size_t)l * 2 * LRUC, F.in[19] + (size_t)l * 2 * LRUC, WSP(float, WS_SP) + (size_t)l * 2 * LRUC, F.in[15] + (size_t)l * 2 * 4 * LRUC};
              pg8::gemm_phase<EpiGate, LruAB>(F.lds, ab, 512, S, E); }
        }
        SEAM(sb + 2);
        if (IN(sb + 3)) { LAUNDER(); attn_phase(F, need_ctx); __syncthreads(); hyena_phase(F, l, need_ctx); __syncthreads(); lru_pass1(F); }
        SEAM(sb + 3);
        if (IN(sb + 4)) { LAUNDER(); lru_pass2(F); }
        SEAM(sb + 4);
        if (IN(sb + 5)) { LAUNDER(); mix_finalize(F, l); }
        SEAM(sb + 5);
        if (IN(sb + 6)) { LAUNDER(); pg8::PlainAB ab{WSP(bf16, WS_YMIX), WSP(bf16, WS_WOUT) + (size_t)l * DM * DMIX, DMIX, DMIX}; pg8::StaticOrder S; S.init(MR / 256, DM / 256, F.G, (int)blockIdx.x);
            pg8::EpiBf16 E{WSP(bf16, WS_MO), DM, nullptr}; pg8::gemm_phase<pg8::EpiBf16, pg8::PlainAB>(F.lds, ab, DMIX, S, E); }
        SEAM(sb + 6);
        if (IN(sb + 7)) { LAUNDER(); norm_pass(F, 1, l); }
        SEAM(sb + 7);
        if (IN(sb + 8)) { LAUNDER(); pg8::PlainAB ab{WSP(bf16, WS_H), WSP(bf16, WS_WUP) + (size_t)l * 2 * DFF * DM, DM, DM}; pg8::StaticOrder S; S.init(MR / 256, 2 * DFF / 256, F.G, (int)blockIdx.x);
            pg8::EpiBf16 E{WSP(bf16, WS_UP), 2 * DFF, nullptr}; pg8::gemm_phase<pg8::EpiBf16, pg8::PlainAB>(F.lds, ab, DM, S, E); }
        SEAM(sb + 8);
        if (IN(sb + 9)) { LAUNDER(); conv_gelu(F, l); }
        SEAM(sb + 9);
        if (IN(sb + 10)) { LAUNDER(); pg8::PlainAB ab{WSP(bf16, WS_ACT), WSP(bf16, WS_WDN) + (size_t)l * DM * DFF, DFF, DFF}; pg8::StaticOrder S; S.init(MR / 256, DM / 256, F.G, (int)blockIdx.x);
            pg8::EpiBf16 E{WSP(bf16, WS_MO), DM, nullptr}; pg8::gemm_phase<pg8::EpiBf16, pg8::PlainAB>(F.lds, ab, DFF, S, E); }
        SEAM(sb + 10);
        if (IN(sb + 11)) { LAUNDER(); norm_pass(F, 2, l); }
        SEAM(sb + 11);
    }
#undef IN
#undef SEAM
}

extern "C" void kernel_launch(void* const* d_in, const int* in_sizes, int n_in, void* d_out, int out_size, void* d_ws, size_t ws_size, hipStream_t stream) {
    static int grid = 0;
    if (grid == 0) {
        if (n_in != 30 || ws_size < WS_END) { fprintf(stderr, "kernel_launch: expected 30 inputs and >= %zu bytes of workspace (got %d, %zu)\n", (size_t)WS_END, n_in, ws_size); grid = -1; return; }
        int dev = 0, cus = 0, per_cu = 0;
        if (hipGetDevice(&dev) != hipSuccess || hipDeviceGetAttribute(&cus, hipDeviceAttributeMultiprocessorCount, dev) != hipSuccess) { grid = -1; return; }
        if (hipFuncSetAttribute((const void*)fwd_kernel, hipFuncAttributeMaxDynamicSharedMemorySize, LDS_BYTES) != hipSuccess) { fprintf(stderr, "kernel_launch: hipFuncSetAttribute failed\n"); grid = -1; return; }
        if (hipOccupancyMaxActiveBlocksPerMultiprocessor(&per_cu, (const void*)fwd_kernel, NTHR, LDS_BYTES) != hipSuccess || per_cu < 1) fprintf(stderr, "kernel_launch: occupancy query says %d\n", per_cu);
        (void)hipGetLastError();
        grid = cus;
    }
    if (grid < 0) return;
    (void)hipMemsetAsync((char*)d_ws + WS_CTL, 0, CTL_ZERO_BYTES, stream);
    Args a{};
    for (int i = 0; i < 30; ++i) a.in[i] = (const float*)d_in[i];
    a.out = (float*)d_out; a.ws = (unsigned char*)d_ws;
#if MK_MULTI
    for (int s = 0; s < NSTEPS; ++s) { a.ph_lo = s; a.ph_hi = s + 1; hipLaunchKernelGGL(fwd_kernel, dim3(grid), dim3(NTHR), LDS_BYTES, stream, a); }
#else
    a.ph_lo = 0; a.ph_hi = NSTEPS; hipLaunchKernelGGL(fwd_kernel, dim3(grid), dim3(NTHR), LDS_BYTES, stream, a);
#endif
}
```

```cpp
#include <hip/hip_runtime.h>
#include <cstdio>
#include <cstdint>

#ifndef MK_MULTI
#define MK_MULTI 0
#endif

constexpr int DM = 2048, NBATCH = 2, SEQ = 4096, CTXL = 256, DEPTH = 4;
constexpr int SEGB = CTXL + SEQ;
constexpr int MR = NBATCH * SEGB;
constexpr int DIN = 3392, DINP = 3584;
constexpr int HYC = 512, LRUC = 512, QRANK = 512, KVRANK = 256, NOPE = 128, ROPED = 64, VD = 128, NH = 8;
constexpr int DQ = NH * (NOPE + ROPED);
constexpr int DKV = NH * (NOPE + VD);
constexpr int DFF = 5632, DMIX = 2048;
constexpr int OFF_LRU_G = 1536, OFF_Q = 2048, OFF_LRU_X = 2560, OFF_KV = 3072, OFF_KR = 3328;
constexpr float EPS = 1e-6f;
constexpr int XR_ROWS = 4364;
constexpr int NCHUNK = MR / 64;
constexpr int HYL = 8192, HYLC = 512;

constexpr size_t MiB = 1u << 20;
constexpr size_t WS_CTL = 0, CTL_ZERO_BYTES = 1 * MiB;
constexpr size_t WS_MOD = 1 * MiB;
constexpr size_t WS_ROPE = 2 * MiB;
constexpr size_t WS_HID = 3 * MiB;
constexpr size_t WS_PART = 8 * MiB;
constexpr size_t WS_RSTD = 9 * MiB;
constexpr size_t WS_SP = 9 * MiB + 256 * 1024;
constexpr size_t WS_CARRY = 10 * MiB;
constexpr size_t WS_G = 16 * MiB;
constexpr size_t WS_GC = 80 * MiB;
constexpr size_t WS_WIN = 96 * MiB;
constexpr size_t WS_WUQ = 152 * MiB;
constexpr size_t WS_WUKV = 158 * MiB;
constexpr size_t WS_WOUT = 162 * MiB;
constexpr size_t WS_WUP = 194 * MiB;
constexpr size_t WS_WDN = 370 * MiB;
constexpr size_t WS_WLRU = 458 * MiB;
constexpr size_t WS_X = 480 * MiB;
constexpr size_t WS_H = 548 * MiB;
constexpr size_t WS_U = 582 * MiB;
constexpr size_t WS_Q = 642 * MiB;
constexpr size_t WS_KV = 668 * MiB;
constexpr size_t WS_KR = 702 * MiB;
constexpr size_t WS_O = 704 * MiB;
constexpr size_t WS_PT = 722 * MiB;
constexpr size_t WS_YT = 748 * MiB;
constexpr size_t WS_XR = 757 * MiB;
constexpr size_t WS_AB = 766 * MiB;
constexpr size_t WS_HF = 834 * MiB;
constexpr size_t WS_YL = 851 * MiB;
constexpr size_t WS_YMIX = 868 * MiB;
constexpr size_t WS_MO = 902 * MiB;
constexpr size_t WS_UP = 936 * MiB;
constexpr size_t WS_ACT = 1123 * MiB;
constexpr size_t WS_END = 1217 * MiB;

constexpr int CW_BAR = 4096;

constexpr int NWAVES = 8, NTHR = 512;
constexpr int RING_BYTES = 131072;
constexpr int LDSCTL_OFF = RING_BYTES, MISC_OFF = LDSCTL_OFF + 320;
constexpr int LDS_BYTES = 147456;

#define GAS __attribute__((address_space(1)))
#define LAS __attribute__((address_space(3)))
typedef unsigned short bf16;
typedef unsigned v4u __attribute__((ext_vector_type(4)));
typedef unsigned v2u __attribute__((ext_vector_type(2)));
typedef float f32x4 __attribute__((ext_vector_type(4)));
typedef float f32x2 __attribute__((ext_vector_type(2)));
typedef float f32x16 __attribute__((ext_vector_type(16)));
typedef short bf16x8 __attribute__((ext_vector_type(8)));
typedef short s16x4 __attribute__((ext_vector_type(4)));
typedef GAS unsigned gu32;
#define RLX_AGENT __ATOMIC_RELAXED, __HIP_MEMORY_SCOPE_AGENT
#define LDS_WAIT() asm volatile("s_waitcnt lgkmcnt(0)" ::: "memory")
#define VM_WAIT() asm volatile("s_waitcnt vmcnt(0)" ::: "memory")

__device__ __forceinline__ unsigned cvt_pk_bf16(float lo, float hi) { unsigned r; asm volatile("v_cvt_pk_bf16_f32 %0, %1, %2" : "=v"(r) : "v"(lo), "v"(hi)); return r; }
__device__ __forceinline__ float bf_lo(unsigned w) { return __uint_as_float(w << 16); }
__device__ __forceinline__ float bf_hi(unsigned w) { return __uint_as_float(w & 0xffff0000u); }
__device__ __forceinline__ float bf2f(bf16 v) { return __uint_as_float(((unsigned)v) << 16); }
__device__ __forceinline__ bf16 f2bf(float f) { return (bf16)(cvt_pk_bf16(f, 0.f) & 0xffffu); }
__device__ __forceinline__ float wave_sum(float v) {
#pragma unroll
    for (int o = 1; o < 64; o <<= 1) v += __shfl_xor(v, o);
    return v;
}
__device__ __forceinline__ float sigmoidf_(float x) { return 1.0f / (1.0f + __expf(-x)); }
__device__ __forceinline__ float gelu_tanh(float x) { const float u = 0.7978845608028654f * (x + 0.044715f * x * x * x); return x / (1.0f + __expf(-2.0f * u)); }

#define XB_TMO      128
#define XB_XCNT(j)  (256  + 64 * (j))
#define XB_XSUB(j)  (1280 + 64 * (j))
#define XB_XGEN(j)  (2304 + 64 * (j))
#define XB_TOP      3328
#define XB_TOPGEN   3392
#define XCD_BAR_WORDS 3456
#define XB_SPIN_CAP (1u << 18)
__device__ __forceinline__ unsigned xb_ld(unsigned* p)              { return __hip_atomic_load(p, __ATOMIC_RELAXED, __HIP_MEMORY_SCOPE_AGENT); }
__device__ __forceinline__ unsigned xb_add(unsigned* p, unsigned v) { return __hip_atomic_fetch_add(p, v, __ATOMIC_RELAXED, __HIP_MEMORY_SCOPE_AGENT); }
__device__ __forceinline__ unsigned xb_xcc_id() { return (unsigned)__builtin_amdgcn_s_getreg((3 << 11) | 20) & 0xFu; }
#define XB_SPIN(cond, bar) do { unsigned _sp = 0; while (cond) { __builtin_amdgcn_s_sleep(1); \
    if ((++_sp & 255u) == 0u) { if (xb_ld(&(bar)[XB_TMO])) break; if (_sp > XB_SPIN_CAP) { atomicAdd(&(bar)[XB_TMO], 1u); break; } } } } while (0)
struct XcdBarrier { unsigned* bar; unsigned x; volatile LAS unsigned* st; };
__device__ __forceinline__ XcdBarrier xcd_barrier_post(unsigned* bar, volatile LAS unsigned* st) {
    XcdBarrier b; b.bar = bar; b.x = xb_xcc_id(); b.st = st;
    if (threadIdx.x == 0) (void)xb_add(&bar[XB_XCNT(b.x)], 1u);
    return b;
}
__device__ __forceinline__ void xcd_barrier_complete(unsigned* bar, unsigned x, unsigned& nloc, unsigned& nx) {
    const unsigned G = gridDim.x * gridDim.y * gridDim.z;
    unsigned sum, cnt, mine, sp = 0u;
    for (;;) {
        sum = 0u; cnt = 0u; mine = 0u;
#pragma unroll
        for (unsigned j = 0; j < 16; ++j) { const unsigned c = xb_ld(&bar[XB_XCNT(j)]); sum += c; cnt += (c > 0u) ? 1u : 0u; mine = (j == x) ? c : mine; }
        if (sum == G) break;
        __builtin_amdgcn_s_sleep(1);
        if ((++sp & 255u) == 0u) { if (xb_ld(&bar[XB_TMO])) break; if (sp > XB_SPIN_CAP) { atomicAdd(&bar[XB_TMO], 1u); break; } }
    }
    nloc = mine > 0u ? mine : 1u; nx = cnt > 0u ? cnt : 1u;
}
__device__ __forceinline__ void xcd_barrier(const XcdBarrier& b) {
    asm volatile("s_waitcnt vmcnt(0)" ::: "memory");
    __syncthreads();
    if (threadIdx.x == 0) {
        unsigned* bar = b.bar;
        __builtin_amdgcn_s_waitcnt(0);
        unsigned nloc = b.st[0], nx = b.st[1];
        if (nloc == 0u) { xcd_barrier_complete(bar, b.x, nloc, nx); b.st[0] = nloc; b.st[1] = nx; }
        const unsigned old = xb_add(&bar[XB_XSUB(b.x)], 1u);
        const unsigned gen = old / nloc;
        if (old + 1u == (gen + 1u) * nloc) {
            __builtin_amdgcn_fence(__ATOMIC_RELEASE, "agent");
            asm volatile("s_waitcnt vmcnt(0)" ::: "memory");
            const unsigned og = xb_add(&bar[XB_TOP], 1u);
            const unsigned tg = og / nx;
            if (og + 1u == (tg + 1u) * nx) xb_add(&bar[XB_TOPGEN], 1u);
            else XB_SPIN(xb_ld(&bar[XB_TOPGEN]) == tg, bar);
            __builtin_amdgcn_fence(__ATOMIC_ACQUIRE, "agent");
            xb_add(&bar[XB_XGEN(b.x)], 1u);
            asm volatile("s_waitcnt vmcnt(0)" ::: "memory");
        } else {
            XB_SPIN(xb_ld(&bar[XB_XGEN(b.x)]) == gen, bar);
            __builtin_amdgcn_fence(__ATOMIC_ACQUIRE, "agent");
            asm volatile("s_waitcnt vmcnt(0)" ::: "memory");
        }
    }
    __syncthreads();
}

struct Args { const float* in[30]; float* out; unsigned char* ws; int ph_lo, ph_hi; };
struct Frame {
    LAS unsigned char* lds;
    unsigned char* ws;
    const float* const* in;
    float* out;
    int tid, lane, wave, vcu, G;
};
#define WSP(T, off) ((T*)(F.ws + (off)))
__device__ __forceinline__ void row_info(int r, int& b, int& isctx, int& t) { b = r >= SEGB ? 1 : 0; const int j = r - b * SEGB; isctx = j < CTXL ? 1 : 0; t = isctx ? j : j - CTXL; }

namespace pg8 {
constexpr int BM = 256, BK = 64, HALF = 128, HTB = HALF * BK * 2, STAGE_BYTES = 8 * HTB, NXCD = 8, WGM = 8;
__host__ __device__ __forceinline__ int lds_byte(int r, int c) { const int st = (r >> 4) * 2 + (c >> 5), rr = r & 15, cc = c & 31, ob = rr * 64 + cc * 2; return st * 1024 + (ob ^ (((ob >> 9) & 1) << 5)); }
__host__ __device__ __forceinline__ void stage_rc(int b, int& R, int& C) { const int st = b / 1024, sb = b % 1024, swz = sb ^ (((sb >> 9) & 1) << 5); R = (st >> 1) * 16 + swz / 64; C = (st & 1) * 32 + (swz % 64) / 2; }
__host__ __device__ __forceinline__ int perm32(int rho) { const int n = rho >> 4, i = rho & 15; return 8 * (i >> 2) + 4 * n + (i & 3); }
struct Unit { int pm, pn; };
struct StaticOrder {
    int nM, nN, nwg, G, c;
    __host__ __device__ void init(int nM_, int nN_, int G_, int c_) { nM = nM_; nN = nN_; nwg = nM * nN; G = G_; c = c_; }
    __host__ __device__ bool next(int i, Unit& u) const {
        const long L = (long)i * G + c; if (L >= nwg) return false;
        int wgid = (int)L; { const int q = nwg / NXCD, r = nwg % NXCD, xcd = wgid % NXCD, off = wgid / NXCD; wgid = (xcd < r ? xcd * (q + 1) : r * (q + 1) + (xcd - r) * q) + off; }
        const int nig = WGM * nN, gid = wgid / nig, fm = gid * WGM, gsz = (nM - fm) < WGM ? (nM - fm) : WGM;
        u.pm = fm + ((wgid % nig) % gsz); u.pn = (wgid % nig) / gsz; return true;
    }
};
struct PlainAB {
    const bf16* A; const bf16* Bt; int lda, ldb;
    __device__ __forceinline__ const char* a_base(const Unit& u) const { return (const char*)(A + (size_t)u.pm * BM * lda); }
    __device__ __forceinline__ const char* b_base(const Unit& u) const { return (const char*)(Bt + (size_t)u.pn * BM * ldb); }
};
struct EpiBf16 {
    static constexpr bool PERM = true;
    bf16* O; int ldc; const float* rowscale;
    __device__ __forceinline__ void operator()(const f32x4 (&acc)[2][2][4][2], const Unit& u, int wr, int wc, int fr, int fq) const {
        const int row0 = u.pm * BM + wr * 64 + fr; const int col0 = u.pn * BM + wc * 32 + 8 * fq;
#pragma unroll
        for (int ai = 0; ai < 2; ++ai)
#pragma unroll
            for (int m = 0; m < 4; ++m) { const int row = row0 + ai * HALF + m * 16; bf16* rowp = O + (size_t)row * ldc + col0; const float sc = rowscale ? rowscale[row] : 1.0f;
#pragma unroll
                for (int bj = 0; bj < 2; ++bj) { const f32x4 v0 = acc[ai][bj][m][0] * sc, v1 = acc[ai][bj][m][1] * sc;
                    v4u w; w.x = cvt_pk_bf16(v0[0], v0[1]); w.y = cvt_pk_bf16(v0[2], v0[3]); w.z = cvt_pk_bf16(v1[0], v1[1]); w.w = cvt_pk_bf16(v1[2], v1[3]);
                    *(v4u*)(rowp + bj * HALF) = w; } }
    }
};

template <class Epi, class AB, bool ALIGN_EPI = true>
__device__ __forceinline__ void gemm_phase(LAS unsigned char* lds, const AB ab, const int K, const StaticOrder& S, const Epi& E) {
    int tid = threadIdx.x; asm volatile("" : "+v"(tid));
    const int wid = __builtin_amdgcn_readfirstlane(tid >> 6), lane = tid & 63, wr = wid >> 2, wc = wid & 3, fr = lane & 15, fq = lane >> 4;
    const int nt = K / BK;
    unsigned voffA[2], voffB[2];
#pragma unroll
    for (int i = 0; i < 2; ++i) { int R, C; stage_rc(tid * 16 + i * 8192, R, C); const int Rb = Epi::PERM ? ((R & ~31) + perm32(R & 31)) : R;
        voffA[i] = (unsigned)(R * ab.lda + C) * 2u; voffB[i] = (unsigned)(Rb * ab.ldb + C) * 2u; }
    const size_t kstep = (size_t)(BK * 2);
    const size_t hstepA = (size_t)HALF * ab.lda * 2, hstepB = (size_t)HALF * ab.ldb * 2;
    const unsigned ldsw = (unsigned)wid * 1024u;
    const int aoff = lds_byte(wr * 64 + fr, fq * 8), boff = lds_byte(wc * 32 + fr, fq * 8);
#define PG8_SA(b, h) (((b) * 2 + (h)) * HTB)
#define PG8_SB(b, h) ((4 + (b) * 2 + (h)) * HTB)
#define PG8_STAGE(bufoff, gbase, voff) do { _Pragma("unroll") for (int _i = 0; _i < 2; ++_i) \
        __builtin_amdgcn_global_load_lds((const unsigned*)((const char*)(gbase) + (voff)[_i]), (LAS unsigned*)(lds + (bufoff) + ldsw + _i * 8192), 16, 0, 0); } while (0)
#define PG8_LDA(dst, b, h) do { _Pragma("unroll") for (int m = 0; m < 4; ++m) _Pragma("unroll") for (int k = 0; k < 2; ++k) dst[m][k] = *(const LAS bf16x8*)(lds + PG8_SA(b, h) + aoff + m * 2048 + k * 1024); } while (0)
#define PG8_LDB(dst, b, h) do { _Pragma("unroll") for (int n = 0; n < 2; ++n) _Pragma("unroll") for (int k = 0; k < 2; ++k) dst[n][k] = *(const LAS bf16x8*)(lds + PG8_SB(b, h) + boff + n * 2048 + k * 1024); } while (0)
#define PG8_MMA(ai, bj, At, Bt) do { __builtin_amdgcn_s_setprio(1); _Pragma("unroll") for (int m = 0; m < 4; ++m) _Pragma("unroll") for (int n = 0; n < 2; ++n) _Pragma("unroll") for (int k = 0; k < 2; ++k) \
        acc[ai][bj][m][n] = __builtin_amdgcn_mfma_f32_16x16x32_bf16(Bt[n][k], At[m][k], acc[ai][bj][m][n], 0, 0, 0); __builtin_amdgcn_s_setprio(0); } while (0)
#define PG8_WAIT_V(n) asm volatile("s_waitcnt vmcnt(" #n ")" ::: "memory")
#define PG8_WAIT_L(n) asm volatile("s_waitcnt lgkmcnt(" #n ")" ::: "memory")
#define PG8_BAR __builtin_amdgcn_s_barrier()
#define PG8_SCHED __builtin_amdgcn_sched_barrier(0)
    Unit cur, nxt; int ui = 0;
    if (!S.next(0, cur)) return;
    f32x4 acc[2][2][4][2];
#pragma unroll
    for (int a = 0; a < 2; ++a)
#pragma unroll
        for (int b = 0; b < 2; ++b)
#pragma unroll
            for (int m = 0; m < 4; ++m)
#pragma unroll
                for (int n = 0; n < 2; ++n) acc[a][b][m][n] = (f32x4){0.f, 0.f, 0.f, 0.f};
    bf16x8 At[4][2], B0[2][2], B1[2][2];
    const char* cA = ab.a_base(cur); const char* cB = ab.b_base(cur);
    PG8_STAGE(PG8_SB(0, 0), cB, voffB); PG8_STAGE(PG8_SB(0, 1), cB + hstepB, voffB); PG8_STAGE(PG8_SA(0, 0), cA, voffA); PG8_STAGE(PG8_SA(0, 1), cA + hstepA, voffA);
    if (wr == 1) PG8_BAR;
    PG8_WAIT_V(2); PG8_BAR;
    PG8_STAGE(PG8_SB(1, 0), cB + kstep, voffB); PG8_STAGE(PG8_SA(1, 0), cA + kstep, voffA); PG8_STAGE(PG8_SB(1, 1), cB + hstepB + kstep, voffB);
    PG8_WAIT_V(6); PG8_BAR;
    for (;;) {
        const bool has_next = S.next(ui + 1, nxt);
        const char* nA = has_next ? ab.a_base(nxt) : cA; const char* nB = has_next ? ab.b_base(nxt) : cB;
        for (int t = 0; t < nt; t += 2) {
            const bool last = (t == nt - 2);
            const char* a1 = cA + (size_t)(t + 1) * kstep;
            const char* a2 = last ? nA : cA + (size_t)(t + 2) * kstep; const char* b2 = last ? nB : cB + (size_t)(t + 2) * kstep;
            const char* a3 = a2 + kstep; const char* b3 = b2 + kstep;
            PG8_LDB(B0, 0, 0); PG8_LDB(B1, 0, 1); PG8_SCHED; PG8_LDA(At, 0, 0); PG8_STAGE(PG8_SA(1, 1), a1 + hstepA, voffA);
            PG8_WAIT_V(8); PG8_WAIT_L(0); PG8_BAR; PG8_MMA(0, 0, At, B0); PG8_MMA(0, 1, At, B1); PG8_BAR; PG8_SCHED;
            PG8_LDA(At, 0, 1); PG8_STAGE(PG8_SB(0, 0), b2, voffB); PG8_STAGE(PG8_SB(0, 1), b2 + hstepB, voffB); PG8_STAGE(PG8_SA(0, 0), a2, voffA);
            PG8_WAIT_V(8); PG8_WAIT_L(0); PG8_BAR; PG8_MMA(1, 0, At, B0); PG8_MMA(1, 1, At, B1); PG8_BAR; PG8_SCHED;
            PG8_LDB(B0, 1, 0); PG8_LDB(B1, 1, 1); PG8_SCHED; PG8_LDA(At, 1, 0); PG8_STAGE(PG8_SA(0, 1), a2 + hstepA, voffA);
            PG8_WAIT_V(8); PG8_WAIT_L(0); PG8_BAR; PG8_MMA(0, 0, At, B0); PG8_MMA(0, 1, At, B1); PG8_BAR; PG8_SCHED;
            PG8_LDA(At, 1, 1); PG8_STAGE(PG8_SB(1, 0), b3, voffB); PG8_STAGE(PG8_SB(1, 1), b3 + hstepB, voffB); PG8_STAGE(PG8_SA(1, 0), a3, voffA);
            PG8_WAIT_V(8); PG8_WAIT_L(0); PG8_BAR; PG8_MMA(1, 0, At, B0); PG8_MMA(1, 1, At, B1); PG8_BAR; PG8_SCHED;
        }
        if constexpr (ALIGN_EPI) { if (wr == 0) PG8_BAR; }
        E(acc, cur, wr, wc, fr, fq);
        if (!has_next) break;
#pragma unroll
        for (int a = 0; a < 2; ++a)
#pragma unroll
            for (int b = 0; b < 2; ++b)
#pragma unroll
                for (int m = 0; m < 4; ++m)
#pragma unroll
                    for (int n = 0; n < 2; ++n) acc[a][b][m][n] = (f32x4){0.f, 0.f, 0.f, 0.f};
        cur = nxt; cA = nA; cB = nB; ++ui;
        if constexpr (ALIGN_EPI) { if (wr == 1) PG8_BAR; }
    }
    PG8_WAIT_V(0);
    if constexpr (!ALIGN_EPI) { if (wr == 0) PG8_BAR; }
    PG8_BAR;
#undef PG8_SA
#undef PG8_SB
#undef PG8_STAGE
#undef PG8_LDA
#undef PG8_LDB
#undef PG8_MMA
#undef PG8_WAIT_V
#undef PG8_WAIT_L
#undef PG8_BAR
#undef PG8_SCHED
}
}

__device__ __forceinline__ void pro_mod(Frame& F) {
    LAS float* sil = (LAS float*)F.lds;
    LAS float* red = (LAS float*)(F.lds + 24576);
    const float* c = F.in[1]; const float* cc = F.in[3];
    for (int i = F.tid; i < 3 * DM; i += NTHR) { const int w = i / DM, k = i - w * DM; const float v = (w < 2) ? c[w * DM + k] : cc[k]; sil[i] = v / (1.0f + expf(-v)); }
    __syncthreads();
    float* MOD = WSP(float, WS_MOD);
    const int k0 = F.wave * 256;
    for (int unit = F.vcu; unit < DEPTH * 192; unit += F.G) {
        const int l = unit / 192, cg = unit - l * 192;
        const float* W = F.in[4] + (size_t)l * DM * (6 * DM) + cg * 64 + F.lane;
        float a0 = 0.f, a1 = 0.f, a2 = 0.f;
#pragma unroll 16
        for (int k = k0; k < k0 + 256; ++k) { const float w = W[(size_t)k * (6 * DM)]; a0 += sil[k] * w; a1 += sil[DM + k] * w; a2 += sil[2 * DM + k] * w; }
        red[(F.wave * 3 + 0) * 64 + F.lane] = a0; red[(F.wave * 3 + 1) * 64 + F.lane] = a1; red[(F.wave * 3 + 2) * 64 + F.lane] = a2;
        __syncthreads();
        if (F.tid < 192) { const int j = F.tid >> 6, ln = F.tid & 63; float s = 0.f;
#pragma unroll
            for (int w = 0; w < 8; ++w) s += red[(w * 3 + j) * 64 + ln];
            MOD[((size_t)l * 3 + j) * (6 * DM) + cg * 64 + ln] = s + F.in[5][(size_t)l * (6 * DM) + cg * 64 + ln]; }
        __syncthreads();
    }
}

__device__ __forceinline__ void tr_tile(const float* __restrict__ W, int K, int N, bf16* __restrict__ WT, const float* kscale, LAS float* scr, int item, int lane) {
    const int nblk = N >> 5, kb = item / nblk, nb = item - kb * nblk, k0 = kb * 64, n0 = nb * 32;
#pragma unroll
    for (int i = 0; i < 8; ++i) { const int kk = 8 * i + (lane >> 3), c4 = (lane & 7) * 4;
        f32x4 v = *(const f32x4*)(W + (size_t)(k0 + kk) * N + n0 + c4); if (kscale) v = v * kscale[k0 + kk];
        scr[kk * 33 + c4 + 0] = v[0]; scr[kk * 33 + c4 + 1] = v[1]; scr[kk * 33 + c4 + 2] = v[2]; scr[kk * 33 + c4 + 3] = v[3]; }
    LDS_WAIT(); asm volatile("" ::: "memory");
    const int c = lane & 7;
#pragma unroll
    for (int j = 0; j < 4; ++j) { const int n = (lane >> 3) + 8 * j; const LAS float* s = scr + (8 * c) * 33 + n;
        v4u o; o.x = cvt_pk_bf16(s[0], s[33]); o.y = cvt_pk_bf16(s[66], s[99]); o.z = cvt_pk_bf16(s[132], s[165]); o.w = cvt_pk_bf16(s[198], s[231]);
        *(v4u*)(WT + (size_t)(n0 + n) * K + k0 + 8 * c) = o; }
    LDS_WAIT(); asm volatile("" ::: "memory");
}
__device__ __forceinline__ void pro_transposes(Frame& F) {
    LAS float* scr = (LAS float*)(F.lds + F.wave * 16384);
    const int gw = F.vcu * NWAVES + F.wave, NGW = F.G * NWAVES;
    constexpr int I0 = 32 * 106, I1 = 8 * 48, I2 = 4 * 64, I3 = 32 * 64, I4 = 32 * 352, I5 = 88 * 64, IL = I0 + I1 + I2 + I3 + I4 + I5;
    for (int it = gw; it < DEPTH * IL; it += NGW) {
        const int l = it / IL; int r = it - l * IL;
        if (r < I0) { tr_tile(F.in[7] + (size_t)l * DM * DIN, DM, DIN, WSP(bf16, WS_WIN) + (size_t)l * DINP * DM, nullptr, scr, r, F.lane); continue; } r -= I0;
        if (r < I1) { tr_tile(F.in[23] + (size_t)l * QRANK * DQ, QRANK, DQ, WSP(bf16, WS_WUQ) + (size_t)l * DQ * QRANK, F.in[21] + l * QRANK, scr, r, F.lane); continue; } r -= I1;
        if (r < I2) { tr_tile(F.in[24] + (size_t)l * KVRANK * DKV, KVRANK, DKV, WSP(bf16, WS_WUKV) + (size_t)l * DKV * KVRANK, F.in[22] + l * KVRANK, scr, r, F.lane); continue; } r -= I2;
        if (r < I3) { tr_tile(F.in[26] + (size_t)l * DMIX * DM, DMIX, DM, WSP(bf16, WS_WOUT) + (size_t)l * DM * DMIX, nullptr, scr, r, F.lane); continue; } r -= I3;
        if (r < I4) { tr_tile(F.in[27] + (size_t)l * DM * 2 * DFF, DM, 2 * DFF, WSP(bf16, WS_WUP) + (size_t)l * 2 * DFF * DM, nullptr, scr, r, F.lane); continue; } r -= I4;
        tr_tile(F.in[29] + (size_t)l * DFF * DM, DFF, DM, WSP(bf16, WS_WDN) + (size_t)l * DM * DFF, nullptr, scr, r, F.lane);
    }
    { const v4u z = {0u, 0u, 0u, 0u}; constexpr int per = (DINP - DIN) * DM / 8;
      for (int i = F.vcu * NTHR + F.tid; i < DEPTH * per; i += F.G * NTHR) { const int l = i / per, j = i - l * per; *(v4u*)(WSP(bf16, WS_WIN) + ((size_t)l * DINP + DIN) * DM + (size_t)j * 8) = z; } }
}
__device__ __forceinline__ void pro_lru_w(Frame& F) {
    bf16* WL = WSP(bf16, WS_WLRU);
    constexpr int total = DEPTH * 2 * 4 * 256 * 64;
    for (int i = F.vcu * NTHR + F.tid; i < total; i += F.G * NTHR) {
        const int ch = i & 63, row = (i >> 6) & 255, blk = (i >> 14) & 3, dir = (i >> 16) & 1, l = i >> 17;
        const int g = row >> 7, e = row & 127, j4 = ch >> 4, d0 = (ch & 15) * 8;
        const float* Wsrc = (g ? F.in[18] : F.in[16]) + ((((size_t)l * 2 + dir) * 4 + blk) * 128) * 128;
        const float* cw = F.in[15] + (((size_t)l * 2 + dir) * 4 + j4) * LRUC + blk * 128 + d0;
        float v[8];
#pragma unroll
        for (int j = 0; j < 8; ++j) v[j] = cw[j] * Wsrc[(size_t)(d0 + j) * 128 + e];
        v4u o; o.x = cvt_pk_bf16(v[0], v[1]); o.y = cvt_pk_bf16(v[2], v[3]); o.z = cvt_pk_bf16(v[4], v[5]); o.w = cvt_pk_bf16(v[6], v[7]);
        *(v4u*)(WL + (size_t)i * 8) = o;
    }
}
__device__ __forceinline__ void pro_rope(Frame& F) {
    { float* SP = WSP(float, WS_SP); for (int i = F.vcu * NTHR + F.tid; i < DEPTH * 2 * LRUC; i += F.G * NTHR) SP[i] = log1pf(expf(-F.in[20][i])); }
    float* R = WSP(float, WS_ROPE);
    for (int i = F.vcu * NTHR + F.tid; i < SEQ * 32; i += F.G * NTHR) { const int t = i >> 5, f = i & 31; const float pos = (f < 16) ? (float)(t >> 6) : (float)(t & 63);
        const float inv = powf(10000.0f, -(float)(f & 15) / 16.0f); const float a = pos * inv; R[t * 64 + f] = cosf(a); R[t * 64 + 32 + f] = sinf(a); }
}
__device__ __forceinline__ void pro_hid(Frame& F) {
    LAS float* h1 = (LAS float*)(F.lds + F.wave * 16384);
    float* HID = WSP(float, WS_HID);
    const int gw = F.vcu * NWAVES + F.wave, NGW = F.G * NWAVES;
    for (int wi = gw; wi < DEPTH * 68; wi += NGW) {
        const int l = __builtin_amdgcn_readfirstlane(wi / 68), tt = (wi - l * 68) * 64 + F.lane;
        const int L = tt < 4096 ? 4096 : 256, t = tt < 4096 ? tt : tt - 4096;
        const float tn = (float)t / (float)L;
        float sb[16], cb[16];
#pragma unroll
        for (int b = 0; b < 16; ++b) { const float ang = (6.2831855f * tn) * (float)(b + 1); sb[b] = sinf(ang); cb[b] = cosf(ang); }
        const float* w1p = F.in[9] + (size_t)l * 33 * 64; const float* b1p = F.in[10] + l * 64;
        const float* w2p = F.in[11] + (size_t)l * 64 * 64; const float* b2p = F.in[12] + l * 64;
        for (int d = 0; d < 64; ++d) { float a = b1p[d] + tn * w1p[d];
#pragma unroll
            for (int b = 0; b < 16; ++b) a += sb[b] * w1p[(1 + b) * 64 + d] + cb[b] * w1p[(17 + b) * 64 + d];
            h1[d * 64 + F.lane] = sinf(a); }
        LDS_WAIT();
        float* dst = HID + ((size_t)l * 4352 + tt) * 64;
        for (int e = 0; e < 64; ++e) { float a = b2p[e];
#pragma unroll 16
            for (int d = 0; d < 64; ++d) a += h1[d * 64 + F.lane] * w2p[d * 64 + e];
            dst[e] = sinf(a); }
        LDS_WAIT();
    }
}
template <bool WRITE> __device__ __forceinline__ void pro_filter(Frame& F) {
    const float* HID = WSP(float, WS_HID); float* PART = WSP(float, WS_PART);
    LAS float* red = (LAS float*)F.lds;
    constexpr float dmin = 3.0701134573253945f, dstep = (15.350567286626973f - 3.0701134573253945f) / 511.0f;
    for (int item = F.vcu; item < DEPTH * 9 * 4 * 8; item += F.G) {
        int r = item; const int cg = r & 7; r >>= 3; const int od = r & 3; r >>= 2; const int tc = r % 9; const int l = r / 9;
        const int kind = tc == 8 ? 1 : 0, L = kind ? 256 : 4096, t = (kind ? 0 : tc * 512) + F.tid; const bool valid = t < L;
        const int o = od >> 1, dir = od & 1;
        const float* hp = HID + ((size_t)l * 4352 + (kind ? 4096 : 0) + (valid ? t : 0)) * 64;
        const float tn = (float)t / (float)L;
        const float* w3 = F.in[13] + (size_t)l * 64 * 2048 + o * 1024 + dir * 512 + cg * 64;
        float acc[64];
#pragma unroll
        for (int j = 0; j < 64; ++j) acc[j] = 0.f;
        for (int e4 = 0; e4 < 64; e4 += 4) {
            const f32x4 h4 = *(const f32x4*)(hp + e4);
#pragma unroll
            for (int ee = 0; ee < 4; ++ee) { const float* wr = w3 + (size_t)(e4 + ee) * 2048; const float h = h4[ee];
#pragma unroll
                for (int j = 0; j < 64; ++j) acc[j] += h * wr[j]; }
        }
        if constexpr (!WRITE) {
#pragma unroll
            for (int j = 0; j < 64; ++j) { const int c = cg * 64 + j; const float delta = dmin + (float)c * dstep; const float v = acc[j] * expf(-tn * delta);
                float a = (valid && (dir == 0 || t >= 1)) ? fabsf(v) : 0.f; a = wave_sum(a); if (F.lane == 0) red[F.wave * 64 + j] = a; }
            __syncthreads();
            if (F.tid < 64) { float s = 0.f;
#pragma unroll
                for (int w = 0; w < 8; ++w) s += red[w * 64 + F.tid];
                PART[((((size_t)l * 2 + kind) * 2 + o) * 2 + dir) * 8 * 512 + (size_t)(kind ? 0 : tc) * 512 + cg * 64 + F.tid] = s; }
            __syncthreads();
        } else {
            const float* pbase = PART + ((((size_t)l * 2 + kind) * 2 + o) * 2) * 8 * 512;
            bf16* gout = kind ? WSP(bf16, WS_GC) + (size_t)l * 512 * 2 * HYLC : WSP(bf16, WS_G) + (size_t)l * 512 * 2 * HYL;
            const int glen = kind ? HYLC : HYL, nch = kind ? 1 : 8;
            const bool zero0 = (dir == 1 && t == 0); const int idx = zero0 ? 0 : (dir == 0 ? L - t : L + t);
#pragma unroll
            for (int j = 0; j < 64; ++j) { const int c = cg * 64 + j; const float delta = dmin + (float)c * dstep; const float v = acc[j] * expf(-tn * delta);
                float nrm = 0.f;
                for (int q = 0; q < 2; ++q) for (int k = 0; k < nch; ++k) nrm += pbase[((size_t)q * 8 + k) * 512 + c];
                if (valid) gout[((size_t)c * 2 + o) * glen + idx] = zero0 ? (bf16)0 : f2bf(v / nrm); }
        }
    }
}

__device__ __forceinline__ void norm_pass(Frame& F, int mode, int l) {
    const float* MOD = WSP(float, WS_MOD); float* X = WSP(float, WS_X); bf16* H = WSP(bf16, WS_H); const bf16* Y = WSP(bf16, WS_MO);
    const float* ng = F.in[6];
    const int gw = F.vcu * NWAVES + F.wave, NGW = F.G * NWAVES;
    const bool last = (mode == 2 && l == DEPTH - 1);
    for (int r = gw; r < MR; r += NGW) {
        int b, isctx, t; row_info(r, b, isctx, t); const int which = isctx ? 2 : b;
        f32x4 xv[8];
        if (mode == 0) { const float* src = isctx ? F.in[2] + ((size_t)b * CTXL + t) * DM : F.in[0] + ((size_t)b * SEQ + t) * DM;
#pragma unroll
            for (int j = 0; j < 8; ++j) xv[j] = *(const f32x4*)(src + 4 * F.lane + 256 * j);
        } else {
            const float* src = X + (size_t)r * DM; const bf16* yp = Y + (size_t)r * DM;
            f32x4 yv[8]; float ss = 0.f;
#pragma unroll
            for (int j = 0; j < 8; ++j) { xv[j] = *(const f32x4*)(src + 4 * F.lane + 256 * j); const v2u w = *(const v2u*)(yp + 4 * F.lane + 256 * j);
                yv[j] = (f32x4){bf_lo(w.x), bf_hi(w.x), bf_lo(w.y), bf_hi(w.y)}; ss += (yv[j][0] * yv[j][0] + yv[j][1] * yv[j][1]) + (yv[j][2] * yv[j][2] + yv[j][3] * yv[j][3]); }
            ss = wave_sum(ss); const float rs = 1.0f / sqrtf(ss * (1.0f / DM) + EPS);
            const float* gpost = ng + ((size_t)l * 4 + (mode == 1 ? 1 : 3)) * DM; const float* gate = MOD + ((size_t)l * 3 + which) * (6 * DM) + (mode == 1 ? 2 : 5) * DM;
#pragma unroll
            for (int j = 0; j < 8; ++j) { const f32x4 gp = *(const f32x4*)(gpost + 4 * F.lane + 256 * j), gt = *(const f32x4*)(gate + 4 * F.lane + 256 * j); xv[j] += gt * (yv[j] * rs * gp); }
        }
        if (!last) {
            float* dst = X + (size_t)r * DM;
#pragma unroll
            for (int j = 0; j < 8; ++j) *(f32x4*)(dst + 4 * F.lane + 256 * j) = xv[j];
        } else { if (!isctx) { float* dst = F.out + ((size_t)b * SEQ + t) * DM;
#pragma unroll
            for (int j = 0; j < 8; ++j) *(f32x4*)(dst + 4 * F.lane + 256 * j) = xv[j]; }
            continue; }
        const int ln = (mode == 2) ? l + 1 : l; const float* gpre = ng + ((size_t)ln * 4 + (mode == 1 ? 2 : 0)) * DM;
        const float* md = MOD + ((size_t)ln * 3 + which) * (6 * DM); const float* sh = md + (mode == 1 ? 3 : 0) * DM; const float* sc = md + (mode == 1 ? 4 : 1) * DM;
        float s2 = 0.f;
#pragma unroll
        for (int j = 0; j < 8; ++j) s2 += (xv[j][0] * xv[j][0] + xv[j][1] * xv[j][1]) + (xv[j][2] * xv[j][2] + xv[j][3] * xv[j][3]);
        s2 = wave_sum(s2); const float rs2 = 1.0f / sqrtf(s2 * (1.0f / DM) + EPS);
        bf16* hp = H + (size_t)r * DM;
#pragma unroll
        for (int j = 0; j < 8; ++j) { const int cidx = 4 * F.lane + 256 * j; const f32x4 gp = *(const f32x4*)(gpre + cidx), s4 = *(const f32x4*)(sc + cidx), h4 = *(const f32x4*)(sh + cidx);
            const f32x4 hv = (xv[j] * rs2 * gp) * (s4 + 1.0f) + h4; v2u w; w.x = cvt_pk_bf16(hv[0], hv[1]); w.y = cvt_pk_bf16(hv[2], hv[3]); *(v2u*)(hp + cidx) = w; }
    }
}

__device__ __forceinline__ bool seg_start(int r) { const int j = r % SEGB; return j == 0 || j == CTXL; }
__device__ __forceinline__ void post_u(Frame& F, int l) {
    const bf16* U = WSP(bf16, WS_U); bf16* PT = WSP(bf16, WS_PT);
    const int gw = F.vcu * NWAVES + F.wave, NGW = F.G * NWAVES;
    LAS bf16* tile = (LAS bf16*)(F.lds + F.wave * 16384);
    const float* hw = F.in[8] + (size_t)l * 3 * 1536;
    for (int wi = gw; wi < (MR / 64) * 24; wi += NGW) {
        const int rt = wi / 24, cgp = wi - rt * 24, r0 = rt * 64, c0 = cgp * 64;
        const bool has_prev = !seg_start(r0), has_next = !seg_start(r0 + 64) && (r0 + 64 < MR);
#pragma unroll
        for (int i = 0; i < 9; ++i) { const int tr = 8 * i + (F.lane >> 3), ch = F.lane & 7;
            if (tr < 66) { const int r = r0 - 1 + tr; const bool ok = (tr == 0) ? has_prev : (tr == 65 ? has_next : true);
                v4u v = {0u, 0u, 0u, 0u}; if (ok) v = *(const v4u*)(U + (size_t)r * DINP + c0 + ch * 8);
                *(LAS v4u*)(tile + tr * 64 + ch * 8) = v; } }
        LDS_WAIT();
        const int c = c0 + F.lane; const float w0 = hw[c], w1 = hw[1536 + c], w2 = hw[2 * 1536 + c];
#pragma unroll
        for (int tb = 0; tb < 8; ++tb) { float v[8];
#pragma unroll
            for (int j = 0; j < 8; ++j) { const int tr = 8 * tb + j; v[j] = w0 * bf2f(tile[tr * 64 + F.lane]) + w1 * bf2f(tile[(tr + 1) * 64 + F.lane]) + w2 * bf2f(tile[(tr + 2) * 64 + F.lane]); }
            v4u o; o.x = cvt_pk_bf16(v[0], v[1]); o.y = cvt_pk_bf16(v[2], v[3]); o.z = cvt_pk_bf16(v[4], v[5]); o.w = cvt_pk_bf16(v[6], v[7]);
            *(v4u*)(PT + (size_t)c * MR + r0 + 8 * tb) = o; }
        LDS_WAIT();
    }
    bf16* XR = WSP(bf16, WS_XR); bf16* KR = WSP(bf16, WS_KR); const float* ROPE = WSP(float, WS_ROPE); float* RSTD = WSP(float, WS_RSTD);
    for (int r = gw; r < MR; r += NGW) {
        int b, isctx, t; row_info(r, b, isctx, t);
        const bf16* ur = U + (size_t)r * DINP;
        { const int blk = F.lane >> 4, k = (F.lane & 15) * 8, prow = isctx ? 3 + t : 265 + t;
          *(v4u*)(XR + (((size_t)b * 4 + blk) * XR_ROWS + prow) * 128 + k) = *(const v4u*)(ur + OFF_LRU_X + 8 * F.lane); }
        if (F.lane < 32) { const float x1 = bf2f(ur[OFF_KR + F.lane]), x2 = bf2f(ur[OFF_KR + 32 + F.lane]); float o1 = x1, o2 = x2;
            if (!isctx) { const float cs = ROPE[t * 64 + F.lane], sn = ROPE[t * 64 + 32 + F.lane]; o1 = x1 * cs - x2 * sn; o2 = x2 * cs + x1 * sn; }
            KR[(size_t)r * 64 + F.lane] = f2bf(o1); KR[(size_t)r * 64 + 32 + F.lane] = f2bf(o2); }
        { const v4u w = *(const v4u*)(ur + OFF_Q + 8 * F.lane); float ss = 0.f;
#pragma unroll
          for (int j = 0; j < 4; ++j) { const float a = bf_lo(w[j]), c2 = bf_hi(w[j]); ss += a * a + c2 * c2; }
          ss = wave_sum(ss); if (F.lane == 0) RSTD[r] = 1.0f / sqrtf(ss * (1.0f / QRANK) + EPS); }
        { float ss = 0.f; if (F.lane < 32) { const v4u w = *(const v4u*)(ur + OFF_KV + 8 * F.lane);
#pragma unroll
            for (int j = 0; j < 4; ++j) { const float a = bf_lo(w[j]), c2 = bf_hi(w[j]); ss += a * a + c2 * c2; } }
          ss = wave_sum(ss); if (F.lane == 0) RSTD[MR + r] = 1.0f / sqrtf(ss * (1.0f / KVRANK) + EPS); }
    }
    for (int i = F.vcu * NTHR + F.tid; i < 2 * 4 * 12 * 16; i += F.G * NTHR) { const int ch = i & 15, pi = (i >> 4) % 12, bb = (i >> 4) / 12;
        const int prow = pi < 3 ? pi : (pi < 9 ? 256 + pi : 4352 + pi);
        unsigned zz = 0u; asm volatile("" : "+v"(zz));
        const v4u z = {zz, zz, zz, zz}; *(v4u*)(XR + ((size_t)bb * XR_ROWS + prow) * 128 + ch * 8) = z; }
}

__device__ __forceinline__ void conv_gelu(Frame& F, int l) {
    const bf16* UP = WSP(bf16, WS_UP); bf16* ACT = WSP(bf16, WS_ACT);
    const float* cw = F.in[28] + (size_t)l * 3 * 2 * DFF;
    const int gw = F.vcu * NWAVES + F.wave, NGW = F.G * NWAVES;
    for (int wi = gw; wi < (MR / 8) * 11; wi += NGW) {
        const int rc = wi / 11, fc = wi - rc * 11, r0 = rc * 8, f0 = fc * 512 + 8 * F.lane;
        const bool has_prev = !seg_start(r0), has_next = !seg_start(r0 + 8) && (r0 + 8 < MR);
        v4u g[10], v[10];
#pragma unroll
        for (int i = 0; i < 10; ++i) { const int r = r0 - 1 + i; const bool ok = (i == 0) ? has_prev : (i == 9 ? has_next : true);
            g[i] = (v4u){0u, 0u, 0u, 0u}; v[i] = (v4u){0u, 0u, 0u, 0u};
            if (ok) { g[i] = *(const v4u*)(UP + (size_t)r * (2 * DFF) + f0); v[i] = *(const v4u*)(UP + (size_t)r * (2 * DFF) + DFF + f0); } }
        float wg[3][8], wv[3][8];
#pragma unroll
        for (int j = 0; j < 3; ++j) { const f32x4 a = *(const f32x4*)(cw + (size_t)j * 2 * DFF + f0), b2 = *(const f32x4*)(cw + (size_t)j * 2 * DFF + f0 + 4);
            const f32x4 c2 = *(const f32x4*)(cw + (size_t)j * 2 * DFF + DFF + f0), d2 = *(const f32x4*)(cw + (size_t)j * 2 * DFF + DFF + f0 + 4);
#pragma unroll
            for (int q = 0; q < 4; ++q) { wg[j][q] = a[q]; wg[j][4 + q] = b2[q]; wv[j][q] = c2[q]; wv[j][4 + q] = d2[q]; } }
#pragma unroll
        for (int i = 0; i < 8; ++i) { float o[8];
#pragma unroll
            for (int q = 0; q < 4; ++q) {
                const float ga = wg[0][2 * q] * bf_lo(g[i][q]) + wg[1][2 * q] * bf_lo(g[i + 1][q]) + wg[2][2 * q] * bf_lo(g[i + 2][q]);
                const float gb = wg[0][2 * q + 1] * bf_hi(g[i][q]) + wg[1][2 * q + 1] * bf_hi(g[i + 1][q]) + wg[2][2 * q + 1] * bf_hi(g[i + 2][q]);
                const float va = wv[0][2 * q] * bf_lo(v[i][q]) + wv[1][2 * q] * bf_lo(v[i + 1][q]) + wv[2][2 * q] * bf_lo(v[i + 2][q]);
                const float vb = wv[0][2 * q + 1] * bf_hi(v[i][q]) + wv[1][2 * q + 1] * bf_hi(v[i + 1][q]) + wv[2][2 * q + 1] * bf_hi(v[i + 2][q]);
                o[2 * q] = gelu_tanh(ga) * va; o[2 * q + 1] = gelu_tanh(gb) * vb; }
            v4u w; w.x = cvt_pk_bf16(o[0], o[1]); w.y = cvt_pk_bf16(o[2], o[3]); w.z = cvt_pk_bf16(o[4], o[5]); w.w = cvt_pk_bf16(o[6], o[7]);
            *(v4u*)(ACT + (size_t)(r0 + i) * DFF + f0) = w; }
    }
}

__device__ __forceinline__ void mix_finalize(Frame& F, int l) {
    const bf16* YT = WSP(bf16, WS_YT); const float* YL = WSP(float, WS_YL); const bf16* O = WSP(bf16, WS_O); bf16* YM = WSP(bf16, WS_YMIX);
    const float* hg = F.in[25] + (size_t)l * DMIX;
    const int gw = F.vcu * NWAVES + F.wave, NGW = F.G * NWAVES;
    LAS bf16* st = (LAS bf16*)(F.lds + F.wave * 16384);
    for (int wi = gw; wi < (MR / 64) * 8; wi += NGW) {
        const int rt = wi >> 3, hp = wi & 7, r0 = rt * 64;
        if (hp < 4) {
            const bf16* src = YT + (size_t)(hp * 128) * MR + r0 + F.lane; float ss = 0.f;
#pragma unroll 16
            for (int c = 0; c < 128; ++c) { const float v = bf2f(src[(size_t)c * MR]); ss += v * v; }
            const float rs = 1.0f / sqrtf(ss * (1.0f / 128.0f) + EPS);
            for (int half = 0; half < 2; ++half) {
#pragma unroll 16
                for (int c = 0; c < 64; ++c) { const int cc = half * 64 + c; const float v = bf2f(src[(size_t)cc * MR]) * rs * hg[hp * 128 + cc]; st[F.lane * 66 + c] = f2bf(v); }
                LDS_WAIT();
#pragma unroll 8
                for (int rr = 0; rr < 32; ++rr) { const int row = 2 * rr + (F.lane >> 5); const unsigned w = *(const LAS unsigned*)(st + row * 66 + 2 * (F.lane & 31));
                    *(unsigned*)(YM + (size_t)(r0 + row) * DMIX + hp * 128 + half * 64 + 2 * (F.lane & 31)) = w; }
                LDS_WAIT();
            }
        } else {
            const int q = F.lane & 3;
            for (int ps = 0; ps < 4; ++ps) { const int row = r0 + ps * 16 + (F.lane >> 2);
                const float* src = YL + (size_t)row * LRUC + (hp - 4) * 128 + q * 32; f32x4 v[8]; float ss = 0.f;
#pragma unroll
                for (int j = 0; j < 8; ++j) { v[j] = *(const f32x4*)(src + 4 * j); ss += (v[j][0] * v[j][0] + v[j][1] * v[j][1]) + (v[j][2] * v[j][2] + v[j][3] * v[j][3]); }
                ss += __shfl_xor(ss, 1); ss += __shfl_xor(ss, 2); const float rs = 1.0f / sqrtf(ss * (1.0f / 128.0f) + EPS);
                const float* g = hg + hp * 128 + q * 32; bf16* dst = YM + (size_t)row * DMIX + hp * 128 + q * 32;
#pragma unroll
                for (int j = 0; j < 4; ++j) { const f32x4 g0 = *(const f32x4*)(g + 8 * j), g1 = *(const f32x4*)(g + 8 * j + 4); const f32x4 a = v[2 * j] * rs * g0, b2 = v[2 * j + 1] * rs * g1;
                    v4u w; w.x = cvt_pk_bf16(a[0], a[1]); w.y = cvt_pk_bf16(a[2], a[3]); w.z = cvt_pk_bf16(b2[0], b2[1]); w.w = cvt_pk_bf16(b2[2], b2[3]); *(v4u*)(dst + 8 * j) = w; } }
        }
        {
            const int q = F.lane & 3;
            for (int ps = 0; ps < 4; ++ps) { const int row = r0 + ps * 16 + (F.lane >> 2);
                const bf16* src = O + (size_t)row * (NH * VD) + hp * 128 + q * 32; v4u v[4]; float ss = 0.f;
#pragma unroll
                for (int j = 0; j < 4; ++j) { v[j] = *(const v4u*)(src + 8 * j);
#pragma unroll
                    for (int k = 0; k < 4; ++k) { const float a = bf_lo(v[j][k]), b2 = bf_hi(v[j][k]); ss += a * a + b2 * b2; } }
                ss += __shfl_xor(ss, 1); ss += __shfl_xor(ss, 2); const float rs = 1.0f / sqrtf(ss * (1.0f / 128.0f) + EPS);
                const float* g = hg + (8 + hp) * 128 + q * 32; bf16* dst = YM + (size_t)row * DMIX + (8 + hp) * 128 + q * 32;
#pragma unroll
                for (int j = 0; j < 4; ++j) { const f32x4 g0 = *(const f32x4*)(g + 8 * j), g1 = *(const f32x4*)(g + 8 * j + 4);
                    v4u w; w.x = cvt_pk_bf16(bf_lo(v[j][0]) * rs * g0[0], bf_hi(v[j][0]) * rs * g0[1]); w.y = cvt_pk_bf16(bf_lo(v[j][1]) * rs * g0[2], bf_hi(v[j][1]) * rs * g0[3]);
                    w.z = cvt_pk_bf16(bf_lo(v[j][2]) * rs * g1[0], bf_hi(v[j][2]) * rs * g1[1]); w.w = cvt_pk_bf16(bf_lo(v[j][3]) * rs * g1[2], bf_hi(v[j][3]) * rs * g1[3]); *(v4u*)(dst + 8 * j) = w; } }
        }
    }
}

namespace att {
constexpr int NW = 8, QBLK = 32, KVBLK = 64;
constexpr float SCALE = 0.07216878364870323f;
constexpr float THR = 8.f;
constexpr int LDQ = DQ, LDK = DKV, LDR = ROPED, LDO = NH * VD;
constexpr int SHM_V = KVBLK * 128 * 2, SHM_K = KVBLK * 128 * 2, SHM_R = KVBLK * 64 * 2;
constexpr int OFF_V = 0, OFF_K = 2 * SHM_V, OFF_R = OFF_K + 2 * SHM_K, OFF_WS = OFF_R + 2 * SHM_R, OFF_QR = OFF_WS + NW * 64 * 4, SHM_ATTN = OFF_QR + NW * 4096;
#define KSWZ(row, colB) ((row) * 256 + ((colB) ^ (((row) & 7) << 4)))
#define RSWZ(row, colB) ((row) * 128 + ((colB) ^ (((row) & 7) << 4)))
#define SBAR() __builtin_amdgcn_sched_barrier(0)
__device__ __forceinline__ int crow(int r, int hi) { return (r & 3) + 8 * (r >> 2) + 4 * hi; }
__device__ __forceinline__ void partialSM(f32x16& p0, f32x16& p1, float& m_reg, float& mn, float& alpha) {
  constexpr float C = SCALE * 1.4426950408889634f;
  float pmax = p0[0]; for (int r = 1; r < 16; ++r) pmax = fmaxf(pmax, p0[r]); for (int r = 0; r < 16; ++r) pmax = fmaxf(pmax, p1[r]);
  { auto rr = __builtin_amdgcn_permlane32_swap(__float_as_uint(pmax), __float_as_uint(pmax), false, false);
    pmax = fmaxf(__uint_as_float(rr[0]), __uint_as_float(rr[1])); }
  if (__builtin_expect(__all(pmax - m_reg <= THR / SCALE), 1)) { mn = m_reg; alpha = 1.f; }
  else { mn = fmaxf(m_reg, pmax); alpha = __builtin_amdgcn_exp2f((m_reg - mn) * C); m_reg = mn; }
  float mnC = -mn * C;
  for (int r = 0; r < 16; ++r) p0[r] = fmaf(p0[r], C, mnC); for (int r = 0; r < 16; ++r) p1[r] = fmaf(p1[r], C, mnC);
  for (int r = 0; r < 16; ++r) p0[r] = __builtin_amdgcn_exp2f(p0[r]);
}
__device__ __forceinline__ void finishSM(f32x16& p0, f32x16& p1, float alpha, float& l_reg, bf16x8& pa0, bf16x8& pa1, bf16x8& pa2, bf16x8& pa3) {
  for (int r = 0; r < 16; ++r) p1[r] = __builtin_amdgcn_exp2f(p1[r]);
  float ps = 0; for (int r = 0; r < 16; ++r) ps += p0[r]; for (int r = 0; r < 16; ++r) ps += p1[r];
  { auto rr = __builtin_amdgcn_permlane32_swap(__float_as_uint(ps), __float_as_uint(ps), false, false);
    ps = __uint_as_float(rr[0]) + __uint_as_float(rr[1]); }
  l_reg = l_reg * alpha + ps;
#define PK4(P, BASE, OUT) do { unsigned a0 = cvt_pk_bf16(P[BASE + 0], P[BASE + 1]), a1 = cvt_pk_bf16(P[BASE + 2], P[BASE + 3]);   \
    unsigned b0 = cvt_pk_bf16(P[BASE + 4], P[BASE + 5]), b1 = cvt_pk_bf16(P[BASE + 6], P[BASE + 7]);                              \
    auto r0 = __builtin_amdgcn_permlane32_swap(a0, b0, false, false); auto r1 = __builtin_amdgcn_permlane32_swap(a1, b1, false, false); \
    v4u w = {r0[0], r1[0], r0[1], r1[1]}; OUT = *reinterpret_cast<bf16x8*>(&w); } while (0)
  PK4(p0, 0, pa0); PK4(p0, 8, pa1); PK4(p1, 0, pa2); PK4(p1, 8, pa3);
#undef PK4
}
__device__ __forceinline__ void qkt(f32x16& p0, f32x16& p1, const LAS char* Ks, const LAS char* Rs, const bf16x8* qr, const LAS char* qrl, int r32, int hi) {
  p0 = f32x16{}; p1 = f32x16{};
#pragma unroll
  for (int d0 = 0; d0 < 8; ++d0) { const int cb = (d0 * 16 + hi * 8) * 2;
    bf16x8 b0 = *(const LAS bf16x8*)(Ks + KSWZ(r32, cb));
    bf16x8 b1 = *(const LAS bf16x8*)(Ks + KSWZ(32 + r32, cb));
    p0 = __builtin_amdgcn_mfma_f32_32x32x16_bf16(b0, qr[d0], p0, 0, 0, 0);
    p1 = __builtin_amdgcn_mfma_f32_32x32x16_bf16(b1, qr[d0], p1, 0, 0, 0); }
#pragma unroll
  for (int d0 = 0; d0 < 4; ++d0) { const int cb = (d0 * 16 + hi * 8) * 2;
    bf16x8 b0 = *(const LAS bf16x8*)(Rs + RSWZ(r32, cb));
    bf16x8 b1 = *(const LAS bf16x8*)(Rs + RSWZ(32 + r32, cb));
    const bf16x8 qf = *(const LAS bf16x8*)(qrl + d0 * 1024);
    p0 = __builtin_amdgcn_mfma_f32_32x32x16_bf16(b0, qf, p0, 0, 0, 0);
    p1 = __builtin_amdgcn_mfma_f32_32x32x16_bf16(b1, qf, p1, 0, 0, 0); }
}
__device__ __forceinline__ int v_st(int k, int c) { const int kk = (k & ~0xC) | ((k & 4) << 1) | ((k & 8) >> 1); return ((kk >> 3) * 4 + (c >> 5)) * 512 + ((kk & 7) * 32 + (c & 31)) * 2; }
__device__ __forceinline__ int v_rd_base(int lane) { return ((lane & 3) << 3) | (((lane >> 2) & 3) << 6) | (((lane >> 4) & 1) << 5) | (((lane >> 5) & 1) << 8); }
constexpr int v_rd_off(int d0, int ks, int half) { return d0 * 512 + ks * 4096 + half * 2048; }
template <int OFF> __device__ __forceinline__ s16x4 tr_read(int vb) {
  s16x4 r; asm volatile("ds_read_b64_tr_b16 %0, %1 offset:%2" : "=&v"(r) : "v"(vb), "i"(OFF) : "memory"); return r;
}
template <int D0> __device__ __forceinline__ void pv_one(f32x16& od, int vb, bf16x8 pa0, bf16x8 pa1, bf16x8 pa2, bf16x8 pa3) {
  const s16x4 l0 = tr_read<v_rd_off(D0, 0, 0)>(vb), h0 = tr_read<v_rd_off(D0, 0, 1)>(vb), l1 = tr_read<v_rd_off(D0, 1, 0)>(vb), h1 = tr_read<v_rd_off(D0, 1, 1)>(vb);
  const s16x4 l2 = tr_read<v_rd_off(D0, 2, 0)>(vb), h2 = tr_read<v_rd_off(D0, 2, 1)>(vb), l3 = tr_read<v_rd_off(D0, 3, 0)>(vb), h3 = tr_read<v_rd_off(D0, 3, 1)>(vb);
  asm volatile("s_waitcnt lgkmcnt(0)" ::: "memory"); SBAR();
#define PK(L, H) (bf16x8){L[0], L[1], L[2], L[3], H[0], H[1], H[2], H[3]}
  od = __builtin_amdgcn_mfma_f32_32x32x16_bf16(pa0, PK(l0, h0), od, 0, 0, 0);
  od = __builtin_amdgcn_mfma_f32_32x32x16_bf16(pa1, PK(l1, h1), od, 0, 0, 0);
  od = __builtin_amdgcn_mfma_f32_32x32x16_bf16(pa2, PK(l2, h2), od, 0, 0, 0);
  od = __builtin_amdgcn_mfma_f32_32x32x16_bf16(pa3, PK(l3, h3), od, 0, 0, 0);
#undef PK
}
__device__ __forceinline__ void pv_d0(f32x16* o, int vb, bf16x8 pa0, bf16x8 pa1, bf16x8 pa2, bf16x8 pa3) {
  pv_one<0>(o[0], vb, pa0, pa1, pa2, pa3); pv_one<1>(o[1], vb, pa0, pa1, pa2, pa3); pv_one<2>(o[2], vb, pa0, pa1, pa2, pa3); pv_one<3>(o[3], vb, pa0, pa1, pa2, pa3);
}
__device__ __forceinline__ void attn_body(const bf16* __restrict__ Qb, const bf16* __restrict__ Kh, const bf16* __restrict__ Vh, const bf16* __restrict__ Rh,
                                          bf16* __restrict__ Ob, int seq, const float* rope_tab, LAS char* lds) {
  int tid = threadIdx.x; asm volatile("" : "+v"(tid));
  const int wid = __builtin_amdgcn_readfirstlane(tid >> 6), lane = tid & 63, r32 = lane & 31, hi = lane >> 5;
  LAS char* V_lds = lds + OFF_V; LAS char* K_lds = lds + OFF_K; LAS char* R_lds = lds + OFF_R;
  LAS float* ws = (LAS float*)(lds + OFF_WS) + wid * 64; LAS float* li_l = ws; LAS float* al_l = ws + 32;
  float m_reg = -1e30f, l_reg = 0; f32x16 o[4] = {}; bf16x8 qr[12];
  LAS char* qrl = lds + OFF_QR + wid * 4096 + lane * 16;
  const bf16* Qw = Qb + (long)(wid * QBLK + r32) * LDQ + hi * 8;
#pragma unroll
  for (int d0 = 0; d0 < 12; ++d0) qr[d0] = *reinterpret_cast<const bf16x8*>(Qw + d0 * 16);
  if (rope_tab) {
    const float* rt = rope_tab + (long)(wid * QBLK + r32) * 64;
#pragma unroll
    for (int p = 0; p < 2; ++p) {
      const float* cs = rt + p * 16 + hi * 8; const f32x4 c0 = *(const f32x4*)cs, c1 = *(const f32x4*)(cs + 4), s0 = *(const f32x4*)(cs + 32), s1 = *(const f32x4*)(cs + 36);
      const v4u x1 = *reinterpret_cast<v4u*>(&qr[8 + p]), x2 = *reinterpret_cast<v4u*>(&qr[10 + p]); v4u y1, y2;
#pragma unroll
      for (int k = 0; k < 4; ++k) { const float ca = k < 2 ? c0[2 * k] : c1[2 * k - 4], cbv = k < 2 ? c0[2 * k + 1] : c1[2 * k - 3], sa = k < 2 ? s0[2 * k] : s1[2 * k - 4], sb = k < 2 ? s0[2 * k + 1] : s1[2 * k - 3];
        const float a1 = bf_lo(x1[k]), b1 = bf_hi(x1[k]), a2 = bf_lo(x2[k]), b2 = bf_hi(x2[k]);
        y1[k] = cvt_pk_bf16(a1 * ca - a2 * sa, b1 * cbv - b2 * sb); y2[k] = cvt_pk_bf16(a2 * ca + a1 * sa, b2 * cbv + b1 * sb); }
      qr[8 + p] = *reinterpret_cast<bf16x8*>(&y1); qr[10 + p] = *reinterpret_cast<bf16x8*>(&y2); }
  }
#pragma unroll
  for (int d0 = 0; d0 < 4; ++d0) *(LAS bf16x8*)(qrl + d0 * 1024) = qr[8 + d0];
  const int sr = tid >> 4, sc = (tid & 15) * 8, vst0 = v_st(sr, sc), vst1 = v_st(32 + sr, sc);
  const int rr_ = tid >> 3, rc_ = (tid & 7) * 8;
  const int vb0 = (int)(uintptr_t)V_lds + v_rd_base(lane);
  constexpr int SDEPTH = 1;
  struct { bf16x8 vs0, vs1, ks0, ks1, rs; } sr_[SDEPTH];
  const unsigned offk0 = (unsigned)(sr * LDK + sc), offk1 = (unsigned)((32 + sr) * LDK + sc), offr = (unsigned)(rr_ * LDR + rc_);
#define SLOAD(i, k0) do { const bf16* vt_ = Vh + (size_t)(k0) * LDK; const bf16* kt_ = Kh + (size_t)(k0) * LDK; const bf16* rt_ = Rh + (size_t)(k0) * LDR; \
    sr_[i].vs0 = *(const bf16x8*)(vt_ + offk0); sr_[i].vs1 = *(const bf16x8*)(vt_ + offk1); \
    sr_[i].ks0 = *(const bf16x8*)(kt_ + offk0); sr_[i].ks1 = *(const bf16x8*)(kt_ + offk1); \
    sr_[i].rs = *(const bf16x8*)(rt_ + offr); } while (0)
#define SWRITE(b, i) do { *(LAS bf16x8*)(V_lds + (b) * SHM_V + vst0) = sr_[i].vs0;          \
    *(LAS bf16x8*)(V_lds + (b) * SHM_V + vst1) = sr_[i].vs1; int kc = sc * 2;               \
    *(LAS bf16x8*)(K_lds + (b) * SHM_K + KSWZ(sr, kc)) = sr_[i].ks0;                       \
    *(LAS bf16x8*)(K_lds + (b) * SHM_K + KSWZ(32 + sr, kc)) = sr_[i].ks1;                  \
    *(LAS bf16x8*)(R_lds + (b) * SHM_R + RSWZ(rr_, rc_ * 2)) = sr_[i].rs; } while (0)
#define SWAIT() do { if constexpr (SDEPTH == 2) asm volatile("s_waitcnt vmcnt(5)" ::: "memory"); else asm volatile("s_waitcnt vmcnt(0)" ::: "memory"); } while (0)
#define RESC(a) do { if (__any((a) < 1.f)) { if (hi == 0) al_l[r32] = (a); asm volatile("s_waitcnt lgkmcnt(0)" ::: "memory"); \
    for (int d = 0; d < 4; ++d) for (int r = 0; r < 16; ++r) o[d][r] *= al_l[crow(r, hi)]; } } while (0)
  f32x16 pA0, pA1, pB0, pB1; float mnA, mnB, alA, alB; bf16x8 pa0, pa1, pa2, pa3; const int NT = seq / KVBLK;
  constexpr int SE = 0, SO = SDEPTH - 1;
  SLOAD(SE, 0); asm volatile("s_waitcnt vmcnt(0)" ::: "memory"); SWRITE(0, SE); __syncthreads();
  qkt(pA0, pA1, K_lds, R_lds, qr, qrl, r32, hi); partialSM(pA0, pA1, m_reg, mnA, alA);
  SLOAD(SO, KVBLK); if constexpr (SDEPTH == 2) { if (2 < NT) SLOAD(SE, 2 * KVBLK); }
  SWAIT(); SWRITE(1, SO); __syncthreads();
  for (int j = 1; j + 1 < NT; j += 2) {
    SBAR(); qkt(pB0, pB1, K_lds + SHM_K, R_lds + SHM_R, qr, qrl, r32, hi);
    finishSM(pA0, pA1, alA, l_reg, pa0, pa1, pa2, pa3); SBAR();
    SLOAD(SO, (j + SDEPTH) * KVBLK); SBAR();
    pv_d0(o, vb0, pa0, pa1, pa2, pa3); partialSM(pB0, pB1, m_reg, mnB, alB);
    __syncthreads(); SWAIT(); SWRITE(0, SE);
    RESC(alB); __syncthreads();
    SBAR(); qkt(pA0, pA1, K_lds, R_lds, qr, qrl, r32, hi);
    finishSM(pB0, pB1, alB, l_reg, pa0, pa1, pa2, pa3); SBAR();
    if (SDEPTH == 1 || j + 3 < NT) SLOAD(SE, (j + 1 + SDEPTH) * KVBLK); SBAR();
    pv_d0(o, vb0 + SHM_V, pa0, pa1, pa2, pa3); partialSM(pA0, pA1, m_reg, mnA, alA);
    __syncthreads(); SWAIT(); SWRITE(1, SO);
    RESC(alA); __syncthreads();
  }
  SBAR(); qkt(pB0, pB1, K_lds + SHM_K, R_lds + SHM_R, qr, qrl, r32, hi);
  finishSM(pA0, pA1, alA, l_reg, pa0, pa1, pa2, pa3); SBAR();
  pv_d0(o, vb0, pa0, pa1, pa2, pa3); partialSM(pB0, pB1, m_reg, mnB, alB);
  __syncthreads(); RESC(alB);
  finishSM(pB0, pB1, alB, l_reg, pa0, pa1, pa2, pa3); SBAR();
  pv_d0(o, vb0 + SHM_V, pa0, pa1, pa2, pa3);
  if (hi == 0) li_l[r32] = l_reg; asm volatile("s_waitcnt lgkmcnt(0)" ::: "memory");
  float rli[16];
#pragma unroll
  for (int r = 0; r < 16; ++r) rli[r] = __builtin_amdgcn_rcpf(li_l[crow(r, hi)]);
  bf16* Ow = Ob + (long)(wid * QBLK) * LDO;
#pragma unroll
  for (int r = 0; r < 16; ++r) { const int orow = crow(r, hi);
#pragma unroll
    for (int d0 = 0; d0 < 4; ++d0) Ow[(long)orow * LDO + d0 * 32 + r32] = f2bf(o[d0][r] * rli[r]); }
  __syncthreads();
#undef SLOAD
#undef SWRITE
#undef SWAIT
#undef RESC
}
}

__device__ __forceinline__ void attn_phase(Frame& F, bool need_ctx) {
    const bf16* Q = WSP(bf16, WS_Q); const bf16* KV = WSP(bf16, WS_KV); const bf16* KR = WSP(bf16, WS_KR); bf16* O = WSP(bf16, WS_O); const float* ROPE = WSP(float, WS_ROPE);
    const int nunits = 256 + (need_ctx ? 16 : 0);
    for (int u = F.vcu; u < nunits; u += F.G) {
        if (u < 256) { const int b = u >> 7, h = (u >> 4) & 7, qb = u & 15; const size_t kb = (size_t)b * SEGB, row0 = kb + CTXL + qb * 256;
            att::attn_body(Q + row0 * DQ + h * 192, KV + kb * DKV + h * 256, KV + kb * DKV + h * 256 + 128, KR + kb * ROPED, O + row0 * (NH * VD) + h * 128, SEGB, ROPE + (size_t)qb * 256 * 64, (LAS char*)F.lds);
        } else { const int b = (u - 256) >> 3, h = (u - 256) & 7; const size_t kb = (size_t)b * SEGB;
            att::attn_body(Q + kb * DQ + h * 192, KV + kb * DKV + h * 256, KV + kb * DKV + h * 256 + 128, KR + kb * ROPED, O + kb * (NH * VD) + h * 128, CTXL, nullptr, (LAS char*)F.lds);
        }
    }
}

struct LruAB {
    const bf16* XR; const bf16* Bt; int lda, ldb;
    __device__ __forceinline__ static int prow0(int pm) { const int jt = pm % 17; return jt == 0 ? 3 : 265 + (jt - 1) * 256; }
    __device__ __forceinline__ const char* a_base(const pg8::Unit& u) const { const int b = u.pm / 17, dir = u.pn >> 2, blk = u.pn & 3;
        return (const char*)(XR + (((size_t)b * 4 + blk) * XR_ROWS + prow0(u.pm) - (dir ? 0 : 3)) * 128); }
    __device__ __forceinline__ const char* b_base(const pg8::Unit& u) const { return (const char*)(Bt + (size_t)u.pn * 256 * 512); }
};
struct EpiGate {
    static constexpr bool PERM = false;
    const bf16* XR; f32x2* AB; const float* ba; const float* bx; const float* sp; const float* cw;
    __device__ __forceinline__ void operator()(const f32x4 (&acc)[2][2][4][2], const pg8::Unit& u, int wr, int wc, int fr, int fq) const {
        asm volatile("" : "+v"(fr), "+v"(fq));
        const int dir = u.pn >> 2, blk = u.pn & 3, b = u.pm / 17, p0 = LruAB::prow0(u.pm);
        const bf16* xb = XR + ((size_t)b * 4 + blk) * XR_ROWS * 128;
        f32x2* abb = AB + (size_t)dir * MR * LRUC;
#pragma unroll 1
        for (int n = 0; n < 2; ++n) { const int cl = wc * 32 + 16 * n + 4 * fq, ch = blk * 128 + cl;
            const f32x4 ba4 = *(const f32x4*)(ba + dir * LRUC + ch), bx4 = *(const f32x4*)(bx + dir * LRUC + ch), sp4 = *(const f32x4*)(sp + dir * LRUC + ch) * -8.0f;
            f32x4 cw4[4];
#pragma unroll
            for (int j = 0; j < 4; ++j) cw4[j] = *(const f32x4*)(cw + ((size_t)dir * 4 + j) * LRUC + ch);
#pragma unroll
            for (int ai = 0; ai < 2; ++ai)
#pragma unroll
                for (int m = 0; m < 4; ++m) { const int rl = ai * 128 + wr * 64 + m * 16 + fr, row = u.pm * 256 + rl, pr = p0 + rl + (dir ? 0 : -3);
                    f32x4 xc = {0.f, 0.f, 0.f, 0.f};
#pragma unroll
                    for (int j = 0; j < 4; ++j) { const v2u w = *(const v2u*)(xb + (unsigned)((pr + j) * 128 + cl)); xc[0] += cw4[j][0] * bf_lo(w.x); xc[1] += cw4[j][1] * bf_hi(w.x); xc[2] += cw4[j][2] * bf_lo(w.y); xc[3] += cw4[j][3] * bf_hi(w.y); }
                    const f32x4 rp = (n == 0 ? acc[ai][0][m][0] : acc[ai][0][m][1]) + ba4, ip = (n == 0 ? acc[ai][1][m][0] : acc[ai][1][m][1]) + bx4;
                    f32x4 o0, o1;
#pragma unroll
                    for (int j = 0; j < 4; ++j) { const float rg = sigmoidf_(rp[j]), ig = sigmoidf_(ip[j]); const float la = rg * sp4[j]; const float a = __expf(la);
                        const float x = 2.0f * la;
                        const float ser = -x * (1.0f + x * (0.5f + x * (0.16666667f + x * (0.041666668f + x * (0.008333334f + x * 0.0013888889f)))));
                        const float om = (x > -0.25f) ? ser : (1.0f - __expf(x));
                        const float bb = sqrtf(om) * (ig * xc[j]); if (j < 2) { o0[2 * j] = a; o0[2 * j + 1] = bb; } else { o1[2 * j - 4] = a; o1[2 * j - 3] = bb; } }
                    f32x2* dst = abb + (unsigned)(row * LRUC + ch); *(f32x4*)dst = o0; *(f32x4*)(dst + 2) = o1;
                    asm volatile("" ::: "memory"); }
        }
    }
};
__device__ __forceinline__ void lru_pass1(Frame& F) {
    const f32x2* AB = WSP(f32x2, WS_AB); f32x2* CARRY = WSP(f32x2, WS_CARRY);
    const int gw = F.vcu * NWAVES + F.wave, NGW = F.G * NWAVES;
    for (int wi = gw; wi < 2 * NCHUNK * 8; wi += NGW) {
        const int chg = wi & 7, cg = (wi >> 3) % NCHUNK, dir = wi / (8 * NCHUNK), ch = chg * 64 + F.lane;
        const f32x2* base = AB + ((size_t)dir * MR + cg * 64) * LRUC + ch;
        float h = 0.f, P = 1.f;
#pragma unroll 16
        for (int i = 0; i < 64; ++i) { const int rr = dir ? 63 - i : i; const f32x2 ab = base[(size_t)rr * LRUC]; h = ab.x * h + ab.y; P *= ab.x; }
        CARRY[((size_t)dir * NCHUNK + cg) * LRUC + ch] = (f32x2){P, h};
    }
}
__device__ __forceinline__ void lru_pass2(Frame& F) {
    const f32x2* AB = WSP(f32x2, WS_AB); const f32x2* CARRY = WSP(f32x2, WS_CARRY); const bf16* U = WSP(bf16, WS_U); float* YL = WSP(float, WS_YL);
    const int gw = F.vcu * NWAVES + F.wave, NGW = F.G * NWAVES;
    for (int wi = gw; wi < NCHUNK * 8; wi += NGW) {
        const int chg = wi & 7, cg = wi >> 3, b = cg / 68, jc = cg - b * 68, ch = chg * 64 + F.lane;
        float hf = 0.f, hb = 0.f;
        const f32x2* cf = CARRY + ((size_t)0 * NCHUNK + b * 68) * LRUC + ch; const f32x2* cbk = CARRY + ((size_t)1 * NCHUNK + b * 68) * LRUC + ch;
        for (int k = 0; k < jc; ++k) { const f32x2 c = cf[(size_t)k * LRUC]; hf = c.x * hf + c.y; }
        if (jc < 4) { for (int k = 3; k > jc; --k) { const f32x2 c = cbk[(size_t)k * LRUC]; hb = c.x * hb + c.y; } }
        else { for (int k = 3; k >= 0; --k) { const f32x2 c = cbk[(size_t)k * LRUC]; hb = c.x * hb + c.y; }
               for (int k = 67; k > jc; --k) { const f32x2 c = cbk[(size_t)k * LRUC]; hb = c.x * hb + c.y; } }
        float hfv[64];
        const f32x2* bf_ = AB + ((size_t)0 * MR + cg * 64) * LRUC + ch; const f32x2* bb_ = AB + ((size_t)1 * MR + cg * 64) * LRUC + ch;
#pragma unroll
        for (int i = 0; i < 64; ++i) { const f32x2 ab = bf_[(size_t)i * LRUC]; hf = ab.x * hf + ab.y; hfv[i] = hf; }
#pragma unroll
        for (int i = 63; i >= 0; --i) { const f32x2 ab = bb_[(size_t)i * LRUC]; hb = ab.x * hb + ab.y; const size_t row = (size_t)cg * 64 + i;
            const float g = bf2f(U[row * DINP + OFF_LRU_G + ch]); YL[row * LRUC + ch] = gelu_tanh(g) * (hfv[i] + hb); }
    }
}

template <int NBLK, int NCH, int WPC>
__device__ __forceinline__ void hyena_item(Frame& F, int l, int item) {
    constexpr int L = 128 * NBLK, GLEN = 2 * L, ZB = NBLK * 136 + 64, ZSZ = 2 * ZB;
    constexpr int CH_BYTES = (GLEN + 2 * ZSZ) * 2 + 64;
    static_assert(CH_BYTES % 16 == 0 && NCH * CH_BYTES <= RING_BYTES && NCH * WPC == NWAVES, "hyena LDS map");
    constexpr int TT = WPC * 64;
    const int cs = F.wave / WPC, q = F.wave % WPC, c = item * NCH + cs, tl = F.tid % TT;
    LAS bf16* Gs = (LAS bf16*)(F.lds + cs * CH_BYTES); LAS bf16* Zc = Gs + GLEN; LAS bf16* Zn = Zc + ZSZ; LAS bf16* zero = Zn + ZSZ;
    const bf16* PT = WSP(bf16, WS_PT); bf16* YT = WSP(bf16, WS_YT);
    const bf16* Gg = (NBLK == 32) ? WSP(bf16, WS_G) + ((size_t)l * 512 + c) * 2 * HYL : WSP(bf16, WS_GC) + ((size_t)l * 512 + c) * 2 * HYLC;
    const int rb0 = (NBLK == 32) ? CTXL : 0;
    for (int i = tl; i < 2 * NBLK * 16; i += TT) { const int b = i / (NBLK * 16), rem = i - b * (NBLK * 16), blk = rem >> 4, e8 = rem & 15;
        *(LAS v4u*)(Zc + b * ZB + blk * 136 + e8 * 8) = *(const v4u*)(PT + (size_t)c * MR + b * SEGB + rb0 + blk * 128 + e8 * 8); }
    if (tl < 16) ((LAS unsigned*)zero)[tl] = 0u;
    const int i16 = F.lane & 15, h4 = F.lane >> 4, nb = i16 >> 3, a = 8 * q + (i16 & 7);
    const int mlo = (8 * q - (NBLK - 1)) > -(NBLK - 1) ? (8 * q - (NBLK - 1)) : -(NBLK - 1), mhi = (8 * q + 7) < (NBLK - 1) ? (8 * q + 7) : (NBLK - 1);
    const float* hb = F.in[14] + (size_t)l * 2 * HYC;
    for (int o = 0; o < 2; ++o) {
        for (int i = tl; i < GLEN / 8; i += TT) *(LAS v4u*)(Gs + 8 * i) = *(const v4u*)(Gg + (size_t)o * GLEN + 8 * i);
        __syncthreads();
        f32x4 acc[8];
#pragma unroll
        for (int r = 0; r < 8; ++r) acc[r] = (f32x4){0.f, 0.f, 0.f, 0.f};
        for (int m = mlo; m <= mhi; ++m) {
            const int blk_in = a - m; const bool valid = (a < NBLK) && blk_in >= 0 && blk_in < NBLK;
            const LAS bf16* zp = valid ? (Zc + nb * ZB + blk_in * 136 + 8 * h4) : zero;
            const int zk = valid ? 1 : 0;
            const LAS bf16* gp = Gs + (L - 128 * m + 8 * (h4 - i16));
#pragma unroll
            for (int k0 = 0; k0 < 128; k0 += 32) {
                const bf16x8 zf = *(const LAS bf16x8*)(zp + zk * k0);
                const v4u lo = *(const LAS v4u*)(gp + k0 - 8), hi = *(const LAS v4u*)(gp + k0);
                const unsigned c0 = lo.x, c1 = lo.y, c2 = lo.z, c3 = lo.w, c4 = hi.x, c5 = hi.y, c6 = hi.z, c7 = hi.w;
                const unsigned s0 = __builtin_amdgcn_alignbit(c1, c0, 16), s1 = __builtin_amdgcn_alignbit(c2, c1, 16), s2 = __builtin_amdgcn_alignbit(c3, c2, 16), s3 = __builtin_amdgcn_alignbit(c4, c3, 16),
                               s4 = __builtin_amdgcn_alignbit(c5, c4, 16), s5 = __builtin_amdgcn_alignbit(c6, c5, 16), s6 = __builtin_amdgcn_alignbit(c7, c6, 16);
#define HYF(x0, x1, x2, x3) __builtin_bit_cast(bf16x8, (v4u){x0, x1, x2, x3})
                acc[0] = __builtin_amdgcn_mfma_f32_16x16x32_bf16(HYF(c4, c5, c6, c7), zf, acc[0], 0, 0, 0);
                acc[1] = __builtin_amdgcn_mfma_f32_16x16x32_bf16(HYF(s3, s4, s5, s6), zf, acc[1], 0, 0, 0);
                acc[2] = __builtin_amdgcn_mfma_f32_16x16x32_bf16(HYF(c3, c4, c5, c6), zf, acc[2], 0, 0, 0);
                acc[3] = __builtin_amdgcn_mfma_f32_16x16x32_bf16(HYF(s2, s3, s4, s5), zf, acc[3], 0, 0, 0);
                acc[4] = __builtin_amdgcn_mfma_f32_16x16x32_bf16(HYF(c2, c3, c4, c5), zf, acc[4], 0, 0, 0);
                acc[5] = __builtin_amdgcn_mfma_f32_16x16x32_bf16(HYF(s1, s2, s3, s4), zf, acc[5], 0, 0, 0);
                acc[6] = __builtin_amdgcn_mfma_f32_16x16x32_bf16(HYF(c1, c2, c3, c4), zf, acc[6], 0, 0, 0);
                acc[7] = __builtin_amdgcn_mfma_f32_16x16x32_bf16(HYF(s0, s1, s2, s3), zf, acc[7], 0, 0, 0);
#undef HYF
            }
        }
        if (a < NBLK) {
            const float bias = hb[o * HYC + c];
            const size_t grow = (size_t)nb * SEGB + rb0 + a * 128 + 32 * h4;
            const bf16* pp = PT + ((size_t)(512 * (o + 1) + c)) * MR + grow;
            const LAS bf16* zz = Zc + nb * ZB + a * 136 + 32 * h4;
#pragma unroll
            for (int jj = 0; jj < 4; ++jj) { const v4u pw = *(const v4u*)(pp + 8 * jj); const v4u zw = *(const LAS v4u*)(zz + 8 * jj); v4u ow;
#pragma unroll
                for (int k = 0; k < 4; ++k) { const float y0 = acc[2 * k][jj], y1 = acc[2 * k + 1][jj];
                    const float r0 = bf_lo(pw[k]) * (y0 + bf_lo(zw[k]) * bias), r1 = bf_hi(pw[k]) * (y1 + bf_hi(zw[k]) * bias); ow[k] = cvt_pk_bf16(r0, r1); }
                if (o == 0) *(LAS v4u*)(Zn + nb * ZB + a * 136 + 32 * h4 + 8 * jj) = ow;
                else *(v4u*)(YT + (size_t)c * MR + grow + 8 * jj) = ow; }
        }
        __syncthreads();
        { LAS bf16* t_ = Zc; Zc = Zn; Zn = t_; }
    }
}
__device__ __forceinline__ void hyena_phase(Frame& F, int l, bool need_ctx) {
    for (int item = F.vcu; item < HYC / 2; item += F.G) hyena_item<32, 2, 4>(F, l, item);
    if (need_ctx) for (int item = F.vcu; item < HYC / 8; item += F.G) hyena_item<2, 8, 1>(F, l, item);
}

constexpr int NSTEPS = 3 + 12 * DEPTH;
__global__ void __launch_bounds__(NTHR, 2) fwd_kernel(Args args) {
    extern __shared__ __attribute__((aligned(16))) unsigned char lds_raw[];
    Frame F;
    F.lds = (LAS unsigned char*)lds_raw; F.ws = args.ws; F.in = args.in; F.out = args.out;
    F.tid = threadIdx.x; F.lane = F.tid & 63; F.wave = __builtin_amdgcn_readfirstlane(F.tid >> 6);
    F.G = gridDim.x; { const int bx = blockIdx.x; F.vcu = (F.G % 8 == 0) ? (bx % 8) * (F.G / 8) + bx / 8 : bx; }
    volatile LAS unsigned* MISC = (volatile LAS unsigned*)(F.lds + MISC_OFF);
    for (int u = F.tid; u < (LDS_BYTES - LDSCTL_OFF) / 4; u += NTHR) ((LAS unsigned*)(F.lds + LDSCTL_OFF))[u] = 0u;
    __syncthreads();
    const int lo = args.ph_lo, hi = args.ph_hi;
    XcdBarrier bar; bar.bar = (unsigned*)(F.ws + WS_CTL) + CW_BAR; bar.x = 0; bar.st = nullptr;
    if (hi - lo > 1) bar = xcd_barrier_post((unsigned*)(F.ws + WS_CTL) + CW_BAR, MISC + 8);
#define LAUNDER() do { asm volatile("" : "+v"(F.tid), "+v"(F.lane)); asm volatile("" : "+s"(F.wave), "+s"(F.vcu)); asm volatile("" : "+s"(l)); } while (0)
#define IN(k) (lo <= (k) && (k) < hi)
#define SEAM(k) do { if (IN(k) && IN((k) + 1)) xcd_barrier(bar); } while (0)

    if (IN(0)) { pro_mod(F); __syncthreads(); pro_transposes(F); pro_lru_w(F); pro_rope(F); __syncthreads(); pro_hid(F); __syncthreads(); }
    SEAM(0);
    if (IN(1)) { pro_filter<false>(F); }
    SEAM(1);
    if (IN(2)) { pro_filter<true>(F); norm_pass(F, 0, 0); }
    SEAM(2);

    for (int li = 0; li < DEPTH; ++li) {
        int l = li; const int sb = 3 + 12 * li; const bool need_ctx = li < DEPTH - 1;
        if (IN(sb + 0)) { LAUNDER(); pg8::PlainAB ab{WSP(bf16, WS_H), WSP(bf16, WS_WIN) + (size_t)l * DINP * DM, DM, DM}; pg8::StaticOrder S; S.init(MR / 256, DINP / 256, F.G, (int)blockIdx.x);
            pg8::EpiBf16 E{WSP(bf16, WS_U), DINP, nullptr}; pg8::gemm_phase<pg8::EpiBf16, pg8::PlainAB>(F.lds, ab, DM, S, E); }
        SEAM(sb + 0);
        if (IN(sb + 1)) { LAUNDER(); post_u(F, l); }
        SEAM(sb + 1);
        if (IN(sb + 2)) { LAUNDER();
            { pg8::PlainAB ab{WSP(bf16, WS_U) + OFF_Q, WSP(bf16, WS_WUQ) + (size_t)l * DQ * QRANK, DINP, QRANK}; pg8::StaticOrder S; S.init(MR / 256, DQ / 256, F.G, (int)blockIdx.x);
              pg8::EpiBf16 E{WSP(bf16, WS_Q), DQ, WSP(float, WS_RSTD)}; pg8::gemm_phase<pg8::EpiBf16, pg8::PlainAB>(F.lds, ab, QRANK, S, E); }
            { pg8::PlainAB ab{WSP(bf16, WS_U) + OFF_KV, WSP(bf16, WS_WUKV) + (size_t)l * DKV * KVRANK, DINP, KVRANK}; pg8::StaticOrder S; S.init(MR / 256, DKV / 256, F.G, (int)blockIdx.x);
              pg8::EpiBf16 E{WSP(bf16, WS_KV), DKV, WSP(float, WS_RSTD) + MR}; pg8::gemm_phase<pg8::EpiBf16, pg8::PlainAB>(F.lds, ab, KVRANK, S, E); }
            { LruAB ab{WSP(bf16, WS_XR), WSP(bf16, WS_WLRU) + (size_t)l * 2 * 4 * 256 * 512, 128, 512}; pg8::StaticOrder S; S.init(MR / 256, 8, F.G, (int)blockIdx.x);
              EpiGate E{WSP(bf16, WS_XR), WSP(f32x2, WS_AB), F.in[17] + (size_t)l * 2 * LRUC, F.in[19] + (size_t)l * 2 * LRUC, WSP(float, WS_SP) + (size_t)l * 2 * LRUC, F.in[15] + (size_t)l * 2 * 4 * LRUC};
              pg8::gemm_phase<EpiGate, LruAB>(F.lds, ab, 512, S, E); }
        }
        SEAM(sb + 2);
        if (IN(sb + 3)) { LAUNDER(); attn_phase(F, need_ctx); __syncthreads(); hyena_phase(F, l, need_ctx); __syncthreads(); lru_pass1(F); }
        SEAM(sb + 3);
        if (IN(sb + 4)) { LAUNDER(); lru_pass2(F); }
        SEAM(sb + 4);
        if (IN(sb + 5)) { LAUNDER(); mix_finalize(F, l); }
        SEAM(sb + 5);
        if (IN(sb + 6)) { LAUNDER(); pg8::PlainAB ab{WSP(bf16, WS_YMIX), WSP(bf16, WS_WOUT) + (size_t)l * DM * DMIX, DMIX, DMIX}; pg8::StaticOrder S; S.init(MR / 256, DM / 256, F.G, (int)blockIdx.x);
            pg8::EpiBf16 E{WSP(bf16, WS_MO), DM, nullptr}; pg8::gemm_phase<pg8::EpiBf16, pg8::PlainAB>(F.lds, ab, DMIX, S, E); }
        SEAM(sb + 6);
        if (IN(sb + 7)) { LAUNDER(); norm_pass(F, 1, l); }
        SEAM(sb + 7);
        if (IN(sb + 8)) { LAUNDER(); pg8::PlainAB ab{WSP(bf16, WS_H), WSP(bf16, WS_WUP) + (size_t)l * 2 * DFF * DM, DM, DM}; pg8::StaticOrder S; S.init(MR / 256, 2 * DFF / 256, F.G, (int)blockIdx.x);
            pg8::EpiBf16 E{WSP(bf16, WS_UP), 2 * DFF, nullptr}; pg8::gemm_phase<pg8::EpiBf16, pg8::PlainAB>(F.lds, ab, DM, S, E); }
        SEAM(sb + 8);
        if (IN(sb + 9)) { LAUNDER(); conv_gelu(F, l); }
        SEAM(sb + 9);
        if (IN(sb + 10)) { LAUNDER(); pg8::PlainAB ab{WSP(bf16, WS_ACT), WSP(bf16, WS_WDN) + (size_t)l * DM * DFF, DFF, DFF}; pg8::StaticOrder S; S.init(MR / 256, DM / 256, F.G, (int)blockIdx.x);
            pg8::EpiBf16 E{WSP(bf16, WS_MO), DM, nullptr}; pg8::gemm_phase<pg8::EpiBf16, pg8::PlainAB>(F.lds, ab, DFF, S, E); }
        SEAM(sb + 10);
        if (IN(sb + 11)) { LAUNDER(); norm_pass(F, 2, l); }
        SEAM(sb + 11);
    }
#undef IN
#undef SEAM
}

extern "C" void kernel_launch(void* const* d_in, const int* in_sizes, int n_in, void* d_out, int out_size, void* d_ws, size_t ws_size, hipStream_t stream) {
    static int grid = 0;
    if (grid == 0) {
        if (n_in != 30 || ws_size < WS_END) { fprintf(stderr, "kernel_launch: expected 30 inputs and >= %zu bytes of workspace (got %d, %zu)\n", (size_t)WS_END, n_in, ws_size); grid = -1; return; }
        int dev = 0, cus = 0, per_cu = 0;
        if (hipGetDevice(&dev) != hipSuccess || hipDeviceGetAttribute(&cus, hipDeviceAttributeMultiprocessorCount, dev) != hipSuccess) { grid = -1; return; }
        if (hipFuncSetAttribute((const void*)fwd_kernel, hipFuncAttributeMaxDynamicSharedMemorySize, LDS_BYTES) != hipSuccess) { fprintf(stderr, "kernel_launch: hipFuncSetAttribute failed\n"); grid = -1; return; }
        if (hipOccupancyMaxActiveBlocksPerMultiprocessor(&per_cu, (const void*)fwd_kernel, NTHR, LDS_BYTES) != hipSuccess || per_cu < 1) fprintf(stderr, "kernel_launch: occupancy query says %d\n", per_cu);
        (void)hipGetLastError();
        grid = cus;
    }
    if (grid < 0) return;
    (void)hipMemsetAsync((char*)d_ws + WS_CTL, 0, CTL_ZERO_BYTES, stream);
    Args a{};
    for (int i = 0; i < 30; ++i) a.in[i] = (const float*)d_in[i];
    a.out = (float*)d_out; a.ws = (unsigned char*)d_ws;
#if MK_MULTI
    for (int s = 0; s < NSTEPS; ++s) { a.ph_lo = s; a.ph_hi = s + 1; hipLaunchKernelGGL(fwd_kernel, dim3(grid), dim3(NTHR), LDS_BYTES, stream, a); }
#else
    a.ph_lo = 0; a.ph_hi = NSTEPS; hipLaunchKernelGGL(fwd_kernel, dim3(grid), dim3(NTHR), LDS_BYTES, stream, a);
#endif
}
```

```cpp
#include <hip/hip_runtime.h>
#include <cstdio>
#include <cstdint>

#ifndef MK_MULTI
#define MK_MULTI 0
#endif

constexpr int DM = 2048, NBATCH = 2, SEQ = 4096, CTXL = 256, DEPTH = 4;
constexpr int SEGB = CTXL + SEQ;
constexpr int MR = NBATCH * SEGB;
constexpr int DIN = 3392, DINP = 3584;
constexpr int HYC = 512, LRUC = 512, QRANK = 512, KVRANK = 256, NOPE = 128, ROPED = 64, VD = 128, NH = 8;
constexpr int DQ = NH * (NOPE + ROPED);
constexpr int DKV = NH * (NOPE + VD);
constexpr int DFF = 5632, DMIX = 2048;
constexpr int OFF_LRU_G = 1536, OFF_Q = 2048, OFF_LRU_X = 2560, OFF_KV = 3072, OFF_KR = 3328;
constexpr float EPS = 1e-6f;
constexpr int XR_ROWS = 4364;
constexpr int NCHUNK = MR / 64;
constexpr int HYL = 8192, HYLC = 512;

constexpr size_t MiB = 1u << 20;
constexpr size_t WS_CTL = 0, CTL_ZERO_BYTES = 1 * MiB;
constexpr size_t WS_MOD = 1 * MiB;
constexpr size_t WS_ROPE = 2 * MiB;
constexpr size_t WS_HID = 3 * MiB;
constexpr size_t WS_PART = 8 * MiB;
constexpr size_t WS_RSTD = 9 * MiB;
constexpr size_t WS_SP = 9 * MiB + 256 * 1024;
constexpr size_t WS_CARRY = 10 * MiB;
constexpr size_t WS_G = 16 * MiB;
constexpr size_t WS_GC = 80 * MiB;
constexpr size_t WS_WIN = 96 * MiB;
constexpr size_t WS_WUQ = 152 * MiB;
constexpr size_t WS_WUKV = 158 * MiB;
constexpr size_t WS_WOUT = 162 * MiB;
constexpr size_t WS_WUP = 194 * MiB;
constexpr size_t WS_WDN = 370 * MiB;
constexpr size_t WS_WLRU = 458 * MiB;
constexpr size_t WS_X = 480 * MiB;
constexpr size_t WS_H = 548 * MiB;
constexpr size_t WS_U = 582 * MiB;
constexpr size_t WS_Q = 642 * MiB;
constexpr size_t WS_KV = 668 * MiB;
constexpr size_t WS_KR = 702 * MiB;
constexpr size_t WS_O = 704 * MiB;
constexpr size_t WS_PT = 722 * MiB;
constexpr size_t WS_YT = 748 * MiB;
constexpr size_t WS_XR = 757 * MiB;
constexpr size_t WS_AB = 766 * MiB;
constexpr size_t WS_HF = 834 * MiB;
constexpr size_t WS_YL = 851 * MiB;
constexpr size_t WS_YMIX = 868 * MiB;
constexpr size_t WS_MO = 902 * MiB;
constexpr size_t WS_UP = 936 * MiB;
constexpr size_t WS_ACT = 1123 * MiB;
constexpr size_t WS_END = 1217 * MiB;

constexpr int CW_BAR = 4096;

constexpr int NWAVES = 8, NTHR = 512;
constexpr int RING_BYTES = 131072;
constexpr int LDSCTL_OFF = RING_BYTES, MISC_OFF = LDSCTL_OFF + 320;
constexpr int LDS_BYTES = 147456;

#define GAS __attribute__((address_space(1)))
#define LAS __attribute__((address_space(3)))
typedef unsigned short bf16;
typedef unsigned v4u __attribute__((ext_vector_type(4)));
typedef unsigned v2u __attribute__((ext_vector_type(2)));
typedef float f32x4 __attribute__((ext_vector_type(4)));
typedef float f32x2 __attribute__((ext_vector_type(2)));
typedef float f32x16 __attribute__((ext_vector_type(16)));
typedef short bf16x8 __attribute__((ext_vector_type(8)));
typedef short s16x4 __attribute__((ext_vector_type(4)));
typedef GAS unsigned gu32;
#define RLX_AGENT __ATOMIC_RELAXED, __HIP_MEMORY_SCOPE_AGENT
#define LDS_WAIT() asm volatile("s_waitcnt lgkmcnt(0)" ::: "memory")
#define VM_WAIT() asm volatile("s_waitcnt vmcnt(0)" ::: "memory")

__device__ __forceinline__ unsigned cvt_pk_bf16(float lo, float hi) { unsigned r; asm volatile("v_cvt_pk_bf16_f32 %0, %1, %2" : "=v"(r) : "v"(lo), "v"(hi)); return r; }
__device__ __forceinline__ float bf_lo(unsigned w) { return __uint_as_float(w << 16); }
__device__ __forceinline__ float bf_hi(unsigned w) { return __uint_as_float(w & 0xffff0000u); }
__device__ __forceinline__ float bf2f(bf16 v) { return __uint_as_float(((unsigned)v) << 16); }
__device__ __forceinline__ bf16 f2bf(float f) { return (bf16)(cvt_pk_bf16(f, 0.f) & 0xffffu); }
__device__ __forceinline__ float wave_sum(float v) {
#pragma unroll
    for (int o = 1; o < 64; o <<= 1) v += __shfl_xor(v, o);
    return v;
}
__device__ __forceinline__ float sigmoidf_(float x) { return 1.0f / (1.0f + __expf(-x)); }
__device__ __forceinline__ float gelu_tanh(float x) { const float u = 0.7978845608028654f * (x + 0.044715f * x * x * x); return x / (1.0f + __expf(-2.0f * u)); }

#define XB_TMO      128
#define XB_XCNT(j)  (256  + 64 * (j))
#define XB_XSUB(j)  (1280 + 64 * (j))
#define XB_XGEN(j)  (2304 + 64 * (j))
#define XB_TOP      3328
#define XB_TOPGEN   3392
#define XCD_BAR_WORDS 3456
#define XB_SPIN_CAP (1u << 18)
__device__ __forceinline__ unsigned xb_ld(unsigned* p)              { return __hip_atomic_load(p, __ATOMIC_RELAXED, __HIP_MEMORY_SCOPE_AGENT); }
__device__ __forceinline__ unsigned xb_add(unsigned* p, unsigned v) { return __hip_atomic_fetch_add(p, v, __ATOMIC_RELAXED, __HIP_MEMORY_SCOPE_AGENT); }
__device__ __forceinline__ unsigned xb_xcc_id() { return (unsigned)__builtin_amdgcn_s_getreg((3 << 11) | 20) & 0xFu; }
#define XB_SPIN(cond, bar) do { unsigned _sp = 0; while (cond) { __builtin_amdgcn_s_sleep(1); \
    if ((++_sp & 255u) == 0u) { if (xb_ld(&(bar)[XB_TMO])) break; if (_sp > XB_SPIN_CAP) { atomicAdd(&(bar)[XB_TMO], 1u); break; } } } } while (0)
struct XcdBarrier { unsigned* bar; unsigned x; volatile LAS unsigned* st; };
__device__ __forceinline__ XcdBarrier xcd_barrier_post(unsigned* bar, volatile LAS unsigned* st) {
    XcdBarrier b; b.bar = bar; b.x = xb_xcc_id(); b.st = st;
    if (threadIdx.x == 0) (void)xb_add(&bar[XB_XCNT(b.x)], 1u);
    return b;
}
__device__ __forceinline__ void xcd_barrier_complete(unsigned* bar, unsigned x, unsigned& nloc, unsigned& nx) {
    const unsigned G = gridDim.x * gridDim.y * gridDim.z;
    unsigned sum, cnt, mine, sp = 0u;
    for (;;) {
        sum = 0u; cnt = 0u; mine = 0u;
#pragma unroll
        for (unsigned j = 0; j < 16; ++j) { const unsigned c = xb_ld(&bar[XB_XCNT(j)]); sum += c; cnt += (c > 0u) ? 1u : 0u; mine = (j == x) ? c : mine; }
        if (sum == G) break;
        __builtin_amdgcn_s_sleep(1);
        if ((++sp & 255u) == 0u) { if (xb_ld(&bar[XB_TMO])) break; if (sp > XB_SPIN_CAP) { atomicAdd(&bar[XB_TMO], 1u); break; } }
    }
    nloc = mine > 0u ? mine : 1u; nx = cnt > 0u ? cnt : 1u;
}
__device__ __forceinline__ void xcd_barrier(const XcdBarrier& b) {
    asm volatile("s_waitcnt vmcnt(0)" ::: "memory");
    __syncthreads();
    unsigned* bar_l; { unsigned long long w_ = (unsigned long long)b.bar; unsigned wl_ = (unsigned)w_, wh_ = (unsigned)(w_ >> 32); asm volatile("" : "+s"(wl_), "+s"(wh_)); bar_l = (unsigned*)(((unsigned long long)wh_ << 32) | wl_); }
    unsigned x_l = b.x; asm volatile("" : "+s"(x_l));
    if (threadIdx.x == 0) {
        unsigned* bar = bar_l;
        __builtin_amdgcn_s_waitcnt(0);
        unsigned nloc = b.st[0], nx = b.st[1];
        if (nloc == 0u) { xcd_barrier_complete(bar, x_l, nloc, nx); b.st[0] = nloc; b.st[1] = nx; }
        const unsigned old = xb_add(&bar[XB_XSUB(x_l)], 1u);
        const unsigned gen = old / nloc;
        if (old + 1u == (gen + 1u) * nloc) {
            __builtin_amdgcn_fence(__ATOMIC_RELEASE, "agent");
            asm volatile("s_waitcnt vmcnt(0)" ::: "memory");
            const unsigned og = xb_add(&bar[XB_TOP], 1u);
            const unsigned tg = og / nx;
            if (og + 1u == (tg + 1u) * nx) xb_add(&bar[XB_TOPGEN], 1u);
            else XB_SPIN(xb_ld(&bar[XB_TOPGEN]) == tg, bar);
            __builtin_amdgcn_fence(__ATOMIC_ACQUIRE, "agent");
            xb_add(&bar[XB_XGEN(x_l)], 1u);
            asm volatile("s_waitcnt vmcnt(0)" ::: "memory");
        } else {
            XB_SPIN(xb_ld(&bar[XB_XGEN(x_l)]) == gen, bar);
            __builtin_amdgcn_fence(__ATOMIC_ACQUIRE, "agent");
            asm volatile("s_waitcnt vmcnt(0)" ::: "memory");
        }
    }
    __syncthreads();
}

struct Args { const float* in[30]; float* out; unsigned char* ws; int ph_lo, ph_hi; };
struct Frame {
    LAS unsigned char* lds;
    unsigned char* ws;
    const float* const* in;
    float* out;
    int tid, lane, wave, vcu, G;
};
#define WSP(T, off) ((T*)(F.ws + (off)))
__device__ __forceinline__ void row_info(int r, int& b, int& isctx, int& t) { b = r >= SEGB ? 1 : 0; const int j = r - b * SEGB; isctx = j < CTXL ? 1 : 0; t = isctx ? j : j - CTXL; }

namespace pg8 {
constexpr int BM = 256, BK = 64, HALF = 128, HTB = HALF * BK * 2, STAGE_BYTES = 8 * HTB, NXCD = 8, WGM = 8;
__host__ __device__ __forceinline__ int lds_byte(int r, int c) { const int st = (r >> 4) * 2 + (c >> 5), rr = r & 15, cc = c & 31, ob = rr * 64 + cc * 2; return st * 1024 + (ob ^ (((ob >> 9) & 1) << 5)); }
__host__ __device__ __forceinline__ void stage_rc(int b, int& R, int& C) { const int st = b / 1024, sb = b % 1024, swz = sb ^ (((sb >> 9) & 1) << 5); R = (st >> 1) * 16 + swz / 64; C = (st & 1) * 32 + (swz % 64) / 2; }
__host__ __device__ __forceinline__ int perm32(int rho) { const int n = rho >> 4, i = rho & 15; return 8 * (i >> 2) + 4 * n + (i & 3); }
struct Unit { int pm, pn; };
struct StaticOrder {
    int nM, nN, nwg, G, c;
    __host__ __device__ void init(int nM_, int nN_, int G_, int c_) { nM = nM_; nN = nN_; nwg = nM * nN; G = G_; c = c_; }
    __host__ __device__ bool next(int i, Unit& u) const {
        const long L = (long)i * G + c; if (L >= nwg) return false;
        int wgid = (int)L; { const int q = nwg / NXCD, r = nwg % NXCD, xcd = wgid % NXCD, off = wgid / NXCD; wgid = (xcd < r ? xcd * (q + 1) : r * (q + 1) + (xcd - r) * q) + off; }
        const int nig = WGM * nN, gid = wgid / nig, fm = gid * WGM, gsz = (nM - fm) < WGM ? (nM - fm) : WGM;
        u.pm = fm + ((wgid % nig) % gsz); u.pn = (wgid % nig) / gsz; return true;
    }
};
struct PlainAB {
    const bf16* A; const bf16* Bt; int lda, ldb;
    __device__ __forceinline__ const char* a_base(const Unit& u) const { return (const char*)(A + (size_t)u.pm * BM * lda); }
    __device__ __forceinline__ const char* b_base(const Unit& u) const { return (const char*)(Bt + (size_t)u.pn * BM * ldb); }
};
struct EpiBf16 {
    static constexpr bool PERM = true;
    bf16* O; int ldc; const float* rowscale;
    __device__ __forceinline__ void operator()(const f32x4 (&acc)[2][2][4][2], const Unit& u, int wr, int wc, int fr, int fq) const {
        const int row0 = u.pm * BM + wr * 64 + fr; const int col0 = u.pn * BM + wc * 32 + 8 * fq;
#pragma unroll
        for (int ai = 0; ai < 2; ++ai)
#pragma unroll
            for (int m = 0; m < 4; ++m) { const int row = row0 + ai * HALF + m * 16; bf16* rowp = O + (size_t)row * ldc + col0; const float sc = rowscale ? rowscale[row] : 1.0f;
#pragma unroll
                for (int bj = 0; bj < 2; ++bj) { const f32x4 v0 = acc[ai][bj][m][0] * sc, v1 = acc[ai][bj][m][1] * sc;
                    v4u w; w.x = cvt_pk_bf16(v0[0], v0[1]); w.y = cvt_pk_bf16(v0[2], v0[3]); w.z = cvt_pk_bf16(v1[0], v1[1]); w.w = cvt_pk_bf16(v1[2], v1[3]);
                    *(v4u*)(rowp + bj * HALF) = w; } }
    }
};

template <class Epi, class AB, bool ALIGN_EPI = true>
__device__ __forceinline__ void gemm_phase(LAS unsigned char* lds, const AB ab, const int K, const StaticOrder& S, const Epi& E) {
    int tid = threadIdx.x; asm volatile("" : "+v"(tid));
    const int wid = __builtin_amdgcn_readfirstlane(tid >> 6), lane = tid & 63, wr = wid >> 2, wc = wid & 3, fr = lane & 15, fq = lane >> 4;
    const int nt = K / BK;
    unsigned voffA[2], voffB[2];
#pragma unroll
    for (int i = 0; i < 2; ++i) { int R, C; stage_rc(tid * 16 + i * 8192, R, C); const int Rb = Epi::PERM ? ((R & ~31) + perm32(R & 31)) : R;
        voffA[i] = (unsigned)(R * ab.lda + C) * 2u; voffB[i] = (unsigned)(Rb * ab.ldb + C) * 2u; }
    const size_t kstep = (size_t)(BK * 2);
    const size_t hstepA = (size_t)HALF * ab.lda * 2, hstepB = (size_t)HALF * ab.ldb * 2;
    const unsigned ldsw = (unsigned)wid * 1024u;
    const int aoff = lds_byte(wr * 64 + fr, fq * 8), boff = lds_byte(wc * 32 + fr, fq * 8);
#define PG8_SA(b, h) (((b) * 2 + (h)) * HTB)
#define PG8_SB(b, h) ((4 + (b) * 2 + (h)) * HTB)
#define PG8_STAGE(bufoff, gbase, voff) do { _Pragma("unroll") for (int _i = 0; _i < 2; ++_i) \
        __builtin_amdgcn_global_load_lds((const unsigned*)((const char*)(gbase) + (voff)[_i]), (LAS unsigned*)(lds + (bufoff) + ldsw + _i * 8192), 16, 0, 0); } while (0)
#define PG8_LDA(dst, b, h) do { _Pragma("unroll") for (int m = 0; m < 4; ++m) _Pragma("unroll") for (int k = 0; k < 2; ++k) dst[m][k] = *(const LAS bf16x8*)(lds + PG8_SA(b, h) + aoff + m * 2048 + k * 1024); } while (0)
#define PG8_LDB(dst, b, h) do { _Pragma("unroll") for (int n = 0; n < 2; ++n) _Pragma("unroll") for (int k = 0; k < 2; ++k) dst[n][k] = *(const LAS bf16x8*)(lds + PG8_SB(b, h) + boff + n * 2048 + k * 1024); } while (0)
#define PG8_MMA(ai, bj, At, Bt) do { __builtin_amdgcn_s_setprio(1); _Pragma("unroll") for (int m = 0; m < 4; ++m) _Pragma("unroll") for (int n = 0; n < 2; ++n) _Pragma("unroll") for (int k = 0; k < 2; ++k) \
        acc[ai][bj][m][n] = __builtin_amdgcn_mfma_f32_16x16x32_bf16(Bt[n][k], At[m][k], acc[ai][bj][m][n], 0, 0, 0); __builtin_amdgcn_s_setprio(0); } while (0)
#define PG8_WAIT_V(n) asm volatile("s_waitcnt vmcnt(" #n ")" ::: "memory")
#define PG8_WAIT_L(n) asm volatile("s_waitcnt lgkmcnt(" #n ")" ::: "memory")
#define PG8_BAR __builtin_amdgcn_s_barrier()
#define PG8_SCHED __builtin_amdgcn_sched_barrier(0)
    Unit cur, nxt; int ui = 0;
    if (!S.next(0, cur)) return;
    f32x4 acc[2][2][4][2];
#pragma unroll
    for (int a = 0; a < 2; ++a)
#pragma unroll
        for (int b = 0; b < 2; ++b)
#pragma unroll
            for (int m = 0; m < 4; ++m)
#pragma unroll
                for (int n = 0; n < 2; ++n) acc[a][b][m][n] = (f32x4){0.f, 0.f, 0.f, 0.f};
    bf16x8 At[4][2], B0[2][2], B1[2][2];
    const char* cA = ab.a_base(cur); const char* cB = ab.b_base(cur);
    PG8_STAGE(PG8_SB(0, 0), cB, voffB); PG8_STAGE(PG8_SB(0, 1), cB + hstepB, voffB); PG8_STAGE(PG8_SA(0, 0), cA, voffA); PG8_STAGE(PG8_SA(0, 1), cA + hstepA, voffA);
    if (wr == 1) PG8_BAR;
    PG8_WAIT_V(2); PG8_BAR;
    PG8_STAGE(PG8_SB(1, 0), cB + kstep, voffB); PG8_STAGE(PG8_SA(1, 0), cA + kstep, voffA); PG8_STAGE(PG8_SB(1, 1), cB + hstepB + kstep, voffB);
    PG8_WAIT_V(6); PG8_BAR;
    for (;;) {
        const bool has_next = S.next(ui + 1, nxt);
        const char* nA = has_next ? ab.a_base(nxt) : cA; const char* nB = has_next ? ab.b_base(nxt) : cB;
        for (int t = 0; t < nt; t += 2) {
            const bool last = (t == nt - 2);
            const char* a1 = cA + (size_t)(t + 1) * kstep;
            const char* a2 = last ? nA : cA + (size_t)(t + 2) * kstep; const char* b2 = last ? nB : cB + (size_t)(t + 2) * kstep;
            const char* a3 = a2 + kstep; const char* b3 = b2 + kstep;
            PG8_LDB(B0, 0, 0); PG8_LDB(B1, 0, 1); PG8_SCHED; PG8_LDA(At, 0, 0); PG8_STAGE(PG8_SA(1, 1), a1 + hstepA, voffA);
            PG8_WAIT_V(8); PG8_WAIT_L(0); PG8_BAR; PG8_MMA(0, 0, At, B0); PG8_MMA(0, 1, At, B1); PG8_BAR; PG8_SCHED;
            PG8_LDA(At, 0, 1); PG8_STAGE(PG8_SB(0, 0), b2, voffB); PG8_STAGE(PG8_SB(0, 1), b2 + hstepB, voffB); PG8_STAGE(PG8_SA(0, 0), a2, voffA);
            PG8_WAIT_V(8); PG8_WAIT_L(0); PG8_BAR; PG8_MMA(1, 0, At, B0); PG8_MMA(1, 1, At, B1); PG8_BAR; PG8_SCHED;
            PG8_LDB(B0, 1, 0); PG8_LDB(B1, 1, 1); PG8_SCHED; PG8_LDA(At, 1, 0); PG8_STAGE(PG8_SA(0, 1), a2 + hstepA, voffA);
            PG8_WAIT_V(8); PG8_WAIT_L(0); PG8_BAR; PG8_MMA(0, 0, At, B0); PG8_MMA(0, 1, At, B1); PG8_BAR; PG8_SCHED;
            PG8_LDA(At, 1, 1); PG8_STAGE(PG8_SB(1, 0), b3, voffB); PG8_STAGE(PG8_SB(1, 1), b3 + hstepB, voffB); PG8_STAGE(PG8_SA(1, 0), a3, voffA);
            PG8_WAIT_V(8); PG8_WAIT_L(0); PG8_BAR; PG8_MMA(1, 0, At, B0); PG8_MMA(1, 1, At, B1); PG8_BAR; PG8_SCHED;
        }
        if constexpr (ALIGN_EPI) { if (wr == 0) PG8_BAR; }
        E(acc, cur, wr, wc, fr, fq);
        if (!has_next) break;
#pragma unroll
        for (int a = 0; a < 2; ++a)
#pragma unroll
            for (int b = 0; b < 2; ++b)
#pragma unroll
                for (int m = 0; m < 4; ++m)
#pragma unroll
                    for (int n = 0; n < 2; ++n) acc[a][b][m][n] = (f32x4){0.f, 0.f, 0.f, 0.f};
        cur = nxt; cA = nA; cB = nB; ++ui;
        if constexpr (ALIGN_EPI) { if (wr == 1) PG8_BAR; }
    }
    PG8_WAIT_V(0);
    if constexpr (!ALIGN_EPI) { if (wr == 0) PG8_BAR; }
    PG8_BAR;
#undef PG8_SA
#undef PG8_SB
#undef PG8_STAGE
#undef PG8_LDA
#undef PG8_LDB
#undef PG8_MMA
#undef PG8_WAIT_V
#undef PG8_WAIT_L
#undef PG8_BAR
#undef PG8_SCHED
}
}

__device__ __forceinline__ void pro_mod(Frame& F) {
    LAS float* sil = (LAS float*)F.lds;
    LAS float* red = (LAS float*)(F.lds + 24576);
    const float* c = F.in[1]; const float* cc = F.in[3];
    for (int i = F.tid; i < 3 * DM; i += NTHR) { const int w = i / DM, k = i - w * DM; const float v = (w < 2) ? c[w * DM + k] : cc[k]; sil[i] = v / (1.0f + expf(-v)); }
    __syncthreads();
    float* MOD = WSP(float, WS_MOD);
    const int k0 = F.wave * 256;
    for (int unit = F.vcu; unit < DEPTH * 192; unit += F.G) {
        const int l = unit / 192, cg = unit - l * 192;
        const float* W = F.in[4] + (size_t)l * DM * (6 * DM) + cg * 64 + F.lane;
        float a0 = 0.f, a1 = 0.f, a2 = 0.f;
#pragma unroll 16
        for (int k = k0; k < k0 + 256; ++k) { const float w = W[(size_t)k * (6 * DM)]; a0 += sil[k] * w; a1 += sil[DM + k] * w; a2 += sil[2 * DM + k] * w; }
        red[(F.wave * 3 + 0) * 64 + F.lane] = a0; red[(F.wave * 3 + 1) * 64 + F.lane] = a1; red[(F.wave * 3 + 2) * 64 + F.lane] = a2;
        __syncthreads();
        if (F.tid < 192) { const int j = F.tid >> 6, ln = F.tid & 63; float s = 0.f;
#pragma unroll
            for (int w = 0; w < 8; ++w) s += red[(w * 3 + j) * 64 + ln];
            MOD[((size_t)l * 3 + j) * (6 * DM) + cg * 64 + ln] = s + F.in[5][(size_t)l * (6 * DM) + cg * 64 + ln]; }
        __syncthreads();
    }
}

__device__ __forceinline__ void tr_tile(const float* __restrict__ W, int K, int N, bf16* __restrict__ WT, const float* kscale, LAS float* scr, int item, int lane) {
    const int nblk = N >> 5, kb = item / nblk, nb = item - kb * nblk, k0 = kb * 64, n0 = nb * 32;
#pragma unroll
    for (int i = 0; i < 8; ++i) { const int kk = 8 * i + (lane >> 3), c4 = (lane & 7) * 4;
        f32x4 v = *(const f32x4*)(W + (size_t)(k0 + kk) * N + n0 + c4); if (kscale) v = v * kscale[k0 + kk];
        scr[kk * 33 + c4 + 0] = v[0]; scr[kk * 33 + c4 + 1] = v[1]; scr[kk * 33 + c4 + 2] = v[2]; scr[kk * 33 + c4 + 3] = v[3]; }
    LDS_WAIT(); asm volatile("" ::: "memory");
    const int c = lane & 7;
#pragma unroll
    for (int j = 0; j < 4; ++j) { const int n = (lane >> 3) + 8 * j; const LAS float* s = scr + (8 * c) * 33 + n;
        v4u o; o.x = cvt_pk_bf16(s[0], s[33]); o.y = cvt_pk_bf16(s[66], s[99]); o.z = cvt_pk_bf16(s[132], s[165]); o.w = cvt_pk_bf16(s[198], s[231]);
        *(v4u*)(WT + (size_t)(n0 + n) * K + k0 + 8 * c) = o; }
    LDS_WAIT(); asm volatile("" ::: "memory");
}
__device__ __forceinline__ void pro_transposes(Frame& F) {
    LAS float* scr = (LAS float*)(F.lds + F.wave * 16384);
    const int gw = F.vcu * NWAVES + F.wave, NGW = F.G * NWAVES;
    constexpr int I0 = 32 * 106, I1 = 8 * 48, I2 = 4 * 64, I3 = 32 * 64, I4 = 32 * 352, I5 = 88 * 64, IL = I0 + I1 + I2 + I3 + I4 + I5;
    for (int it = gw; it < DEPTH * IL; it += NGW) {
        const int l = it / IL; int r = it - l * IL;
        if (r < I0) { tr_tile(F.in[7] + (size_t)l * DM * DIN, DM, DIN, WSP(bf16, WS_WIN) + (size_t)l * DINP * DM, nullptr, scr, r, F.lane); continue; } r -= I0;
        if (r < I1) { tr_tile(F.in[23] + (size_t)l * QRANK * DQ, QRANK, DQ, WSP(bf16, WS_WUQ) + (size_t)l * DQ * QRANK, F.in[21] + l * QRANK, scr, r, F.lane); continue; } r -= I1;
        if (r < I2) { tr_tile(F.in[24] + (size_t)l * KVRANK * DKV, KVRANK, DKV, WSP(bf16, WS_WUKV) + (size_t)l * DKV * KVRANK, F.in[22] + l * KVRANK, scr, r, F.lane); continue; } r -= I2;
        if (r < I3) { tr_tile(F.in[26] + (size_t)l * DMIX * DM, DMIX, DM, WSP(bf16, WS_WOUT) + (size_t)l * DM * DMIX, nullptr, scr, r, F.lane); continue; } r -= I3;
        if (r < I4) { tr_tile(F.in[27] + (size_t)l * DM * 2 * DFF, DM, 2 * DFF, WSP(bf16, WS_WUP) + (size_t)l * 2 * DFF * DM, nullptr, scr, r, F.lane); continue; } r -= I4;
        tr_tile(F.in[29] + (size_t)l * DFF * DM, DFF, DM, WSP(bf16, WS_WDN) + (size_t)l * DM * DFF, nullptr, scr, r, F.lane);
    }
    { const v4u z = {0u, 0u, 0u, 0u}; constexpr int per = (DINP - DIN) * DM / 8;
      for (int i = F.vcu * NTHR + F.tid; i < DEPTH * per; i += F.G * NTHR) { const int l = i / per, j = i - l * per; *(v4u*)(WSP(bf16, WS_WIN) + ((size_t)l * DINP + DIN) * DM + (size_t)j * 8) = z; } }
}
__device__ __forceinline__ void pro_lru_w(Frame& F) {
    bf16* WL = WSP(bf16, WS_WLRU);
    constexpr int total = DEPTH * 2 * 4 * 256 * 64;
    for (int i = F.vcu * NTHR + F.tid; i < total; i += F.G * NTHR) {
        const int ch = i & 63, row = (i >> 6) & 255, blk = (i >> 14) & 3, dir = (i >> 16) & 1, l = i >> 17;
        const int g = row >> 7, e = row & 127, j4 = ch >> 4, d0 = (ch & 15) * 8;
        const float* Wsrc = (g ? F.in[18] : F.in[16]) + ((((size_t)l * 2 + dir) * 4 + blk) * 128) * 128;
        const float* cw = F.in[15] + (((size_t)l * 2 + dir) * 4 + j4) * LRUC + blk * 128 + d0;
        float v[8];
#pragma unroll
        for (int j = 0; j < 8; ++j) v[j] = cw[j] * Wsrc[(size_t)(d0 + j) * 128 + e];
        v4u o; o.x = cvt_pk_bf16(v[0], v[1]); o.y = cvt_pk_bf16(v[2], v[3]); o.z = cvt_pk_bf16(v[4], v[5]); o.w = cvt_pk_bf16(v[6], v[7]);
        *(v4u*)(WL + (size_t)i * 8) = o;
    }
}
__device__ __forceinline__ void pro_rope(Frame& F) {
    { float* SP = WSP(float, WS_SP); for (int i = F.vcu * NTHR + F.tid; i < DEPTH * 2 * LRUC; i += F.G * NTHR) SP[i] = log1pf(expf(-F.in[20][i])); }
    float* R = WSP(float, WS_ROPE);
    for (int i = F.vcu * NTHR + F.tid; i < SEQ * 32; i += F.G * NTHR) { const int t = i >> 5, f = i & 31; const float pos = (f < 16) ? (float)(t >> 6) : (float)(t & 63);
        const float inv = powf(10000.0f, -(float)(f & 15) / 16.0f); const float a = pos * inv; R[t * 64 + f] = cosf(a); R[t * 64 + 32 + f] = sinf(a); }
}
__device__ __forceinline__ void pro_hid(Frame& F) {
    LAS float* h1 = (LAS float*)(F.lds + F.wave * 16384);
    float* HID = WSP(float, WS_HID);
    const int gw = F.vcu * NWAVES + F.wave, NGW = F.G * NWAVES;
    for (int wi = gw; wi < DEPTH * 68; wi += NGW) {
        const int l = __builtin_amdgcn_readfirstlane(wi / 68), tt = (wi - l * 68) * 64 + F.lane;
        const int L = tt < 4096 ? 4096 : 256, t = tt < 4096 ? tt : tt - 4096;
        const float tn = (float)t / (float)L;
        float sb[16], cb[16];
#pragma unroll
        for (int b = 0; b < 16; ++b) { const float ang = (6.2831855f * tn) * (float)(b + 1); sb[b] = sinf(ang); cb[b] = cosf(ang); }
        const float* w1p = F.in[9] + (size_t)l * 33 * 64; const float* b1p = F.in[10] + l * 64;
        const float* w2p = F.in[11] + (size_t)l * 64 * 64; const float* b2p = F.in[12] + l * 64;
        for (int d = 0; d < 64; ++d) { float a = b1p[d] + tn * w1p[d];
#pragma unroll
            for (int b = 0; b < 16; ++b) a += sb[b] * w1p[(1 + b) * 64 + d] + cb[b] * w1p[(17 + b) * 64 + d];
            h1[d * 64 + F.lane] = sinf(a); }
        LDS_WAIT();
        float* dst = HID + ((size_t)l * 4352 + tt) * 64;
        for (int e = 0; e < 64; ++e) { float a = b2p[e];
#pragma unroll 16
            for (int d = 0; d < 64; ++d) a += h1[d * 64 + F.lane] * w2p[d * 64 + e];
            dst[e] = sinf(a); }
        LDS_WAIT();
    }
}
__device__ __forceinline__ void pro_filter(Frame& F) {
    const float* HID = WSP(float, WS_HID); float* PART = WSP(float, WS_PART);
    LAS float* red = (LAS float*)F.lds;
    constexpr float dmin = 3.0701134573253945f, dstep = (15.350567286626973f - 3.0701134573253945f) / 511.0f;
    for (int item = F.vcu; item < DEPTH * 9 * 4 * 8; item += F.G) {
        int r = item; const int cg = r & 7; r >>= 3; const int od = r & 3; r >>= 2; const int tc = r % 9; const int l = r / 9;
        const int kind = tc == 8 ? 1 : 0, L = kind ? 256 : 4096, t = (kind ? 0 : tc * 512) + F.tid; const bool valid = t < L;
        const int o = od >> 1, dir = od & 1;
        const float* hp = HID + ((size_t)l * 4352 + (kind ? 4096 : 0) + (valid ? t : 0)) * 64;
        const float tn = (float)t / (float)L;
        const float* w3 = F.in[13] + (size_t)l * 64 * 2048 + o * 1024 + dir * 512 + cg * 64;
        float acc[64];
#pragma unroll
        for (int j = 0; j < 64; ++j) acc[j] = 0.f;
        for (int e4 = 0; e4 < 64; e4 += 4) {
            const f32x4 h4 = *(const f32x4*)(hp + e4);
#pragma unroll
            for (int ee = 0; ee < 4; ++ee) { const float* wr = w3 + (size_t)(e4 + ee) * 2048; const float h = h4[ee];
#pragma unroll
                for (int j = 0; j < 64; ++j) acc[j] += h * wr[j]; }
        }
        bf16* gout = kind ? WSP(bf16, WS_GC) + (size_t)l * 512 * 2 * HYLC : WSP(bf16, WS_G) + (size_t)l * 512 * 2 * HYL;
        const int glen = kind ? HYLC : HYL;
        const bool zero0 = (dir == 1 && t == 0); const int idx = zero0 ? 0 : (dir == 0 ? L - t : L + t);
        const float keep = (valid && !zero0) ? 1.0f : 0.0f;
#pragma unroll
        for (int j = 0; j < 64; ++j) { const int c = cg * 64 + j; const float delta = dmin + (float)c * dstep; const float v = acc[j] * __expf(-tn * delta) * keep;
            if (valid) gout[((size_t)c * 2 + o) * glen + idx] = f2bf(v);
            const float a = wave_sum(fabsf(v)); if (F.lane == 0) red[F.wave * 64 + j] = a; }
        __syncthreads();
        if (F.tid < 64) { float s = 0.f;
#pragma unroll
            for (int w = 0; w < 8; ++w) s += red[w * 64 + F.tid];
            PART[((((size_t)l * 2 + kind) * 2 + o) * 2 + dir) * 8 * 512 + (size_t)(kind ? 0 : tc) * 512 + cg * 64 + F.tid] = s; }
        __syncthreads();
    }
}

__device__ __forceinline__ void norm_pass(Frame& F, int mode, int l, bool dry = false) {
    const float* MOD = WSP(float, WS_MOD); float* X = WSP(float, WS_X); bf16* H = dry ? WSP(bf16, WS_UP) : WSP(bf16, WS_H); const bf16* Y = WSP(bf16, WS_MO); float* XO = dry ? WSP(float, WS_ACT) : X;
    const float* ng = F.in[6];
    const int gw = F.vcu * NWAVES + F.wave, NGW = F.G * NWAVES;
    const bool last = (mode == 2 && l == DEPTH - 1);
    for (int r = gw; r < MR; r += NGW) {
        int b, isctx, t; row_info(r, b, isctx, t); const int which = isctx ? 2 : b;
        f32x4 xv[8];
        if (mode == 0) { const float* src = isctx ? F.in[2] + ((size_t)b * CTXL + t) * DM : F.in[0] + ((size_t)b * SEQ + t) * DM;
#pragma unroll
            for (int j = 0; j < 8; ++j) xv[j] = *(const f32x4*)(src + 4 * F.lane + 256 * j);
        } else {
            const float* src = X + (size_t)r * DM; const bf16* yp = Y + (size_t)r * DM;
            f32x4 yv[8]; float ss = 0.f;
#pragma unroll
            for (int j = 0; j < 8; ++j) { xv[j] = *(const f32x4*)(src + 4 * F.lane + 256 * j); const v2u w = *(const v2u*)(yp + 4 * F.lane + 256 * j);
                yv[j] = (f32x4){bf_lo(w.x), bf_hi(w.x), bf_lo(w.y), bf_hi(w.y)}; ss += (yv[j][0] * yv[j][0] + yv[j][1] * yv[j][1]) + (yv[j][2] * yv[j][2] + yv[j][3] * yv[j][3]); }
            ss = wave_sum(ss); const float rs = 1.0f / sqrtf(ss * (1.0f / DM) + EPS);
            const float* gpost = ng + ((size_t)l * 4 + (mode == 1 ? 1 : 3)) * DM; const float* gate = MOD + ((size_t)l * 3 + which) * (6 * DM) + (mode == 1 ? 2 : 5) * DM;
#pragma unroll
            for (int j = 0; j < 8; ++j) { const f32x4 gp = *(const f32x4*)(gpost + 4 * F.lane + 256 * j), gt = *(const f32x4*)(gate + 4 * F.lane + 256 * j); xv[j] += gt * (yv[j] * rs * gp); }
        }
        if (!last) {
            float* dst = XO + (size_t)r * DM;
#pragma unroll
            for (int j = 0; j < 8; ++j) *(f32x4*)(dst + 4 * F.lane + 256 * j) = xv[j];
        } else { if (!isctx) { float* dst = (dry ? XO : F.out) + ((size_t)b * SEQ + t) * DM;
#pragma unroll
            for (int j = 0; j < 8; ++j) *(f32x4*)(dst + 4 * F.lane + 256 * j) = xv[j]; }
            continue; }
        const int ln = (mode == 2) ? l + 1 : l; const float* gpre = ng + ((size_t)ln * 4 + (mode == 1 ? 2 : 0)) * DM;
        const float* md = MOD + ((size_t)ln * 3 + which) * (6 * DM); const float* sh = md + (mode == 1 ? 3 : 0) * DM; const float* sc = md + (mode == 1 ? 4 : 1) * DM;
        float s2 = 0.f;
#pragma unroll
        for (int j = 0; j < 8; ++j) s2 += (xv[j][0] * xv[j][0] + xv[j][1] * xv[j][1]) + (xv[j][2] * xv[j][2] + xv[j][3] * xv[j][3]);
        s2 = wave_sum(s2); const float rs2 = 1.0f / sqrtf(s2 * (1.0f / DM) + EPS);
        bf16* hp = H + (size_t)r * DM;
#pragma unroll
        for (int j = 0; j < 8; ++j) { const int cidx = 4 * F.lane + 256 * j; const f32x4 gp = *(const f32x4*)(gpre + cidx), s4 = *(const f32x4*)(sc + cidx), h4 = *(const f32x4*)(sh + cidx);
            const f32x4 hv = (xv[j] * rs2 * gp) * (s4 + 1.0f) + h4; v2u w; w.x = cvt_pk_bf16(hv[0], hv[1]); w.y = cvt_pk_bf16(hv[2], hv[3]); *(v2u*)(hp + cidx) = w; }
    }
}

__device__ __forceinline__ bool seg_start(int r) { const int j = r % SEGB; return j == 0 || j == CTXL; }
__device__ __forceinline__ void post_u(Frame& F, int l) {
    const bf16* U = WSP(bf16, WS_U); bf16* PT = WSP(bf16, WS_PT);
    const int gw = F.vcu * NWAVES + F.wave, NGW = F.G * NWAVES;
    LAS bf16* tile = (LAS bf16*)(F.lds + F.wave * 16384);
    const float* hw = F.in[8] + (size_t)l * 3 * 1536;
    for (int wi = gw; wi < (MR / 64) * 24; wi += NGW) {
        const int rt = wi / 24, cgp = wi - rt * 24, r0 = rt * 64, c0 = cgp * 64;
        const bool has_prev = !seg_start(r0), has_next = !seg_start(r0 + 64) && (r0 + 64 < MR);
#pragma unroll
        for (int i = 0; i < 9; ++i) { const int tr = 8 * i + (F.lane >> 3), ch = F.lane & 7;
            if (tr < 66) { const int r = r0 - 1 + tr; const bool ok = (tr == 0) ? has_prev : (tr == 65 ? has_next : true);
                v4u v = {0u, 0u, 0u, 0u}; if (ok) v = *(const v4u*)(U + (size_t)r * DINP + c0 + ch * 8);
                *(LAS v4u*)(tile + tr * 64 + ch * 8) = v; } }
        LDS_WAIT();
        const int c = c0 + F.lane; const float w0 = hw[c], w1 = hw[1536 + c], w2 = hw[2 * 1536 + c];
#pragma unroll
        for (int tb = 0; tb < 8; ++tb) { float v[8];
#pragma unroll
            for (int j = 0; j < 8; ++j) { const int tr = 8 * tb + j; v[j] = w0 * bf2f(tile[tr * 64 + F.lane]) + w1 * bf2f(tile[(tr + 1) * 64 + F.lane]) + w2 * bf2f(tile[(tr + 2) * 64 + F.lane]); }
            v4u o; o.x = cvt_pk_bf16(v[0], v[1]); o.y = cvt_pk_bf16(v[2], v[3]); o.z = cvt_pk_bf16(v[4], v[5]); o.w = cvt_pk_bf16(v[6], v[7]);
            *(v4u*)(PT + (size_t)c * MR + r0 + 8 * tb) = o; }
        LDS_WAIT();
    }
    bf16* XR = WSP(bf16, WS_XR); bf16* KR = WSP(bf16, WS_KR); const float* ROPE = WSP(float, WS_ROPE); float* RSTD = WSP(float, WS_RSTD);
    for (int r = gw; r < MR; r += NGW) {
        int b, isctx, t; row_info(r, b, isctx, t);
        const bf16* ur = U + (size_t)r * DINP;
        { const int blk = F.lane >> 4, k = (F.lane & 15) * 8, prow = isctx ? 3 + t : 265 + t;
          *(v4u*)(XR + (((size_t)b * 4 + blk) * XR_ROWS + prow) * 128 + k) = *(const v4u*)(ur + OFF_LRU_X + 8 * F.lane); }
        if (F.lane < 32) { const float x1 = bf2f(ur[OFF_KR + F.lane]), x2 = bf2f(ur[OFF_KR + 32 + F.lane]); float o1 = x1, o2 = x2;
            if (!isctx) { const float cs = ROPE[t * 64 + F.lane], sn = ROPE[t * 64 + 32 + F.lane]; o1 = x1 * cs - x2 * sn; o2 = x2 * cs + x1 * sn; }
            KR[(size_t)r * 64 + F.lane] = f2bf(o1); KR[(size_t)r * 64 + 32 + F.lane] = f2bf(o2); }
        { const v4u w = *(const v4u*)(ur + OFF_Q + 8 * F.lane); float ss = 0.f;
#pragma unroll
          for (int j = 0; j < 4; ++j) { const float a = bf_lo(w[j]), c2 = bf_hi(w[j]); ss += a * a + c2 * c2; }
          ss = wave_sum(ss); if (F.lane == 0) RSTD[r] = 1.0f / sqrtf(ss * (1.0f / QRANK) + EPS); }
        { float ss = 0.f; if (F.lane < 32) { const v4u w = *(const v4u*)(ur + OFF_KV + 8 * F.lane);
#pragma unroll
            for (int j = 0; j < 4; ++j) { const float a = bf_lo(w[j]), c2 = bf_hi(w[j]); ss += a * a + c2 * c2; } }
          ss = wave_sum(ss); if (F.lane == 0) RSTD[MR + r] = 1.0f / sqrtf(ss * (1.0f / KVRANK) + EPS); }
    }
    for (int i = F.vcu * NTHR + F.tid; i < 2 * 4 * 12 * 16; i += F.G * NTHR) { const int ch = i & 15, pi = (i >> 4) % 12, bb = (i >> 4) / 12;
        const int prow = pi < 3 ? pi : (pi < 9 ? 256 + pi : 4352 + pi);
        unsigned zz = 0u; asm volatile("" : "+v"(zz));
        const v4u z = {zz, zz, zz, zz}; *(v4u*)(XR + ((size_t)bb * XR_ROWS + prow) * 128 + ch * 8) = z; }
}

__device__ __forceinline__ void conv_gelu(Frame& F, int l) {
    const bf16* UP = WSP(bf16, WS_UP); bf16* ACT = WSP(bf16, WS_ACT);
    const float* cw = F.in[28] + (size_t)l * 3 * 2 * DFF;
    const int gw = F.vcu * NWAVES + F.wave, NGW = F.G * NWAVES;
    for (int wi = gw; wi < (MR / 8) * 11; wi += NGW) {
        const int rc = wi / 11, fc = wi - rc * 11, r0 = rc * 8, f0 = fc * 512 + 8 * F.lane;
        const bool has_prev = !seg_start(r0), has_next = !seg_start(r0 + 8) && (r0 + 8 < MR);
        v4u g[10], v[10];
#pragma unroll
        for (int i = 0; i < 10; ++i) { const int r = r0 - 1 + i; const bool ok = (i == 0) ? has_prev : (i == 9 ? has_next : true);
            g[i] = (v4u){0u, 0u, 0u, 0u}; v[i] = (v4u){0u, 0u, 0u, 0u};
            if (ok) { g[i] = *(const v4u*)(UP + (size_t)r * (2 * DFF) + f0); v[i] = *(const v4u*)(UP + (size_t)r * (2 * DFF) + DFF + f0); } }
        float wg[3][8], wv[3][8];
#pragma unroll
        for (int j = 0; j < 3; ++j) { const f32x4 a = *(const f32x4*)(cw + (size_t)j * 2 * DFF + f0), b2 = *(const f32x4*)(cw + (size_t)j * 2 * DFF + f0 + 4);
            const f32x4 c2 = *(const f32x4*)(cw + (size_t)j * 2 * DFF + DFF + f0), d2 = *(const f32x4*)(cw + (size_t)j * 2 * DFF + DFF + f0 + 4);
#pragma unroll
            for (int q = 0; q < 4; ++q) { wg[j][q] = a[q]; wg[j][4 + q] = b2[q]; wv[j][q] = c2[q]; wv[j][4 + q] = d2[q]; } }
#pragma unroll
        for (int i = 0; i < 8; ++i) { float o[8];
#pragma unroll
            for (int q = 0; q < 4; ++q) {
                const float ga = wg[0][2 * q] * bf_lo(g[i][q]) + wg[1][2 * q] * bf_lo(g[i + 1][q]) + wg[2][2 * q] * bf_lo(g[i + 2][q]);
                const float gb = wg[0][2 * q + 1] * bf_hi(g[i][q]) + wg[1][2 * q + 1] * bf_hi(g[i + 1][q]) + wg[2][2 * q + 1] * bf_hi(g[i + 2][q]);
                const float va = wv[0][2 * q] * bf_lo(v[i][q]) + wv[1][2 * q] * bf_lo(v[i + 1][q]) + wv[2][2 * q] * bf_lo(v[i + 2][q]);
                const float vb = wv[0][2 * q + 1] * bf_hi(v[i][q]) + wv[1][2 * q + 1] * bf_hi(v[i + 1][q]) + wv[2][2 * q + 1] * bf_hi(v[i + 2][q]);
                o[2 * q] = gelu_tanh(ga) * va; o[2 * q + 1] = gelu_tanh(gb) * vb; }
            v4u w; w.x = cvt_pk_bf16(o[0], o[1]); w.y = cvt_pk_bf16(o[2], o[3]); w.z = cvt_pk_bf16(o[4], o[5]); w.w = cvt_pk_bf16(o[6], o[7]);
            *(v4u*)(ACT + (size_t)(r0 + i) * DFF + f0) = w; }
    }
}

__device__ __forceinline__ void mix_finalize(Frame& F, int l) {
    const bf16* YT = WSP(bf16, WS_YT); const float* YL = WSP(float, WS_YL); const bf16* O = WSP(bf16, WS_O); bf16* YM = WSP(bf16, WS_YMIX);
    const float* hg = F.in[25] + (size_t)l * DMIX;
    const int gw = F.vcu * NWAVES + F.wave, NGW = F.G * NWAVES;
    LAS bf16* st = (LAS bf16*)(F.lds + F.wave * 16384);
    for (int wi = gw; wi < (MR / 64) * 8; wi += NGW) {
        const int rt = wi >> 3, hp = wi & 7, r0 = rt * 64;
        if (hp < 4) {
            const bf16* src = YT + (size_t)(hp * 128) * MR + r0 + F.lane; float ss = 0.f;
#pragma unroll 16
            for (int c = 0; c < 128; ++c) { const float v = bf2f(src[(size_t)c * MR]); ss += v * v; }
            const float rs = 1.0f / sqrtf(ss * (1.0f / 128.0f) + EPS);
            for (int half = 0; half < 2; ++half) {
#pragma unroll 16
                for (int c = 0; c < 64; ++c) { const int cc = half * 64 + c; const float v = bf2f(src[(size_t)cc * MR]) * rs * hg[hp * 128 + cc]; st[F.lane * 66 + c] = f2bf(v); }
                LDS_WAIT();
#pragma unroll 8
                for (int rr = 0; rr < 32; ++rr) { const int row = 2 * rr + (F.lane >> 5); const unsigned w = *(const LAS unsigned*)(st + row * 66 + 2 * (F.lane & 31));
                    *(unsigned*)(YM + (size_t)(r0 + row) * DMIX + hp * 128 + half * 64 + 2 * (F.lane & 31)) = w; }
                LDS_WAIT();
            }
        } else {
            const int q = F.lane & 3;
            for (int ps = 0; ps < 4; ++ps) { const int row = r0 + ps * 16 + (F.lane >> 2);
                const float* src = YL + (size_t)row * LRUC + (hp - 4) * 128 + q * 32; f32x4 v[8]; float ss = 0.f;
#pragma unroll
                for (int j = 0; j < 8; ++j) { v[j] = *(const f32x4*)(src + 4 * j); ss += (v[j][0] * v[j][0] + v[j][1] * v[j][1]) + (v[j][2] * v[j][2] + v[j][3] * v[j][3]); }
                ss += __shfl_xor(ss, 1); ss += __shfl_xor(ss, 2); const float rs = 1.0f / sqrtf(ss * (1.0f / 128.0f) + EPS);
                const float* g = hg + hp * 128 + q * 32; bf16* dst = YM + (size_t)row * DMIX + hp * 128 + q * 32;
#pragma unroll
                for (int j = 0; j < 4; ++j) { const f32x4 g0 = *(const f32x4*)(g + 8 * j), g1 = *(const f32x4*)(g + 8 * j + 4); const f32x4 a = v[2 * j] * rs * g0, b2 = v[2 * j + 1] * rs * g1;
                    v4u w; w.x = cvt_pk_bf16(a[0], a[1]); w.y = cvt_pk_bf16(a[2], a[3]); w.z = cvt_pk_bf16(b2[0], b2[1]); w.w = cvt_pk_bf16(b2[2], b2[3]); *(v4u*)(dst + 8 * j) = w; } }
        }
        {
            const int q = F.lane & 3;
            for (int ps = 0; ps < 4; ++ps) { const int row = r0 + ps * 16 + (F.lane >> 2);
                const bf16* src = O + (size_t)row * (NH * VD) + hp * 128 + q * 32; v4u v[4]; float ss = 0.f;
#pragma unroll
                for (int j = 0; j < 4; ++j) { v[j] = *(const v4u*)(src + 8 * j);
#pragma unroll
                    for (int k = 0; k < 4; ++k) { const float a = bf_lo(v[j][k]), b2 = bf_hi(v[j][k]); ss += a * a + b2 * b2; } }
                ss += __shfl_xor(ss, 1); ss += __shfl_xor(ss, 2); const float rs = 1.0f / sqrtf(ss * (1.0f / 128.0f) + EPS);
                const float* g = hg + (8 + hp) * 128 + q * 32; bf16* dst = YM + (size_t)row * DMIX + (8 + hp) * 128 + q * 32;
#pragma unroll
                for (int j = 0; j < 4; ++j) { const f32x4 g0 = *(const f32x4*)(g + 8 * j), g1 = *(const f32x4*)(g + 8 * j + 4);
                    v4u w; w.x = cvt_pk_bf16(bf_lo(v[j][0]) * rs * g0[0], bf_hi(v[j][0]) * rs * g0[1]); w.y = cvt_pk_bf16(bf_lo(v[j][1]) * rs * g0[2], bf_hi(v[j][1]) * rs * g0[3]);
                    w.z = cvt_pk_bf16(bf_lo(v[j][2]) * rs * g1[0], bf_hi(v[j][2]) * rs * g1[1]); w.w = cvt_pk_bf16(bf_lo(v[j][3]) * rs * g1[2], bf_hi(v[j][3]) * rs * g1[3]); *(v4u*)(dst + 8 * j) = w; } }
        }
    }
}

namespace att {
constexpr int NW = 8, QBLK = 32, KVBLK = 64;
constexpr float SCALE = 0.07216878364870323f;
constexpr float THR = 8.f;
constexpr int LDQ = DQ, LDK = DKV, LDR = ROPED, LDO = NH * VD;
constexpr int SHM_V = KVBLK * 128 * 2, SHM_K = KVBLK * 128 * 2, SHM_R = KVBLK * 64 * 2;
constexpr int OFF_V = 0, OFF_K = 2 * SHM_V, OFF_R = OFF_K + 2 * SHM_K, OFF_WS = OFF_R + 2 * SHM_R, OFF_QR = OFF_WS + NW * 64 * 4, SHM_ATTN = OFF_QR + NW * 4096;
#define KSWZ(row, colB) ((row) * 256 + ((colB) ^ (((row) & 7) << 4)))
#define RSWZ(row, colB) ((row) * 128 + ((colB) ^ (((row) & 7) << 4)))
#define SBAR() __builtin_amdgcn_sched_barrier(0)
__device__ __forceinline__ int crow(int r, int hi) { return (r & 3) + 8 * (r >> 2) + 4 * hi; }
__device__ __forceinline__ void partialSM(f32x16& p0, f32x16& p1, float& m_reg, float& mn, float& alpha) {
  constexpr float C = SCALE * 1.4426950408889634f;
  float pmax = p0[0]; for (int r = 1; r < 16; ++r) pmax = fmaxf(pmax, p0[r]); for (int r = 0; r < 16; ++r) pmax = fmaxf(pmax, p1[r]);
  { auto rr = __builtin_amdgcn_permlane32_swap(__float_as_uint(pmax), __float_as_uint(pmax), false, false);
    pmax = fmaxf(__uint_as_float(rr[0]), __uint_as_float(rr[1])); }
  if (__builtin_expect(__all(pmax - m_reg <= THR / SCALE), 1)) { mn = m_reg; alpha = 1.f; }
  else { mn = fmaxf(m_reg, pmax); alpha = __builtin_amdgcn_exp2f((m_reg - mn) * C); m_reg = mn; }
  float mnC = -mn * C;
  for (int r = 0; r < 16; ++r) p0[r] = fmaf(p0[r], C, mnC); for (int r = 0; r < 16; ++r) p1[r] = fmaf(p1[r], C, mnC);
  for (int r = 0; r < 16; ++r) p0[r] = __builtin_amdgcn_exp2f(p0[r]);
}
__device__ __forceinline__ void finishSM(f32x16& p0, f32x16& p1, float alpha, float& l_reg, bf16x8& pa0, bf16x8& pa1, bf16x8& pa2, bf16x8& pa3) {
  for (int r = 0; r < 16; ++r) p1[r] = __builtin_amdgcn_exp2f(p1[r]);
  float ps = 0; for (int r = 0; r < 16; ++r) ps += p0[r]; for (int r = 0; r < 16; ++r) ps += p1[r];
  { auto rr = __builtin_amdgcn_permlane32_swap(__float_as_uint(ps), __float_as_uint(ps), false, false);
    ps = __uint_as_float(rr[0]) + __uint_as_float(rr[1]); }
  l_reg = l_reg * alpha + ps;
#define PK4(P, BASE, OUT) do { unsigned a0 = cvt_pk_bf16(P[BASE + 0], P[BASE + 1]), a1 = cvt_pk_bf16(P[BASE + 2], P[BASE + 3]);   \
    unsigned b0 = cvt_pk_bf16(P[BASE + 4], P[BASE + 5]), b1 = cvt_pk_bf16(P[BASE + 6], P[BASE + 7]);                              \
    auto r0 = __builtin_amdgcn_permlane32_swap(a0, b0, false, false); auto r1 = __builtin_amdgcn_permlane32_swap(a1, b1, false, false); \
    v4u w = {r0[0], r1[0], r0[1], r1[1]}; OUT = *reinterpret_cast<bf16x8*>(&w); } while (0)
  PK4(p0, 0, pa0); PK4(p0, 8, pa1); PK4(p1, 0, pa2); PK4(p1, 8, pa3);
#undef PK4
}
__device__ __forceinline__ void qkt(f32x16& p0, f32x16& p1, const LAS char* Ks, const LAS char* Rs, const bf16x8* qr, const LAS char* qrl, int r32, int hi) {
  p0 = f32x16{}; p1 = f32x16{};
#pragma unroll
  for (int d0 = 0; d0 < 8; ++d0) { const int cb = (d0 * 16 + hi * 8) * 2;
    bf16x8 b0 = *(const LAS bf16x8*)(Ks + KSWZ(r32, cb));
    bf16x8 b1 = *(const LAS bf16x8*)(Ks + KSWZ(32 + r32, cb));
    p0 = __builtin_amdgcn_mfma_f32_32x32x16_bf16(b0, qr[d0], p0, 0, 0, 0);
    p1 = __builtin_amdgcn_mfma_f32_32x32x16_bf16(b1, qr[d0], p1, 0, 0, 0); }
#pragma unroll
  for (int d0 = 0; d0 < 4; ++d0) { const int cb = (d0 * 16 + hi * 8) * 2;
    bf16x8 b0 = *(const LAS bf16x8*)(Rs + RSWZ(r32, cb));
    bf16x8 b1 = *(const LAS bf16x8*)(Rs + RSWZ(32 + r32, cb));
    const bf16x8 qf = *(const LAS bf16x8*)(qrl + d0 * 1024);
    p0 = __builtin_amdgcn_mfma_f32_32x32x16_bf16(b0, qf, p0, 0, 0, 0);
    p1 = __builtin_amdgcn_mfma_f32_32x32x16_bf16(b1, qf, p1, 0, 0, 0); }
}
__device__ __forceinline__ int v_st(int k, int c) { const int kk = (k & ~0xC) | ((k & 4) << 1) | ((k & 8) >> 1); return ((kk >> 3) * 4 + (c >> 5)) * 512 + ((kk & 7) * 32 + (c & 31)) * 2; }
__device__ __forceinline__ int v_rd_base(int lane) { return ((lane & 3) << 3) | (((lane >> 2) & 3) << 6) | (((lane >> 4) & 1) << 5) | (((lane >> 5) & 1) << 8); }
constexpr int v_rd_off(int d0, int ks, int half) { return d0 * 512 + ks * 4096 + half * 2048; }
template <int OFF> __device__ __forceinline__ s16x4 tr_read(int vb) {
  s16x4 r; asm volatile("ds_read_b64_tr_b16 %0, %1 offset:%2" : "=&v"(r) : "v"(vb), "i"(OFF) : "memory"); return r;
}
template <int D0> __device__ __forceinline__ void pv_one(f32x16& od, int vb, bf16x8 pa0, bf16x8 pa1, bf16x8 pa2, bf16x8 pa3) {
  const s16x4 l0 = tr_read<v_rd_off(D0, 0, 0)>(vb), h0 = tr_read<v_rd_off(D0, 0, 1)>(vb), l1 = tr_read<v_rd_off(D0, 1, 0)>(vb), h1 = tr_read<v_rd_off(D0, 1, 1)>(vb);
  const s16x4 l2 = tr_read<v_rd_off(D0, 2, 0)>(vb), h2 = tr_read<v_rd_off(D0, 2, 1)>(vb), l3 = tr_read<v_rd_off(D0, 3, 0)>(vb), h3 = tr_read<v_rd_off(D0, 3, 1)>(vb);
  asm volatile("s_waitcnt lgkmcnt(0)" ::: "memory"); SBAR();
#define PK(L, H) (bf16x8){L[0], L[1], L[2], L[3], H[0], H[1], H[2], H[3]}
  od = __builtin_amdgcn_mfma_f32_32x32x16_bf16(pa0, PK(l0, h0), od, 0, 0, 0);
  od = __builtin_amdgcn_mfma_f32_32x32x16_bf16(pa1, PK(l1, h1), od, 0, 0, 0);
  od = __builtin_amdgcn_mfma_f32_32x32x16_bf16(pa2, PK(l2, h2), od, 0, 0, 0);
  od = __builtin_amdgcn_mfma_f32_32x32x16_bf16(pa3, PK(l3, h3), od, 0, 0, 0);
#undef PK
}
__device__ __forceinline__ void pv_d0(f32x16* o, int vb, bf16x8 pa0, bf16x8 pa1, bf16x8 pa2, bf16x8 pa3) {
  pv_one<0>(o[0], vb, pa0, pa1, pa2, pa3); pv_one<1>(o[1], vb, pa0, pa1, pa2, pa3); pv_one<2>(o[2], vb, pa0, pa1, pa2, pa3); pv_one<3>(o[3], vb, pa0, pa1, pa2, pa3);
}
__device__ __forceinline__ void attn_body(const bf16* __restrict__ Qb, const bf16* __restrict__ Kh, const bf16* __restrict__ Vh, const bf16* __restrict__ Rh,
                                          bf16* __restrict__ Ob, int seq, const float* rope_tab, LAS char* lds) {
  int tid = threadIdx.x; asm volatile("" : "+v"(tid));
  const int wid = __builtin_amdgcn_readfirstlane(tid >> 6), lane = tid & 63, r32 = lane & 31, hi = lane >> 5;
  LAS char* V_lds = lds + OFF_V; LAS char* K_lds = lds + OFF_K; LAS char* R_lds = lds + OFF_R;
  LAS float* ws = (LAS float*)(lds + OFF_WS) + wid * 64; LAS float* li_l = ws; LAS float* al_l = ws + 32;
  float m_reg = -1e30f, l_reg = 0; f32x16 o[4] = {}; bf16x8 qr[12];
  LAS char* qrl = lds + OFF_QR + wid * 4096 + lane * 16;
  const bf16* Qw = Qb + (long)(wid * QBLK + r32) * LDQ + hi * 8;
#pragma unroll
  for (int d0 = 0; d0 < 12; ++d0) qr[d0] = *reinterpret_cast<const bf16x8*>(Qw + d0 * 16);
  if (rope_tab) {
    const float* rt = rope_tab + (long)(wid * QBLK + r32) * 64;
#pragma unroll
    for (int p = 0; p < 2; ++p) {
      const float* cs = rt + p * 16 + hi * 8; const f32x4 c0 = *(const f32x4*)cs, c1 = *(const f32x4*)(cs + 4), s0 = *(const f32x4*)(cs + 32), s1 = *(const f32x4*)(cs + 36);
      const v4u x1 = *reinterpret_cast<v4u*>(&qr[8 + p]), x2 = *reinterpret_cast<v4u*>(&qr[10 + p]); v4u y1, y2;
#pragma unroll
      for (int k = 0; k < 4; ++k) { const float ca = k < 2 ? c0[2 * k] : c1[2 * k - 4], cbv = k < 2 ? c0[2 * k + 1] : c1[2 * k - 3], sa = k < 2 ? s0[2 * k] : s1[2 * k - 4], sb = k < 2 ? s0[2 * k + 1] : s1[2 * k - 3];
        const float a1 = bf_lo(x1[k]), b1 = bf_hi(x1[k]), a2 = bf_lo(x2[k]), b2 = bf_hi(x2[k]);
        y1[k] = cvt_pk_bf16(a1 * ca - a2 * sa, b1 * cbv - b2 * sb); y2[k] = cvt_pk_bf16(a2 * ca + a1 * sa, b2 * cbv + b1 * sb); }
      qr[8 + p] = *reinterpret_cast<bf16x8*>(&y1); qr[10 + p] = *reinterpret_cast<bf16x8*>(&y2); }
  }
#pragma unroll
  for (int d0 = 0; d0 < 4; ++d0) *(LAS bf16x8*)(qrl + d0 * 1024) = qr[8 + d0];
  const int sr = tid >> 4, sc = (tid & 15) * 8, vst0 = v_st(sr, sc), vst1 = v_st(32 + sr, sc);
  const int rr_ = tid >> 3, rc_ = (tid & 7) * 8;
  const int vb0 = (int)(uintptr_t)V_lds + v_rd_base(lane);
  constexpr int SDEPTH = 1;
  struct { bf16x8 vs0, vs1, ks0, ks1, rs; } sr_[SDEPTH];
  const unsigned offk0 = (unsigned)(sr * LDK + sc), offk1 = (unsigned)((32 + sr) * LDK + sc), offr = (unsigned)(rr_ * LDR + rc_);
#define SLOAD(i, k0) do { const bf16* vt_ = Vh + (size_t)(k0) * LDK; const bf16* kt_ = Kh + (size_t)(k0) * LDK; const bf16* rt_ = Rh + (size_t)(k0) * LDR; \
    sr_[i].vs0 = *(const bf16x8*)(vt_ + offk0); sr_[i].vs1 = *(const bf16x8*)(vt_ + offk1); \
    sr_[i].ks0 = *(const bf16x8*)(kt_ + offk0); sr_[i].ks1 = *(const bf16x8*)(kt_ + offk1); \
    sr_[i].rs = *(const bf16x8*)(rt_ + offr); } while (0)
#define SWRITE(b, i) do { *(LAS bf16x8*)(V_lds + (b) * SHM_V + vst0) = sr_[i].vs0;          \
    *(LAS bf16x8*)(V_lds + (b) * SHM_V + vst1) = sr_[i].vs1; int kc = sc * 2;               \
    *(LAS bf16x8*)(K_lds + (b) * SHM_K + KSWZ(sr, kc)) = sr_[i].ks0;                       \
    *(LAS bf16x8*)(K_lds + (b) * SHM_K + KSWZ(32 + sr, kc)) = sr_[i].ks1;                  \
    *(LAS bf16x8*)(R_lds + (b) * SHM_R + RSWZ(rr_, rc_ * 2)) = sr_[i].rs; } while (0)
#define SWAIT() do { if constexpr (SDEPTH == 2) asm volatile("s_waitcnt vmcnt(5)" ::: "memory"); else asm volatile("s_waitcnt vmcnt(0)" ::: "memory"); } while (0)
#define RESC(a) do { if (__any((a) < 1.f)) { if (hi == 0) al_l[r32] = (a); asm volatile("s_waitcnt lgkmcnt(0)" ::: "memory"); \
    for (int d = 0; d < 4; ++d) for (int r = 0; r < 16; ++r) o[d][r] *= al_l[crow(r, hi)]; } } while (0)
  f32x16 pA0, pA1, pB0, pB1; float mnA, mnB, alA, alB; bf16x8 pa0, pa1, pa2, pa3; const int NT = seq / KVBLK;
  constexpr int SE = 0, SO = SDEPTH - 1;
  SLOAD(SE, 0); asm volatile("s_waitcnt vmcnt(0)" ::: "memory"); SWRITE(0, SE); __syncthreads();
  qkt(pA0, pA1, K_lds, R_lds, qr, qrl, r32, hi); partialSM(pA0, pA1, m_reg, mnA, alA);
  SLOAD(SO, KVBLK); if constexpr (SDEPTH == 2) { if (2 < NT) SLOAD(SE, 2 * KVBLK); }
  SWAIT(); SWRITE(1, SO); __syncthreads();
  for (int j = 1; j + 1 < NT; j += 2) {
    SBAR(); qkt(pB0, pB1, K_lds + SHM_K, R_lds + SHM_R, qr, qrl, r32, hi);
    finishSM(pA0, pA1, alA, l_reg, pa0, pa1, pa2, pa3); SBAR();
    SLOAD(SO, (j + SDEPTH) * KVBLK); SBAR();
    pv_d0(o, vb0, pa0, pa1, pa2, pa3); partialSM(pB0, pB1, m_reg, mnB, alB);
    __syncthreads(); SWAIT(); SWRITE(0, SE);
    RESC(alB); __syncthreads();
    SBAR(); qkt(pA0, pA1, K_lds, R_lds, qr, qrl, r32, hi);
    finishSM(pB0, pB1, alB, l_reg, pa0, pa1, pa2, pa3); SBAR();
    if (SDEPTH == 1 || j + 3 < NT) SLOAD(SE, (j + 1 + SDEPTH) * KVBLK); SBAR();
    pv_d0(o, vb0 + SHM_V, pa0, pa1, pa2, pa3); partialSM(pA0, pA1, m_reg, mnA, alA);
    __syncthreads(); SWAIT(); SWRITE(1, SO);
    RESC(alA); __syncthreads();
  }
  SBAR(); qkt(pB0, pB1, K_lds + SHM_K, R_lds + SHM_R, qr, qrl, r32, hi);
  finishSM(pA0, pA1, alA, l_reg, pa0, pa1, pa2, pa3); SBAR();
  pv_d0(o, vb0, pa0, pa1, pa2, pa3); partialSM(pB0, pB1, m_reg, mnB, alB);
  __syncthreads(); RESC(alB);
  finishSM(pB0, pB1, alB, l_reg, pa0, pa1, pa2, pa3); SBAR();
  pv_d0(o, vb0 + SHM_V, pa0, pa1, pa2, pa3);
  if (hi == 0) li_l[r32] = l_reg; asm volatile("s_waitcnt lgkmcnt(0)" ::: "memory");
  float rli[16];
#pragma unroll
  for (int r = 0; r < 16; ++r) rli[r] = __builtin_amdgcn_rcpf(li_l[crow(r, hi)]);
  bf16* Ow = Ob + (long)(wid * QBLK) * LDO;
#pragma unroll
  for (int r = 0; r < 16; ++r) { const int orow = crow(r, hi);
#pragma unroll
    for (int d0 = 0; d0 < 4; ++d0) Ow[(long)orow * LDO + d0 * 32 + r32] = f2bf(o[d0][r] * rli[r]); }
  __syncthreads();
#undef SLOAD
#undef SWRITE
#undef SWAIT
#undef RESC
}
}

__device__ __forceinline__ void attn_phase(Frame& F, bool need_ctx) {
    const bf16* Q = WSP(bf16, WS_Q); const bf16* KV = WSP(bf16, WS_KV); const bf16* KR = WSP(bf16, WS_KR); bf16* O = WSP(bf16, WS_O); const float* ROPE = WSP(float, WS_ROPE);
    const int nunits = 256 + (need_ctx ? 16 : 0);
    for (int u = F.vcu; u < nunits; u += F.G) {
        if (u < 256) { const int b = u >> 7, h = (u >> 4) & 7, qb = u & 15; const size_t kb = (size_t)b * SEGB, row0 = kb + CTXL + qb * 256;
            att::attn_body(Q + row0 * DQ + h * 192, KV + kb * DKV + h * 256, KV + kb * DKV + h * 256 + 128, KR + kb * ROPED, O + row0 * (NH * VD) + h * 128, SEGB, ROPE + (size_t)qb * 256 * 64, (LAS char*)F.lds);
        } else { const int b = (u - 256) >> 3, h = (u - 256) & 7; const size_t kb = (size_t)b * SEGB;
            att::attn_body(Q + kb * DQ + h * 192, KV + kb * DKV + h * 256, KV + kb * DKV + h * 256 + 128, KR + kb * ROPED, O + kb * (NH * VD) + h * 128, CTXL, nullptr, (LAS char*)F.lds);
        }
    }
}

struct LruAB {
    const bf16* XR; const bf16* Bt; int lda, ldb;
    __device__ __forceinline__ static int prow0(int pm) { const int jt = pm % 17; return jt == 0 ? 3 : 265 + (jt - 1) * 256; }
    __device__ __forceinline__ const char* a_base(const pg8::Unit& u) const { const int b = u.pm / 17, dir = u.pn >> 2, blk = u.pn & 3;
        return (const char*)(XR + (((size_t)b * 4 + blk) * XR_ROWS + prow0(u.pm) - (dir ? 0 : 3)) * 128); }
    __device__ __forceinline__ const char* b_base(const pg8::Unit& u) const { return (const char*)(Bt + (size_t)u.pn * 256 * 512); }
};
struct EpiGate {
    static constexpr bool PERM = false;
    const bf16* XR; f32x2* AB; const float* ba; const float* bx; const float* sp; const float* cw;
    __device__ __forceinline__ void operator()(const f32x4 (&acc)[2][2][4][2], const pg8::Unit& u, int wr, int wc, int fr, int fq) const {
        asm volatile("" : "+v"(fr), "+v"(fq));
        const int dir = u.pn >> 2, blk = u.pn & 3, b = u.pm / 17, p0 = LruAB::prow0(u.pm);
        const bf16* xb = XR + ((size_t)b * 4 + blk) * XR_ROWS * 128;
        f32x2* abb = AB + (size_t)dir * MR * LRUC;
#pragma unroll 1
        for (int n = 0; n < 2; ++n) { const int cl = wc * 32 + 16 * n + 4 * fq, ch = blk * 128 + cl;
            const f32x4 ba4 = *(const f32x4*)(ba + dir * LRUC + ch), bx4 = *(const f32x4*)(bx + dir * LRUC + ch), sp4 = *(const f32x4*)(sp + dir * LRUC + ch) * -8.0f;
            f32x4 cw4[4];
#pragma unroll
            for (int j = 0; j < 4; ++j) cw4[j] = *(const f32x4*)(cw + ((size_t)dir * 4 + j) * LRUC + ch);
#pragma unroll
            for (int ai = 0; ai < 2; ++ai)
#pragma unroll
                for (int m = 0; m < 4; ++m) { const int rl = ai * 128 + wr * 64 + m * 16 + fr, row = u.pm * 256 + rl, pr = p0 + rl + (dir ? 0 : -3);
                    f32x4 xc = {0.f, 0.f, 0.f, 0.f};
#pragma unroll
                    for (int j = 0; j < 4; ++j) { const v2u w = *(const v2u*)(xb + (unsigned)((pr + j) * 128 + cl)); xc[0] += cw4[j][0] * bf_lo(w.x); xc[1] += cw4[j][1] * bf_hi(w.x); xc[2] += cw4[j][2] * bf_lo(w.y); xc[3] += cw4[j][3] * bf_hi(w.y); }
                    const f32x4 rp = (n == 0 ? acc[ai][0][m][0] : acc[ai][0][m][1]) + ba4, ip = (n == 0 ? acc[ai][1][m][0] : acc[ai][1][m][1]) + bx4;
                    f32x4 o0, o1;
#pragma unroll
                    for (int j = 0; j < 4; ++j) { const float rg = sigmoidf_(rp[j]), ig = sigmoidf_(ip[j]); const float la = rg * sp4[j]; const float a = __expf(la);
                        const float x = 2.0f * la;
                        const float ser = -x * (1.0f + x * (0.5f + x * (0.16666667f + x * (0.041666668f + x * (0.008333334f + x * 0.0013888889f)))));
                        const float om = (x > -0.25f) ? ser : (1.0f - __expf(x));
                        const float bb = sqrtf(om) * (ig * xc[j]); if (j < 2) { o0[2 * j] = a; o0[2 * j + 1] = bb; } else { o1[2 * j - 4] = a; o1[2 * j - 3] = bb; } }
                    f32x2* dst = abb + (unsigned)(row * LRUC + ch); *(f32x4*)dst = o0; *(f32x4*)(dst + 2) = o1;
                    asm volatile("" ::: "memory"); }
        }
    }
};
__device__ __forceinline__ void lru_pass1(Frame& F) {
    const f32x2* AB = WSP(f32x2, WS_AB); f32x2* CARRY = WSP(f32x2, WS_CARRY);
    const int gw = F.vcu * NWAVES + F.wave, NGW = F.G * NWAVES;
    for (int wi = gw; wi < 2 * NCHUNK * 8; wi += NGW) {
        const int chg = wi & 7, cg = (wi >> 3) % NCHUNK, dir = wi / (8 * NCHUNK), ch = chg * 64 + F.lane;
        const f32x2* base = AB + ((size_t)dir * MR + cg * 64) * LRUC + ch;
        float h = 0.f, P = 1.f;
#pragma unroll 16
        for (int i = 0; i < 64; ++i) { const int rr = dir ? 63 - i : i; const f32x2 ab = base[(size_t)rr * LRUC]; h = ab.x * h + ab.y; P *= ab.x; }
        CARRY[((size_t)dir * NCHUNK + cg) * LRUC + ch] = (f32x2){P, h};
    }
}
__device__ __forceinline__ void lru_pass2(Frame& F) {
    const f32x2* AB = WSP(f32x2, WS_AB); const f32x2* CARRY = WSP(f32x2, WS_CARRY); const bf16* U = WSP(bf16, WS_U); float* YL = WSP(float, WS_YL);
    const int gw = F.vcu * NWAVES + F.wave, NGW = F.G * NWAVES;
    for (int wi = gw; wi < NCHUNK * 8; wi += NGW) {
        const int chg = wi & 7, cg = wi >> 3, b = cg / 68, jc = cg - b * 68, ch = chg * 64 + F.lane;
        float hf = 0.f, hb = 0.f;
        const f32x2* cf = CARRY + ((size_t)0 * NCHUNK + b * 68) * LRUC + ch; const f32x2* cbk = CARRY + ((size_t)1 * NCHUNK + b * 68) * LRUC + ch;
        for (int k = 0; k < jc; ++k) { const f32x2 c = cf[(size_t)k * LRUC]; hf = c.x * hf + c.y; }
        if (jc < 4) { for (int k = 3; k > jc; --k) { const f32x2 c = cbk[(size_t)k * LRUC]; hb = c.x * hb + c.y; } }
        else { for (int k = 3; k >= 0; --k) { const f32x2 c = cbk[(size_t)k * LRUC]; hb = c.x * hb + c.y; }
               for (int k = 67; k > jc; --k) { const f32x2 c = cbk[(size_t)k * LRUC]; hb = c.x * hb + c.y; } }
        float hfv[64];
        const f32x2* bf_ = AB + ((size_t)0 * MR + cg * 64) * LRUC + ch; const f32x2* bb_ = AB + ((size_t)1 * MR + cg * 64) * LRUC + ch;
#pragma unroll
        for (int i = 0; i < 64; ++i) { const f32x2 ab = bf_[(size_t)i * LRUC]; hf = ab.x * hf + ab.y; hfv[i] = hf; }
#pragma unroll
        for (int i = 63; i >= 0; --i) { const f32x2 ab = bb_[(size_t)i * LRUC]; hb = ab.x * hb + ab.y; const size_t row = (size_t)cg * 64 + i;
            const float g = bf2f(U[row * DINP + OFF_LRU_G + ch]); YL[row * LRUC + ch] = gelu_tanh(g) * (hfv[i] + hb); }
    }
}

template <int NBLK, int NCH, int WPC>
__device__ __forceinline__ void hyena_item(Frame& F, int l, int item) {
    constexpr int L = 128 * NBLK, GLEN = 2 * L, ZB = NBLK * 136 + 64, ZSZ = 2 * ZB;
    constexpr int CH_BYTES = (GLEN + 2 * ZSZ) * 2 + 64;
    static_assert(CH_BYTES % 16 == 0 && NCH * CH_BYTES <= RING_BYTES && NCH * WPC == NWAVES, "hyena LDS map");
    constexpr int TT = WPC * 64;
    const int cs = F.wave / WPC, q = F.wave % WPC, c = item * NCH + cs, tl = F.tid % TT;
    LAS bf16* Gs = (LAS bf16*)(F.lds + cs * CH_BYTES); LAS bf16* Zc = Gs + GLEN; LAS bf16* Zn = Zc + ZSZ; LAS bf16* zero = Zn + ZSZ;
    const bf16* PT = WSP(bf16, WS_PT); bf16* YT = WSP(bf16, WS_YT);
    const bf16* Gg = (NBLK == 32) ? WSP(bf16, WS_G) + ((size_t)l * 512 + c) * 2 * HYL : WSP(bf16, WS_GC) + ((size_t)l * 512 + c) * 2 * HYLC;
    const int rb0 = (NBLK == 32) ? CTXL : 0;
    for (int i = tl; i < 2 * NBLK * 16; i += TT) { const int b = i / (NBLK * 16), rem = i - b * (NBLK * 16), blk = rem >> 4, e8 = rem & 15;
        *(LAS v4u*)(Zc + b * ZB + blk * 136 + e8 * 8) = *(const v4u*)(PT + (size_t)c * MR + b * SEGB + rb0 + blk * 128 + e8 * 8); }
    if (tl < 16) ((LAS unsigned*)zero)[tl] = 0u;
    const int i16 = F.lane & 15, h4 = F.lane >> 4, nb = i16 >> 3, a = 8 * q + (i16 & 7);
    const int mlo = (8 * q - (NBLK - 1)) > -(NBLK - 1) ? (8 * q - (NBLK - 1)) : -(NBLK - 1), mhi = (8 * q + 7) < (NBLK - 1) ? (8 * q + 7) : (NBLK - 1);
    const float* hb = F.in[14] + (size_t)l * 2 * HYC;
    for (int o = 0; o < 2; ++o) {
        for (int i = tl; i < GLEN / 8; i += TT) *(LAS v4u*)(Gs + 8 * i) = *(const v4u*)(Gg + (size_t)o * GLEN + 8 * i);
        __syncthreads();
        f32x4 acc[8];
#pragma unroll
        for (int r = 0; r < 8; ++r) acc[r] = (f32x4){0.f, 0.f, 0.f, 0.f};
        for (int m = mlo; m <= mhi; ++m) {
            const int blk_in = a - m; const bool valid = (a < NBLK) && blk_in >= 0 && blk_in < NBLK;
            const LAS bf16* zp = valid ? (Zc + nb * ZB + blk_in * 136 + 8 * h4) : zero;
            const int zk = valid ? 1 : 0;
            const LAS bf16* gp = Gs + (L - 128 * m + 8 * (h4 - i16));
#pragma unroll
            for (int k0 = 0; k0 < 128; k0 += 32) {
                const bf16x8 zf = *(const LAS bf16x8*)(zp + zk * k0);
                const v4u lo = *(const LAS v4u*)(gp + k0 - 8), hi = *(const LAS v4u*)(gp + k0);
                const unsigned c0 = lo.x, c1 = lo.y, c2 = lo.z, c3 = lo.w, c4 = hi.x, c5 = hi.y, c6 = hi.z, c7 = hi.w;
                const unsigned s0 = __builtin_amdgcn_alignbit(c1, c0, 16), s1 = __builtin_amdgcn_alignbit(c2, c1, 16), s2 = __builtin_amdgcn_alignbit(c3, c2, 16), s3 = __builtin_amdgcn_alignbit(c4, c3, 16),
                               s4 = __builtin_amdgcn_alignbit(c5, c4, 16), s5 = __builtin_amdgcn_alignbit(c6, c5, 16), s6 = __builtin_amdgcn_alignbit(c7, c6, 16);
#define HYF(x0, x1, x2, x3) __builtin_bit_cast(bf16x8, (v4u){x0, x1, x2, x3})
                acc[0] = __builtin_amdgcn_mfma_f32_16x16x32_bf16(HYF(c4, c5, c6, c7), zf, acc[0], 0, 0, 0);
                acc[1] = __builtin_amdgcn_mfma_f32_16x16x32_bf16(HYF(s3, s4, s5, s6), zf, acc[1], 0, 0, 0);
                acc[2] = __builtin_amdgcn_mfma_f32_16x16x32_bf16(HYF(c3, c4, c5, c6), zf, acc[2], 0, 0, 0);
                acc[3] = __builtin_amdgcn_mfma_f32_16x16x32_bf16(HYF(s2, s3, s4, s5), zf, acc[3], 0, 0, 0);
                acc[4] = __builtin_amdgcn_mfma_f32_16x16x32_bf16(HYF(c2, c3, c4, c5), zf, acc[4], 0, 0, 0);
                acc[5] = __builtin_amdgcn_mfma_f32_16x16x32_bf16(HYF(s1, s2, s3, s4), zf, acc[5], 0, 0, 0);
                acc[6] = __builtin_amdgcn_mfma_f32_16x16x32_bf16(HYF(c1, c2, c3, c4), zf, acc[6], 0, 0, 0);
                acc[7] = __builtin_amdgcn_mfma_f32_16x16x32_bf16(HYF(s0, s1, s2, s3), zf, acc[7], 0, 0, 0);
#undef HYF
            }
        }
        if (a < NBLK) {
            const float bias = hb[o * HYC + c];
            float nrm = 0.f; { const float* pb = WSP(float, WS_PART) + ((((size_t)l * 2 + (NBLK == 32 ? 0 : 1)) * 2 + o) * 2) * 8 * 512 + c;
#pragma unroll
                for (int k = 0; k < (NBLK == 32 ? 8 : 1); ++k) nrm += pb[k * 512] + pb[(8 + k) * 512]; }
            const float invn = 1.0f / nrm;
            const size_t grow = (size_t)nb * SEGB + rb0 + a * 128 + 32 * h4;
            const bf16* pp = PT + ((size_t)(512 * (o + 1) + c)) * MR + grow;
            const LAS bf16* zz = Zc + nb * ZB + a * 136 + 32 * h4;
#pragma unroll
            for (int jj = 0; jj < 4; ++jj) { const v4u pw = *(const v4u*)(pp + 8 * jj); const v4u zw = *(const LAS v4u*)(zz + 8 * jj); v4u ow;
#pragma unroll
                for (int k = 0; k < 4; ++k) { const float y0 = acc[2 * k][jj] * invn, y1 = acc[2 * k + 1][jj] * invn;
                    const float r0 = bf_lo(pw[k]) * (y0 + bf_lo(zw[k]) * bias), r1 = bf_hi(pw[k]) * (y1 + bf_hi(zw[k]) * bias); ow[k] = cvt_pk_bf16(r0, r1); }
                if (o == 0) *(LAS v4u*)(Zn + nb * ZB + a * 136 + 32 * h4 + 8 * jj) = ow;
                else *(v4u*)(YT + (size_t)c * MR + grow + 8 * jj) = ow; }
        }
        __syncthreads();
        { LAS bf16* t_ = Zc; Zc = Zn; Zn = t_; }
    }
}
__device__ __forceinline__ void hyena_phase(Frame& F, int l, bool need_ctx) {
    for (int item = F.vcu; item < HYC / 2; item += F.G) hyena_item<32, 2, 4>(F, l, item);
    if (need_ctx) for (int item = F.vcu; item < HYC / 8; item += F.G) hyena_item<2, 8, 1>(F, l, item);
}

constexpr int NSTEPS = 2 + 12 * DEPTH;
#ifndef PROBE_DUP
#define PROBE_DUP 0x0
#endif
#define REP(bit) for (int rep_ = 0; rep_ < (int)((PROBE_DUP >> (bit)) & 1) + 1; ++rep_)
#define LAUNDER() do { asm volatile("" : "+v"(F.tid), "+v"(F.lane)); asm volatile("" : "+s"(F.wave), "+s"(F.vcu)); asm volatile("" : "+s"(l)); \
    { unsigned long long w_ = (unsigned long long)F.ws; unsigned wl_ = (unsigned)w_, wh_ = (unsigned)(w_ >> 32); asm volatile("" : "+s"(wl_), "+s"(wh_)); F.ws = (unsigned char*)(((unsigned long long)wh_ << 32) | wl_); } } while (0)
#define IN(k) (lo <= (k) && (k) < hi)
#define SEAM(k) do { if (IN(k) && IN((k) + 1)) { xcd_barrier(bar); if (PROBE_DUP & (1u << 13)) xcd_barrier(bar); } } while (0)

template <int LI> __device__ __forceinline__ void layer_steps(Frame& F, const XcdBarrier& bar, const int lo, const int hi) {
        int l = LI; constexpr int li = LI;
        constexpr int sb = 2 + 12 * li; constexpr bool need_ctx = li < DEPTH - 1;
        if (IN(sb + 0)) REP(2) { LAUNDER(); pg8::PlainAB ab{WSP(bf16, WS_H), WSP(bf16, WS_WIN) + (size_t)l * DINP * DM, DM, DM}; pg8::StaticOrder S; S.init(MR / 256, DINP / 256, F.G, (int)blockIdx.x);
            pg8::EpiBf16 E{WSP(bf16, WS_U), DINP, nullptr}; pg8::gemm_phase<pg8::EpiBf16, pg8::PlainAB>(F.lds, ab, DM, S, E); }
        SEAM(sb + 0);
        if (IN(sb + 1)) REP(3) { LAUNDER(); post_u(F, l); __syncthreads(); }
        SEAM(sb + 1);
        if (IN(sb + 2)) REP(4) { LAUNDER();
            { pg8::PlainAB ab{WSP(bf16, WS_U) + OFF_Q, WSP(bf16, WS_WUQ) + (size_t)l * DQ * QRANK, DINP, QRANK}; pg8::StaticOrder S; S.init(MR / 256, DQ / 256, F.G, (int)blockIdx.x);
              pg8::EpiBf16 E{WSP(bf16, WS_Q), DQ, WSP(float, WS_RSTD)}; pg8::gemm_phase<pg8::EpiBf16, pg8::PlainAB>(F.lds, ab, QRANK, S, E); }
            { pg8::PlainAB ab{WSP(bf16, WS_U) + OFF_KV, WSP(bf16, WS_WUKV) + (size_t)l * DKV * KVRANK, DINP, KVRANK}; pg8::StaticOrder S; S.init(MR / 256, DKV / 256, F.G, (int)blockIdx.x);
              pg8::EpiBf16 E{WSP(bf16, WS_KV), DKV, WSP(float, WS_RSTD) + MR}; pg8::gemm_phase<pg8::EpiBf16, pg8::PlainAB>(F.lds, ab, KVRANK, S, E); }
            { LruAB ab{WSP(bf16, WS_XR), WSP(bf16, WS_WLRU) + (size_t)l * 2 * 4 * 256 * 512, 128, 512}; pg8::StaticOrder S; S.init(MR / 256, 8, F.G, (int)blockIdx.x);
              EpiGate E{WSP(bf16, WS_XR), WSP(f32x2, WS_AB), F.in[17] + (size_t)l * 2 * LRUC, F.in[19] + (size_t)l * 2 * LRUC, WSP(float, WS_SP) + (size_t)l * 2 * LRUC, F.in[15] + (size_t)l * 2 * 4 * LRUC};
              pg8::gemm_phase<EpiGate, LruAB>(F.lds, ab, 512, S, E); }
        }
        SEAM(sb + 2);
        if (IN(sb + 3)) { LAUNDER(); REP(5) { attn_phase(F, need_ctx); __syncthreads(); } REP(6) { hyena_phase(F, l, need_ctx); __syncthreads(); } REP(7) { lru_pass1(F); } }
        SEAM(sb + 3);
        if (IN(sb + 4)) REP(7) { LAUNDER(); lru_pass2(F); }
        SEAM(sb + 4);
        if (IN(sb + 5)) REP(8) { LAUNDER(); mix_finalize(F, l); __syncthreads(); }
        SEAM(sb + 5);
        if (IN(sb + 6)) REP(9) { LAUNDER(); pg8::PlainAB ab{WSP(bf16, WS_YMIX), WSP(bf16, WS_WOUT) + (size_t)l * DM * DMIX, DMIX, DMIX}; pg8::StaticOrder S; S.init(MR / 256, DM / 256, F.G, (int)blockIdx.x);
            pg8::EpiBf16 E{WSP(bf16, WS_MO), DM, nullptr}; pg8::gemm_phase<pg8::EpiBf16, pg8::PlainAB>(F.lds, ab, DMIX, S, E); }
        SEAM(sb + 6);
        if (IN(sb + 7)) { LAUNDER(); if (PROBE_DUP & (1u << 14)) norm_pass(F, 1, l, true); norm_pass(F, 1, l); }
        SEAM(sb + 7);
        if (IN(sb + 8)) REP(10) { LAUNDER(); pg8::PlainAB ab{WSP(bf16, WS_H), WSP(bf16, WS_WUP) + (size_t)l * 2 * DFF * DM, DM, DM}; pg8::StaticOrder S; S.init(MR / 256, 2 * DFF / 256, F.G, (int)blockIdx.x);
            pg8::EpiBf16 E{WSP(bf16, WS_UP), 2 * DFF, nullptr}; pg8::gemm_phase<pg8::EpiBf16, pg8::PlainAB>(F.lds, ab, DM, S, E); }
        SEAM(sb + 8);
        if (IN(sb + 9)) REP(11) { LAUNDER(); conv_gelu(F, l); }
        SEAM(sb + 9);
        if (IN(sb + 10)) REP(12) { LAUNDER(); pg8::PlainAB ab{WSP(bf16, WS_ACT), WSP(bf16, WS_WDN) + (size_t)l * DM * DFF, DFF, DFF}; pg8::StaticOrder S; S.init(MR / 256, DM / 256, F.G, (int)blockIdx.x);
            pg8::EpiBf16 E{WSP(bf16, WS_MO), DM, nullptr}; pg8::gemm_phase<pg8::EpiBf16, pg8::PlainAB>(F.lds, ab, DFF, S, E); }
        SEAM(sb + 10);
        if (IN(sb + 11)) { LAUNDER(); if (PROBE_DUP & (1u << 14)) norm_pass(F, 2, l, true); norm_pass(F, 2, l); }
        SEAM(sb + 11);
}

__global__ void __launch_bounds__(NTHR, 2) fwd_kernel(Args args) {
    extern __shared__ __attribute__((aligned(16))) unsigned char lds_raw[];
    Frame F;
    F.lds = (LAS unsigned char*)lds_raw; F.ws = args.ws; F.in = args.in; F.out = args.out;
    F.tid = threadIdx.x; F.lane = F.tid & 63; F.wave = __builtin_amdgcn_readfirstlane(F.tid >> 6);
    F.G = gridDim.x; { const int bx = blockIdx.x; F.vcu = (F.G % 8 == 0) ? (bx % 8) * (F.G / 8) + bx / 8 : bx; }
    volatile LAS unsigned* MISC = (volatile LAS unsigned*)(F.lds + MISC_OFF);
    for (int u = F.tid; u < (LDS_BYTES - LDSCTL_OFF) / 4; u += NTHR) ((LAS unsigned*)(F.lds + LDSCTL_OFF))[u] = 0u;
    __syncthreads();
#if MK_MULTI
    const int lo = args.ph_lo, hi = args.ph_hi;
#else
    constexpr int lo = 0, hi = NSTEPS;
#endif
    XcdBarrier bar; bar.bar = (unsigned*)(F.ws + WS_CTL) + CW_BAR; bar.x = 0; bar.st = nullptr;
    if (hi - lo > 1) bar = xcd_barrier_post((unsigned*)(F.ws + WS_CTL) + CW_BAR, MISC + 8);

    if (IN(0)) REP(0) { REP(15) { pro_mod(F); __syncthreads(); } REP(16) { pro_transposes(F); __syncthreads(); } REP(17) { pro_lru_w(F); pro_rope(F); __syncthreads(); } REP(18) { pro_hid(F); __syncthreads(); } }
    SEAM(0);
    if (IN(1)) REP(1) { pro_filter(F); __syncthreads(); norm_pass(F, 0, 0); __syncthreads(); }
    SEAM(1);

    layer_steps<0>(F, bar, lo, hi); layer_steps<1>(F, bar, lo, hi); layer_steps<2>(F, bar, lo, hi); layer_steps<3>(F, bar, lo, hi);
#undef IN
#undef SEAM
}

extern "C" void kernel_launch(void* const* d_in, const int* in_sizes, int n_in, void* d_out, int out_size, void* d_ws, size_t ws_size, hipStream_t stream) {
    static int grid = 0;
    if (grid == 0) {
        if (n_in != 30 || ws_size < WS_END) { fprintf(stderr, "kernel_launch: expected 30 inputs and >= %zu bytes of workspace (got %d, %zu)\n", (size_t)WS_END, n_in, ws_size); grid = -1; return; }
        int dev = 0, cus = 0, per_cu = 0;
        if (hipGetDevice(&dev) != hipSuccess || hipDeviceGetAttribute(&cus, hipDeviceAttributeMultiprocessorCount, dev) != hipSuccess) { grid = -1; return; }
        if (hipFuncSetAttribute((const void*)fwd_kernel, hipFuncAttributeMaxDynamicSharedMemorySize, LDS_BYTES) != hipSuccess) { fprintf(stderr, "kernel_launch: hipFuncSetAttribute failed\n"); grid = -1; return; }
        if (hipOccupancyMaxActiveBlocksPerMultiprocessor(&per_cu, (const void*)fwd_kernel, NTHR, LDS_BYTES) != hipSuccess || per_cu < 1) fprintf(stderr, "kernel_launch: occupancy query says %d\n", per_cu);
        (void)hipGetLastError();
        grid = cus;
    }
    if (grid < 0) return;
    (void)hipMemsetAsync((char*)d_ws + WS_CTL, 0, CTL_ZERO_BYTES, stream);
    Args a{};
    for (int i = 0; i < 30; ++i) a.in[i] = (const float*)d_in[i];
    a.out = (float*)d_out; a.ws = (unsigned char*)d_ws;
#if MK_MULTI
    for (int s = 0; s < NSTEPS; ++s) { a.ph_lo = s; a.ph_hi = s + 1; hipLaunchKernelGGL(fwd_kernel, dim3(grid), dim3(NTHR), LDS_BYTES, stream, a); }
#else
    a.ph_lo = 0; a.ph_hi = NSTEPS; hipLaunchKernelGGL(fwd_kernel, dim3(grid), dim3(NTHR), LDS_BYTES, stream, a);
#endif
}
```

```cpp
#include <hip/hip_runtime.h>
#include <cstdio>
#include <cstdint>

#ifndef MK_MULTI
#define MK_MULTI 0
#endif

constexpr int DM = 2048, NBATCH = 2, SEQ = 4096, CTXL = 256, DEPTH = 4;
constexpr int SEGB = CTXL + SEQ;
constexpr int MR = NBATCH * SEGB;
constexpr int DIN = 3392, DINP = 3584;
constexpr int HYC = 512, LRUC = 512, QRANK = 512, KVRANK = 256, NOPE = 128, ROPED = 64, VD = 128, NH = 8;
constexpr int DQ = NH * (NOPE + ROPED);
constexpr int DKV = NH * (NOPE + VD);
constexpr int DFF = 5632, DMIX = 2048;
constexpr int OFF_LRU_G = 1536, OFF_Q = 2048, OFF_LRU_X = 2560, OFF_KV = 3072, OFF_KR = 3328;
constexpr float EPS = 1e-6f;
constexpr int XR_ROWS = 4364;
constexpr int NCHUNK = MR / 64;
constexpr int HYL = 8192, HYLC = 512;

constexpr size_t MiB = 1u << 20;
constexpr size_t WS_CTL = 0, CTL_ZERO_BYTES = 1 * MiB;
constexpr size_t WS_MOD = 1 * MiB;
constexpr size_t WS_ROPE = 2 * MiB;
constexpr size_t WS_HID = 3 * MiB;
constexpr size_t WS_PART = 8 * MiB;
constexpr size_t WS_RSTD = 9 * MiB;
constexpr size_t WS_SP = 9 * MiB + 256 * 1024;
constexpr size_t WS_CARRY = 10 * MiB;
constexpr size_t WS_G = 16 * MiB;
constexpr size_t WS_GC = 80 * MiB;
constexpr size_t WS_WIN = 96 * MiB;
constexpr size_t WS_WUQ = 152 * MiB;
constexpr size_t WS_WUKV = 158 * MiB;
constexpr size_t WS_WOUT = 162 * MiB;
constexpr size_t WS_WUP = 194 * MiB;
constexpr size_t WS_WDN = 370 * MiB;
constexpr size_t WS_WLRU = 458 * MiB;
constexpr size_t WS_X = 480 * MiB;
constexpr size_t WS_H = 548 * MiB;
constexpr size_t WS_U = 582 * MiB;
constexpr size_t WS_Q = 642 * MiB;
constexpr size_t WS_KV = 668 * MiB;
constexpr size_t WS_KR = 702 * MiB;
constexpr size_t WS_O = 704 * MiB;
constexpr size_t WS_PT = 722 * MiB;
constexpr size_t WS_YT = 748 * MiB;
constexpr size_t WS_XR = 757 * MiB;
constexpr size_t WS_AB = 766 * MiB;
constexpr size_t WS_HF = 834 * MiB;
constexpr size_t WS_YL = 851 * MiB;
constexpr size_t WS_YMIX = 868 * MiB;
constexpr size_t WS_MO = 902 * MiB;
constexpr size_t WS_UP = 936 * MiB;
constexpr size_t WS_ACT = 1123 * MiB;
constexpr size_t WS_SLAB = 1217 * MiB;
constexpr size_t WS_END = 1265 * MiB;

constexpr int CW_BAR = 4096;

constexpr int NWAVES = 8, NTHR = 512;
constexpr int RING_BYTES = 131072;
constexpr int LDSCTL_OFF = RING_BYTES, MISC_OFF = LDSCTL_OFF + 320;
constexpr int LDS_BYTES = 147456;

#define GAS __attribute__((address_space(1)))
#define LAS __attribute__((address_space(3)))
#define CAS __attribute__((address_space(4)))
typedef const float CAS cfloat_c;
typedef unsigned short bf16;
typedef unsigned v4u __attribute__((ext_vector_type(4)));
typedef unsigned v2u __attribute__((ext_vector_type(2)));
typedef float f32x4 __attribute__((ext_vector_type(4)));
typedef float f32x2 __attribute__((ext_vector_type(2)));
typedef float f32x16 __attribute__((ext_vector_type(16)));
typedef short bf16x8 __attribute__((ext_vector_type(8)));
typedef short s16x4 __attribute__((ext_vector_type(4)));
typedef GAS unsigned gu32;
#define RLX_AGENT __ATOMIC_RELAXED, __HIP_MEMORY_SCOPE_AGENT
#define LDS_WAIT() asm volatile("s_waitcnt lgkmcnt(0)" ::: "memory")
#define VM_WAIT() asm volatile("s_waitcnt vmcnt(0)" ::: "memory")

__device__ __forceinline__ unsigned cvt_pk_bf16(float lo, float hi) { unsigned r; asm volatile("v_cvt_pk_bf16_f32 %0, %1, %2" : "=v"(r) : "v"(lo), "v"(hi)); return r; }
__device__ __forceinline__ float bf_lo(unsigned w) { return __uint_as_float(w << 16); }
__device__ __forceinline__ float bf_hi(unsigned w) { return __uint_as_float(w & 0xffff0000u); }
__device__ __forceinline__ float bf2f(bf16 v) { return __uint_as_float(((unsigned)v) << 16); }
__device__ __forceinline__ bf16 f2bf(float f) { return (bf16)(cvt_pk_bf16(f, 0.f) & 0xffffu); }
__device__ __forceinline__ float wave_sum(float v) {
#pragma unroll
    for (int o = 1; o < 64; o <<= 1) v += __shfl_xor(v, o);
    return v;
}
__device__ __forceinline__ float sigmoidf_(float x) { return 1.0f / (1.0f + __expf(-x)); }
__device__ __forceinline__ float gelu_tanh(float x) { const float u = 0.7978845608028654f * (x + 0.044715f * x * x * x); return x / (1.0f + __expf(-2.0f * u)); }

#define XB_TMO      128
#define XB_XCNT(j)  (256  + 64 * (j))
#define XB_XSUB(j)  (1280 + 64 * (j))
#define XB_XGEN(j)  (2304 + 64 * (j))
#define XB_TOP      3328
#define XB_TOPGEN   3392
#define XCD_BAR_WORDS 3456
#define XB_SPIN_CAP (1u << 18)
__device__ __forceinline__ unsigned xb_ld(unsigned* p)              { return __hip_atomic_load(p, __ATOMIC_RELAXED, __HIP_MEMORY_SCOPE_AGENT); }
__device__ __forceinline__ unsigned xb_add(unsigned* p, unsigned v) { return __hip_atomic_fetch_add(p, v, __ATOMIC_RELAXED, __HIP_MEMORY_SCOPE_AGENT); }
__device__ __forceinline__ unsigned xb_xcc_id() { return (unsigned)__builtin_amdgcn_s_getreg((3 << 11) | 20) & 0xFu; }
#define XB_SPIN(cond, bar) do { unsigned _sp = 0; while (cond) { __builtin_amdgcn_s_sleep(1); \
    if ((++_sp & 255u) == 0u) { if (xb_ld(&(bar)[XB_TMO])) break; if (_sp > XB_SPIN_CAP) { atomicAdd(&(bar)[XB_TMO], 1u); break; } } } } while (0)
struct XcdBarrier { unsigned* bar; unsigned x; volatile LAS unsigned* st; };
__device__ __forceinline__ XcdBarrier xcd_barrier_post(unsigned* bar, volatile LAS unsigned* st) {
    XcdBarrier b; b.bar = bar; b.x = xb_xcc_id(); b.st = st;
    if (threadIdx.x == 0) (void)xb_add(&bar[XB_XCNT(b.x)], 1u);
    return b;
}
__device__ __forceinline__ void xcd_barrier_complete(unsigned* bar, unsigned x, unsigned& nloc, unsigned& nx) {
    const unsigned G = gridDim.x * gridDim.y * gridDim.z;
    unsigned sum, cnt, mine, sp = 0u;
    for (;;) {
        sum = 0u; cnt = 0u; mine = 0u;
#pragma unroll
        for (unsigned j = 0; j < 16; ++j) { const unsigned c = xb_ld(&bar[XB_XCNT(j)]); sum += c; cnt += (c > 0u) ? 1u : 0u; mine = (j == x) ? c : mine; }
        if (sum == G) break;
        __builtin_amdgcn_s_sleep(1);
        if ((++sp & 255u) == 0u) { if (xb_ld(&bar[XB_TMO])) break; if (sp > XB_SPIN_CAP) { atomicAdd(&bar[XB_TMO], 1u); break; } }
    }
    nloc = mine > 0u ? mine : 1u; nx = cnt > 0u ? cnt : 1u;
}
__device__ __forceinline__ void xcd_barrier(const XcdBarrier& b) {
    asm volatile("s_waitcnt vmcnt(0)" ::: "memory");
    __syncthreads();
    unsigned* bar_l; { unsigned long long w_ = (unsigned long long)b.bar; unsigned wl_ = (unsigned)w_, wh_ = (unsigned)(w_ >> 32); asm volatile("" : "+s"(wl_), "+s"(wh_)); bar_l = (unsigned*)(((unsigned long long)wh_ << 32) | wl_); }
    unsigned x_l = b.x; asm volatile("" : "+s"(x_l));
    if (threadIdx.x == 0) {
        unsigned* bar = bar_l;
        __builtin_amdgcn_s_waitcnt(0);
        unsigned nloc = b.st[0], nx = b.st[1];
        if (nloc == 0u) { xcd_barrier_complete(bar, x_l, nloc, nx); b.st[0] = nloc; b.st[1] = nx; }
        const unsigned old = xb_add(&bar[XB_XSUB(x_l)], 1u);
        const unsigned gen = old / nloc;
        if (old + 1u == (gen + 1u) * nloc) {
            __builtin_amdgcn_fence(__ATOMIC_RELEASE, "agent");
            asm volatile("s_waitcnt vmcnt(0)" ::: "memory");
            const unsigned og = xb_add(&bar[XB_TOP], 1u);
            const unsigned tg = og / nx;
            if (og + 1u == (tg + 1u) * nx) xb_add(&bar[XB_TOPGEN], 1u);
            else XB_SPIN(xb_ld(&bar[XB_TOPGEN]) == tg, bar);
            __builtin_amdgcn_fence(__ATOMIC_ACQUIRE, "agent");
            xb_add(&bar[XB_XGEN(x_l)], 1u);
            asm volatile("s_waitcnt vmcnt(0)" ::: "memory");
        } else {
            XB_SPIN(xb_ld(&bar[XB_XGEN(x_l)]) == gen, bar);
            __builtin_amdgcn_fence(__ATOMIC_ACQUIRE, "agent");
            asm volatile("s_waitcnt vmcnt(0)" ::: "memory");
        }
    }
    __syncthreads();
}

struct Args { const float* in[30]; float* out; unsigned char* ws; int ph_lo, ph_hi; };
struct Frame {
    LAS unsigned char* lds;
    unsigned char* ws;
    const float* const* in;
    float* out;
    int tid, lane, wave, vcu, G;
};
#define WSP(T, off) ((T*)(F.ws + (off)))
__device__ __forceinline__ void row_info(int r, int& b, int& isctx, int& t) { b = r >= SEGB ? 1 : 0; const int j = r - b * SEGB; isctx = j < CTXL ? 1 : 0; t = isctx ? j : j - CTXL; }

namespace pg8 {
constexpr int BM = 256, BK = 64, HALF = 128, HTB = HALF * BK * 2, STAGE_BYTES = 8 * HTB, NXCD = 8, WGM = 8;
__host__ __device__ __forceinline__ int lds_byte(int r, int c) { const int st = (r >> 4) * 2 + (c >> 5), rr = r & 15, cc = c & 31, ob = rr * 64 + cc * 2; return st * 1024 + (ob ^ (((ob >> 9) & 1) << 5)); }
__host__ __device__ __forceinline__ void stage_rc(int b, int& R, int& C) { const int st = b / 1024, sb = b % 1024, swz = sb ^ (((sb >> 9) & 1) << 5); R = (st >> 1) * 16 + swz / 64; C = (st & 1) * 32 + (swz % 64) / 2; }
__host__ __device__ __forceinline__ int perm32(int rho) { const int n = rho >> 4, i = rho & 15; return 8 * (i >> 2) + 4 * n + (i & 3); }
struct Unit { int pm, pn, ks; };
struct StaticOrder {
    int nM, nN, nwg, G, c;
    __host__ __device__ void init(int nM_, int nN_, int G_, int c_) { nM = nM_; nN = nN_; nwg = nM * nN; G = G_; c = c_; }
    __host__ __device__ bool next(int i, Unit& u) const {
        const long L = (long)i * G + c; if (L >= nwg) return false;
        int wgid = (int)L; { const int q = nwg / NXCD, r = nwg % NXCD, xcd = wgid % NXCD, off = wgid / NXCD; wgid = (xcd < r ? xcd * (q + 1) : r * (q + 1) + (xcd - r) * q) + off; }
        const int nig = WGM * nN, gid = wgid / nig, fm = gid * WGM, gsz = (nM - fm) < WGM ? (nM - fm) : WGM;
        u.pm = fm + ((wgid % nig) % gsz); u.pn = (wgid % nig) / gsz; u.ks = 0; return true;
    }
};
struct LatentOrder : StaticOrder {
    __host__ __device__ bool next(int i, Unit& u) const { if (!StaticOrder::next(i, u)) return false; u.pm = u.pm < 16 ? u.pm + 1 : u.pm + 2; return true; }
};
struct PieceOrder {
    int nN, S, n, G, c;
    __host__ __device__ void init(int nN_, int S_, int G_, int c_) { nN = nN_; S = S_; n = 2 * nN_ * S_; G = G_; c = c_; }
    __host__ __device__ bool next(int i, Unit& u) const { const long L = (long)i * G + c; if (L >= n) return false; const int li = (int)L; u.ks = li % S; u.pn = (li / S) % nN; u.pm = (li / (S * nN)) ? 17 : 0; return true; }
};
struct PieceAB {
    const bf16* A; const bf16* Bt; int lda, ldb, Kp;
    __device__ __forceinline__ const char* a_base(const Unit& u) const { return (const char*)(A + (size_t)u.pm * BM * lda + (size_t)u.ks * Kp); }
    __device__ __forceinline__ const char* b_base(const Unit& u) const { return (const char*)(Bt + (size_t)u.pn * BM * ldb + (size_t)u.ks * Kp); }
};
struct EpiSlab {
    static constexpr bool PERM = false;
    float* slab;
    __device__ __forceinline__ void operator()(const f32x4 (&acc)[2][2][4][2], const Unit& u, int wr, int wc, int fr, int fq) const {
        const int row0 = (u.pm ? 256 : 0) + wr * 64 + fr, col0 = u.pn * BM + wc * 32 + 4 * fq; float* base = slab + (size_t)u.ks * (512 * 2048);
#pragma unroll
        for (int ai = 0; ai < 2; ++ai)
#pragma unroll
            for (int m = 0; m < 4; ++m) { float* rowp = base + (size_t)(row0 + ai * HALF + m * 16) * 2048 + col0;
#pragma unroll
                for (int bj = 0; bj < 2; ++bj)
#pragma unroll
                    for (int n = 0; n < 2; ++n) *(f32x4*)(rowp + bj * HALF + n * 16) = acc[ai][bj][m][n]; }
    }
};
struct PlainAB {
    const bf16* A; const bf16* Bt; int lda, ldb;
    __device__ __forceinline__ const char* a_base(const Unit& u) const { return (const char*)(A + (size_t)u.pm * BM * lda); }
    __device__ __forceinline__ const char* b_base(const Unit& u) const { return (const char*)(Bt + (size_t)u.pn * BM * ldb); }
};
struct EpiBf16 {
    static constexpr bool PERM = true;
    bf16* O; int ldc; const float* rowscale;
    __device__ __forceinline__ void operator()(const f32x4 (&acc)[2][2][4][2], const Unit& u, int wr, int wc, int fr, int fq) const {
        const int row0 = u.pm * BM + wr * 64 + fr; const int col0 = u.pn * BM + wc * 32 + 8 * fq;
#pragma unroll
        for (int ai = 0; ai < 2; ++ai)
#pragma unroll
            for (int m = 0; m < 4; ++m) { const int row = row0 + ai * HALF + m * 16; bf16* rowp = O + (size_t)row * ldc + col0; const float sc = rowscale ? rowscale[row] : 1.0f;
#pragma unroll
                for (int bj = 0; bj < 2; ++bj) { const f32x4 v0 = acc[ai][bj][m][0] * sc, v1 = acc[ai][bj][m][1] * sc;
                    v4u w; w.x = cvt_pk_bf16(v0[0], v0[1]); w.y = cvt_pk_bf16(v0[2], v0[3]); w.z = cvt_pk_bf16(v1[0], v1[1]); w.w = cvt_pk_bf16(v1[2], v1[3]);
                    *(v4u*)(rowp + bj * HALF) = w; } }
    }
};

template <class Epi, class AB, class Sched = StaticOrder, bool ALIGN_EPI = true>
__device__ __forceinline__ void gemm_phase(LAS unsigned char* lds, const AB ab, const int K, const Sched& S, const Epi& E) {
    int tid = threadIdx.x; asm volatile("" : "+v"(tid));
    const int wid = __builtin_amdgcn_readfirstlane(tid >> 6), lane = tid & 63, wr = wid >> 2, wc = wid & 3, fr = lane & 15, fq = lane >> 4;
    const int nt = K / BK;
    unsigned voffA[2], voffB[2];
#pragma unroll
    for (int i = 0; i < 2; ++i) { int R, C; stage_rc(tid * 16 + i * 8192, R, C); const int Rb = Epi::PERM ? ((R & ~31) + perm32(R & 31)) : R;
        voffA[i] = (unsigned)(R * ab.lda + C) * 2u; voffB[i] = (unsigned)(Rb * ab.ldb + C) * 2u; }
    const size_t kstep = (size_t)(BK * 2);
    const size_t hstepA = (size_t)HALF * ab.lda * 2, hstepB = (size_t)HALF * ab.ldb * 2;
    const unsigned ldsw = (unsigned)wid * 1024u;
    const int aoff = lds_byte(wr * 64 + fr, fq * 8), boff = lds_byte(wc * 32 + fr, fq * 8);
#define PG8_SA(b, h) (((b) * 2 + (h)) * HTB)
#define PG8_SB(b, h) ((4 + (b) * 2 + (h)) * HTB)
#define PG8_STAGE(bufoff, gbase, voff) do { _Pragma("unroll") for (int _i = 0; _i < 2; ++_i) \
        __builtin_amdgcn_global_load_lds((const unsigned*)((const char*)(gbase) + (voff)[_i]), (LAS unsigned*)(lds + (bufoff) + ldsw + _i * 8192), 16, 0, 0); } while (0)
#define PG8_LDA(dst, b, h) do { _Pragma("unroll") for (int m = 0; m < 4; ++m) _Pragma("unroll") for (int k = 0; k < 2; ++k) dst[m][k] = *(const LAS bf16x8*)(lds + PG8_SA(b, h) + aoff + m * 2048 + k * 1024); } while (0)
#define PG8_LDB(dst, b, h) do { _Pragma("unroll") for (int n = 0; n < 2; ++n) _Pragma("unroll") for (int k = 0; k < 2; ++k) dst[n][k] = *(const LAS bf16x8*)(lds + PG8_SB(b, h) + boff + n * 2048 + k * 1024); } while (0)
#define PG8_MMA(ai, bj, At, Bt) do { __builtin_amdgcn_s_setprio(1); _Pragma("unroll") for (int m = 0; m < 4; ++m) _Pragma("unroll") for (int n = 0; n < 2; ++n) _Pragma("unroll") for (int k = 0; k < 2; ++k) \
        acc[ai][bj][m][n] = __builtin_amdgcn_mfma_f32_16x16x32_bf16(Bt[n][k], At[m][k], acc[ai][bj][m][n], 0, 0, 0); __builtin_amdgcn_s_setprio(0); } while (0)
#define PG8_WAIT_V(n) asm volatile("s_waitcnt vmcnt(" #n ")" ::: "memory")
#define PG8_WAIT_L(n) asm volatile("s_waitcnt lgkmcnt(" #n ")" ::: "memory")
#define PG8_BAR __builtin_amdgcn_s_barrier()
#define PG8_SCHED __builtin_amdgcn_sched_barrier(0)
    Unit cur, nxt; int ui = 0;
    if (!S.next(0, cur)) return;
    f32x4 acc[2][2][4][2];
#pragma unroll
    for (int a = 0; a < 2; ++a)
#pragma unroll
        for (int b = 0; b < 2; ++b)
#pragma unroll
            for (int m = 0; m < 4; ++m)
#pragma unroll
                for (int n = 0; n < 2; ++n) acc[a][b][m][n] = (f32x4){0.f, 0.f, 0.f, 0.f};
    bf16x8 At[4][2], B0[2][2], B1[2][2];
    const char* cA = ab.a_base(cur); const char* cB = ab.b_base(cur);
    PG8_STAGE(PG8_SB(0, 0), cB, voffB); PG8_STAGE(PG8_SB(0, 1), cB + hstepB, voffB); PG8_STAGE(PG8_SA(0, 0), cA, voffA); PG8_STAGE(PG8_SA(0, 1), cA + hstepA, voffA);
    if (wr == 1) PG8_BAR;
    PG8_WAIT_V(2); PG8_BAR;
    PG8_STAGE(PG8_SB(1, 0), cB + kstep, voffB); PG8_STAGE(PG8_SA(1, 0), cA + kstep, voffA); PG8_STAGE(PG8_SB(1, 1), cB + hstepB + kstep, voffB);
    PG8_WAIT_V(6); PG8_BAR;
    for (;;) {
        const bool has_next = S.next(ui + 1, nxt);
        const char* nA = has_next ? ab.a_base(nxt) : cA; const char* nB = has_next ? ab.b_base(nxt) : cB;
        for (int t = 0; t < nt; t += 2) {
            const bool last = (t == nt - 2);
            const char* a1 = cA + (size_t)(t + 1) * kstep;
            const char* a2 = last ? nA : cA + (size_t)(t + 2) * kstep; const char* b2 = last ? nB : cB + (size_t)(t + 2) * kstep;
            const char* a3 = a2 + kstep; const char* b3 = b2 + kstep;
            PG8_LDB(B0, 0, 0); PG8_LDB(B1, 0, 1); PG8_SCHED; PG8_LDA(At, 0, 0); PG8_STAGE(PG8_SA(1, 1), a1 + hstepA, voffA);
            PG8_WAIT_V(8); PG8_WAIT_L(0); PG8_BAR; PG8_MMA(0, 0, At, B0); PG8_MMA(0, 1, At, B1); PG8_BAR; PG8_SCHED;
            PG8_LDA(At, 0, 1); PG8_STAGE(PG8_SB(0, 0), b2, voffB); PG8_STAGE(PG8_SB(0, 1), b2 + hstepB, voffB); PG8_STAGE(PG8_SA(0, 0), a2, voffA);
            PG8_WAIT_V(8); PG8_WAIT_L(0); PG8_BAR; PG8_MMA(1, 0, At, B0); PG8_MMA(1, 1, At, B1); PG8_BAR; PG8_SCHED;
            PG8_LDB(B0, 1, 0); PG8_LDB(B1, 1, 1); PG8_SCHED; PG8_LDA(At, 1, 0); PG8_STAGE(PG8_SA(0, 1), a2 + hstepA, voffA);
            PG8_WAIT_V(8); PG8_WAIT_L(0); PG8_BAR; PG8_MMA(0, 0, At, B0); PG8_MMA(0, 1, At, B1); PG8_BAR; PG8_SCHED;
            PG8_LDA(At, 1, 1); PG8_STAGE(PG8_SB(1, 0), b3, voffB); PG8_STAGE(PG8_SB(1, 1), b3 + hstepB, voffB); PG8_STAGE(PG8_SA(1, 0), a3, voffA);
            PG8_WAIT_V(8); PG8_WAIT_L(0); PG8_BAR; PG8_MMA(1, 0, At, B0); PG8_MMA(1, 1, At, B1); PG8_BAR; PG8_SCHED;
        }
        if constexpr (ALIGN_EPI) { if (wr == 0) PG8_BAR; }
        E(acc, cur, wr, wc, fr, fq);
        if (!has_next) break;
#pragma unroll
        for (int a = 0; a < 2; ++a)
#pragma unroll
            for (int b = 0; b < 2; ++b)
#pragma unroll
                for (int m = 0; m < 4; ++m)
#pragma unroll
                    for (int n = 0; n < 2; ++n) acc[a][b][m][n] = (f32x4){0.f, 0.f, 0.f, 0.f};
        cur = nxt; cA = nA; cB = nB; ++ui;
        if constexpr (ALIGN_EPI) { if (wr == 1) PG8_BAR; }
    }
    PG8_WAIT_V(0);
    if constexpr (!ALIGN_EPI) { if (wr == 0) PG8_BAR; }
    PG8_BAR;
#undef PG8_SA
#undef PG8_SB
#undef PG8_STAGE
#undef PG8_LDA
#undef PG8_LDB
#undef PG8_MMA
#undef PG8_WAIT_V
#undef PG8_WAIT_L
#undef PG8_BAR
#undef PG8_SCHED
}
}

__device__ __forceinline__ void pro_mod(Frame& F) {
    LAS float* sil = (LAS float*)F.lds;
    LAS float* red = (LAS float*)(F.lds + 24576);
    const float* c = F.in[1]; const float* cc = F.in[3];
    for (int i = F.tid; i < 3 * DM; i += NTHR) { const int w = i / DM, k = i - w * DM; const float v = (w < 2) ? c[w * DM + k] : cc[k]; sil[i] = v / (1.0f + expf(-v)); }
    __syncthreads();
    float* MOD = WSP(float, WS_MOD);
    const int k0 = F.wave * 256;
    for (int unit = F.vcu; unit < DEPTH * 192; unit += F.G) {
        const int l = unit / 192, cg = unit - l * 192;
        const float* W = F.in[4] + (size_t)l * DM * (6 * DM) + cg * 64 + F.lane;
        float a0 = 0.f, a1 = 0.f, a2 = 0.f;
#pragma unroll 16
        for (int k = k0; k < k0 + 256; ++k) { const float w = W[(size_t)k * (6 * DM)]; a0 += sil[k] * w; a1 += sil[DM + k] * w; a2 += sil[2 * DM + k] * w; }
        red[(F.wave * 3 + 0) * 64 + F.lane] = a0; red[(F.wave * 3 + 1) * 64 + F.lane] = a1; red[(F.wave * 3 + 2) * 64 + F.lane] = a2;
        __syncthreads();
        if (F.tid < 192) { const int j = F.tid >> 6, ln = F.tid & 63; float s = 0.f;
#pragma unroll
            for (int w = 0; w < 8; ++w) s += red[(w * 3 + j) * 64 + ln];
            MOD[((size_t)l * 3 + j) * (6 * DM) + cg * 64 + ln] = s + F.in[5][(size_t)l * (6 * DM) + cg * 64 + ln]; }
        __syncthreads();
    }
}

__device__ __forceinline__ void tr_tile(const float* __restrict__ W, int K, int N, bf16* __restrict__ WT, const float* kscale, LAS float* scr, int item, int lane) {
    const int nblk = N >> 5, kb = item / nblk, nb = item - kb * nblk, k0 = kb * 64, n0 = nb * 32;
#pragma unroll
    for (int i = 0; i < 8; ++i) { const int kk = 8 * i + (lane >> 3), c4 = (lane & 7) * 4;
        f32x4 v = *(const f32x4*)(W + (size_t)(k0 + kk) * N + n0 + c4); if (kscale) v = v * kscale[k0 + kk];
        scr[kk * 33 + c4 + 0] = v[0]; scr[kk * 33 + c4 + 1] = v[1]; scr[kk * 33 + c4 + 2] = v[2]; scr[kk * 33 + c4 + 3] = v[3]; }
    LDS_WAIT(); asm volatile("" ::: "memory");
    const int c = lane & 7;
#pragma unroll
    for (int j = 0; j < 4; ++j) { const int n = (lane >> 3) + 8 * j; const LAS float* s = scr + (8 * c) * 33 + n;
        v4u o; o.x = cvt_pk_bf16(s[0], s[33]); o.y = cvt_pk_bf16(s[66], s[99]); o.z = cvt_pk_bf16(s[132], s[165]); o.w = cvt_pk_bf16(s[198], s[231]);
        *(v4u*)(WT + (size_t)(n0 + n) * K + k0 + 8 * c) = o; }
    LDS_WAIT(); asm volatile("" ::: "memory");
}
__device__ __forceinline__ void pro_transposes(Frame& F) {
    LAS float* scr = (LAS float*)(F.lds + F.wave * 16384);
    const int gw = F.vcu * NWAVES + F.wave, NGW = F.G * NWAVES;
    constexpr int I0 = 32 * 106, I1 = 8 * 48, I2 = 4 * 64, I3 = 32 * 64, I4 = 32 * 352, I5 = 88 * 64, IL = I0 + I1 + I2 + I3 + I4 + I5;
    for (int it = gw; it < DEPTH * IL; it += NGW) {
        const int l = it / IL; int r = it - l * IL;
        if (r < I0) { tr_tile(F.in[7] + (size_t)l * DM * DIN, DM, DIN, WSP(bf16, WS_WIN) + (size_t)l * DINP * DM, nullptr, scr, r, F.lane); continue; } r -= I0;
        if (r < I1) { tr_tile(F.in[23] + (size_t)l * QRANK * DQ, QRANK, DQ, WSP(bf16, WS_WUQ) + (size_t)l * DQ * QRANK, F.in[21] + l * QRANK, scr, r, F.lane); continue; } r -= I1;
        if (r < I2) { tr_tile(F.in[24] + (size_t)l * KVRANK * DKV, KVRANK, DKV, WSP(bf16, WS_WUKV) + (size_t)l * DKV * KVRANK, F.in[22] + l * KVRANK, scr, r, F.lane); continue; } r -= I2;
        if (r < I3) { tr_tile(F.in[26] + (size_t)l * DMIX * DM, DMIX, DM, WSP(bf16, WS_WOUT) + (size_t)l * DM * DMIX, nullptr, scr, r, F.lane); continue; } r -= I3;
        if (r < I4) { tr_tile(F.in[27] + (size_t)l * DM * 2 * DFF, DM, 2 * DFF, WSP(bf16, WS_WUP) + (size_t)l * 2 * DFF * DM, nullptr, scr, r, F.lane); continue; } r -= I4;
        tr_tile(F.in[29] + (size_t)l * DFF * DM, DFF, DM, WSP(bf16, WS_WDN) + (size_t)l * DM * DFF, nullptr, scr, r, F.lane);
    }
    { const v4u z = {0u, 0u, 0u, 0u}; constexpr int per = (DINP - DIN) * DM / 8;
      for (int i = F.vcu * NTHR + F.tid; i < DEPTH * per; i += F.G * NTHR) { const int l = i / per, j = i - l * per; *(v4u*)(WSP(bf16, WS_WIN) + ((size_t)l * DINP + DIN) * DM + (size_t)j * 8) = z; } }
}
__device__ __forceinline__ void pro_lru_w(Frame& F) {
    bf16* WL = WSP(bf16, WS_WLRU);
    constexpr int total = DEPTH * 2 * 4 * 256 * 64;
    for (int i = F.vcu * NTHR + F.tid; i < total; i += F.G * NTHR) {
        const int ch = i & 63, row = (i >> 6) & 255, blk = (i >> 14) & 3, dir = (i >> 16) & 1, l = i >> 17;
        const int g = row >> 7, e = row & 127, j4 = ch >> 4, d0 = (ch & 15) * 8;
        const float* Wsrc = (g ? F.in[18] : F.in[16]) + ((((size_t)l * 2 + dir) * 4 + blk) * 128) * 128;
        const float* cw = F.in[15] + (((size_t)l * 2 + dir) * 4 + j4) * LRUC + blk * 128 + d0;
        float v[8];
#pragma unroll
        for (int j = 0; j < 8; ++j) v[j] = cw[j] * Wsrc[(size_t)(d0 + j) * 128 + e];
        v4u o; o.x = cvt_pk_bf16(v[0], v[1]); o.y = cvt_pk_bf16(v[2], v[3]); o.z = cvt_pk_bf16(v[4], v[5]); o.w = cvt_pk_bf16(v[6], v[7]);
        *(v4u*)(WL + (size_t)i * 8) = o;
    }
}
__device__ __forceinline__ void pro_rope(Frame& F) {
    { float* SP = WSP(float, WS_SP); for (int i = F.vcu * NTHR + F.tid; i < DEPTH * 2 * LRUC; i += F.G * NTHR) SP[i] = log1pf(expf(-F.in[20][i])); }
    float* R = WSP(float, WS_ROPE);
    for (int i = F.vcu * NTHR + F.tid; i < SEQ * 32; i += F.G * NTHR) { const int t = i >> 5, f = i & 31; const float pos = (f < 16) ? (float)(t >> 6) : (float)(t & 63);
        const float inv = powf(10000.0f, -(float)(f & 15) / 16.0f); const float a = pos * inv; R[t * 64 + f] = cosf(a); R[t * 64 + 32 + f] = sinf(a); }
}
__device__ __forceinline__ void pro_hid(Frame& F) {
    LAS float* h1 = (LAS float*)(F.lds + F.wave * 16384);
    float* HID = WSP(float, WS_HID);
    const int gw = F.vcu * NWAVES + F.wave, NGW = F.G * NWAVES;
    for (int wi = gw; wi < DEPTH * 68; wi += NGW) {
        const int l = __builtin_amdgcn_readfirstlane(wi / 68), tt = (wi - l * 68) * 64 + F.lane;
        const int L = tt < 4096 ? 4096 : 256, t = tt < 4096 ? tt : tt - 4096;
        const float tn = (float)t / (float)L;
        float sb[16], cb[16];
#pragma unroll
        for (int b = 0; b < 16; ++b) { const float ang = (6.2831855f * tn) * (float)(b + 1); sb[b] = sinf(ang); cb[b] = cosf(ang); }
        const cfloat_c* w1p = (const cfloat_c*)(uintptr_t)(F.in[9] + (size_t)l * 33 * 64); const cfloat_c* b1p = (const cfloat_c*)(uintptr_t)(F.in[10] + l * 64);
        const cfloat_c* w2p = (const cfloat_c*)(uintptr_t)(F.in[11] + (size_t)l * 64 * 64); const cfloat_c* b2p = (const cfloat_c*)(uintptr_t)(F.in[12] + l * 64);
        for (int d = 0; d < 64; ++d) { float a = b1p[d] + tn * w1p[d];
#pragma unroll
            for (int b = 0; b < 16; ++b) a += sb[b] * w1p[(1 + b) * 64 + d] + cb[b] * w1p[(17 + b) * 64 + d];
            h1[d * 64 + F.lane] = sinf(a); }
        LDS_WAIT();
        float* dst = HID + ((size_t)l * 4352 + tt) * 64;
        for (int e = 0; e < 64; ++e) { float a = b2p[e];
#pragma unroll 16
            for (int d = 0; d < 64; ++d) a += h1[d * 64 + F.lane] * w2p[d * 64 + e];
            dst[e] = sinf(a); }
        LDS_WAIT();
    }
}
__device__ __forceinline__ void pro_filter(Frame& F) {
    const float* HID = WSP(float, WS_HID); float* PART = WSP(float, WS_PART);
    LAS float* red = (LAS float*)F.lds;
    constexpr float dmin = 3.0701134573253945f, dstep = (15.350567286626973f - 3.0701134573253945f) / 511.0f;
    for (int item = F.vcu; item < DEPTH * 9 * 4 * 8; item += F.G) {
        int r = item; const int cg = r & 7; r >>= 3; const int od = r & 3; r >>= 2; const int tc = r % 9; const int l = r / 9;
        const int kind = tc == 8 ? 1 : 0, L = kind ? 256 : 4096, t = (kind ? 0 : tc * 512) + F.tid; const bool valid = t < L;
        const int o = od >> 1, dir = od & 1;
        const float* hp = HID + ((size_t)l * 4352 + (kind ? 4096 : 0) + (valid ? t : 0)) * 64;
        const float tn = (float)t / (float)L;
        const cfloat_c* w3 = (const cfloat_c*)(uintptr_t)(F.in[13] + (size_t)l * 64 * 2048 + o * 1024 + dir * 512 + cg * 64);
        float acc[64];
#pragma unroll
        for (int j = 0; j < 64; ++j) acc[j] = 0.f;
        for (int e4 = 0; e4 < 64; e4 += 4) {
            const f32x4 h4 = *(const f32x4*)(hp + e4);
#pragma unroll
            for (int ee = 0; ee < 4; ++ee) { const cfloat_c* wr = w3 + (size_t)(e4 + ee) * 2048; const float h = h4[ee];
#pragma unroll
                for (int j = 0; j < 64; ++j) acc[j] += h * wr[j]; }
        }
        bf16* gout = kind ? WSP(bf16, WS_GC) + (size_t)l * 512 * 2 * HYLC : WSP(bf16, WS_G) + (size_t)l * 512 * 2 * HYL;
        const int glen = kind ? HYLC : HYL;
        const bool zero0 = (dir == 1 && t == 0); const int idx = zero0 ? 0 : (dir == 0 ? L - t : L + t);
        const float keep = (valid && !zero0) ? 1.0f : 0.0f;
#pragma unroll
        for (int j = 0; j < 64; ++j) { const int c = cg * 64 + j; const float delta = dmin + (float)c * dstep; const float v = acc[j] * __expf(-tn * delta) * keep;
            if (valid) gout[((size_t)c * 2 + o) * glen + idx] = f2bf(v);
            const float a = wave_sum(fabsf(v)); if (F.lane == 0) red[F.wave * 64 + j] = a; }
        __syncthreads();
        if (F.tid < 64) { float s = 0.f;
#pragma unroll
            for (int w = 0; w < 8; ++w) s += red[w * 64 + F.tid];
            PART[((((size_t)l * 2 + kind) * 2 + o) * 2 + dir) * 8 * 512 + (size_t)(kind ? 0 : tc) * 512 + cg * 64 + F.tid] = s; }
        __syncthreads();
    }
}

__device__ __forceinline__ void norm_pass(Frame& F, int mode, int l, bool dry = false) {
    const float* MOD = WSP(float, WS_MOD); float* X = WSP(float, WS_X); bf16* H = dry ? WSP(bf16, WS_UP) : WSP(bf16, WS_H); const bf16* Y = WSP(bf16, WS_MO); float* XO = dry ? WSP(float, WS_ACT) : X;
    const float* ng = F.in[6];
    const int gw = F.vcu * NWAVES + F.wave, NGW = F.G * NWAVES;
    const bool last = (mode == 2 && l == DEPTH - 1);
    for (int r = gw; r < MR; r += NGW) {
        int b, isctx, t; row_info(r, b, isctx, t); const int which = isctx ? 2 : b;
        f32x4 xv[8];
        if (mode == 0) { const float* src = isctx ? F.in[2] + ((size_t)b * CTXL + t) * DM : F.in[0] + ((size_t)b * SEQ + t) * DM;
#pragma unroll
            for (int j = 0; j < 8; ++j) xv[j] = *(const f32x4*)(src + 4 * F.lane + 256 * j);
        } else {
            if (isctx && l == DEPTH - 1) continue;
            const float* src = X + (size_t)r * DM; const bf16* yp = Y + (size_t)r * DM;
            f32x4 yv[8]; float ss = 0.f;
            if (!isctx) {
#pragma unroll
                for (int j = 0; j < 8; ++j) { const v2u w = *(const v2u*)(yp + 4 * F.lane + 256 * j); yv[j] = (f32x4){bf_lo(w.x), bf_hi(w.x), bf_lo(w.y), bf_hi(w.y)}; }
            } else {
                const float* sp_ = WSP(float, WS_SLAB) + (size_t)(b * CTXL + t) * DM; const int ns = (mode == 1) ? 8 : 11;
#pragma unroll
                for (int j = 0; j < 8; ++j) yv[j] = (f32x4){0.f, 0.f, 0.f, 0.f};
                for (int s = 0; s < ns; ++s) {
#pragma unroll
                    for (int j = 0; j < 8; ++j) yv[j] += *(const f32x4*)(sp_ + (size_t)s * (512 * DM) + 4 * F.lane + 256 * j); }
            }
#pragma unroll
            for (int j = 0; j < 8; ++j) { xv[j] = *(const f32x4*)(src + 4 * F.lane + 256 * j);
                ss += (yv[j][0] * yv[j][0] + yv[j][1] * yv[j][1]) + (yv[j][2] * yv[j][2] + yv[j][3] * yv[j][3]); }
            ss = wave_sum(ss); const float rs = 1.0f / sqrtf(ss * (1.0f / DM) + EPS);
            const float* gpost = ng + ((size_t)l * 4 + (mode == 1 ? 1 : 3)) * DM; const float* gate = MOD + ((size_t)l * 3 + which) * (6 * DM) + (mode == 1 ? 2 : 5) * DM;
#pragma unroll
            for (int j = 0; j < 8; ++j) { const f32x4 gp = *(const f32x4*)(gpost + 4 * F.lane + 256 * j), gt = *(const f32x4*)(gate + 4 * F.lane + 256 * j); xv[j] += gt * (yv[j] * rs * gp); }
        }
        if (!last) {
            float* dst = XO + (size_t)r * DM;
#pragma unroll
            for (int j = 0; j < 8; ++j) *(f32x4*)(dst + 4 * F.lane + 256 * j) = xv[j];
        } else { if (!isctx) { float* dst = (dry ? XO : F.out) + ((size_t)b * SEQ + t) * DM;
#pragma unroll
            for (int j = 0; j < 8; ++j) *(f32x4*)(dst + 4 * F.lane + 256 * j) = xv[j]; }
            continue; }
        const int ln = (mode == 2) ? l + 1 : l; const float* gpre = ng + ((size_t)ln * 4 + (mode == 1 ? 2 : 0)) * DM;
        const float* md = MOD + ((size_t)ln * 3 + which) * (6 * DM); const float* sh = md + (mode == 1 ? 3 : 0) * DM; const float* sc = md + (mode == 1 ? 4 : 1) * DM;
        float s2 = 0.f;
#pragma unroll
        for (int j = 0; j < 8; ++j) s2 += (xv[j][0] * xv[j][0] + xv[j][1] * xv[j][1]) + (xv[j][2] * xv[j][2] + xv[j][3] * xv[j][3]);
        s2 = wave_sum(s2); const float rs2 = 1.0f / sqrtf(s2 * (1.0f / DM) + EPS);
        bf16* hp = H + (size_t)r * DM;
#pragma unroll
        for (int j = 0; j < 8; ++j) { const int cidx = 4 * F.lane + 256 * j; const f32x4 gp = *(const f32x4*)(gpre + cidx), s4 = *(const f32x4*)(sc + cidx), h4 = *(const f32x4*)(sh + cidx);
            const f32x4 hv = (xv[j] * rs2 * gp) * (s4 + 1.0f) + h4; v2u w; w.x = cvt_pk_bf16(hv[0], hv[1]); w.y = cvt_pk_bf16(hv[2], hv[3]); *(v2u*)(hp + cidx) = w; }
    }
}

__device__ __forceinline__ bool seg_start(int r) { const int j = r % SEGB; return j == 0 || j == CTXL; }
__device__ __forceinline__ void post_u(Frame& F, int l) {
    const bf16* U = WSP(bf16, WS_U); bf16* PT = WSP(bf16, WS_PT);
    const int gw = F.vcu * NWAVES + F.wave, NGW = F.G * NWAVES;
    LAS bf16* tile = (LAS bf16*)(F.lds + F.wave * 16384);
    const float* hw = F.in[8] + (size_t)l * 3 * 1536;
    for (int wi = gw; wi < (MR / 64) * 24; wi += NGW) {
        const int rt = wi / 24, cgp = wi - rt * 24, r0 = rt * 64, c0 = cgp * 64;
        const bool has_prev = !seg_start(r0), has_next = !seg_start(r0 + 64) && (r0 + 64 < MR);
#pragma unroll
        for (int i = 0; i < 9; ++i) { const int tr = 8 * i + (F.lane >> 3), ch = F.lane & 7;
            if (tr < 66) { const int r = r0 - 1 + tr; const bool ok = (tr == 0) ? has_prev : (tr == 65 ? has_next : true);
                v4u v = {0u, 0u, 0u, 0u}; if (ok) v = *(const v4u*)(U + (size_t)r * DINP + c0 + ch * 8);
                *(LAS v4u*)(tile + tr * 64 + ch * 8) = v; } }
        LDS_WAIT();
        const int c = c0 + F.lane; const float w0 = hw[c], w1 = hw[1536 + c], w2 = hw[2 * 1536 + c];
#pragma unroll
        for (int tb = 0; tb < 8; ++tb) { float v[8];
#pragma unroll
            for (int j = 0; j < 8; ++j) { const int tr = 8 * tb + j; v[j] = w0 * bf2f(tile[tr * 64 + F.lane]) + w1 * bf2f(tile[(tr + 1) * 64 + F.lane]) + w2 * bf2f(tile[(tr + 2) * 64 + F.lane]); }
            v4u o; o.x = cvt_pk_bf16(v[0], v[1]); o.y = cvt_pk_bf16(v[2], v[3]); o.z = cvt_pk_bf16(v[4], v[5]); o.w = cvt_pk_bf16(v[6], v[7]);
            *(v4u*)(PT + (size_t)c * MR + r0 + 8 * tb) = o; }
        LDS_WAIT();
    }
    bf16* XR = WSP(bf16, WS_XR); bf16* KR = WSP(bf16, WS_KR); const float* ROPE = WSP(float, WS_ROPE); float* RSTD = WSP(float, WS_RSTD);
    for (int r = gw; r < MR; r += NGW) {
        int b, isctx, t; row_info(r, b, isctx, t);
        const bf16* ur = U + (size_t)r * DINP;
        { const int blk = F.lane >> 4, k = (F.lane & 15) * 8, prow = isctx ? 3 + t : 265 + t;
          *(v4u*)(XR + (((size_t)b * 4 + blk) * XR_ROWS + prow) * 128 + k) = *(const v4u*)(ur + OFF_LRU_X + 8 * F.lane); }
        if (F.lane < 32) { const float x1 = bf2f(ur[OFF_KR + F.lane]), x2 = bf2f(ur[OFF_KR + 32 + F.lane]); float o1 = x1, o2 = x2;
            if (!isctx) { const float cs = ROPE[t * 64 + F.lane], sn = ROPE[t * 64 + 32 + F.lane]; o1 = x1 * cs - x2 * sn; o2 = x2 * cs + x1 * sn; }
            KR[(size_t)r * 64 + F.lane] = f2bf(o1); KR[(size_t)r * 64 + 32 + F.lane] = f2bf(o2); }
        { const v4u w = *(const v4u*)(ur + OFF_Q + 8 * F.lane); float ss = 0.f;
#pragma unroll
          for (int j = 0; j < 4; ++j) { const float a = bf_lo(w[j]), c2 = bf_hi(w[j]); ss += a * a + c2 * c2; }
          ss = wave_sum(ss); if (F.lane == 0) RSTD[r] = 1.0f / sqrtf(ss * (1.0f / QRANK) + EPS); }
        { float ss = 0.f; if (F.lane < 32) { const v4u w = *(const v4u*)(ur + OFF_KV + 8 * F.lane);
#pragma unroll
            for (int j = 0; j < 4; ++j) { const float a = bf_lo(w[j]), c2 = bf_hi(w[j]); ss += a * a + c2 * c2; } }
          ss = wave_sum(ss); if (F.lane == 0) RSTD[MR + r] = 1.0f / sqrtf(ss * (1.0f / KVRANK) + EPS); }
    }
    for (int i = F.vcu * NTHR + F.tid; i < 2 * 4 * 12 * 16; i += F.G * NTHR) { const int ch = i & 15, pi = (i >> 4) % 12, bb = (i >> 4) / 12;
        const int prow = pi < 3 ? pi : (pi < 9 ? 256 + pi : 4352 + pi);
        unsigned zz = 0u; asm volatile("" : "+v"(zz));
        const v4u z = {zz, zz, zz, zz}; *(v4u*)(XR + ((size_t)bb * XR_ROWS + prow) * 128 + ch * 8) = z; }
}

__device__ __forceinline__ void conv_gelu(Frame& F, int l) {
    const bf16* UP = WSP(bf16, WS_UP); bf16* ACT = WSP(bf16, WS_ACT);
    const float* cw = F.in[28] + (size_t)l * 3 * 2 * DFF;
    const int gw = F.vcu * NWAVES + F.wave, NGW = F.G * NWAVES;
    for (int wi = gw; wi < (MR / 8) * 11; wi += NGW) {
        const int rc = wi / 11, fc = wi - rc * 11, r0 = rc * 8, f0 = fc * 512 + 8 * F.lane;
        const bool has_prev = !seg_start(r0), has_next = !seg_start(r0 + 8) && (r0 + 8 < MR);
        v4u g[10], v[10];
#pragma unroll
        for (int i = 0; i < 10; ++i) { const int r = r0 - 1 + i; const bool ok = (i == 0) ? has_prev : (i == 9 ? has_next : true);
            g[i] = (v4u){0u, 0u, 0u, 0u}; v[i] = (v4u){0u, 0u, 0u, 0u};
            if (ok) { g[i] = *(const v4u*)(UP + (size_t)r * (2 * DFF) + f0); v[i] = *(const v4u*)(UP + (size_t)r * (2 * DFF) + DFF + f0); } }
        float wg[3][8], wv[3][8];
#pragma unroll
        for (int j = 0; j < 3; ++j) { const f32x4 a = *(const f32x4*)(cw + (size_t)j * 2 * DFF + f0), b2 = *(const f32x4*)(cw + (size_t)j * 2 * DFF + f0 + 4);
            const f32x4 c2 = *(const f32x4*)(cw + (size_t)j * 2 * DFF + DFF + f0), d2 = *(const f32x4*)(cw + (size_t)j * 2 * DFF + DFF + f0 + 4);
#pragma unroll
            for (int q = 0; q < 4; ++q) { wg[j][q] = a[q]; wg[j][4 + q] = b2[q]; wv[j][q] = c2[q]; wv[j][4 + q] = d2[q]; } }
#pragma unroll
        for (int i = 0; i < 8; ++i) { float o[8];
#pragma unroll
            for (int q = 0; q < 4; ++q) {
                const float ga = wg[0][2 * q] * bf_lo(g[i][q]) + wg[1][2 * q] * bf_lo(g[i + 1][q]) + wg[2][2 * q] * bf_lo(g[i + 2][q]);
                const float gb = wg[0][2 * q + 1] * bf_hi(g[i][q]) + wg[1][2 * q + 1] * bf_hi(g[i + 1][q]) + wg[2][2 * q + 1] * bf_hi(g[i + 2][q]);
                const float va = wv[0][2 * q] * bf_lo(v[i][q]) + wv[1][2 * q] * bf_lo(v[i + 1][q]) + wv[2][2 * q] * bf_lo(v[i + 2][q]);
                const float vb = wv[0][2 * q + 1] * bf_hi(v[i][q]) + wv[1][2 * q + 1] * bf_hi(v[i + 1][q]) + wv[2][2 * q + 1] * bf_hi(v[i + 2][q]);
                o[2 * q] = gelu_tanh(ga) * va; o[2 * q + 1] = gelu_tanh(gb) * vb; }
            v4u w; w.x = cvt_pk_bf16(o[0], o[1]); w.y = cvt_pk_bf16(o[2], o[3]); w.z = cvt_pk_bf16(o[4], o[5]); w.w = cvt_pk_bf16(o[6], o[7]);
            *(v4u*)(ACT + (size_t)(r0 + i) * DFF + f0) = w; }
    }
}

__device__ __forceinline__ void mix_finalize(Frame& F, int l) {
    const bf16* YT = WSP(bf16, WS_YT); const float* YL = WSP(float, WS_YL); const bf16* O = WSP(bf16, WS_O); bf16* YM = WSP(bf16, WS_YMIX);
    const float* hg = F.in[25] + (size_t)l * DMIX;
    const int gw = F.vcu * NWAVES + F.wave, NGW = F.G * NWAVES;
    LAS bf16* st = (LAS bf16*)(F.lds + F.wave * 16384);
    constexpr int NHY = (MR / 32) * 4, NLR = (MR / 64) * 4, NAT = (MR / 64) * 8;
    for (int wi = gw; wi < NHY + NLR + NAT; wi += NGW) {
        if (wi < NHY) {
            const int rt = wi >> 2, hd = wi & 3, r0 = rt * 32, cs = F.lane >> 2, rc = F.lane & 3;
            const bf16* src = YT + (size_t)(hd * 128 + cs) * MR + r0 + 8 * rc;
            v4u v[8]; float ss[8];
#pragma unroll
            for (int k = 0; k < 8; ++k) ss[k] = 0.f;
#pragma unroll
            for (int i = 0; i < 8; ++i) { v[i] = *(const v4u*)(src + (size_t)(16 * i) * MR);
#pragma unroll
                for (int k = 0; k < 4; ++k) { const float a = bf_lo(v[i][k]), b2 = bf_hi(v[i][k]); ss[2 * k] += a * a; ss[2 * k + 1] += b2 * b2; } }
#pragma unroll
            for (int k = 0; k < 8; ++k) { float s = ss[k]; s += __shfl_xor(s, 4); s += __shfl_xor(s, 8); s += __shfl_xor(s, 16); s += __shfl_xor(s, 32); ss[k] = 1.0f / sqrtf(s * (1.0f / 128.0f) + EPS); }
#pragma unroll
            for (int i = 0; i < 8; ++i) { const int c = 16 * i + cs; const float g = hg[hd * 128 + c];
#pragma unroll
                for (int k = 0; k < 4; ++k) { st[(8 * rc + 2 * k) * 130 + c] = f2bf(bf_lo(v[i][k]) * ss[2 * k] * g); st[(8 * rc + 2 * k + 1) * 130 + c] = f2bf(bf_hi(v[i][k]) * ss[2 * k + 1] * g); } }
            LDS_WAIT();
#pragma unroll 8
            for (int row = 0; row < 32; ++row) { const unsigned w = *(const LAS unsigned*)(st + row * 130 + 2 * F.lane);
                *(unsigned*)(YM + (size_t)(r0 + row) * DMIX + hd * 128 + 2 * F.lane) = w; }
            LDS_WAIT();
        } else if (wi < NHY + NLR) {
            const int w2 = wi - NHY, rt = w2 >> 2, hd = w2 & 3, r0 = rt * 64, q = F.lane & 3;
            for (int ps = 0; ps < 4; ++ps) { const int row = r0 + ps * 16 + (F.lane >> 2);
                const float* src = YL + (size_t)row * LRUC + hd * 128 + q * 32; f32x4 v[8]; float ss = 0.f;
#pragma unroll
                for (int j = 0; j < 8; ++j) { v[j] = *(const f32x4*)(src + 4 * j); ss += (v[j][0] * v[j][0] + v[j][1] * v[j][1]) + (v[j][2] * v[j][2] + v[j][3] * v[j][3]); }
                ss += __shfl_xor(ss, 1); ss += __shfl_xor(ss, 2); const float rs = 1.0f / sqrtf(ss * (1.0f / 128.0f) + EPS);
                const float* g = hg + (4 + hd) * 128 + q * 32; bf16* dst = YM + (size_t)row * DMIX + (4 + hd) * 128 + q * 32;
#pragma unroll
                for (int j = 0; j < 4; ++j) { const f32x4 g0 = *(const f32x4*)(g + 8 * j), g1 = *(const f32x4*)(g + 8 * j + 4); const f32x4 a = v[2 * j] * rs * g0, b2 = v[2 * j + 1] * rs * g1;
                    v4u w; w.x = cvt_pk_bf16(a[0], a[1]); w.y = cvt_pk_bf16(a[2], a[3]); w.z = cvt_pk_bf16(b2[0], b2[1]); w.w = cvt_pk_bf16(b2[2], b2[3]); *(v4u*)(dst + 8 * j) = w; } }
        } else {
            const int w2 = wi - NHY - NLR, rt = w2 >> 3, hd = w2 & 7, r0 = rt * 64, q = F.lane & 3;
            for (int ps = 0; ps < 4; ++ps) { const int row = r0 + ps * 16 + (F.lane >> 2);
                const bf16* src = O + (size_t)row * (NH * VD) + hd * 128 + q * 32; v4u v[4]; float ss = 0.f;
#pragma unroll
                for (int j = 0; j < 4; ++j) { v[j] = *(const v4u*)(src + 8 * j);
#pragma unroll
                    for (int k = 0; k < 4; ++k) { const float a = bf_lo(v[j][k]), b2 = bf_hi(v[j][k]); ss += a * a + b2 * b2; } }
                ss += __shfl_xor(ss, 1); ss += __shfl_xor(ss, 2); const float rs = 1.0f / sqrtf(ss * (1.0f / 128.0f) + EPS);
                const float* g = hg + (8 + hd) * 128 + q * 32; bf16* dst = YM + (size_t)row * DMIX + (8 + hd) * 128 + q * 32;
#pragma unroll
                for (int j = 0; j < 4; ++j) { const f32x4 g0 = *(const f32x4*)(g + 8 * j), g1 = *(const f32x4*)(g + 8 * j + 4);
                    v4u w; w.x = cvt_pk_bf16(bf_lo(v[j][0]) * rs * g0[0], bf_hi(v[j][0]) * rs * g0[1]); w.y = cvt_pk_bf16(bf_lo(v[j][1]) * rs * g0[2], bf_hi(v[j][1]) * rs * g0[3]);
                    w.z = cvt_pk_bf16(bf_lo(v[j][2]) * rs * g1[0], bf_hi(v[j][2]) * rs * g1[1]); w.w = cvt_pk_bf16(bf_lo(v[j][3]) * rs * g1[2], bf_hi(v[j][3]) * rs * g1[3]); *(v4u*)(dst + 8 * j) = w; } }
        }
    }
}

namespace att {
constexpr int NW = 8, QBLK = 32, KVBLK = 64;
constexpr float SCALE = 0.07216878364870323f;
constexpr float THR = 8.f;
constexpr int LDQ = DQ, LDK = DKV, LDR = ROPED, LDO = NH * VD;
constexpr int SHM_V = KVBLK * 128 * 2, SHM_K = KVBLK * 128 * 2, SHM_R = KVBLK * 64 * 2;
constexpr int OFF_V = 0, OFF_K = 2 * SHM_V, OFF_R = OFF_K + 2 * SHM_K, OFF_WS = OFF_R + 2 * SHM_R, OFF_QR = OFF_WS + NW * 64 * 4, SHM_ATTN = OFF_QR + NW * 4096;
#define KSWZ(row, colB) ((row) * 256 + ((colB) ^ (((row) & 7) << 4)))
#define RSWZ(row, colB) ((row) * 128 + ((colB) ^ (((row) & 7) << 4)))
#define SBAR() __builtin_amdgcn_sched_barrier(0)
__device__ __forceinline__ int crow(int r, int hi) { return (r & 3) + 8 * (r >> 2) + 4 * hi; }
__device__ __forceinline__ void partialSM(f32x16& p0, f32x16& p1, float& m_reg, float& mn, float& alpha) {
  constexpr float C = SCALE * 1.4426950408889634f;
  float pmax = p0[0]; for (int r = 1; r < 16; ++r) pmax = fmaxf(pmax, p0[r]); for (int r = 0; r < 16; ++r) pmax = fmaxf(pmax, p1[r]);
  { auto rr = __builtin_amdgcn_permlane32_swap(__float_as_uint(pmax), __float_as_uint(pmax), false, false);
    pmax = fmaxf(__uint_as_float(rr[0]), __uint_as_float(rr[1])); }
  if (__builtin_expect(__all(pmax - m_reg <= THR / SCALE), 1)) { mn = m_reg; alpha = 1.f; }
  else { mn = fmaxf(m_reg, pmax); alpha = __builtin_amdgcn_exp2f((m_reg - mn) * C); m_reg = mn; }
  float mnC = -mn * C;
  for (int r = 0; r < 16; ++r) p0[r] = fmaf(p0[r], C, mnC); for (int r = 0; r < 16; ++r) p1[r] = fmaf(p1[r], C, mnC);
  for (int r = 0; r < 16; ++r) p0[r] = __builtin_amdgcn_exp2f(p0[r]);
}
__device__ __forceinline__ void finishSM(f32x16& p0, f32x16& p1, float alpha, float& l_reg, bf16x8& pa0, bf16x8& pa1, bf16x8& pa2, bf16x8& pa3) {
  for (int r = 0; r < 16; ++r) p1[r] = __builtin_amdgcn_exp2f(p1[r]);
  float ps = 0; for (int r = 0; r < 16; ++r) ps += p0[r]; for (int r = 0; r < 16; ++r) ps += p1[r];
  { auto rr = __builtin_amdgcn_permlane32_swap(__float_as_uint(ps), __float_as_uint(ps), false, false);
    ps = __uint_as_float(rr[0]) + __uint_as_float(rr[1]); }
  l_reg = l_reg * alpha + ps;
#define PK4(P, BASE, OUT) do { unsigned a0 = cvt_pk_bf16(P[BASE + 0], P[BASE + 1]), a1 = cvt_pk_bf16(P[BASE + 2], P[BASE + 3]);   \
    unsigned b0 = cvt_pk_bf16(P[BASE + 4], P[BASE + 5]), b1 = cvt_pk_bf16(P[BASE + 6], P[BASE + 7]);                              \
    auto r0 = __builtin_amdgcn_permlane32_swap(a0, b0, false, false); auto r1 = __builtin_amdgcn_permlane32_swap(a1, b1, false, false); \
    v4u w = {r0[0], r1[0], r0[1], r1[1]}; OUT = *reinterpret_cast<bf16x8*>(&w); } while (0)
  PK4(p0, 0, pa0); PK4(p0, 8, pa1); PK4(p1, 0, pa2); PK4(p1, 8, pa3);
#undef PK4
}
__device__ __forceinline__ void qkt(f32x16& p0, f32x16& p1, const LAS char* Ks, const LAS char* Rs, const bf16x8* qr, const LAS char* qrl, int r32, int hi) {
  p0 = f32x16{}; p1 = f32x16{};
#pragma unroll
  for (int d0 = 0; d0 < 8; ++d0) { const int cb = (d0 * 16 + hi * 8) * 2;
    bf16x8 b0 = *(const LAS bf16x8*)(Ks + KSWZ(r32, cb));
    bf16x8 b1 = *(const LAS bf16x8*)(Ks + KSWZ(32 + r32, cb));
    p0 = __builtin_amdgcn_mfma_f32_32x32x16_bf16(b0, qr[d0], p0, 0, 0, 0);
    p1 = __builtin_amdgcn_mfma_f32_32x32x16_bf16(b1, qr[d0], p1, 0, 0, 0); }
#pragma unroll
  for (int d0 = 0; d0 < 4; ++d0) { const int cb = (d0 * 16 + hi * 8) * 2;
    bf16x8 b0 = *(const LAS bf16x8*)(Rs + RSWZ(r32, cb));
    bf16x8 b1 = *(const LAS bf16x8*)(Rs + RSWZ(32 + r32, cb));
    const bf16x8 qf = *(const LAS bf16x8*)(qrl + d0 * 1024);
    p0 = __builtin_amdgcn_mfma_f32_32x32x16_bf16(b0, qf, p0, 0, 0, 0);
    p1 = __builtin_amdgcn_mfma_f32_32x32x16_bf16(b1, qf, p1, 0, 0, 0); }
}
__device__ __forceinline__ int v_st(int k, int c) { const int kk = (k & ~0xC) | ((k & 4) << 1) | ((k & 8) >> 1); return ((kk >> 3) * 4 + (c >> 5)) * 512 + ((kk & 7) * 32 + (c & 31)) * 2; }
__device__ __forceinline__ int v_rd_base(int lane) { return ((lane & 3) << 3) | (((lane >> 2) & 3) << 6) | (((lane >> 4) & 1) << 5) | (((lane >> 5) & 1) << 8); }
constexpr int v_rd_off(int d0, int ks, int half) { return d0 * 512 + ks * 4096 + half * 2048; }
template <int OFF> __device__ __forceinline__ s16x4 tr_read(int vb) {
  s16x4 r; asm volatile("ds_read_b64_tr_b16 %0, %1 offset:%2" : "=&v"(r) : "v"(vb), "i"(OFF) : "memory"); return r;
}
template <int D0> __device__ __forceinline__ void pv_one(f32x16& od, int vb, bf16x8 pa0, bf16x8 pa1, bf16x8 pa2, bf16x8 pa3) {
  const s16x4 l0 = tr_read<v_rd_off(D0, 0, 0)>(vb), h0 = tr_read<v_rd_off(D0, 0, 1)>(vb), l1 = tr_read<v_rd_off(D0, 1, 0)>(vb), h1 = tr_read<v_rd_off(D0, 1, 1)>(vb);
  const s16x4 l2 = tr_read<v_rd_off(D0, 2, 0)>(vb), h2 = tr_read<v_rd_off(D0, 2, 1)>(vb), l3 = tr_read<v_rd_off(D0, 3, 0)>(vb), h3 = tr_read<v_rd_off(D0, 3, 1)>(vb);
  asm volatile("s_waitcnt lgkmcnt(0)" ::: "memory"); SBAR();
#define PK(L, H) (bf16x8){L[0], L[1], L[2], L[3], H[0], H[1], H[2], H[3]}
  od = __builtin_amdgcn_mfma_f32_32x32x16_bf16(pa0, PK(l0, h0), od, 0, 0, 0);
  od = __builtin_amdgcn_mfma_f32_32x32x16_bf16(pa1, PK(l1, h1), od, 0, 0, 0);
  od = __builtin_amdgcn_mfma_f32_32x32x16_bf16(pa2, PK(l2, h2), od, 0, 0, 0);
  od = __builtin_amdgcn_mfma_f32_32x32x16_bf16(pa3, PK(l3, h3), od, 0, 0, 0);
#undef PK
}
__device__ __forceinline__ void pv_d0(f32x16* o, int vb, bf16x8 pa0, bf16x8 pa1, bf16x8 pa2, bf16x8 pa3) {
  pv_one<0>(o[0], vb, pa0, pa1, pa2, pa3); pv_one<1>(o[1], vb, pa0, pa1, pa2, pa3); pv_one<2>(o[2], vb, pa0, pa1, pa2, pa3); pv_one<3>(o[3], vb, pa0, pa1, pa2, pa3);
}
__device__ __forceinline__ void attn_body(const bf16* __restrict__ Qb, const bf16* __restrict__ Kh, const bf16* __restrict__ Vh, const bf16* __restrict__ Rh,
                                          bf16* __restrict__ Ob, int seq, const float* rope_tab, LAS char* lds) {
  int tid = threadIdx.x; asm volatile("" : "+v"(tid));
  const int wid = __builtin_amdgcn_readfirstlane(tid >> 6), lane = tid & 63, r32 = lane & 31, hi = lane >> 5;
  LAS char* V_lds = lds + OFF_V; LAS char* K_lds = lds + OFF_K; LAS char* R_lds = lds + OFF_R;
  LAS float* ws = (LAS float*)(lds + OFF_WS) + wid * 64; LAS float* li_l = ws; LAS float* al_l = ws + 32;
  float m_reg = -1e30f, l_reg = 0; f32x16 o[4] = {}; bf16x8 qr[12];
  LAS char* qrl = lds + OFF_QR + wid * 4096 + lane * 16;
  const bf16* Qw = Qb + (long)(wid * QBLK + r32) * LDQ + hi * 8;
#pragma unroll
  for (int d0 = 0; d0 < 12; ++d0) qr[d0] = *reinterpret_cast<const bf16x8*>(Qw + d0 * 16);
  if (rope_tab) {
    const float* rt = rope_tab + (long)(wid * QBLK + r32) * 64;
#pragma unroll
    for (int p = 0; p < 2; ++p) {
      const float* cs = rt + p * 16 + hi * 8; const f32x4 c0 = *(const f32x4*)cs, c1 = *(const f32x4*)(cs + 4), s0 = *(const f32x4*)(cs + 32), s1 = *(const f32x4*)(cs + 36);
      const v4u x1 = *reinterpret_cast<v4u*>(&qr[8 + p]), x2 = *reinterpret_cast<v4u*>(&qr[10 + p]); v4u y1, y2;
#pragma unroll
      for (int k = 0; k < 4; ++k) { const float ca = k < 2 ? c0[2 * k] : c1[2 * k - 4], cbv = k < 2 ? c0[2 * k + 1] : c1[2 * k - 3], sa = k < 2 ? s0[2 * k] : s1[2 * k - 4], sb = k < 2 ? s0[2 * k + 1] : s1[2 * k - 3];
        const float a1 = bf_lo(x1[k]), b1 = bf_hi(x1[k]), a2 = bf_lo(x2[k]), b2 = bf_hi(x2[k]);
        y1[k] = cvt_pk_bf16(a1 * ca - a2 * sa, b1 * cbv - b2 * sb); y2[k] = cvt_pk_bf16(a2 * ca + a1 * sa, b2 * cbv + b1 * sb); }
      qr[8 + p] = *reinterpret_cast<bf16x8*>(&y1); qr[10 + p] = *reinterpret_cast<bf16x8*>(&y2); }
  }
#pragma unroll
  for (int d0 = 0; d0 < 4; ++d0) *(LAS bf16x8*)(qrl + d0 * 1024) = qr[8 + d0];
  const int sr = tid >> 4, sc = (tid & 15) * 8, vst0 = v_st(sr, sc), vst1 = v_st(32 + sr, sc);
  const int rr_ = tid >> 3, rc_ = (tid & 7) * 8;
  const int vb0 = (int)(uintptr_t)V_lds + v_rd_base(lane);
  constexpr int SDEPTH = 1;
  struct { bf16x8 vs0, vs1, ks0, ks1, rs; } sr_[SDEPTH];
  const unsigned offk0 = (unsigned)(sr * LDK + sc), offk1 = (unsigned)((32 + sr) * LDK + sc), offr = (unsigned)(rr_ * LDR + rc_);
#define SLOAD(i, k0) do { const bf16* vt_ = Vh + (size_t)(k0) * LDK; const bf16* kt_ = Kh + (size_t)(k0) * LDK; const bf16* rt_ = Rh + (size_t)(k0) * LDR; \
    sr_[i].vs0 = *(const bf16x8*)(vt_ + offk0); sr_[i].vs1 = *(const bf16x8*)(vt_ + offk1); \
    sr_[i].ks0 = *(const bf16x8*)(kt_ + offk0); sr_[i].ks1 = *(const bf16x8*)(kt_ + offk1); \
    sr_[i].rs = *(const bf16x8*)(rt_ + offr); } while (0)
#define SWRITE(b, i) do { *(LAS bf16x8*)(V_lds + (b) * SHM_V + vst0) = sr_[i].vs0;          \
    *(LAS bf16x8*)(V_lds + (b) * SHM_V + vst1) = sr_[i].vs1; int kc = sc * 2;               \
    *(LAS bf16x8*)(K_lds + (b) * SHM_K + KSWZ(sr, kc)) = sr_[i].ks0;                       \
    *(LAS bf16x8*)(K_lds + (b) * SHM_K + KSWZ(32 + sr, kc)) = sr_[i].ks1;                  \
    *(LAS bf16x8*)(R_lds + (b) * SHM_R + RSWZ(rr_, rc_ * 2)) = sr_[i].rs; } while (0)
#define SWAIT() do { if constexpr (SDEPTH == 2) asm volatile("s_waitcnt vmcnt(5)" ::: "memory"); else asm volatile("s_waitcnt vmcnt(0)" ::: "memory"); } while (0)
#define RESC(a) do { if (__any((a) < 1.f)) { if (hi == 0) al_l[r32] = (a); asm volatile("s_waitcnt lgkmcnt(0)" ::: "memory"); \
    for (int d = 0; d < 4; ++d) for (int r = 0; r < 16; ++r) o[d][r] *= al_l[crow(r, hi)]; } } while (0)
  f32x16 pA0, pA1, pB0, pB1; float mnA, mnB, alA, alB; bf16x8 pa0, pa1, pa2, pa3; const int NT = seq / KVBLK;
  constexpr int SE = 0, SO = SDEPTH - 1;
  SLOAD(SE, 0); asm volatile("s_waitcnt vmcnt(0)" ::: "memory"); SWRITE(0, SE); __syncthreads();
  qkt(pA0, pA1, K_lds, R_lds, qr, qrl, r32, hi); partialSM(pA0, pA1, m_reg, mnA, alA);
  SLOAD(SO, KVBLK); if constexpr (SDEPTH == 2) { if (2 < NT) SLOAD(SE, 2 * KVBLK); }
  SWAIT(); SWRITE(1, SO); __syncthreads();
  for (int j = 1; j + 1 < NT; j += 2) {
    SBAR(); qkt(pB0, pB1, K_lds + SHM_K, R_lds + SHM_R, qr, qrl, r32, hi);
    finishSM(pA0, pA1, alA, l_reg, pa0, pa1, pa2, pa3); SBAR();
    SLOAD(SO, (j + SDEPTH) * KVBLK); SBAR();
    pv_d0(o, vb0, pa0, pa1, pa2, pa3); partialSM(pB0, pB1, m_reg, mnB, alB);
    __syncthreads(); SWAIT(); SWRITE(0, SE);
    RESC(alB); __syncthreads();
    SBAR(); qkt(pA0, pA1, K_lds, R_lds, qr, qrl, r32, hi);
    finishSM(pB0, pB1, alB, l_reg, pa0, pa1, pa2, pa3); SBAR();
    if (SDEPTH == 1 || j + 3 < NT) SLOAD(SE, (j + 1 + SDEPTH) * KVBLK); SBAR();
    pv_d0(o, vb0 + SHM_V, pa0, pa1, pa2, pa3); partialSM(pA0, pA1, m_reg, mnA, alA);
    __syncthreads(); SWAIT(); SWRITE(1, SO);
    RESC(alA); __syncthreads();
  }
  SBAR(); qkt(pB0, pB1, K_lds + SHM_K, R_lds + SHM_R, qr, qrl, r32, hi);
  finishSM(pA0, pA1, alA, l_reg, pa0, pa1, pa2, pa3); SBAR();
  pv_d0(o, vb0, pa0, pa1, pa2, pa3); partialSM(pB0, pB1, m_reg, mnB, alB);
  __syncthreads(); RESC(alB);
  finishSM(pB0, pB1, alB, l_reg, pa0, pa1, pa2, pa3); SBAR();
  pv_d0(o, vb0 + SHM_V, pa0, pa1, pa2, pa3);
  if (hi == 0) li_l[r32] = l_reg; asm volatile("s_waitcnt lgkmcnt(0)" ::: "memory");
  float rli[16];
#pragma unroll
  for (int r = 0; r < 16; ++r) rli[r] = __builtin_amdgcn_rcpf(li_l[crow(r, hi)]);
  bf16* Ow = Ob + (long)(wid * QBLK) * LDO;
#pragma unroll
  for (int r = 0; r < 16; ++r) { const int orow = crow(r, hi);
#pragma unroll
    for (int d0 = 0; d0 < 4; ++d0) Ow[(long)orow * LDO + d0 * 32 + r32] = f2bf(o[d0][r] * rli[r]); }
  __syncthreads();
#undef SLOAD
#undef SWRITE
#undef SWAIT
#undef RESC
}
}

__device__ __forceinline__ void attn_phase(Frame& F, bool need_ctx) {
    const bf16* Q = WSP(bf16, WS_Q); const bf16* KV = WSP(bf16, WS_KV); const bf16* KR = WSP(bf16, WS_KR); bf16* O = WSP(bf16, WS_O); const float* ROPE = WSP(float, WS_ROPE);
    const int nunits = 256 + (need_ctx ? 16 : 0);
    for (int u = F.vcu; u < nunits; u += F.G) {
        if (u < 256) { const int b = u >> 7, h = (u >> 4) & 7, qb = u & 15; const size_t kb = (size_t)b * SEGB, row0 = kb + CTXL + qb * 256;
            att::attn_body(Q + row0 * DQ + h * 192, KV + kb * DKV + h * 256, KV + kb * DKV + h * 256 + 128, KR + kb * ROPED, O + row0 * (NH * VD) + h * 128, SEGB, ROPE + (size_t)qb * 256 * 64, (LAS char*)F.lds);
        } else { const int b = (u - 256) >> 3, h = (u - 256) & 7; const size_t kb = (size_t)b * SEGB;
            att::attn_body(Q + kb * DQ + h * 192, KV + kb * DKV + h * 256, KV + kb * DKV + h * 256 + 128, KR + kb * ROPED, O + kb * (NH * VD) + h * 128, CTXL, nullptr, (LAS char*)F.lds);
        }
    }
}

struct LruAB {
    const bf16* XR; const bf16* Bt; int lda, ldb;
    __device__ __forceinline__ static int prow0(int pm) { const int jt = pm % 17; return jt == 0 ? 3 : 265 + (jt - 1) * 256; }
    __device__ __forceinline__ const char* a_base(const pg8::Unit& u) const { const int b = u.pm / 17, dir = u.pn >> 2, blk = u.pn & 3;
        return (const char*)(XR + (((size_t)b * 4 + blk) * XR_ROWS + prow0(u.pm) - (dir ? 0 : 3)) * 128); }
    __device__ __forceinline__ const char* b_base(const pg8::Unit& u) const { return (const char*)(Bt + (size_t)u.pn * 256 * 512); }
};
struct EpiGate {
    static constexpr bool PERM = false;
    const bf16* XR; f32x2* AB; const float* ba; const float* bx; const float* sp; const float* cw;
    __device__ __forceinline__ void operator()(const f32x4 (&acc)[2][2][4][2], const pg8::Unit& u, int wr, int wc, int fr, int fq) const {
        asm volatile("" : "+v"(fr), "+v"(fq));
        const int dir = u.pn >> 2, blk = u.pn & 3, b = u.pm / 17, p0 = LruAB::prow0(u.pm);
        const bf16* xb = XR + ((size_t)b * 4 + blk) * XR_ROWS * 128;
        f32x2* abb = AB + (size_t)dir * MR * LRUC;
#pragma unroll 1
        for (int n = 0; n < 2; ++n) { const int cl = wc * 32 + 16 * n + 4 * fq, ch = blk * 128 + cl;
            const f32x4 ba4 = *(const f32x4*)(ba + dir * LRUC + ch), bx4 = *(const f32x4*)(bx + dir * LRUC + ch), sp4 = *(const f32x4*)(sp + dir * LRUC + ch) * -8.0f;
            f32x4 cw4[4];
#pragma unroll
            for (int j = 0; j < 4; ++j) cw4[j] = *(const f32x4*)(cw + ((size_t)dir * 4 + j) * LRUC + ch);
#pragma unroll
            for (int ai = 0; ai < 2; ++ai)
#pragma unroll
                for (int m = 0; m < 4; ++m) { const int rl = ai * 128 + wr * 64 + m * 16 + fr, row = u.pm * 256 + rl, pr = p0 + rl + (dir ? 0 : -3);
                    f32x4 xc = {0.f, 0.f, 0.f, 0.f};
#pragma unroll
                    for (int j = 0; j < 4; ++j) { const v2u w = *(const v2u*)(xb + (unsigned)((pr + j) * 128 + cl)); xc[0] += cw4[j][0] * bf_lo(w.x); xc[1] += cw4[j][1] * bf_hi(w.x); xc[2] += cw4[j][2] * bf_lo(w.y); xc[3] += cw4[j][3] * bf_hi(w.y); }
                    const f32x4 rp = (n == 0 ? acc[ai][0][m][0] : acc[ai][0][m][1]) + ba4, ip = (n == 0 ? acc[ai][1][m][0] : acc[ai][1][m][1]) + bx4;
                    f32x4 o0, o1;
#pragma unroll
                    for (int j = 0; j < 4; ++j) { const float rg = sigmoidf_(rp[j]), ig = sigmoidf_(ip[j]); const float la = rg * sp4[j]; const float a = __expf(la);
                        const float x = 2.0f * la;
                        const float ser = -x * (1.0f + x * (0.5f + x * (0.16666667f + x * (0.041666668f + x * (0.008333334f + x * 0.0013888889f)))));
                        const float om = (x > -0.25f) ? ser : (1.0f - __expf(x));
                        const float bb = sqrtf(om) * (ig * xc[j]); if (j < 2) { o0[2 * j] = a; o0[2 * j + 1] = bb; } else { o1[2 * j - 4] = a; o1[2 * j - 3] = bb; } }
                    f32x2* dst = abb + (unsigned)(row * LRUC + ch); *(f32x4*)dst = o0; *(f32x4*)(dst + 2) = o1;
                    asm volatile("" ::: "memory"); }
        }
    }
};
__device__ __forceinline__ void lru_pass1(Frame& F) {
    const f32x2* AB = WSP(f32x2, WS_AB); f32x2* CARRY = WSP(f32x2, WS_CARRY);
    const int gw = F.vcu * NWAVES + F.wave, NGW = F.G * NWAVES;
    for (int wi = gw; wi < 2 * NCHUNK * 8; wi += NGW) {
        const int chg = wi & 7, cg = (wi >> 3) % NCHUNK, dir = wi / (8 * NCHUNK), ch = chg * 64 + F.lane;
        const f32x2* base = AB + ((size_t)dir * MR + cg * 64) * LRUC + ch;
        float h = 0.f, P = 1.f;
#pragma unroll 16
        for (int i = 0; i < 64; ++i) { const int rr = dir ? 63 - i : i; const f32x2 ab = base[(size_t)rr * LRUC]; h = ab.x * h + ab.y; P *= ab.x; }
        CARRY[((size_t)dir * NCHUNK + cg) * LRUC + ch] = (f32x2){P, h};
    }
}
__device__ __forceinline__ void lru_pass2(Frame& F) {
    const f32x2* AB = WSP(f32x2, WS_AB); const f32x2* CARRY = WSP(f32x2, WS_CARRY); const bf16* U = WSP(bf16, WS_U); float* YL = WSP(float, WS_YL);
    const int gw = F.vcu * NWAVES + F.wave, NGW = F.G * NWAVES;
    for (int wi = gw; wi < NCHUNK * 8; wi += NGW) {
        const int chg = wi & 7, cg = wi >> 3, b = cg / 68, jc = cg - b * 68, ch = chg * 64 + F.lane;
        float hf = 0.f, hb = 0.f;
        const f32x2* cf = CARRY + ((size_t)0 * NCHUNK + b * 68) * LRUC + ch; const f32x2* cbk = CARRY + ((size_t)1 * NCHUNK + b * 68) * LRUC + ch;
        for (int k = 0; k < jc; ++k) { const f32x2 c = cf[(size_t)k * LRUC]; hf = c.x * hf + c.y; }
        if (jc < 4) { for (int k = 3; k > jc; --k) { const f32x2 c = cbk[(size_t)k * LRUC]; hb = c.x * hb + c.y; } }
        else { for (int k = 3; k >= 0; --k) { const f32x2 c = cbk[(size_t)k * LRUC]; hb = c.x * hb + c.y; }
               for (int k = 67; k > jc; --k) { const f32x2 c = cbk[(size_t)k * LRUC]; hb = c.x * hb + c.y; } }
        float hfv[64];
        const f32x2* bf_ = AB + ((size_t)0 * MR + cg * 64) * LRUC + ch; const f32x2* bb_ = AB + ((size_t)1 * MR + cg * 64) * LRUC + ch;
#pragma unroll
        for (int i = 0; i < 64; ++i) { const f32x2 ab = bf_[(size_t)i * LRUC]; hf = ab.x * hf + ab.y; hfv[i] = hf; }
#pragma unroll
        for (int i = 63; i >= 0; --i) { const f32x2 ab = bb_[(size_t)i * LRUC]; hb = ab.x * hb + ab.y; const size_t row = (size_t)cg * 64 + i;
            const float g = bf2f(U[row * DINP + OFF_LRU_G + ch]); YL[row * LRUC + ch] = gelu_tanh(g) * (hfv[i] + hb); }
    }
}

template <int NBLK, int NCH, int WPC>
__device__ __forceinline__ void hyena_item(Frame& F, int l, int item) {
    constexpr int L = 128 * NBLK, GLEN = 2 * L, ZB = NBLK * 136 + 64, ZSZ = 2 * ZB;
    constexpr int CH_BYTES = (GLEN + 2 * ZSZ) * 2 + 64;
    static_assert(CH_BYTES % 16 == 0 && NCH * CH_BYTES <= RING_BYTES && NCH * WPC == NWAVES, "hyena LDS map");
    constexpr int TT = WPC * 64;
    const int cs = F.wave / WPC, q = F.wave % WPC, c = item * NCH + cs, tl = F.tid % TT;
    LAS bf16* Gs = (LAS bf16*)(F.lds + cs * CH_BYTES); LAS bf16* Zc = Gs + GLEN; LAS bf16* Zn = Zc + ZSZ; LAS bf16* zero = Zn + ZSZ;
    const bf16* PT = WSP(bf16, WS_PT); bf16* YT = WSP(bf16, WS_YT);
    const bf16* Gg = (NBLK == 32) ? WSP(bf16, WS_G) + ((size_t)l * 512 + c) * 2 * HYL : WSP(bf16, WS_GC) + ((size_t)l * 512 + c) * 2 * HYLC;
    const int rb0 = (NBLK == 32) ? CTXL : 0;
    for (int i = tl; i < 2 * NBLK * 16; i += TT) { const int b = i / (NBLK * 16), rem = i - b * (NBLK * 16), blk = rem >> 4, e8 = rem & 15;
        *(LAS v4u*)(Zc + b * ZB + blk * 136 + e8 * 8) = *(const v4u*)(PT + (size_t)c * MR + b * SEGB + rb0 + blk * 128 + e8 * 8); }
    if (tl < 16) ((LAS unsigned*)zero)[tl] = 0u;
    const int i16 = F.lane & 15, h4 = F.lane >> 4, nb = i16 >> 3, a = 8 * q + (i16 & 7);
    const int mlo = (8 * q - (NBLK - 1)) > -(NBLK - 1) ? (8 * q - (NBLK - 1)) : -(NBLK - 1), mhi = (8 * q + 7) < (NBLK - 1) ? (8 * q + 7) : (NBLK - 1);
    const float* hb = F.in[14] + (size_t)l * 2 * HYC;
    for (int o = 0; o < 2; ++o) {
        for (int i = tl; i < GLEN / 8; i += TT) *(LAS v4u*)(Gs + 8 * i) = *(const v4u*)(Gg + (size_t)o * GLEN + 8 * i);
        __syncthreads();
        f32x4 acc[8];
#pragma unroll
        for (int r = 0; r < 8; ++r) acc[r] = (f32x4){0.f, 0.f, 0.f, 0.f};
        for (int m = mlo; m <= mhi; ++m) {
            const int blk_in = a - m; const bool valid = (a < NBLK) && blk_in >= 0 && blk_in < NBLK;
            const LAS bf16* zp = valid ? (Zc + nb * ZB + blk_in * 136 + 8 * h4) : zero;
            const int zk = valid ? 1 : 0;
            const LAS bf16* gp = Gs + (L - 128 * m + 8 * (h4 - i16));
#pragma unroll
            for (int k0 = 0; k0 < 128; k0 += 32) {
                const bf16x8 zf = *(const LAS bf16x8*)(zp + zk * k0);
                const v4u lo = *(const LAS v4u*)(gp + k0 - 8), hi = *(const LAS v4u*)(gp + k0);
                const unsigned c0 = lo.x, c1 = lo.y, c2 = lo.z, c3 = lo.w, c4 = hi.x, c5 = hi.y, c6 = hi.z, c7 = hi.w;
                const unsigned s0 = __builtin_amdgcn_alignbit(c1, c0, 16), s1 = __builtin_amdgcn_alignbit(c2, c1, 16), s2 = __builtin_amdgcn_alignbit(c3, c2, 16), s3 = __builtin_amdgcn_alignbit(c4, c3, 16),
                               s4 = __builtin_amdgcn_alignbit(c5, c4, 16), s5 = __builtin_amdgcn_alignbit(c6, c5, 16), s6 = __builtin_amdgcn_alignbit(c7, c6, 16);
#define HYF(x0, x1, x2, x3) __builtin_bit_cast(bf16x8, (v4u){x0, x1, x2, x3})
                acc[0] = __builtin_amdgcn_mfma_f32_16x16x32_bf16(HYF(c4, c5, c6, c7), zf, acc[0], 0, 0, 0);
                acc[1] = __builtin_amdgcn_mfma_f32_16x16x32_bf16(HYF(s3, s4, s5, s6), zf, acc[1], 0, 0, 0);
                acc[2] = __builtin_amdgcn_mfma_f32_16x16x32_bf16(HYF(c3, c4, c5, c6), zf, acc[2], 0, 0, 0);
                acc[3] = __builtin_amdgcn_mfma_f32_16x16x32_bf16(HYF(s2, s3, s4, s5), zf, acc[3], 0, 0, 0);
                acc[4] = __builtin_amdgcn_mfma_f32_16x16x32_bf16(HYF(c2, c3, c4, c5), zf, acc[4], 0, 0, 0);
                acc[5] = __builtin_amdgcn_mfma_f32_16x16x32_bf16(HYF(s1, s2, s3, s4), zf, acc[5], 0, 0, 0);
                acc[6] = __builtin_amdgcn_mfma_f32_16x16x32_bf16(HYF(c1, c2, c3, c4), zf, acc[6], 0, 0, 0);
                acc[7] = __builtin_amdgcn_mfma_f32_16x16x32_bf16(HYF(s0, s1, s2, s3), zf, acc[7], 0, 0, 0);
#undef HYF
            }
        }
        if (a < NBLK) {
            const float bias = hb[o * HYC + c];
            float nrm = 0.f; { const float* pb = WSP(float, WS_PART) + ((((size_t)l * 2 + (NBLK == 32 ? 0 : 1)) * 2 + o) * 2) * 8 * 512 + c;
#pragma unroll
                for (int k = 0; k < (NBLK == 32 ? 8 : 1); ++k) nrm += pb[k * 512] + pb[(8 + k) * 512]; }
            const float invn = 1.0f / nrm;
            const size_t grow = (size_t)nb * SEGB + rb0 + a * 128 + 32 * h4;
            const bf16* pp = PT + ((size_t)(512 * (o + 1) + c)) * MR + grow;
            const LAS bf16* zz = Zc + nb * ZB + a * 136 + 32 * h4;
#pragma unroll
            for (int jj = 0; jj < 4; ++jj) { const v4u pw = *(const v4u*)(pp + 8 * jj); const v4u zw = *(const LAS v4u*)(zz + 8 * jj); v4u ow;
#pragma unroll
                for (int k = 0; k < 4; ++k) { const float y0 = acc[2 * k][jj] * invn, y1 = acc[2 * k + 1][jj] * invn;
                    const float r0 = bf_lo(pw[k]) * (y0 + bf_lo(zw[k]) * bias), r1 = bf_hi(pw[k]) * (y1 + bf_hi(zw[k]) * bias); ow[k] = cvt_pk_bf16(r0, r1); }
                if (o == 0) *(LAS v4u*)(Zn + nb * ZB + a * 136 + 32 * h4 + 8 * jj) = ow;
                else *(v4u*)(YT + (size_t)c * MR + grow + 8 * jj) = ow; }
        }
        __syncthreads();
        { LAS bf16* t_ = Zc; Zc = Zn; Zn = t_; }
    }
}
__device__ __forceinline__ void hyena_phase(Frame& F, int l, bool need_ctx) {
    for (int item = F.vcu; item < HYC / 2; item += F.G) hyena_item<32, 2, 4>(F, l, item);
    if (need_ctx) for (int item = F.vcu; item < HYC / 8; item += F.G) hyena_item<2, 8, 1>(F, l, item);
}

constexpr int NSTEPS = 2 + 12 * DEPTH;
#ifndef PROBE_DUP
#define PROBE_DUP 0x0
#endif
#define REP(bit) for (int rep_ = 0; rep_ < (int)((PROBE_DUP >> (bit)) & 1) + 1; ++rep_)
#define LAUNDER() do { asm volatile("" : "+v"(F.tid), "+v"(F.lane)); asm volatile("" : "+s"(F.wave), "+s"(F.vcu)); asm volatile("" : "+s"(l)); \
    { unsigned long long w_ = (unsigned long long)F.ws; unsigned wl_ = (unsigned)w_, wh_ = (unsigned)(w_ >> 32); asm volatile("" : "+s"(wl_), "+s"(wh_)); F.ws = (unsigned char*)(((unsigned long long)wh_ << 32) | wl_); } } while (0)
#define IN(k) (lo <= (k) && (k) < hi)
#define SEAM(k) do { if (IN(k) && IN((k) + 1)) { xcd_barrier(bar); if (PROBE_DUP & (1u << 13)) xcd_barrier(bar); } } while (0)

template <int LI> __device__ __forceinline__ void layer_steps(Frame& F, const XcdBarrier& bar, const int lo, const int hi) {
        int l = LI; constexpr int li = LI;
        constexpr int sb = 2 + 12 * li; constexpr bool need_ctx = li < DEPTH - 1;
        if (IN(sb + 0)) REP(2) { LAUNDER(); pg8::PlainAB ab{WSP(bf16, WS_H), WSP(bf16, WS_WIN) + (size_t)l * DINP * DM, DM, DM}; pg8::StaticOrder S; S.init(MR / 256, DINP / 256, F.G, (int)blockIdx.x);
            pg8::EpiBf16 E{WSP(bf16, WS_U), DINP, nullptr}; pg8::gemm_phase<pg8::EpiBf16, pg8::PlainAB>(F.lds, ab, DM, S, E); }
        SEAM(sb + 0);
        if (IN(sb + 1)) REP(3) { LAUNDER(); post_u(F, l); __syncthreads(); }
        SEAM(sb + 1);
        if (IN(sb + 2)) REP(4) { LAUNDER();
            { pg8::PlainAB ab{WSP(bf16, WS_U) + OFF_Q, WSP(bf16, WS_WUQ) + (size_t)l * DQ * QRANK, DINP, QRANK}; pg8::StaticOrder S; S.init(MR / 256, DQ / 256, F.G, (int)blockIdx.x);
              pg8::EpiBf16 E{WSP(bf16, WS_Q), DQ, WSP(float, WS_RSTD)}; pg8::gemm_phase<pg8::EpiBf16, pg8::PlainAB>(F.lds, ab, QRANK, S, E); }
            { pg8::PlainAB ab{WSP(bf16, WS_U) + OFF_KV, WSP(bf16, WS_WUKV) + (size_t)l * DKV * KVRANK, DINP, KVRANK}; pg8::StaticOrder S; S.init(MR / 256, DKV / 256, F.G, (int)((blockIdx.x + F.G - 204 % F.G) % F.G));
              pg8::EpiBf16 E{WSP(bf16, WS_KV), DKV, WSP(float, WS_RSTD) + MR}; pg8::gemm_phase<pg8::EpiBf16, pg8::PlainAB>(F.lds, ab, KVRANK, S, E); }
            { LruAB ab{WSP(bf16, WS_XR), WSP(bf16, WS_WLRU) + (size_t)l * 2 * 4 * 256 * 512, 128, 512}; pg8::StaticOrder S; S.init(MR / 256, 8, F.G, (int)((blockIdx.x + F.G - 220 % F.G) % F.G));
              EpiGate E{WSP(bf16, WS_XR), WSP(f32x2, WS_AB), F.in[17] + (size_t)l * 2 * LRUC, F.in[19] + (size_t)l * 2 * LRUC, WSP(float, WS_SP) + (size_t)l * 2 * LRUC, F.in[15] + (size_t)l * 2 * 4 * LRUC};
              pg8::gemm_phase<EpiGate, LruAB>(F.lds, ab, 512, S, E); }
        }
        SEAM(sb + 2);
        if (IN(sb + 3)) { LAUNDER(); REP(5) { attn_phase(F, need_ctx); __syncthreads(); } REP(6) { hyena_phase(F, l, need_ctx); __syncthreads(); } REP(7) { lru_pass1(F); } }
        SEAM(sb + 3);
        if (IN(sb + 4)) REP(7) { LAUNDER(); lru_pass2(F); }
        SEAM(sb + 4);
        if (IN(sb + 5)) REP(8) { LAUNDER(); mix_finalize(F, l); __syncthreads(); }
        SEAM(sb + 5);
        if (IN(sb + 6)) REP(9) { LAUNDER();
            { pg8::PlainAB ab{WSP(bf16, WS_YMIX), WSP(bf16, WS_WOUT) + (size_t)l * DM * DMIX, DMIX, DMIX}; pg8::LatentOrder S; S.init(32, DM / 256, F.G, (int)blockIdx.x);
              pg8::EpiBf16 E{WSP(bf16, WS_MO), DM, nullptr}; pg8::gemm_phase<pg8::EpiBf16, pg8::PlainAB, pg8::LatentOrder>(F.lds, ab, DMIX, S, E); }
            if (need_ctx) { pg8::PieceAB ab{WSP(bf16, WS_YMIX), WSP(bf16, WS_WOUT) + (size_t)l * DM * DMIX, DMIX, DMIX, 256}; pg8::PieceOrder S; S.init(DM / 256, 8, F.G, (int)blockIdx.x);
              pg8::EpiSlab E{WSP(float, WS_SLAB)}; pg8::gemm_phase<pg8::EpiSlab, pg8::PieceAB, pg8::PieceOrder>(F.lds, ab, 256, S, E); } }
        SEAM(sb + 6);
        if (IN(sb + 7)) { LAUNDER(); if (PROBE_DUP & (1u << 14)) norm_pass(F, 1, l, true); norm_pass(F, 1, l); }
        SEAM(sb + 7);
        if (IN(sb + 8)) REP(10) { LAUNDER(); pg8::PlainAB ab{WSP(bf16, WS_H), WSP(bf16, WS_WUP) + (size_t)l * 2 * DFF * DM, DM, DM}; pg8::StaticOrder S; S.init(MR / 256, 2 * DFF / 256, F.G, (int)blockIdx.x);
            pg8::EpiBf16 E{WSP(bf16, WS_UP), 2 * DFF, nullptr}; pg8::gemm_phase<pg8::EpiBf16, pg8::PlainAB>(F.lds, ab, DM, S, E); }
        SEAM(sb + 8);
        if (IN(sb + 9)) REP(11) { LAUNDER(); conv_gelu(F, l); }
        SEAM(sb + 9);
        if (IN(sb + 10)) REP(12) { LAUNDER();
            { pg8::PlainAB ab{WSP(bf16, WS_ACT), WSP(bf16, WS_WDN) + (size_t)l * DM * DFF, DFF, DFF}; pg8::LatentOrder S; S.init(32, DM / 256, F.G, (int)blockIdx.x);
              pg8::EpiBf16 E{WSP(bf16, WS_MO), DM, nullptr}; pg8::gemm_phase<pg8::EpiBf16, pg8::PlainAB, pg8::LatentOrder>(F.lds, ab, DFF, S, E); }
            if (need_ctx) { pg8::PieceAB ab{WSP(bf16, WS_ACT), WSP(bf16, WS_WDN) + (size_t)l * DM * DFF, DFF, DFF, 512}; pg8::PieceOrder S; S.init(DM / 256, 11, F.G, (int)blockIdx.x);
              pg8::EpiSlab E{WSP(float, WS_SLAB)}; pg8::gemm_phase<pg8::EpiSlab, pg8::PieceAB, pg8::PieceOrder>(F.lds, ab, 512, S, E); } }
        SEAM(sb + 10);
        if (IN(sb + 11)) { LAUNDER(); if (PROBE_DUP & (1u << 14)) norm_pass(F, 2, l, true); norm_pass(F, 2, l); }
        SEAM(sb + 11);
}

__global__ void __launch_bounds__(NTHR, 2) fwd_kernel(Args args) {
    extern __shared__ __attribute__((aligned(16))) unsigned char lds_raw[];
    Frame F;
    F.lds = (LAS unsigned char*)lds_raw; F.ws = args.ws; F.in = args.in; F.out = args.out;
    F.tid = threadIdx.x; F.lane = F.tid & 63; F.wave = __builtin_amdgcn_readfirstlane(F.tid >> 6);
    F.G = gridDim.x; { const int bx = blockIdx.x; F.vcu = (F.G % 8 == 0) ? (bx % 8) * (F.G / 8) + bx / 8 : bx; }
    volatile LAS unsigned* MISC = (volatile LAS unsigned*)(F.lds + MISC_OFF);
    for (int u = F.tid; u < (LDS_BYTES - LDSCTL_OFF) / 4; u += NTHR) ((LAS unsigned*)(F.lds + LDSCTL_OFF))[u] = 0u;
    __syncthreads();
#if MK_MULTI
    const int lo = args.ph_lo, hi = args.ph_hi;
#else
    constexpr int lo = 0, hi = NSTEPS;
#endif
    XcdBarrier bar; bar.bar = (unsigned*)(F.ws + WS_CTL) + CW_BAR; bar.x = 0; bar.st = nullptr;
    if (hi - lo > 1) bar = xcd_barrier_post((unsigned*)(F.ws + WS_CTL) + CW_BAR, MISC + 8);

    if (IN(0)) REP(0) { REP(15) { pro_mod(F); __syncthreads(); } REP(16) { pro_transposes(F); __syncthreads(); } REP(17) { pro_lru_w(F); pro_rope(F); __syncthreads(); } REP(18) { pro_hid(F); __syncthreads(); } }
    SEAM(0);
    if (IN(1)) REP(1) { pro_filter(F); __syncthreads(); norm_pass(F, 0, 0); __syncthreads(); }
    SEAM(1);

    layer_steps<0>(F, bar, lo, hi); layer_steps<1>(F, bar, lo, hi); layer_steps<2>(F, bar, lo, hi); layer_steps<3>(F, bar, lo, hi);
#undef IN
#undef SEAM
}

extern "C" void kernel_launch(void* const* d_in, const int* in_sizes, int n_in, void* d_out, int out_size, void* d_ws, size_t ws_size, hipStream_t stream) {
    static int grid = 0;
    if (grid == 0) {
        if (n_in != 30 || ws_size < WS_END) { fprintf(stderr, "kernel_launch: expected 30 inputs and >= %zu bytes of workspace (got %d, %zu)\n", (size_t)WS_END, n_in, ws_size); grid = -1; return; }
        int dev = 0, cus = 0, per_cu = 0;
        if (hipGetDevice(&dev) != hipSuccess || hipDeviceGetAttribute(&cus, hipDeviceAttributeMultiprocessorCount, dev) != hipSuccess) { grid = -1; return; }
        if (hipFuncSetAttribute((const void*)fwd_kernel, hipFuncAttributeMaxDynamicSharedMemorySize, LDS_BYTES) != hipSuccess) { fprintf(stderr, "kernel_launch: hipFuncSetAttribute failed\n"); grid = -1; return; }
        if (hipOccupancyMaxActiveBlocksPerMultiprocessor(&per_cu, (const void*)fwd_kernel, NTHR, LDS_BYTES) != hipSuccess || per_cu < 1) fprintf(stderr, "kernel_launch: occupancy query says %d\n", per_cu);
        (void)hipGetLastError();
        grid = cus;
    }
    if (grid < 0) return;
    (void)hipMemsetAsync((char*)d_ws + WS_CTL, 0, CTL_ZERO_BYTES, stream);
    Args a{};
    for (int i = 0; i < 30; ++i) a.in[i] = (const float*)d_in[i];
    a.out = (float*)d_out; a.ws = (unsigned char*)d_ws;
#if MK_MULTI
    for (int s = 0; s < NSTEPS; ++s) { a.ph_lo = s; a.ph_hi = s + 1; hipLaunchKernelGGL(fwd_kernel, dim3(grid), dim3(NTHR), LDS_BYTES, stream, a); }
#else
    a.ph_lo = 0; a.ph_hi = NSTEPS; hipLaunchKernelGGL(fwd_kernel, dim3(grid), dim3(NTHR), LDS_BYTES, stream, a);
#endif
}
```

```cpp
#include <hip/hip_runtime.h>
#include <cstdio>
#include <cstdint>

#ifndef MK_MULTI
#define MK_MULTI 0
#endif

constexpr int DM = 2048, NBATCH = 2, SEQ = 4096, CTXL = 256, DEPTH = 4;
constexpr int SEGB = CTXL + SEQ;
constexpr int MR = NBATCH * SEGB;
constexpr int DIN = 3392, DINP = 3584;
constexpr int HYC = 512, LRUC = 512, QRANK = 512, KVRANK = 256, NOPE = 128, ROPED = 64, VD = 128, NH = 8;
constexpr int DQ = NH * (NOPE + ROPED);
constexpr int DKV = NH * (NOPE + VD);
constexpr int DFF = 5632, DMIX = 2048;
constexpr int OFF_LRU_G = 1536, OFF_Q = 2048, OFF_LRU_X = 2560, OFF_KV = 3072, OFF_KR = 3328;
constexpr float EPS = 1e-6f;
constexpr int XR_ROWS = 4364;
constexpr int NCHUNK = MR / 64;
constexpr int HYL = 8192, HYLC = 512;

constexpr size_t MiB = 1u << 20;
constexpr size_t WS_CTL = 0, CTL_ZERO_BYTES = 1 * MiB;
constexpr size_t WS_MOD = 1 * MiB;
constexpr size_t WS_ROPE = 2 * MiB;
constexpr size_t WS_HID = 3 * MiB;
constexpr size_t WS_PART = 8 * MiB;
constexpr size_t WS_RSTD = 9 * MiB;
constexpr size_t WS_SP = 9 * MiB + 256 * 1024;
constexpr size_t WS_CARRY = 10 * MiB;
constexpr size_t WS_G = 16 * MiB;
constexpr size_t WS_GC = 80 * MiB;
constexpr size_t WS_WIN = 96 * MiB;
constexpr size_t WS_WUQ = 152 * MiB;
constexpr size_t WS_WUKV = 158 * MiB;
constexpr size_t WS_WOUT = 162 * MiB;
constexpr size_t WS_WUP = 194 * MiB;
constexpr size_t WS_WDN = 370 * MiB;
constexpr size_t WS_WLRU = 458 * MiB;
constexpr size_t WS_X = 480 * MiB;
constexpr size_t WS_H = 548 * MiB;
constexpr size_t WS_U = 582 * MiB;
constexpr size_t WS_Q = 642 * MiB;
constexpr size_t WS_KV = 668 * MiB;
constexpr size_t WS_KR = 702 * MiB;
constexpr size_t WS_O = 704 * MiB;
constexpr size_t WS_PT = 722 * MiB;
constexpr size_t WS_YT = 748 * MiB;
constexpr size_t WS_XR = 757 * MiB;
constexpr size_t WS_AB = 766 * MiB;
constexpr size_t WS_HF = 834 * MiB;
constexpr size_t WS_YL = 851 * MiB;
constexpr size_t WS_YMIX = 868 * MiB;
constexpr size_t WS_MO = 902 * MiB;
constexpr size_t WS_UP = 936 * MiB;
constexpr size_t WS_ACT = 1123 * MiB;
constexpr size_t WS_SLAB = 1217 * MiB;
constexpr size_t WS_WUKV2 = 1265 * MiB;
constexpr size_t WS_WSM = 1273 * MiB;
constexpr int WSM_ROWS = 1536 + 2048 + 2048;
constexpr size_t WS_END = 1297 * MiB;

constexpr int CW_BAR = 4096;

constexpr int NWAVES = 8, NTHR = 512;
constexpr int RING_BYTES = 131072;
constexpr int LDSCTL_OFF = RING_BYTES, MISC_OFF = LDSCTL_OFF + 320;
constexpr int LDS_BYTES = 147456;

#define GAS __attribute__((address_space(1)))
#define LAS __attribute__((address_space(3)))
#define CAS __attribute__((address_space(4)))
typedef const float CAS cfloat_c;
typedef unsigned short bf16;
typedef unsigned v4u __attribute__((ext_vector_type(4)));
typedef unsigned v2u __attribute__((ext_vector_type(2)));
typedef float f32x4 __attribute__((ext_vector_type(4)));
typedef float f32x2 __attribute__((ext_vector_type(2)));
typedef float f32x16 __attribute__((ext_vector_type(16)));
typedef short bf16x8 __attribute__((ext_vector_type(8)));
typedef short s16x4 __attribute__((ext_vector_type(4)));
typedef GAS unsigned gu32;
#define RLX_AGENT __ATOMIC_RELAXED, __HIP_MEMORY_SCOPE_AGENT
#define LDS_WAIT() asm volatile("s_waitcnt lgkmcnt(0)" ::: "memory")
#define VM_WAIT() asm volatile("s_waitcnt vmcnt(0)" ::: "memory")

__device__ __forceinline__ unsigned cvt_pk_bf16(float lo, float hi) { unsigned r; asm volatile("v_cvt_pk_bf16_f32 %0, %1, %2" : "=v"(r) : "v"(lo), "v"(hi)); return r; }
__device__ __forceinline__ float bf_lo(unsigned w) { return __uint_as_float(w << 16); }
__device__ __forceinline__ float bf_hi(unsigned w) { return __uint_as_float(w & 0xffff0000u); }
__device__ __forceinline__ float bf2f(bf16 v) { return __uint_as_float(((unsigned)v) << 16); }
__device__ __forceinline__ bf16 f2bf(float f) { return (bf16)(cvt_pk_bf16(f, 0.f) & 0xffffu); }
__device__ __forceinline__ float wave_sum(float v) {
#pragma unroll
    for (int o = 1; o < 64; o <<= 1) v += __shfl_xor(v, o);
    return v;
}
__device__ __forceinline__ float sigmoidf_(float x) { return 1.0f / (1.0f + __expf(-x)); }
__device__ __forceinline__ float gelu_tanh(float x) { const float u = 0.7978845608028654f * (x + 0.044715f * x * x * x); return x / (1.0f + __expf(-2.0f * u)); }

#define XB_TMO      128
#define XB_XCNT(j)  (256  + 64 * (j))
#define XB_XSUB(j)  (1280 + 64 * (j))
#define XB_XGEN(j)  (2304 + 64 * (j))
#define XB_TOP      3328
#define XB_TOPGEN   3392
#define XCD_BAR_WORDS 3456
#define XB_SPIN_CAP (1u << 18)
__device__ __forceinline__ unsigned xb_ld(unsigned* p)              { return __hip_atomic_load(p, __ATOMIC_RELAXED, __HIP_MEMORY_SCOPE_AGENT); }
__device__ __forceinline__ unsigned xb_add(unsigned* p, unsigned v) { return __hip_atomic_fetch_add(p, v, __ATOMIC_RELAXED, __HIP_MEMORY_SCOPE_AGENT); }
__device__ __forceinline__ unsigned xb_xcc_id() { return (unsigned)__builtin_amdgcn_s_getreg((3 << 11) | 20) & 0xFu; }
#define XB_SPIN(cond, bar) do { unsigned _sp = 0; while (cond) { __builtin_amdgcn_s_sleep(1); \
    if ((++_sp & 255u) == 0u) { if (xb_ld(&(bar)[XB_TMO])) break; if (_sp > XB_SPIN_CAP) { atomicAdd(&(bar)[XB_TMO], 1u); break; } } } } while (0)
struct XcdBarrier { unsigned* bar; unsigned x; volatile LAS unsigned* st; };
__device__ __forceinline__ XcdBarrier xcd_barrier_post(unsigned* bar, volatile LAS unsigned* st) {
    XcdBarrier b; b.bar = bar; b.x = xb_xcc_id(); b.st = st;
    if (threadIdx.x == 0) (void)xb_add(&bar[XB_XCNT(b.x)], 1u);
    return b;
}
__device__ __forceinline__ void xcd_barrier_complete(unsigned* bar, unsigned x, unsigned& nloc, unsigned& nx) {
    const unsigned G = gridDim.x * gridDim.y * gridDim.z;
    unsigned sum, cnt, mine, sp = 0u;
    for (;;) {
        sum = 0u; cnt = 0u; mine = 0u;
#pragma unroll
        for (unsigned j = 0; j < 16; ++j) { const unsigned c = xb_ld(&bar[XB_XCNT(j)]); sum += c; cnt += (c > 0u) ? 1u : 0u; mine = (j == x) ? c : mine; }
        if (sum == G) break;
        __builtin_amdgcn_s_sleep(1);
        if ((++sp & 255u) == 0u) { if (xb_ld(&bar[XB_TMO])) break; if (sp > XB_SPIN_CAP) { atomicAdd(&bar[XB_TMO], 1u); break; } }
    }
    nloc = mine > 0u ? mine : 1u; nx = cnt > 0u ? cnt : 1u;
}
__device__ __forceinline__ void xcd_barrier(const XcdBarrier& b) {
    asm volatile("s_waitcnt vmcnt(0)" ::: "memory");
    __syncthreads();
    unsigned* bar_l; { unsigned long long w_ = (unsigned long long)b.bar; unsigned wl_ = (unsigned)w_, wh_ = (unsigned)(w_ >> 32); asm volatile("" : "+s"(wl_), "+s"(wh_)); bar_l = (unsigned*)(((unsigned long long)wh_ << 32) | wl_); }
    unsigned x_l = b.x; asm volatile("" : "+s"(x_l));
    if (threadIdx.x == 0) {
        unsigned* bar = bar_l;
        __builtin_amdgcn_s_waitcnt(0);
        unsigned nloc = b.st[0], nx = b.st[1];
        if (nloc == 0u) { xcd_barrier_complete(bar, x_l, nloc, nx); b.st[0] = nloc; b.st[1] = nx; }
        const unsigned old = xb_add(&bar[XB_XSUB(x_l)], 1u);
        const unsigned gen = old / nloc;
        if (old + 1u == (gen + 1u) * nloc) {
            __builtin_amdgcn_fence(__ATOMIC_RELEASE, "agent");
            asm volatile("s_waitcnt vmcnt(0)" ::: "memory");
            const unsigned og = xb_add(&bar[XB_TOP], 1u);
            const unsigned tg = og / nx;
            if (og + 1u == (tg + 1u) * nx) xb_add(&bar[XB_TOPGEN], 1u);
            else XB_SPIN(xb_ld(&bar[XB_TOPGEN]) == tg, bar);
            __builtin_amdgcn_fence(__ATOMIC_ACQUIRE, "agent");
            xb_add(&bar[XB_XGEN(x_l)], 1u);
            asm volatile("s_waitcnt vmcnt(0)" ::: "memory");
        } else {
            XB_SPIN(xb_ld(&bar[XB_XGEN(x_l)]) == gen, bar);
            __builtin_amdgcn_fence(__ATOMIC_ACQUIRE, "agent");
            asm volatile("s_waitcnt vmcnt(0)" ::: "memory");
        }
    }
    __syncthreads();
}

struct Args { const float* in[30]; float* out; unsigned char* ws; int ph_lo, ph_hi; };
struct Frame {
    LAS unsigned char* lds;
    unsigned char* ws;
    const float* const* in;
    float* out;
    int tid, lane, wave, vcu, G;
};
#define WSP(T, off) ((T*)(F.ws + (off)))
__device__ __forceinline__ void row_info(int r, int& b, int& isctx, int& t) { b = r >= SEGB ? 1 : 0; const int j = r - b * SEGB; isctx = j < CTXL ? 1 : 0; t = isctx ? j : j - CTXL; }

namespace pg8 {
constexpr int BM = 256, BK = 64, HALF = 128, HTB = HALF * BK * 2, STAGE_BYTES = 8 * HTB, NXCD = 8, WGM = 8;
__host__ __device__ __forceinline__ int lds_byte(int r, int c) { const int st = (r >> 4) * 2 + (c >> 5), rr = r & 15, cc = c & 31, ob = rr * 64 + cc * 2; return st * 1024 + (ob ^ (((ob >> 9) & 1) << 5)); }
__host__ __device__ __forceinline__ void stage_rc(int b, int& R, int& C) { const int st = b / 1024, sb = b % 1024, swz = sb ^ (((sb >> 9) & 1) << 5); R = (st >> 1) * 16 + swz / 64; C = (st & 1) * 32 + (swz % 64) / 2; }
__host__ __device__ __forceinline__ int perm32(int rho) { const int n = rho >> 4, i = rho & 15; return 8 * (i >> 2) + 4 * n + (i & 3); }
struct Unit { int pm, pn, ks; };
struct StaticOrder {
    int nM, nN, nwg, G, c;
    __host__ __device__ void init(int nM_, int nN_, int G_, int c_) { nM = nM_; nN = nN_; nwg = nM * nN; G = G_; c = c_; }
    __host__ __device__ bool next(int i, Unit& u) const {
        const long L = (long)i * G + c; if (L >= nwg) return false;
        int wgid = (int)L; { const int q = nwg / NXCD, r = nwg % NXCD, xcd = wgid % NXCD, off = wgid / NXCD; wgid = (xcd < r ? xcd * (q + 1) : r * (q + 1) + (xcd - r) * q) + off; }
        const int nig = WGM * nN, gid = wgid / nig, fm = gid * WGM, gsz = (nM - fm) < WGM ? (nM - fm) : WGM;
        u.pm = fm + ((wgid % nig) % gsz); u.pn = (wgid % nig) / gsz; u.ks = 0; return true;
    }
};
struct LatentOrder : StaticOrder {
    __host__ __device__ bool next(int i, Unit& u) const { if (!StaticOrder::next(i, u)) return false; u.pm = u.pm < 16 ? u.pm + 1 : u.pm + 2; return true; }
};
struct PieceOrder {
    int nN, S, n, G, c;
    __host__ __device__ void init(int nN_, int S_, int G_, int c_) { nN = nN_; S = S_; n = 2 * nN_ * S_; G = G_; c = c_; }
    __host__ __device__ bool next(int i, Unit& u) const { const long L = (long)i * G + c; if (L >= n) return false; const int li = (int)L; u.ks = li % S; u.pn = (li / S) % nN; u.pm = (li / (S * nN)) ? 17 : 0; return true; }
};
struct PieceAB {
    static constexpr bool VARK = false;
    const bf16* A; const bf16* Bt; int lda, ldb, Kp;
    __device__ __forceinline__ const char* a_base(const Unit& u) const { return (const char*)(A + (size_t)u.pm * BM * lda + (size_t)u.ks * Kp); }
    __device__ __forceinline__ const char* b_base(const Unit& u) const { return (const char*)(Bt + (size_t)u.pn * BM * ldb + (size_t)u.ks * Kp); }
};
struct EpiSlab {
    static constexpr bool PERM = false;
    float* slab;
    __device__ __forceinline__ void operator()(const f32x4 (&acc)[2][2][4][2], const Unit& u, int wr, int wc, int fr, int fq) const {
        const int row0 = (u.pm ? 256 : 0) + wr * 64 + fr, col0 = u.pn * BM + wc * 32 + 4 * fq; float* base = slab + (size_t)u.ks * (512 * 2048);
#pragma unroll
        for (int ai = 0; ai < 2; ++ai)
#pragma unroll
            for (int m = 0; m < 4; ++m) { float* rowp = base + (size_t)(row0 + ai * HALF + m * 16) * 2048 + col0;
#pragma unroll
                for (int bj = 0; bj < 2; ++bj)
#pragma unroll
                    for (int n = 0; n < 2; ++n) *(f32x4*)(rowp + bj * HALF + n * 16) = acc[ai][bj][m][n]; }
    }
};
struct PlainAB {
    static constexpr bool VARK = false;
    const bf16* A; const bf16* Bt; int lda, ldb;
    __device__ __forceinline__ const char* a_base(const Unit& u) const { return (const char*)(A + (size_t)u.pm * BM * lda); }
    __device__ __forceinline__ const char* b_base(const Unit& u) const { return (const char*)(Bt + (size_t)u.pn * BM * ldb); }
};
struct EpiBf16 {
    static constexpr bool PERM = true;
    bf16* O; int ldc; const float* rowscale;
    __device__ __forceinline__ void operator()(const f32x4 (&acc)[2][2][4][2], const Unit& u, int wr, int wc, int fr, int fq) const {
        const int row0 = u.pm * BM + wr * 64 + fr; const int col0 = u.pn * BM + wc * 32 + 8 * fq;
#pragma unroll
        for (int ai = 0; ai < 2; ++ai)
#pragma unroll
            for (int m = 0; m < 4; ++m) { const int row = row0 + ai * HALF + m * 16; bf16* rowp = O + (size_t)row * ldc + col0; const float sc = rowscale ? rowscale[row] : 1.0f;
#pragma unroll
                for (int bj = 0; bj < 2; ++bj) { const f32x4 v0 = acc[ai][bj][m][0] * sc, v1 = acc[ai][bj][m][1] * sc;
                    v4u w; w.x = cvt_pk_bf16(v0[0], v0[1]); w.y = cvt_pk_bf16(v0[2], v0[3]); w.z = cvt_pk_bf16(v1[0], v1[1]); w.w = cvt_pk_bf16(v1[2], v1[3]);
                    *(v4u*)(rowp + bj * HALF) = w; } }
    }
};

template <class Epi, class AB, class Sched = StaticOrder, bool ALIGN_EPI = true>
__device__ __forceinline__ void gemm_phase(LAS unsigned char* lds, const AB ab, const int K, const Sched& S, const Epi& E) {
    int tid = threadIdx.x; asm volatile("" : "+v"(tid));
    const int wid = __builtin_amdgcn_readfirstlane(tid >> 6), lane = tid & 63, wr = wid >> 2, wc = wid & 3, fr = lane & 15, fq = lane >> 4;
    int nt = K / BK;
    unsigned voffA[2], voffB[2], voffAn[2]; int stR[2], stC[2];
#pragma unroll
    for (int i = 0; i < 2; ++i) { int R, C; stage_rc(tid * 16 + i * 8192, R, C); const int Rb = Epi::PERM ? ((R & ~31) + perm32(R & 31)) : R; stR[i] = R; stC[i] = C;
        voffA[i] = (unsigned)(R * ab.lda + C) * 2u; voffB[i] = (unsigned)(Rb * ab.ldb + C) * 2u; voffAn[i] = voffA[i]; }
    const size_t kstep = (size_t)(BK * 2);
    size_t hstepA = (size_t)HALF * ab.lda * 2, hstepAn = hstepA; const size_t hstepB = (size_t)HALF * ab.ldb * 2; int ntn = nt;
    const unsigned ldsw = (unsigned)wid * 1024u;
    const int aoff = lds_byte(wr * 64 + fr, fq * 8), boff = lds_byte(wc * 32 + fr, fq * 8);
#define PG8_SA(b, h) (((b) * 2 + (h)) * HTB)
#define PG8_SB(b, h) ((4 + (b) * 2 + (h)) * HTB)
#define PG8_STAGE(bufoff, gbase, voff) do { _Pragma("unroll") for (int _i = 0; _i < 2; ++_i) \
        __builtin_amdgcn_global_load_lds((const unsigned*)((const char*)(gbase) + (voff)[_i]), (LAS unsigned*)(lds + (bufoff) + ldsw + _i * 8192), 16, 0, 0); } while (0)
#define PG8_LDA(dst, b, h) do { _Pragma("unroll") for (int m = 0; m < 4; ++m) _Pragma("unroll") for (int k = 0; k < 2; ++k) dst[m][k] = *(const LAS bf16x8*)(lds + PG8_SA(b, h) + aoff + m * 2048 + k * 1024); } while (0)
#define PG8_LDB(dst, b, h) do { _Pragma("unroll") for (int n = 0; n < 2; ++n) _Pragma("unroll") for (int k = 0; k < 2; ++k) dst[n][k] = *(const LAS bf16x8*)(lds + PG8_SB(b, h) + boff + n * 2048 + k * 1024); } while (0)
#define PG8_MMA(ai, bj, At, Bt) do { __builtin_amdgcn_s_setprio(1); _Pragma("unroll") for (int m = 0; m < 4; ++m) _Pragma("unroll") for (int n = 0; n < 2; ++n) _Pragma("unroll") for (int k = 0; k < 2; ++k) \
        acc[ai][bj][m][n] = __builtin_amdgcn_mfma_f32_16x16x32_bf16(Bt[n][k], At[m][k], acc[ai][bj][m][n], 0, 0, 0); __builtin_amdgcn_s_setprio(0); } while (0)
#define PG8_WAIT_V(n) asm volatile("s_waitcnt vmcnt(" #n ")" ::: "memory")
#define PG8_WAIT_L(n) asm volatile("s_waitcnt lgkmcnt(" #n ")" ::: "memory")
#define PG8_BAR __builtin_amdgcn_s_barrier()
#define PG8_SCHED __builtin_amdgcn_sched_barrier(0)
    Unit cur, nxt; int ui = 0;
    if (!S.next(0, cur)) return;
    f32x4 acc[2][2][4][2];
#pragma unroll
    for (int a = 0; a < 2; ++a)
#pragma unroll
        for (int b = 0; b < 2; ++b)
#pragma unroll
            for (int m = 0; m < 4; ++m)
#pragma unroll
                for (int n = 0; n < 2; ++n) acc[a][b][m][n] = (f32x4){0.f, 0.f, 0.f, 0.f};
    bf16x8 At[4][2], B0[2][2], B1[2][2];
    const char* cA = ab.a_base(cur); const char* cB = ab.b_base(cur);
    if constexpr (AB::VARK) { const int la_ = ab.lda_of(cur); nt = ab.ktiles(cur); hstepA = (size_t)HALF * la_ * 2;
#pragma unroll
        for (int i = 0; i < 2; ++i) voffA[i] = (unsigned)(stR[i] * la_ + stC[i]) * 2u; }
    PG8_STAGE(PG8_SB(0, 0), cB, voffB); PG8_STAGE(PG8_SB(0, 1), cB + hstepB, voffB); PG8_STAGE(PG8_SA(0, 0), cA, voffA); PG8_STAGE(PG8_SA(0, 1), cA + hstepA, voffA);
    if (wr == 1) PG8_BAR;
    PG8_WAIT_V(2); PG8_BAR;
    PG8_STAGE(PG8_SB(1, 0), cB + kstep, voffB); PG8_STAGE(PG8_SA(1, 0), cA + kstep, voffA); PG8_STAGE(PG8_SB(1, 1), cB + hstepB + kstep, voffB);
    PG8_WAIT_V(6); PG8_BAR;
    for (;;) {
        const bool has_next = S.next(ui + 1, nxt);
        const char* nA = has_next ? ab.a_base(nxt) : cA; const char* nB = has_next ? ab.b_base(nxt) : cB;
        if constexpr (AB::VARK) { if (has_next) { const int la_ = ab.lda_of(nxt); ntn = ab.ktiles(nxt); hstepAn = (size_t)HALF * la_ * 2;
#pragma unroll
                for (int i = 0; i < 2; ++i) voffAn[i] = (unsigned)(stR[i] * la_ + stC[i]) * 2u; } else { ntn = nt; hstepAn = hstepA; voffAn[0] = voffA[0]; voffAn[1] = voffA[1]; } }
        for (int t = 0; t < nt; t += 2) {
            const bool last = (t == nt - 2);
            const char* a1 = cA + (size_t)(t + 1) * kstep;
            const char* a2 = last ? nA : cA + (size_t)(t + 2) * kstep; const char* b2 = last ? nB : cB + (size_t)(t + 2) * kstep;
            const char* a3 = a2 + kstep; const char* b3 = b2 + kstep;
            unsigned voffA2[2]; size_t hstepA2;
            if constexpr (AB::VARK) { voffA2[0] = last ? voffAn[0] : voffA[0]; voffA2[1] = last ? voffAn[1] : voffA[1]; hstepA2 = last ? hstepAn : hstepA; }
            else { voffA2[0] = voffA[0]; voffA2[1] = voffA[1]; hstepA2 = hstepA; }
            PG8_LDB(B0, 0, 0); PG8_LDB(B1, 0, 1); PG8_SCHED; PG8_LDA(At, 0, 0); PG8_STAGE(PG8_SA(1, 1), a1 + hstepA, voffA);
            PG8_WAIT_V(8); PG8_WAIT_L(0); PG8_BAR; PG8_MMA(0, 0, At, B0); PG8_MMA(0, 1, At, B1); PG8_BAR; PG8_SCHED;
            PG8_LDA(At, 0, 1); PG8_STAGE(PG8_SB(0, 0), b2, voffB); PG8_STAGE(PG8_SB(0, 1), b2 + hstepB, voffB); PG8_STAGE(PG8_SA(0, 0), a2, voffA2);
            PG8_WAIT_V(8); PG8_WAIT_L(0); PG8_BAR; PG8_MMA(1, 0, At, B0); PG8_MMA(1, 1, At, B1); PG8_BAR; PG8_SCHED;
            PG8_LDB(B0, 1, 0); PG8_LDB(B1, 1, 1); PG8_SCHED; PG8_LDA(At, 1, 0); PG8_STAGE(PG8_SA(0, 1), a2 + hstepA2, voffA2);
            PG8_WAIT_V(8); PG8_WAIT_L(0); PG8_BAR; PG8_MMA(0, 0, At, B0); PG8_MMA(0, 1, At, B1); PG8_BAR; PG8_SCHED;
            PG8_LDA(At, 1, 1); PG8_STAGE(PG8_SB(1, 0), b3, voffB); PG8_STAGE(PG8_SB(1, 1), b3 + hstepB, voffB); PG8_STAGE(PG8_SA(1, 0), a3, voffA2);
            PG8_WAIT_V(8); PG8_WAIT_L(0); PG8_BAR; PG8_MMA(1, 0, At, B0); PG8_MMA(1, 1, At, B1); PG8_BAR; PG8_SCHED;
        }
        if constexpr (ALIGN_EPI) { if (wr == 0) PG8_BAR; }
        E(acc, cur, wr, wc, fr, fq);
        if (!has_next) break;
#pragma unroll
        for (int a = 0; a < 2; ++a)
#pragma unroll
            for (int b = 0; b < 2; ++b)
#pragma unroll
                for (int m = 0; m < 4; ++m)
#pragma unroll
                    for (int n = 0; n < 2; ++n) acc[a][b][m][n] = (f32x4){0.f, 0.f, 0.f, 0.f};
        cur = nxt; cA = nA; cB = nB; ++ui;
        if constexpr (AB::VARK) { nt = ntn; hstepA = hstepAn; voffA[0] = voffAn[0]; voffA[1] = voffAn[1]; }
        if constexpr (ALIGN_EPI) { if (wr == 1) PG8_BAR; }
    }
    PG8_WAIT_V(0);
    if constexpr (!ALIGN_EPI) { if (wr == 0) PG8_BAR; }
    PG8_BAR;
#undef PG8_SA
#undef PG8_SB
#undef PG8_STAGE
#undef PG8_LDA
#undef PG8_LDB
#undef PG8_MMA
#undef PG8_WAIT_V
#undef PG8_WAIT_L
#undef PG8_BAR
#undef PG8_SCHED
}
}

__device__ __forceinline__ void pro_mod(Frame& F) {
    LAS float* sil = (LAS float*)F.lds;
    LAS float* red = (LAS float*)(F.lds + 24576);
    const float* c = F.in[1]; const float* cc = F.in[3];
    for (int i = F.tid; i < 3 * DM; i += NTHR) { const int w = i / DM, k = i - w * DM; const float v = (w < 2) ? c[w * DM + k] : cc[k]; sil[i] = v / (1.0f + expf(-v)); }
    __syncthreads();
    float* MOD = WSP(float, WS_MOD);
    const int k0 = F.wave * 256;
    for (int unit = F.vcu; unit < DEPTH * 192; unit += F.G) {
        const int l = unit / 192, cg = unit - l * 192;
        const float* W = F.in[4] + (size_t)l * DM * (6 * DM) + cg * 64 + F.lane;
        float a0 = 0.f, a1 = 0.f, a2 = 0.f;
#pragma unroll 16
        for (int k = k0; k < k0 + 256; ++k) { const float w = W[(size_t)k * (6 * DM)]; a0 += sil[k] * w; a1 += sil[DM + k] * w; a2 += sil[2 * DM + k] * w; }
        red[(F.wave * 3 + 0) * 64 + F.lane] = a0; red[(F.wave * 3 + 1) * 64 + F.lane] = a1; red[(F.wave * 3 + 2) * 64 + F.lane] = a2;
        __syncthreads();
        if (F.tid < 192) { const int j = F.tid >> 6, ln = F.tid & 63; float s = 0.f;
#pragma unroll
            for (int w = 0; w < 8; ++w) s += red[(w * 3 + j) * 64 + ln];
            MOD[((size_t)l * 3 + j) * (6 * DM) + cg * 64 + ln] = s + F.in[5][(size_t)l * (6 * DM) + cg * 64 + ln]; }
        __syncthreads();
    }
}

__device__ __forceinline__ void tr_tile(const float* __restrict__ W, int K, int N, bf16* __restrict__ WT, const float* kscale, LAS float* scr, int item, int lane, int ldk = 0) {
    if (ldk == 0) ldk = K;
    const int nblk = N >> 5, kb = item / nblk, nb = item - kb * nblk, k0 = kb * 64, n0 = nb * 32;
#pragma unroll
    for (int i = 0; i < 8; ++i) { const int kk = 8 * i + (lane >> 3), c4 = (lane & 7) * 4;
        f32x4 v = *(const f32x4*)(W + (size_t)(k0 + kk) * N + n0 + c4); if (kscale) v = v * kscale[k0 + kk];
        scr[kk * 33 + c4 + 0] = v[0]; scr[kk * 33 + c4 + 1] = v[1]; scr[kk * 33 + c4 + 2] = v[2]; scr[kk * 33 + c4 + 3] = v[3]; }
    LDS_WAIT(); asm volatile("" ::: "memory");
    const int c = lane & 7;
#pragma unroll
    for (int j = 0; j < 4; ++j) { const int n = (lane >> 3) + 8 * j; const LAS float* s = scr + (8 * c) * 33 + n;
        v4u o; o.x = cvt_pk_bf16(s[0], s[33]); o.y = cvt_pk_bf16(s[66], s[99]); o.z = cvt_pk_bf16(s[132], s[165]); o.w = cvt_pk_bf16(s[198], s[231]);
        *(v4u*)(WT + (size_t)(n0 + n) * ldk + k0 + 8 * c) = o; }
    LDS_WAIT(); asm volatile("" ::: "memory");
}
__device__ __forceinline__ void pro_transposes(Frame& F) {
    LAS float* scr = (LAS float*)(F.lds + F.wave * 16384);
    const int gw = F.vcu * NWAVES + F.wave, NGW = F.G * NWAVES;
    constexpr int I0 = 32 * 106, I1 = 8 * 48, I2 = 4 * 64, I3 = 32 * 64, I4 = 32 * 352, I5 = 88 * 64, IL = I0 + I1 + I2 + I3 + I4 + I5;
    for (int it = gw; it < DEPTH * IL; it += NGW) {
        const int l = it / IL; int r = it - l * IL;
        if (r < I0) { tr_tile(F.in[7] + (size_t)l * DM * DIN, DM, DIN, WSP(bf16, WS_WIN) + (size_t)l * DINP * DM, nullptr, scr, r, F.lane); continue; } r -= I0;
        if (r < I1) { tr_tile(F.in[23] + (size_t)l * QRANK * DQ, QRANK, DQ, WSP(bf16, WS_WSM) + (size_t)l * WSM_ROWS * 512, F.in[21] + l * QRANK, scr, r, F.lane); continue; } r -= I1;
        if (r < I2) { tr_tile(F.in[24] + (size_t)l * KVRANK * DKV, KVRANK, DKV, WSP(bf16, WS_WSM) + ((size_t)l * WSM_ROWS + 3584) * 512, F.in[22] + l * KVRANK, scr, r, F.lane, 512); continue; } r -= I2;
        if (r < I3) { tr_tile(F.in[26] + (size_t)l * DMIX * DM, DMIX, DM, WSP(bf16, WS_WOUT) + (size_t)l * DM * DMIX, nullptr, scr, r, F.lane); continue; } r -= I3;
        if (r < I4) { tr_tile(F.in[27] + (size_t)l * DM * 2 * DFF, DM, 2 * DFF, WSP(bf16, WS_WUP) + (size_t)l * 2 * DFF * DM, nullptr, scr, r, F.lane); continue; } r -= I4;
        tr_tile(F.in[29] + (size_t)l * DFF * DM, DFF, DM, WSP(bf16, WS_WDN) + (size_t)l * DM * DFF, nullptr, scr, r, F.lane);
    }
    { const v4u z = {0u, 0u, 0u, 0u}; constexpr int per = (DINP - DIN) * DM / 8;
      for (int i = F.vcu * NTHR + F.tid; i < DEPTH * per; i += F.G * NTHR) { const int l = i / per, j = i - l * per; *(v4u*)(WSP(bf16, WS_WIN) + ((size_t)l * DINP + DIN) * DM + (size_t)j * 8) = z; } }
}
__device__ __forceinline__ void pro_lru_w(Frame& F) {
    bf16* WL = WSP(bf16, WS_WLRU);
    constexpr int total = DEPTH * 2 * 4 * 256 * 64;
    for (int i = F.vcu * NTHR + F.tid; i < total; i += F.G * NTHR) {
        const int ch = i & 63, row = (i >> 6) & 255, blk = (i >> 14) & 3, dir = (i >> 16) & 1, l = i >> 17;
        const int g = row >> 7, e = row & 127, j4 = ch >> 4, d0 = (ch & 15) * 8;
        const float* Wsrc = (g ? F.in[18] : F.in[16]) + ((((size_t)l * 2 + dir) * 4 + blk) * 128) * 128;
        const float* cw = F.in[15] + (((size_t)l * 2 + dir) * 4 + j4) * LRUC + blk * 128 + d0;
        float v[8];
#pragma unroll
        for (int j = 0; j < 8; ++j) v[j] = cw[j] * Wsrc[(size_t)(d0 + j) * 128 + e];
        v4u o; o.x = cvt_pk_bf16(v[0], v[1]); o.y = cvt_pk_bf16(v[2], v[3]); o.z = cvt_pk_bf16(v[4], v[5]); o.w = cvt_pk_bf16(v[6], v[7]);
        *(v4u*)(WSP(bf16, WS_WSM) + ((size_t)l * WSM_ROWS + 1536) * 512 + (size_t)(i & ((1 << 17) - 1)) * 8) = o;
    }
}
__device__ __forceinline__ void pro_rope(Frame& F) {
    { float* SP = WSP(float, WS_SP); for (int i = F.vcu * NTHR + F.tid; i < DEPTH * 2 * LRUC; i += F.G * NTHR) SP[i] = log1pf(expf(-F.in[20][i])); }
    float* R = WSP(float, WS_ROPE);
    for (int i = F.vcu * NTHR + F.tid; i < SEQ * 32; i += F.G * NTHR) { const int t = i >> 5, f = i & 31; const float pos = (f < 16) ? (float)(t >> 6) : (float)(t & 63);
        const float inv = powf(10000.0f, -(float)(f & 15) / 16.0f); const float a = pos * inv; R[t * 64 + f] = cosf(a); R[t * 64 + 32 + f] = sinf(a); }
}
__device__ __forceinline__ void pro_hid(Frame& F) {
    LAS float* h1 = (LAS float*)(F.lds + F.wave * 16384);
    float* HID = WSP(float, WS_HID);
    const int gw = F.vcu * NWAVES + F.wave, NGW = F.G * NWAVES;
    const int tl = F.lane & 15, part = F.lane >> 4;
    for (int wi = gw; wi < DEPTH * 272; wi += NGW) {
        const int l = __builtin_amdgcn_readfirstlane(wi / 272), tt = (wi - l * 272) * 16 + tl;
        const int L = tt < 4096 ? 4096 : 256, t = tt < 4096 ? tt : tt - 4096;
        const float tn = (float)t / (float)L;
        float sb[16], cb[16];
#pragma unroll
        for (int b = 0; b < 16; ++b) { const float ang = (6.2831855f * tn) * (float)(b + 1); sb[b] = sinf(ang); cb[b] = cosf(ang); }
        const float* w1p = F.in[9] + (size_t)l * 33 * 64 + part * 16; const float* b1p = F.in[10] + l * 64 + part * 16;
        const float* w2p = F.in[11] + (size_t)l * 64 * 64 + part * 16; const float* b2p = F.in[12] + l * 64 + part * 16;
        for (int dd = 0; dd < 16; ++dd) { float a = b1p[dd] + tn * w1p[dd];
#pragma unroll
            for (int b = 0; b < 16; ++b) a += sb[b] * w1p[(1 + b) * 64 + dd] + cb[b] * w1p[(17 + b) * 64 + dd];
            h1[(part * 16 + dd) * 16 + tl] = sinf(a); }
        LDS_WAIT();
        float* dst = HID + ((size_t)l * 4352 + tt) * 64 + part * 16;
        float acc[16];
#pragma unroll
        for (int ee = 0; ee < 16; ++ee) acc[ee] = b2p[ee];
        for (int d = 0; d < 64; ++d) { const float hv = h1[d * 16 + tl];
#pragma unroll
            for (int ee = 0; ee < 16; ++ee) acc[ee] += hv * w2p[d * 64 + ee]; }
#pragma unroll
        for (int ee = 0; ee < 16; ee += 4) *(f32x4*)(dst + ee) = (f32x4){sinf(acc[ee]), sinf(acc[ee + 1]), sinf(acc[ee + 2]), sinf(acc[ee + 3])};
        LDS_WAIT();
    }
}
__device__ __forceinline__ void pro_filter(Frame& F) {
    const float* HID = WSP(float, WS_HID); float* PART = WSP(float, WS_PART);
    LAS float* red = (LAS float*)F.lds;
    constexpr float dmin = 3.0701134573253945f, dstep = (15.350567286626973f - 3.0701134573253945f) / 511.0f;
    for (int item = F.vcu; item < DEPTH * 9 * 4 * 8; item += F.G) {
        int r = item; const int cg = r & 7; r >>= 3; const int od = r & 3; r >>= 2; const int tc = r % 9; const int l = r / 9;
        const int kind = tc == 8 ? 1 : 0, L = kind ? 256 : 4096, t = (kind ? 0 : tc * 512) + F.tid; const bool valid = t < L;
        const int o = od >> 1, dir = od & 1;
        const float* hp = HID + ((size_t)l * 4352 + (kind ? 4096 : 0) + (valid ? t : 0)) * 64;
        const float tn = (float)t / (float)L;
        const cfloat_c* w3 = (const cfloat_c*)(uintptr_t)(F.in[13] + (size_t)l * 64 * 2048 + o * 1024 + dir * 512 + cg * 64);
        float acc[64];
#pragma unroll
        for (int j = 0; j < 64; ++j) acc[j] = 0.f;
        for (int e4 = 0; e4 < 64; e4 += 4) {
            const f32x4 h4 = *(const f32x4*)(hp + e4);
#pragma unroll
            for (int ee = 0; ee < 4; ++ee) { const cfloat_c* wr = w3 + (size_t)(e4 + ee) * 2048; const float h = h4[ee];
#pragma unroll
                for (int j = 0; j < 64; ++j) acc[j] += h * wr[j]; }
        }
        bf16* gout = kind ? WSP(bf16, WS_GC) + (size_t)l * 512 * 2 * HYLC : WSP(bf16, WS_G) + (size_t)l * 512 * 2 * HYL;
        const int glen = kind ? HYLC : HYL;
        const bool zero0 = (dir == 1 && t == 0); const int idx = zero0 ? 0 : (dir == 0 ? L - t : L + t);
        const float keep = (valid && !zero0) ? 1.0f : 0.0f;
#pragma unroll
        for (int j = 0; j < 64; ++j) { const int c = cg * 64 + j; const float delta = dmin + (float)c * dstep; const float v = acc[j] * __expf(-tn * delta) * keep;
            if (valid) gout[((size_t)c * 2 + o) * glen + idx] = f2bf(v);
            const float a = wave_sum(fabsf(v)); if (F.lane == 0) red[F.wave * 64 + j] = a; }
        __syncthreads();
        if (F.tid < 64) { float s = 0.f;
#pragma unroll
            for (int w = 0; w < 8; ++w) s += red[w * 64 + F.tid];
            PART[((((size_t)l * 2 + kind) * 2 + o) * 2 + dir) * 8 * 512 + (size_t)(kind ? 0 : tc) * 512 + cg * 64 + F.tid] = s; }
        __syncthreads();
    }
}

__device__ __forceinline__ void norm_pass(Frame& F, int mode, int l, bool dry = false) {
    const float* MOD = WSP(float, WS_MOD); float* X = WSP(float, WS_X); bf16* H = dry ? WSP(bf16, WS_UP) : WSP(bf16, WS_H); const bf16* Y = WSP(bf16, WS_MO); float* XO = dry ? WSP(float, WS_ACT) : X;
    const float* ng = F.in[6];
    const int gw = F.vcu * NWAVES + F.wave, NGW = F.G * NWAVES;
    const bool last = (mode == 2 && l == DEPTH - 1);
    for (int r = gw; r < MR; r += NGW) {
        int b, isctx, t; row_info(r, b, isctx, t); const int which = isctx ? 2 : b;
        f32x4 xv[8];
        if (mode == 0) { const float* src = isctx ? F.in[2] + ((size_t)b * CTXL + t) * DM : F.in[0] + ((size_t)b * SEQ + t) * DM;
#pragma unroll
            for (int j = 0; j < 8; ++j) xv[j] = *(const f32x4*)(src + 4 * F.lane + 256 * j);
        } else {
            if (isctx && l == DEPTH - 1) continue;
            const float* src = X + (size_t)r * DM; const bf16* yp = Y + (size_t)r * DM;
            f32x4 yv[8]; float ss = 0.f;
            if (!isctx) {
#pragma unroll
                for (int j = 0; j < 8; ++j) { const v2u w = *(const v2u*)(yp + 4 * F.lane + 256 * j); yv[j] = (f32x4){bf_lo(w.x), bf_hi(w.x), bf_lo(w.y), bf_hi(w.y)}; }
            } else {
                const float* sp_ = WSP(float, WS_SLAB) + (size_t)(b * CTXL + t) * DM; const int ns = (mode == 1) ? 8 : 11;
#pragma unroll
                for (int j = 0; j < 8; ++j) yv[j] = (f32x4){0.f, 0.f, 0.f, 0.f};
                for (int s = 0; s < ns; ++s) {
#pragma unroll
                    for (int j = 0; j < 8; ++j) yv[j] += *(const f32x4*)(sp_ + (size_t)s * (512 * DM) + 4 * F.lane + 256 * j); }
            }
#pragma unroll
            for (int j = 0; j < 8; ++j) { xv[j] = *(const f32x4*)(src + 4 * F.lane + 256 * j);
                ss += (yv[j][0] * yv[j][0] + yv[j][1] * yv[j][1]) + (yv[j][2] * yv[j][2] + yv[j][3] * yv[j][3]); }
            ss = wave_sum(ss); const float rs = 1.0f / sqrtf(ss * (1.0f / DM) + EPS);
            const float* gpost = ng + ((size_t)l * 4 + (mode == 1 ? 1 : 3)) * DM; const float* gate = MOD + ((size_t)l * 3 + which) * (6 * DM) + (mode == 1 ? 2 : 5) * DM;
#pragma unroll
            for (int j = 0; j < 8; ++j) { const f32x4 gp = *(const f32x4*)(gpost + 4 * F.lane + 256 * j), gt = *(const f32x4*)(gate + 4 * F.lane + 256 * j); xv[j] += gt * (yv[j] * rs * gp); }
        }
        if (!last) {
            float* dst = XO + (size_t)r * DM;
#pragma unroll
            for (int j = 0; j < 8; ++j) *(f32x4*)(dst + 4 * F.lane + 256 * j) = xv[j];
        } else { if (!isctx) { float* dst = (dry ? XO : F.out) + ((size_t)b * SEQ + t) * DM;
#pragma unroll
            for (int j = 0; j < 8; ++j) *(f32x4*)(dst + 4 * F.lane + 256 * j) = xv[j]; }
            continue; }
        const int ln = (mode == 2) ? l + 1 : l; const float* gpre = ng + ((size_t)ln * 4 + (mode == 1 ? 2 : 0)) * DM;
        const float* md = MOD + ((size_t)ln * 3 + which) * (6 * DM); const float* sh = md + (mode == 1 ? 3 : 0) * DM; const float* sc = md + (mode == 1 ? 4 : 1) * DM;
        float s2 = 0.f;
#pragma unroll
        for (int j = 0; j < 8; ++j) s2 += (xv[j][0] * xv[j][0] + xv[j][1] * xv[j][1]) + (xv[j][2] * xv[j][2] + xv[j][3] * xv[j][3]);
        s2 = wave_sum(s2); const float rs2 = 1.0f / sqrtf(s2 * (1.0f / DM) + EPS);
        bf16* hp = H + (size_t)r * DM;
#pragma unroll
        for (int j = 0; j < 8; ++j) { const int cidx = 4 * F.lane + 256 * j; const f32x4 gp = *(const f32x4*)(gpre + cidx), s4 = *(const f32x4*)(sc + cidx), h4 = *(const f32x4*)(sh + cidx);
            const f32x4 hv = (xv[j] * rs2 * gp) * (s4 + 1.0f) + h4; v2u w; w.x = cvt_pk_bf16(hv[0], hv[1]); w.y = cvt_pk_bf16(hv[2], hv[3]); *(v2u*)(hp + cidx) = w; }
    }
}

__device__ __forceinline__ bool seg_start(int r) { const int j = r % SEGB; return j == 0 || j == CTXL; }
__device__ __forceinline__ void post_u(Frame& F, int l) {
    const bf16* U = WSP(bf16, WS_U); bf16* PT = WSP(bf16, WS_PT);
    const int gw = F.vcu * NWAVES + F.wave, NGW = F.G * NWAVES;
    LAS bf16* tile = (LAS bf16*)(F.lds + F.wave * 16384);
    const float* hw = F.in[8] + (size_t)l * 3 * 1536;
    for (int wi = gw; wi < (MR / 64) * 24; wi += NGW) {
        const int rt = wi / 24, cgp = wi - rt * 24, r0 = rt * 64, c0 = cgp * 64;
        const bool has_prev = !seg_start(r0), has_next = !seg_start(r0 + 64) && (r0 + 64 < MR);
#pragma unroll
        for (int i = 0; i < 9; ++i) { const int tr = 8 * i + (F.lane >> 3), ch = F.lane & 7;
            if (tr < 66) { const int r = r0 - 1 + tr; const bool ok = (tr == 0) ? has_prev : (tr == 65 ? has_next : true);
                v4u v = {0u, 0u, 0u, 0u}; if (ok) v = *(const v4u*)(U + (size_t)r * DINP + c0 + ch * 8);
                *(LAS v4u*)(tile + tr * 64 + ch * 8) = v; } }
        LDS_WAIT();
        const int c = c0 + F.lane; const float w0 = hw[c], w1 = hw[1536 + c], w2 = hw[2 * 1536 + c];
#pragma unroll
        for (int tb = 0; tb < 8; ++tb) { float v[8];
#pragma unroll
            for (int j = 0; j < 8; ++j) { const int tr = 8 * tb + j; v[j] = w0 * bf2f(tile[tr * 64 + F.lane]) + w1 * bf2f(tile[(tr + 1) * 64 + F.lane]) + w2 * bf2f(tile[(tr + 2) * 64 + F.lane]); }
            v4u o; o.x = cvt_pk_bf16(v[0], v[1]); o.y = cvt_pk_bf16(v[2], v[3]); o.z = cvt_pk_bf16(v[4], v[5]); o.w = cvt_pk_bf16(v[6], v[7]);
            *(v4u*)(PT + (size_t)c * MR + r0 + 8 * tb) = o; }
        LDS_WAIT();
    }
    bf16* XR = WSP(bf16, WS_XR); bf16* KR = WSP(bf16, WS_KR); const float* ROPE = WSP(float, WS_ROPE); float* RSTD = WSP(float, WS_RSTD);
    for (int r = gw; r < MR; r += NGW) {
        int b, isctx, t; row_info(r, b, isctx, t);
        const bf16* ur = U + (size_t)r * DINP;
        { const int blk = F.lane >> 4, k = (F.lane & 15) * 8, prow = isctx ? 3 + t : 265 + t;
          *(v4u*)(XR + (((size_t)b * 4 + blk) * XR_ROWS + prow) * 128 + k) = *(const v4u*)(ur + OFF_LRU_X + 8 * F.lane); }
        if (F.lane < 32) { const float x1 = bf2f(ur[OFF_KR + F.lane]), x2 = bf2f(ur[OFF_KR + 32 + F.lane]); float o1 = x1, o2 = x2;
            if (!isctx) { const float cs = ROPE[t * 64 + F.lane], sn = ROPE[t * 64 + 32 + F.lane]; o1 = x1 * cs - x2 * sn; o2 = x2 * cs + x1 * sn; }
            KR[(size_t)r * 64 + F.lane] = f2bf(o1); KR[(size_t)r * 64 + 32 + F.lane] = f2bf(o2); }
        { const v4u w = *(const v4u*)(ur + OFF_Q + 8 * F.lane); float ss = 0.f;
#pragma unroll
          for (int j = 0; j < 4; ++j) { const float a = bf_lo(w[j]), c2 = bf_hi(w[j]); ss += a * a + c2 * c2; }
          ss = wave_sum(ss); if (F.lane == 0) RSTD[r] = 1.0f / sqrtf(ss * (1.0f / QRANK) + EPS); }
        { float ss = 0.f; if (F.lane < 32) { const v4u w = *(const v4u*)(ur + OFF_KV + 8 * F.lane);
#pragma unroll
            for (int j = 0; j < 4; ++j) { const float a = bf_lo(w[j]), c2 = bf_hi(w[j]); ss += a * a + c2 * c2; } }
          ss = wave_sum(ss); if (F.lane == 0) RSTD[MR + r] = 1.0f / sqrtf(ss * (1.0f / KVRANK) + EPS); }
    }
    for (int i = F.vcu * NTHR + F.tid; i < 2 * 4 * 12 * 16; i += F.G * NTHR) { const int ch = i & 15, pi = (i >> 4) % 12, bb = (i >> 4) / 12;
        const int prow = pi < 3 ? pi : (pi < 9 ? 256 + pi : 4352 + pi);
        unsigned zz = 0u; asm volatile("" : "+v"(zz));
        const v4u z = {zz, zz, zz, zz}; *(v4u*)(XR + ((size_t)bb * XR_ROWS + prow) * 128 + ch * 8) = z; }
}

__device__ __forceinline__ void conv_gelu(Frame& F, int l) {
    const bf16* UP = WSP(bf16, WS_UP); bf16* ACT = WSP(bf16, WS_ACT);
    const float* cw = F.in[28] + (size_t)l * 3 * 2 * DFF;
    const int gw = F.vcu * NWAVES + F.wave, NGW = F.G * NWAVES;
    for (int wi = gw; wi < (MR / 8) * 11; wi += NGW) {
        const int rc = wi / 11, fc = wi - rc * 11, r0 = rc * 8, f0 = fc * 512 + 8 * F.lane;
        const bool has_prev = !seg_start(r0), has_next = !seg_start(r0 + 8) && (r0 + 8 < MR);
        v4u g[10], v[10];
#pragma unroll
        for (int i = 0; i < 10; ++i) { const int r = r0 - 1 + i; const bool ok = (i == 0) ? has_prev : (i == 9 ? has_next : true);
            g[i] = (v4u){0u, 0u, 0u, 0u}; v[i] = (v4u){0u, 0u, 0u, 0u};
            if (ok) { g[i] = *(const v4u*)(UP + (size_t)r * (2 * DFF) + f0); v[i] = *(const v4u*)(UP + (size_t)r * (2 * DFF) + DFF + f0); } }
        float wg[3][8], wv[3][8];
#pragma unroll
        for (int j = 0; j < 3; ++j) { const f32x4 a = *(const f32x4*)(cw + (size_t)j * 2 * DFF + f0), b2 = *(const f32x4*)(cw + (size_t)j * 2 * DFF + f0 + 4);
            const f32x4 c2 = *(const f32x4*)(cw + (size_t)j * 2 * DFF + DFF + f0), d2 = *(const f32x4*)(cw + (size_t)j * 2 * DFF + DFF + f0 + 4);
#pragma unroll
            for (int q = 0; q < 4; ++q) { wg[j][q] = a[q]; wg[j][4 + q] = b2[q]; wv[j][q] = c2[q]; wv[j][4 + q] = d2[q]; } }
#pragma unroll
        for (int i = 0; i < 8; ++i) { float o[8];
#pragma unroll
            for (int q = 0; q < 4; ++q) {
                const float ga = wg[0][2 * q] * bf_lo(g[i][q]) + wg[1][2 * q] * bf_lo(g[i + 1][q]) + wg[2][2 * q] * bf_lo(g[i + 2][q]);
                const float gb = wg[0][2 * q + 1] * bf_hi(g[i][q]) + wg[1][2 * q + 1] * bf_hi(g[i + 1][q]) + wg[2][2 * q + 1] * bf_hi(g[i + 2][q]);
                const float va = wv[0][2 * q] * bf_lo(v[i][q]) + wv[1][2 * q] * bf_lo(v[i + 1][q]) + wv[2][2 * q] * bf_lo(v[i + 2][q]);
                const float vb = wv[0][2 * q + 1] * bf_hi(v[i][q]) + wv[1][2 * q + 1] * bf_hi(v[i + 1][q]) + wv[2][2 * q + 1] * bf_hi(v[i + 2][q]);
                o[2 * q] = gelu_tanh(ga) * va; o[2 * q + 1] = gelu_tanh(gb) * vb; }
            v4u w; w.x = cvt_pk_bf16(o[0], o[1]); w.y = cvt_pk_bf16(o[2], o[3]); w.z = cvt_pk_bf16(o[4], o[5]); w.w = cvt_pk_bf16(o[6], o[7]);
            *(v4u*)(ACT + (size_t)(r0 + i) * DFF + f0) = w; }
    }
}

__device__ __forceinline__ void mix_finalize(Frame& F, int l) {
    const bf16* YT = WSP(bf16, WS_YT); const float* YL = WSP(float, WS_YL); const bf16* O = WSP(bf16, WS_O); bf16* YM = WSP(bf16, WS_YMIX);
    const float* hg = F.in[25] + (size_t)l * DMIX;
    const int gw = F.vcu * NWAVES + F.wave, NGW = F.G * NWAVES;
    LAS bf16* st = (LAS bf16*)(F.lds + F.wave * 16384);
    constexpr int NHY = (MR / 32) * 4, NLR = (MR / 64) * 4, NAT = (MR / 64) * 8;
    for (int wi = gw; wi < NHY + NLR + NAT; wi += NGW) {
        if (wi < NHY) {
            const int rt = wi >> 2, hd = wi & 3, r0 = rt * 32, cs = F.lane >> 2, rc = F.lane & 3;
            const bf16* src = YT + (size_t)(hd * 128 + cs) * MR + r0 + 8 * rc;
            v4u v[8]; float ss[8];
#pragma unroll
            for (int k = 0; k < 8; ++k) ss[k] = 0.f;
#pragma unroll
            for (int i = 0; i < 8; ++i) { v[i] = *(const v4u*)(src + (size_t)(16 * i) * MR);
#pragma unroll
                for (int k = 0; k < 4; ++k) { const float a = bf_lo(v[i][k]), b2 = bf_hi(v[i][k]); ss[2 * k] += a * a; ss[2 * k + 1] += b2 * b2; } }
#pragma unroll
            for (int k = 0; k < 8; ++k) { float s = ss[k]; s += __shfl_xor(s, 4); s += __shfl_xor(s, 8); s += __shfl_xor(s, 16); s += __shfl_xor(s, 32); ss[k] = 1.0f / sqrtf(s * (1.0f / 128.0f) + EPS); }
#pragma unroll
            for (int i = 0; i < 8; ++i) { const int c = 16 * i + cs; const float g = hg[hd * 128 + c];
#pragma unroll
                for (int k = 0; k < 4; ++k) { st[(8 * rc + 2 * k) * 130 + c] = f2bf(bf_lo(v[i][k]) * ss[2 * k] * g); st[(8 * rc + 2 * k + 1) * 130 + c] = f2bf(bf_hi(v[i][k]) * ss[2 * k + 1] * g); } }
            LDS_WAIT();
#pragma unroll 8
            for (int row = 0; row < 32; ++row) { const unsigned w = *(const LAS unsigned*)(st + row * 130 + 2 * F.lane);
                *(unsigned*)(YM + (size_t)(r0 + row) * DMIX + hd * 128 + 2 * F.lane) = w; }
            LDS_WAIT();
        } else if (wi < NHY + NLR) {
            const int w2 = wi - NHY, rt = w2 >> 2, hd = w2 & 3, r0 = rt * 64, q = F.lane & 3;
            for (int ps = 0; ps < 4; ++ps) { const int row = r0 + ps * 16 + (F.lane >> 2);
                const float* src = YL + (size_t)row * LRUC + hd * 128 + q * 32; f32x4 v[8]; float ss = 0.f;
#pragma unroll
                for (int j = 0; j < 8; ++j) { v[j] = *(const f32x4*)(src + 4 * j); ss += (v[j][0] * v[j][0] + v[j][1] * v[j][1]) + (v[j][2] * v[j][2] + v[j][3] * v[j][3]); }
                ss += __shfl_xor(ss, 1); ss += __shfl_xor(ss, 2); const float rs = 1.0f / sqrtf(ss * (1.0f / 128.0f) + EPS);
                const float* g = hg + (4 + hd) * 128 + q * 32; bf16* dst = YM + (size_t)row * DMIX + (4 + hd) * 128 + q * 32;
#pragma unroll
                for (int j = 0; j < 4; ++j) { const f32x4 g0 = *(const f32x4*)(g + 8 * j), g1 = *(const f32x4*)(g + 8 * j + 4); const f32x4 a = v[2 * j] * rs * g0, b2 = v[2 * j + 1] * rs * g1;
                    v4u w; w.x = cvt_pk_bf16(a[0], a[1]); w.y = cvt_pk_bf16(a[2], a[3]); w.z = cvt_pk_bf16(b2[0], b2[1]); w.w = cvt_pk_bf16(b2[2], b2[3]); *(v4u*)(dst + 8 * j) = w; } }
        } else {
            const int w2 = wi - NHY - NLR, rt = w2 >> 3, hd = w2 & 7, r0 = rt * 64, q = F.lane & 3;
            for (int ps = 0; ps < 4; ++ps) { const int row = r0 + ps * 16 + (F.lane >> 2);
                const bf16* src = O + (size_t)row * (NH * VD) + hd * 128 + q * 32; v4u v[4]; float ss = 0.f;
#pragma unroll
                for (int j = 0; j < 4; ++j) { v[j] = *(const v4u*)(src + 8 * j);
#pragma unroll
                    for (int k = 0; k < 4; ++k) { const float a = bf_lo(v[j][k]), b2 = bf_hi(v[j][k]); ss += a * a + b2 * b2; } }
                ss += __shfl_xor(ss, 1); ss += __shfl_xor(ss, 2); const float rs = 1.0f / sqrtf(ss * (1.0f / 128.0f) + EPS);
                const float* g = hg + (8 + hd) * 128 + q * 32; bf16* dst = YM + (size_t)row * DMIX + (8 + hd) * 128 + q * 32;
#pragma unroll
                for (int j = 0; j < 4; ++j) { const f32x4 g0 = *(const f32x4*)(g + 8 * j), g1 = *(const f32x4*)(g + 8 * j + 4);
                    v4u w; w.x = cvt_pk_bf16(bf_lo(v[j][0]) * rs * g0[0], bf_hi(v[j][0]) * rs * g0[1]); w.y = cvt_pk_bf16(bf_lo(v[j][1]) * rs * g0[2], bf_hi(v[j][1]) * rs * g0[3]);
                    w.z = cvt_pk_bf16(bf_lo(v[j][2]) * rs * g1[0], bf_hi(v[j][2]) * rs * g1[1]); w.w = cvt_pk_bf16(bf_lo(v[j][3]) * rs * g1[2], bf_hi(v[j][3]) * rs * g1[3]); *(v4u*)(dst + 8 * j) = w; } }
        }
    }
}

namespace att {
constexpr int NW = 8, QBLK = 32, KVBLK = 64;
constexpr float SCALE = 0.07216878364870323f;
constexpr float THR = 8.f;
constexpr int LDQ = DQ, LDK = DKV, LDR = ROPED, LDO = NH * VD;
constexpr int SHM_V = KVBLK * 128 * 2, SHM_K = KVBLK * 128 * 2, SHM_R = KVBLK * 64 * 2;
constexpr int OFF_V = 0, OFF_K = 2 * SHM_V, OFF_R = OFF_K + 2 * SHM_K, OFF_WS = OFF_R + 2 * SHM_R, OFF_QR = OFF_WS + NW * 64 * 4, SHM_ATTN = OFF_QR + NW * 4096;
#define KSWZ(row, colB) ((row) * 256 + ((colB) ^ (((row) & 7) << 4)))
#define RSWZ(row, colB) ((row) * 128 + ((colB) ^ (((row) & 7) << 4)))
#define SBAR() __builtin_amdgcn_sched_barrier(0)
__device__ __forceinline__ int crow(int r, int hi) { return (r & 3) + 8 * (r >> 2) + 4 * hi; }
__device__ __forceinline__ void partialSM(f32x16& p0, f32x16& p1, float& m_reg, float& mn, float& alpha) {
  constexpr float C = SCALE * 1.4426950408889634f;
  float pmax = p0[0]; for (int r = 1; r < 16; ++r) pmax = fmaxf(pmax, p0[r]); for (int r = 0; r < 16; ++r) pmax = fmaxf(pmax, p1[r]);
  { auto rr = __builtin_amdgcn_permlane32_swap(__float_as_uint(pmax), __float_as_uint(pmax), false, false);
    pmax = fmaxf(__uint_as_float(rr[0]), __uint_as_float(rr[1])); }
  if (__builtin_expect(__all(pmax - m_reg <= THR / SCALE), 1)) { mn = m_reg; alpha = 1.f; }
  else { mn = fmaxf(m_reg, pmax); alpha = __builtin_amdgcn_exp2f((m_reg - mn) * C); m_reg = mn; }
  float mnC = -mn * C;
  for (int r = 0; r < 16; ++r) p0[r] = fmaf(p0[r], C, mnC); for (int r = 0; r < 16; ++r) p1[r] = fmaf(p1[r], C, mnC);
  for (int r = 0; r < 16; ++r) p0[r] = __builtin_amdgcn_exp2f(p0[r]);
}
__device__ __forceinline__ void finishSM(f32x16& p0, f32x16& p1, float alpha, float& l_reg, bf16x8& pa0, bf16x8& pa1, bf16x8& pa2, bf16x8& pa3) {
  for (int r = 0; r < 16; ++r) p1[r] = __builtin_amdgcn_exp2f(p1[r]);
  float ps = 0; for (int r = 0; r < 16; ++r) ps += p0[r]; for (int r = 0; r < 16; ++r) ps += p1[r];
  { auto rr = __builtin_amdgcn_permlane32_swap(__float_as_uint(ps), __float_as_uint(ps), false, false);
    ps = __uint_as_float(rr[0]) + __uint_as_float(rr[1]); }
  l_reg = l_reg * alpha + ps;
#define PK4(P, BASE, OUT) do { unsigned a0 = cvt_pk_bf16(P[BASE + 0], P[BASE + 1]), a1 = cvt_pk_bf16(P[BASE + 2], P[BASE + 3]);   \
    unsigned b0 = cvt_pk_bf16(P[BASE + 4], P[BASE + 5]), b1 = cvt_pk_bf16(P[BASE + 6], P[BASE + 7]);                              \
    auto r0 = __builtin_amdgcn_permlane32_swap(a0, b0, false, false); auto r1 = __builtin_amdgcn_permlane32_swap(a1, b1, false, false); \
    v4u w = {r0[0], r1[0], r0[1], r1[1]}; OUT = *reinterpret_cast<bf16x8*>(&w); } while (0)
  PK4(p0, 0, pa0); PK4(p0, 8, pa1); PK4(p1, 0, pa2); PK4(p1, 8, pa3);
#undef PK4
}
__device__ __forceinline__ void qkt(f32x16& p0, f32x16& p1, const LAS char* Ks, const LAS char* Rs, const bf16x8* qr, const LAS char* qrl, int r32, int hi) {
  p0 = f32x16{}; p1 = f32x16{};
#pragma unroll
  for (int d0 = 0; d0 < 8; ++d0) { const int cb = (d0 * 16 + hi * 8) * 2;
    bf16x8 b0 = *(const LAS bf16x8*)(Ks + KSWZ(r32, cb));
    bf16x8 b1 = *(const LAS bf16x8*)(Ks + KSWZ(32 + r32, cb));
    p0 = __builtin_amdgcn_mfma_f32_32x32x16_bf16(b0, qr[d0], p0, 0, 0, 0);
    p1 = __builtin_amdgcn_mfma_f32_32x32x16_bf16(b1, qr[d0], p1, 0, 0, 0); }
#pragma unroll
  for (int d0 = 0; d0 < 4; ++d0) { const int cb = (d0 * 16 + hi * 8) * 2;
    bf16x8 b0 = *(const LAS bf16x8*)(Rs + RSWZ(r32, cb));
    bf16x8 b1 = *(const LAS bf16x8*)(Rs + RSWZ(32 + r32, cb));
    const bf16x8 qf = *(const LAS bf16x8*)(qrl + d0 * 1024);
    p0 = __builtin_amdgcn_mfma_f32_32x32x16_bf16(b0, qf, p0, 0, 0, 0);
    p1 = __builtin_amdgcn_mfma_f32_32x32x16_bf16(b1, qf, p1, 0, 0, 0); }
}
__device__ __forceinline__ int v_st(int k, int c) { const int kk = (k & ~0xC) | ((k & 4) << 1) | ((k & 8) >> 1); return ((kk >> 3) * 4 + (c >> 5)) * 512 + ((kk & 7) * 32 + (c & 31)) * 2; }
__device__ __forceinline__ int v_rd_base(int lane) { return ((lane & 3) << 3) | (((lane >> 2) & 3) << 6) | (((lane >> 4) & 1) << 5) | (((lane >> 5) & 1) << 8); }
constexpr int v_rd_off(int d0, int ks, int half) { return d0 * 512 + ks * 4096 + half * 2048; }
template <int OFF> __device__ __forceinline__ s16x4 tr_read(int vb) {
  s16x4 r; asm volatile("ds_read_b64_tr_b16 %0, %1 offset:%2" : "=&v"(r) : "v"(vb), "i"(OFF) : "memory"); return r;
}
template <int D0> __device__ __forceinline__ void pv_one(f32x16& od, int vb, bf16x8 pa0, bf16x8 pa1, bf16x8 pa2, bf16x8 pa3) {
  const s16x4 l0 = tr_read<v_rd_off(D0, 0, 0)>(vb), h0 = tr_read<v_rd_off(D0, 0, 1)>(vb), l1 = tr_read<v_rd_off(D0, 1, 0)>(vb), h1 = tr_read<v_rd_off(D0, 1, 1)>(vb);
  const s16x4 l2 = tr_read<v_rd_off(D0, 2, 0)>(vb), h2 = tr_read<v_rd_off(D0, 2, 1)>(vb), l3 = tr_read<v_rd_off(D0, 3, 0)>(vb), h3 = tr_read<v_rd_off(D0, 3, 1)>(vb);
  asm volatile("s_waitcnt lgkmcnt(0)" ::: "memory"); SBAR();
#define PK(L, H) (bf16x8){L[0], L[1], L[2], L[3], H[0], H[1], H[2], H[3]}
  od = __builtin_amdgcn_mfma_f32_32x32x16_bf16(pa0, PK(l0, h0), od, 0, 0, 0);
  od = __builtin_amdgcn_mfma_f32_32x32x16_bf16(pa1, PK(l1, h1), od, 0, 0, 0);
  od = __builtin_amdgcn_mfma_f32_32x32x16_bf16(pa2, PK(l2, h2), od, 0, 0, 0);
  od = __builtin_amdgcn_mfma_f32_32x32x16_bf16(pa3, PK(l3, h3), od, 0, 0, 0);
#undef PK
}
__device__ __forceinline__ void pv_d0(f32x16* o, int vb, bf16x8 pa0, bf16x8 pa1, bf16x8 pa2, bf16x8 pa3) {
  pv_one<0>(o[0], vb, pa0, pa1, pa2, pa3); pv_one<1>(o[1], vb, pa0, pa1, pa2, pa3); pv_one<2>(o[2], vb, pa0, pa1, pa2, pa3); pv_one<3>(o[3], vb, pa0, pa1, pa2, pa3);
}
__device__ __forceinline__ void attn_body(const bf16* __restrict__ Qb, const bf16* __restrict__ Kh, const bf16* __restrict__ Vh, const bf16* __restrict__ Rh,
                                          bf16* __restrict__ Ob, int seq, const float* rope_tab, LAS char* lds) {
  int tid = threadIdx.x; asm volatile("" : "+v"(tid));
  const int wid = __builtin_amdgcn_readfirstlane(tid >> 6), lane = tid & 63, r32 = lane & 31, hi = lane >> 5;
  LAS char* V_lds = lds + OFF_V; LAS char* K_lds = lds + OFF_K; LAS char* R_lds = lds + OFF_R;
  LAS float* ws = (LAS float*)(lds + OFF_WS) + wid * 64; LAS float* li_l = ws; LAS float* al_l = ws + 32;
  float m_reg = -1e30f, l_reg = 0; f32x16 o[4] = {}; bf16x8 qr[12];
  LAS char* qrl = lds + OFF_QR + wid * 4096 + lane * 16;
  const bf16* Qw = Qb + (long)(wid * QBLK + r32) * LDQ + hi * 8;
#pragma unroll
  for (int d0 = 0; d0 < 12; ++d0) qr[d0] = *reinterpret_cast<const bf16x8*>(Qw + d0 * 16);
  if (rope_tab) {
    const float* rt = rope_tab + (long)(wid * QBLK + r32) * 64;
#pragma unroll
    for (int p = 0; p < 2; ++p) {
      const float* cs = rt + p * 16 + hi * 8; const f32x4 c0 = *(const f32x4*)cs, c1 = *(const f32x4*)(cs + 4), s0 = *(const f32x4*)(cs + 32), s1 = *(const f32x4*)(cs + 36);
      const v4u x1 = *reinterpret_cast<v4u*>(&qr[8 + p]), x2 = *reinterpret_cast<v4u*>(&qr[10 + p]); v4u y1, y2;
#pragma unroll
      for (int k = 0; k < 4; ++k) { const float ca = k < 2 ? c0[2 * k] : c1[2 * k - 4], cbv = k < 2 ? c0[2 * k + 1] : c1[2 * k - 3], sa = k < 2 ? s0[2 * k] : s1[2 * k - 4], sb = k < 2 ? s0[2 * k + 1] : s1[2 * k - 3];
        const float a1 = bf_lo(x1[k]), b1 = bf_hi(x1[k]), a2 = bf_lo(x2[k]), b2 = bf_hi(x2[k]);
        y1[k] = cvt_pk_bf16(a1 * ca - a2 * sa, b1 * cbv - b2 * sb); y2[k] = cvt_pk_bf16(a2 * ca + a1 * sa, b2 * cbv + b1 * sb); }
      qr[8 + p] = *reinterpret_cast<bf16x8*>(&y1); qr[10 + p] = *reinterpret_cast<bf16x8*>(&y2); }
  }
#pragma unroll
  for (int d0 = 0; d0 < 4; ++d0) *(LAS bf16x8*)(qrl + d0 * 1024) = qr[8 + d0];
  const int sr = tid >> 4, sc = (tid & 15) * 8, vst0 = v_st(sr, sc), vst1 = v_st(32 + sr, sc);
  const int rr_ = tid >> 3, rc_ = (tid & 7) * 8;
  const int vb0 = (int)(uintptr_t)V_lds + v_rd_base(lane);
  constexpr int SDEPTH = 1;
  struct { bf16x8 vs0, vs1, ks0, ks1, rs; } sr_[SDEPTH];
  const unsigned offk0 = (unsigned)(sr * LDK + sc), offk1 = (unsigned)((32 + sr) * LDK + sc), offr = (unsigned)(rr_ * LDR + rc_);
#define SLOAD(i, k0) do { const bf16* vt_ = Vh + (size_t)(k0) * LDK; const bf16* kt_ = Kh + (size_t)(k0) * LDK; const bf16* rt_ = Rh + (size_t)(k0) * LDR; \
    sr_[i].vs0 = *(const bf16x8*)(vt_ + offk0); sr_[i].vs1 = *(const bf16x8*)(vt_ + offk1); \
    sr_[i].ks0 = *(const bf16x8*)(kt_ + offk0); sr_[i].ks1 = *(const bf16x8*)(kt_ + offk1); \
    sr_[i].rs = *(const bf16x8*)(rt_ + offr); } while (0)
#define SWRITE(b, i) do { *(LAS bf16x8*)(V_lds + (b) * SHM_V + vst0) = sr_[i].vs0;          \
    *(LAS bf16x8*)(V_lds + (b) * SHM_V + vst1) = sr_[i].vs1; int kc = sc * 2;               \
    *(LAS bf16x8*)(K_lds + (b) * SHM_K + KSWZ(sr, kc)) = sr_[i].ks0;                       \
    *(LAS bf16x8*)(K_lds + (b) * SHM_K + KSWZ(32 + sr, kc)) = sr_[i].ks1;                  \
    *(LAS bf16x8*)(R_lds + (b) * SHM_R + RSWZ(rr_, rc_ * 2)) = sr_[i].rs; } while (0)
#define SWAIT() do { if constexpr (SDEPTH == 2) asm volatile("s_waitcnt vmcnt(5)" ::: "memory"); else asm volatile("s_waitcnt vmcnt(0)" ::: "memory"); } while (0)
#define RESC(a) do { if (__any((a) < 1.f)) { if (hi == 0) al_l[r32] = (a); asm volatile("s_waitcnt lgkmcnt(0)" ::: "memory"); \
    for (int d = 0; d < 4; ++d) for (int r = 0; r < 16; ++r) o[d][r] *= al_l[crow(r, hi)]; } } while (0)
  f32x16 pA0, pA1, pB0, pB1; float mnA, mnB, alA, alB; bf16x8 pa0, pa1, pa2, pa3; const int NT = seq / KVBLK;
  constexpr int SE = 0, SO = SDEPTH - 1;
  SLOAD(SE, 0); asm volatile("s_waitcnt vmcnt(0)" ::: "memory"); SWRITE(0, SE); __syncthreads();
  qkt(pA0, pA1, K_lds, R_lds, qr, qrl, r32, hi); partialSM(pA0, pA1, m_reg, mnA, alA);
  SLOAD(SO, KVBLK); if constexpr (SDEPTH == 2) { if (2 < NT) SLOAD(SE, 2 * KVBLK); }
  SWAIT(); SWRITE(1, SO); __syncthreads();
  for (int j = 1; j + 1 < NT; j += 2) {
    SBAR(); qkt(pB0, pB1, K_lds + SHM_K, R_lds + SHM_R, qr, qrl, r32, hi);
    finishSM(pA0, pA1, alA, l_reg, pa0, pa1, pa2, pa3); SBAR();
    SLOAD(SO, (j + SDEPTH) * KVBLK); SBAR();
    pv_d0(o, vb0, pa0, pa1, pa2, pa3); partialSM(pB0, pB1, m_reg, mnB, alB);
    __syncthreads(); SWAIT(); SWRITE(0, SE);
    RESC(alB); __syncthreads();
    SBAR(); qkt(pA0, pA1, K_lds, R_lds, qr, qrl, r32, hi);
    finishSM(pB0, pB1, alB, l_reg, pa0, pa1, pa2, pa3); SBAR();
    if (SDEPTH == 1 || j + 3 < NT) SLOAD(SE, (j + 1 + SDEPTH) * KVBLK); SBAR();
    pv_d0(o, vb0 + SHM_V, pa0, pa1, pa2, pa3); partialSM(pA0, pA1, m_reg, mnA, alA);
    __syncthreads(); SWAIT(); SWRITE(1, SO);
    RESC(alA); __syncthreads();
  }
  SBAR(); qkt(pB0, pB1, K_lds + SHM_K, R_lds + SHM_R, qr, qrl, r32, hi);
  finishSM(pA0, pA1, alA, l_reg, pa0, pa1, pa2, pa3); SBAR();
  pv_d0(o, vb0, pa0, pa1, pa2, pa3); partialSM(pB0, pB1, m_reg, mnB, alB);
  __syncthreads(); RESC(alB);
  finishSM(pB0, pB1, alB, l_reg, pa0, pa1, pa2, pa3); SBAR();
  pv_d0(o, vb0 + SHM_V, pa0, pa1, pa2, pa3);
  if (hi == 0) li_l[r32] = l_reg; asm volatile("s_waitcnt lgkmcnt(0)" ::: "memory");
  float rli[16];
#pragma unroll
  for (int r = 0; r < 16; ++r) rli[r] = __builtin_amdgcn_rcpf(li_l[crow(r, hi)]);
  bf16* Ow = Ob + (long)(wid * QBLK) * LDO;
#pragma unroll
  for (int r = 0; r < 16; ++r) { const int orow = crow(r, hi);
#pragma unroll
    for (int d0 = 0; d0 < 4; ++d0) Ow[(long)orow * LDO + d0 * 32 + r32] = f2bf(o[d0][r] * rli[r]); }
  __syncthreads();
#undef SLOAD
#undef SWRITE
#undef SWAIT
#undef RESC
}
}

__device__ __forceinline__ void attn_phase(Frame& F, bool need_ctx) {
    const bf16* Q = WSP(bf16, WS_Q); const bf16* KV = WSP(bf16, WS_KV); const bf16* KR = WSP(bf16, WS_KR); bf16* O = WSP(bf16, WS_O); const float* ROPE = WSP(float, WS_ROPE);
    const int nunits = 256 + (need_ctx ? 16 : 0);
    for (int u = F.vcu; u < nunits; u += F.G) {
        if (u < 256) { const int b = u >> 7, h = (u >> 4) & 7, qb = u & 15; const size_t kb = (size_t)b * SEGB, row0 = kb + CTXL + qb * 256;
            att::attn_body(Q + row0 * DQ + h * 192, KV + kb * DKV + h * 256, KV + kb * DKV + h * 256 + 128, KR + kb * ROPED, O + row0 * (NH * VD) + h * 128, SEGB, ROPE + (size_t)qb * 256 * 64, (LAS char*)F.lds);
        } else { const int b = (u - 256) >> 3, h = (u - 256) & 7; const size_t kb = (size_t)b * SEGB;
            att::attn_body(Q + kb * DQ + h * 192, KV + kb * DKV + h * 256, KV + kb * DKV + h * 256 + 128, KR + kb * ROPED, O + kb * (NH * VD) + h * 128, CTXL, nullptr, (LAS char*)F.lds);
        }
    }
}

struct LruAB {
    static constexpr bool VARK = false;
    const bf16* XR; const bf16* Bt; int lda, ldb;
    __device__ __forceinline__ static int prow0(int pm) { const int jt = pm % 17; return jt == 0 ? 3 : 265 + (jt - 1) * 256; }
    __device__ __forceinline__ const char* a_base(const pg8::Unit& u) const { const int b = u.pm / 17, dir = u.pn >> 2, blk = u.pn & 3;
        return (const char*)(XR + (((size_t)b * 4 + blk) * XR_ROWS + prow0(u.pm) - (dir ? 0 : 3)) * 128); }
    __device__ __forceinline__ const char* b_base(const pg8::Unit& u) const { return (const char*)(Bt + (size_t)u.pn * 256 * 512); }
};
struct EpiGate {
    static constexpr bool PERM = true;
    const bf16* XR; unsigned* AB; const float* ba; const float* bx; const float* sp; const float* cw;
    __device__ __forceinline__ void operator()(const f32x4 (&acc)[2][2][4][2], const pg8::Unit& u, int wr, int wc, int fr, int fq) const {
        asm volatile("" : "+v"(fr), "+v"(fq));
        const int dir = u.pn >> 2, blk = u.pn & 3, b = u.pm / 17, p0 = LruAB::prow0(u.pm);
        const bf16* xb = XR + ((size_t)b * 4 + blk) * XR_ROWS * 128;
        unsigned* abb = AB + (size_t)dir * MR * LRUC;
#pragma unroll 1
        for (int n = 0; n < 2; ++n) { const int cl = wc * 32 + 8 * fq + 4 * n, ch = blk * 128 + cl;
            const f32x4 ba4 = *(const f32x4*)(ba + dir * LRUC + ch), bx4 = *(const f32x4*)(bx + dir * LRUC + ch), sp4 = *(const f32x4*)(sp + dir * LRUC + ch) * -8.0f;
            f32x4 cw4[4];
#pragma unroll
            for (int j = 0; j < 4; ++j) cw4[j] = *(const f32x4*)(cw + ((size_t)dir * 4 + j) * LRUC + ch);
#pragma unroll
            for (int ai = 0; ai < 2; ++ai)
#pragma unroll
                for (int m = 0; m < 4; ++m) { const int rl = ai * 128 + wr * 64 + m * 16 + fr, row = u.pm * 256 + rl, pr = p0 + rl + (dir ? 0 : -3);
                    f32x4 xc = {0.f, 0.f, 0.f, 0.f};
#pragma unroll
                    for (int j = 0; j < 4; ++j) { const v2u w = *(const v2u*)(xb + (unsigned)((pr + j) * 128 + cl)); xc[0] += cw4[j][0] * bf_lo(w.x); xc[1] += cw4[j][1] * bf_hi(w.x); xc[2] += cw4[j][2] * bf_lo(w.y); xc[3] += cw4[j][3] * bf_hi(w.y); }
                    const f32x4 rp = (n == 0 ? acc[ai][0][m][0] : acc[ai][0][m][1]) + ba4, ip = (n == 0 ? acc[ai][1][m][0] : acc[ai][1][m][1]) + bx4;
                    v4u o;
#pragma unroll
                    for (int j = 0; j < 4; ++j) { const float rg = sigmoidf_(rp[j]), ig = sigmoidf_(ip[j]); const float la = rg * sp4[j];
                        const float x = 2.0f * la;
                        const float ser = -x * (1.0f + x * (0.5f + x * (0.16666667f + x * (0.041666668f + x * (0.008333334f + x * 0.0013888889f)))));
                        const float om = (x > -0.25f) ? ser : (1.0f - __expf(x));
                        const float bb = sqrtf(om) * (ig * xc[j]); o[j] = cvt_pk_bf16(la, bb); }
                    *(v4u*)(abb + (unsigned)(row * LRUC + ch)) = o;
                    asm volatile("" ::: "memory"); }
        }
    }
};
__device__ __forceinline__ void lru_pass1(Frame& F) {
    const unsigned* AB = WSP(unsigned, WS_AB); f32x2* CARRY = WSP(f32x2, WS_CARRY);
    const int gw = F.vcu * NWAVES + F.wave, NGW = F.G * NWAVES;
    for (int wi = gw; wi < 2 * NCHUNK * 8; wi += NGW) {
        const int chg = wi & 7, cg = (wi >> 3) % NCHUNK, dir = wi / (8 * NCHUNK), ch = chg * 64 + F.lane;
        const unsigned* base = AB + ((size_t)dir * MR + cg * 64) * LRUC + ch;
        float h = 0.f, S = 0.f;
#pragma unroll 16
        for (int i = 0; i < 64; ++i) { const int rr = dir ? 63 - i : i; const unsigned w = base[(size_t)rr * LRUC]; const float la = bf_lo(w); h = __expf(la) * h + bf_hi(w); S += la; }
        CARRY[((size_t)dir * NCHUNK + cg) * LRUC + ch] = (f32x2){__expf(S), h};
    }
}
__device__ __forceinline__ void lru_pass2(Frame& F) {
    const unsigned* AB = WSP(unsigned, WS_AB); const f32x2* CARRY = WSP(f32x2, WS_CARRY); const bf16* U = WSP(bf16, WS_U); float* YL = WSP(float, WS_YL);
    const int gw = F.vcu * NWAVES + F.wave, NGW = F.G * NWAVES;
    for (int wi = gw; wi < NCHUNK * 8; wi += NGW) {
        const int chg = wi & 7, cg = wi >> 3, b = cg / 68, jc = cg - b * 68, ch = chg * 64 + F.lane;
        float hf = 0.f, hb = 0.f;
        const f32x2* cf = CARRY + ((size_t)0 * NCHUNK + b * 68) * LRUC + ch; const f32x2* cbk = CARRY + ((size_t)1 * NCHUNK + b * 68) * LRUC + ch;
        for (int k = 0; k < jc; ++k) { const f32x2 c = cf[(size_t)k * LRUC]; hf = c.x * hf + c.y; }
        if (jc < 4) { for (int k = 3; k > jc; --k) { const f32x2 c = cbk[(size_t)k * LRUC]; hb = c.x * hb + c.y; } }
        else { for (int k = 3; k >= 0; --k) { const f32x2 c = cbk[(size_t)k * LRUC]; hb = c.x * hb + c.y; }
               for (int k = 67; k > jc; --k) { const f32x2 c = cbk[(size_t)k * LRUC]; hb = c.x * hb + c.y; } }
        float hfv[64];
        const unsigned* bf_ = AB + ((size_t)0 * MR + cg * 64) * LRUC + ch; const unsigned* bb_ = AB + ((size_t)1 * MR + cg * 64) * LRUC + ch;
#pragma unroll
        for (int i = 0; i < 64; ++i) { const unsigned w = bf_[(size_t)i * LRUC]; hf = __expf(bf_lo(w)) * hf + bf_hi(w); hfv[i] = hf; }
#pragma unroll
        for (int i = 63; i >= 0; --i) { const unsigned w = bb_[(size_t)i * LRUC]; hb = __expf(bf_lo(w)) * hb + bf_hi(w); const size_t row = (size_t)cg * 64 + i;
            const float g = bf2f(U[row * DINP + OFF_LRU_G + ch]); YL[row * LRUC + ch] = gelu_tanh(g) * (hfv[i] + hb); }
    }
}

template <int NBLK, int NCH, int WPC>
__device__ __forceinline__ void hyena_item(Frame& F, int l, int item) {
    constexpr int L = 128 * NBLK, GLEN = 2 * L, ZB = NBLK * 136 + 64, ZSZ = 2 * ZB;
    constexpr int CH_BYTES = (GLEN + 2 * ZSZ) * 2 + 64;
    static_assert(CH_BYTES % 16 == 0 && NCH * CH_BYTES <= RING_BYTES && NCH * WPC == NWAVES, "hyena LDS map");
    constexpr int TT = WPC * 64;
    const int cs = F.wave / WPC, q = F.wave % WPC, c = item * NCH + cs, tl = F.tid % TT;
    LAS bf16* Gs = (LAS bf16*)(F.lds + cs * CH_BYTES); LAS bf16* Zc = Gs + GLEN; LAS bf16* Zn = Zc + ZSZ; LAS bf16* zero = Zn + ZSZ;
    const bf16* PT = WSP(bf16, WS_PT); bf16* YT = WSP(bf16, WS_YT);
    const bf16* Gg = (NBLK == 32) ? WSP(bf16, WS_G) + ((size_t)l * 512 + c) * 2 * HYL : WSP(bf16, WS_GC) + ((size_t)l * 512 + c) * 2 * HYLC;
    const int rb0 = (NBLK == 32) ? CTXL : 0;
    for (int i = tl; i < 2 * NBLK * 16; i += TT) { const int b = i / (NBLK * 16), rem = i - b * (NBLK * 16), blk = rem >> 4, e8 = rem & 15;
        *(LAS v4u*)(Zc + b * ZB + blk * 136 + e8 * 8) = *(const v4u*)(PT + (size_t)c * MR + b * SEGB + rb0 + blk * 128 + e8 * 8); }
    if (tl < 16) ((LAS unsigned*)zero)[tl] = 0u;
    const int i16 = F.lane & 15, h4 = F.lane >> 4, nb = i16 >> 3, a = 8 * q + (i16 & 7);
    const int mlo = (8 * q - (NBLK - 1)) > -(NBLK - 1) ? (8 * q - (NBLK - 1)) : -(NBLK - 1), mhi = (8 * q + 7) < (NBLK - 1) ? (8 * q + 7) : (NBLK - 1);
    const float* hb = F.in[14] + (size_t)l * 2 * HYC;
    for (int o = 0; o < 2; ++o) {
        for (int i = tl; i < GLEN / 8; i += TT) *(LAS v4u*)(Gs + 8 * i) = *(const v4u*)(Gg + (size_t)o * GLEN + 8 * i);
        __syncthreads();
        f32x4 acc[8];
#pragma unroll
        for (int r = 0; r < 8; ++r) acc[r] = (f32x4){0.f, 0.f, 0.f, 0.f};
        for (int m = mlo; m <= mhi; ++m) {
            const int blk_in = a - m; const bool valid = (a < NBLK) && blk_in >= 0 && blk_in < NBLK;
            const LAS bf16* zp = valid ? (Zc + nb * ZB + blk_in * 136 + 8 * h4) : zero;
            const int zk = valid ? 1 : 0;
            const LAS bf16* gp = Gs + (L - 128 * m + 8 * (h4 - i16));
#pragma unroll
            for (int k0 = 0; k0 < 128; k0 += 32) {
                const bf16x8 zf = *(const LAS bf16x8*)(zp + zk * k0);
                const v4u lo = *(const LAS v4u*)(gp + k0 - 8), hi = *(const LAS v4u*)(gp + k0);
                const unsigned c0 = lo.x, c1 = lo.y, c2 = lo.z, c3 = lo.w, c4 = hi.x, c5 = hi.y, c6 = hi.z, c7 = hi.w;
                const unsigned s0 = __builtin_amdgcn_alignbit(c1, c0, 16), s1 = __builtin_amdgcn_alignbit(c2, c1, 16), s2 = __builtin_amdgcn_alignbit(c3, c2, 16), s3 = __builtin_amdgcn_alignbit(c4, c3, 16),
                               s4 = __builtin_amdgcn_alignbit(c5, c4, 16), s5 = __builtin_amdgcn_alignbit(c6, c5, 16), s6 = __builtin_amdgcn_alignbit(c7, c6, 16);
#define HYF(x0, x1, x2, x3) __builtin_bit_cast(bf16x8, (v4u){x0, x1, x2, x3})
                acc[0] = __builtin_amdgcn_mfma_f32_16x16x32_bf16(HYF(c4, c5, c6, c7), zf, acc[0], 0, 0, 0);
                acc[1] = __builtin_amdgcn_mfma_f32_16x16x32_bf16(HYF(s3, s4, s5, s6), zf, acc[1], 0, 0, 0);
                acc[2] = __builtin_amdgcn_mfma_f32_16x16x32_bf16(HYF(c3, c4, c5, c6), zf, acc[2], 0, 0, 0);
                acc[3] = __builtin_amdgcn_mfma_f32_16x16x32_bf16(HYF(s2, s3, s4, s5), zf, acc[3], 0, 0, 0);
                acc[4] = __builtin_amdgcn_mfma_f32_16x16x32_bf16(HYF(c2, c3, c4, c5), zf, acc[4], 0, 0, 0);
                acc[5] = __builtin_amdgcn_mfma_f32_16x16x32_bf16(HYF(s1, s2, s3, s4), zf, acc[5], 0, 0, 0);
                acc[6] = __builtin_amdgcn_mfma_f32_16x16x32_bf16(HYF(c1, c2, c3, c4), zf, acc[6], 0, 0, 0);
                acc[7] = __builtin_amdgcn_mfma_f32_16x16x32_bf16(HYF(s0, s1, s2, s3), zf, acc[7], 0, 0, 0);
#undef HYF
            }
        }
        if (a < NBLK) {
            const float bias = hb[o * HYC + c];
            float nrm = 0.f; { const float* pb = WSP(float, WS_PART) + ((((size_t)l * 2 + (NBLK == 32 ? 0 : 1)) * 2 + o) * 2) * 8 * 512 + c;
#pragma unroll
                for (int k = 0; k < (NBLK == 32 ? 8 : 1); ++k) nrm += pb[k * 512] + pb[(8 + k) * 512]; }
            const float invn = 1.0f / nrm;
            const size_t grow = (size_t)nb * SEGB + rb0 + a * 128 + 32 * h4;
            const bf16* pp = PT + ((size_t)(512 * (o + 1) + c)) * MR + grow;
            const LAS bf16* zz = Zc + nb * ZB + a * 136 + 32 * h4;
#pragma unroll
            for (int jj = 0; jj < 4; ++jj) { const v4u pw = *(const v4u*)(pp + 8 * jj); const v4u zw = *(const LAS v4u*)(zz + 8 * jj); v4u ow;
#pragma unroll
                for (int k = 0; k < 4; ++k) { const float y0 = acc[2 * k][jj] * invn, y1 = acc[2 * k + 1][jj] * invn;
                    const float r0 = bf_lo(pw[k]) * (y0 + bf_lo(zw[k]) * bias), r1 = bf_hi(pw[k]) * (y1 + bf_hi(zw[k]) * bias); ow[k] = cvt_pk_bf16(r0, r1); }
                if (o == 0) *(LAS v4u*)(Zn + nb * ZB + a * 136 + 32 * h4 + 8 * jj) = ow;
                else *(v4u*)(YT + (size_t)c * MR + grow + 8 * jj) = ow; }
        }
        __syncthreads();
        { LAS bf16* t_ = Zc; Zc = Zn; Zn = t_; }
    }
}
__device__ __forceinline__ void hyena_phase(Frame& F, int l, bool need_ctx) {
    for (int item = F.vcu; item < HYC / 2; item += F.G) hyena_item<32, 2, 4>(F, l, item);
    if (need_ctx) for (int item = F.vcu; item < HYC / 8; item += F.G) hyena_item<2, 8, 1>(F, l, item);
}

struct SmallOrder {
    int G, c;
    __host__ __device__ void init(int G_, int c_) { G = G_; c = c_; }
    __host__ __device__ bool next(int i, pg8::Unit& u) const { const long L = (long)i * G + c; if (L >= 204 + 272 + 272) return false; int li = (int)L;
        if (li < 204) { u.ks = 0; u.pm = li / 6; u.pn = li % 6; } else if (li < 476) { li -= 204; u.ks = 1; u.pm = li >> 3; u.pn = li & 7; } else { li -= 476; u.ks = 2; u.pm = li >> 3; u.pn = li & 7; } return true; }
};
struct SmallAB {
    static constexpr bool VARK = true;
    const bf16* U; const bf16* XR; const bf16* W; int lda, ldb;
    __device__ __forceinline__ int lda_of(const pg8::Unit& u) const { return u.ks == 1 ? 128 : DINP; }
    __device__ __forceinline__ int ktiles(const pg8::Unit& u) const { return u.ks == 2 ? 4 : 8; }
    __device__ __forceinline__ const char* a_base(const pg8::Unit& u) const {
        if (u.ks == 1) { const int b = u.pm / 17, dir = u.pn >> 2, blk = u.pn & 3; return (const char*)(XR + (((size_t)b * 4 + blk) * XR_ROWS + LruAB::prow0(u.pm) - (dir ? 0 : 3)) * 128); }
        return (const char*)(U + (size_t)u.pm * 256 * DINP + (u.ks == 0 ? OFF_Q : OFF_KV)); }
    __device__ __forceinline__ const char* b_base(const pg8::Unit& u) const { const int r0 = (u.ks == 0 ? 0 : (u.ks == 1 ? 1536 : 3584)) + u.pn * 256; return (const char*)(W + (size_t)r0 * 512); }
};
struct EpiSmall {
    static constexpr bool PERM = true;
    pg8::EpiBf16 eq, ekv; EpiGate eg;
    __device__ __forceinline__ void operator()(const f32x4 (&acc)[2][2][4][2], const pg8::Unit& u, int wr, int wc, int fr, int fq) const {
        if (u.ks == 1) eg(acc, u, wr, wc, fr, fq); else if (u.ks == 0) eq(acc, u, wr, wc, fr, fq); else ekv(acc, u, wr, wc, fr, fq); }
};

constexpr int NSTEPS = 2 + 12 * DEPTH;
#ifndef PROBE_DUP
#define PROBE_DUP 0x0
#endif
#define REP(bit) for (int rep_ = 0; rep_ < (int)((PROBE_DUP >> (bit)) & 1) + 1; ++rep_)
#define LAUNDER() do { asm volatile("" : "+v"(F.tid), "+v"(F.lane)); asm volatile("" : "+s"(F.wave), "+s"(F.vcu)); asm volatile("" : "+s"(l)); \
    { unsigned long long w_ = (unsigned long long)F.ws; unsigned wl_ = (unsigned)w_, wh_ = (unsigned)(w_ >> 32); asm volatile("" : "+s"(wl_), "+s"(wh_)); F.ws = (unsigned char*)(((unsigned long long)wh_ << 32) | wl_); } } while (0)
#define IN(k) (lo <= (k) && (k) < hi)
#define SEAM(k) do { if (IN(k) && IN((k) + 1)) { xcd_barrier(bar); if (PROBE_DUP & (1u << 13)) xcd_barrier(bar); } } while (0)

template <int LI> __device__ __forceinline__ void layer_steps(Frame& F, const XcdBarrier& bar, const int lo, const int hi) {
        int l = LI; constexpr int li = LI;
        constexpr int sb = 2 + 12 * li; constexpr bool need_ctx = li < DEPTH - 1;
        if (IN(sb + 0)) REP(2) { LAUNDER(); pg8::PlainAB ab{WSP(bf16, WS_H), WSP(bf16, WS_WIN) + (size_t)l * DINP * DM, DM, DM}; pg8::StaticOrder S; S.init(MR / 256, DINP / 256, F.G, (int)blockIdx.x);
            pg8::EpiBf16 E{WSP(bf16, WS_U), DINP, nullptr}; pg8::gemm_phase<pg8::EpiBf16, pg8::PlainAB>(F.lds, ab, DM, S, E); }
        SEAM(sb + 0);
        if (IN(sb + 1)) REP(3) { LAUNDER(); post_u(F, l); __syncthreads(); }
        SEAM(sb + 1);
        if (IN(sb + 2)) REP(4) { LAUNDER();
            SmallAB ab{WSP(bf16, WS_U), WSP(bf16, WS_XR), WSP(bf16, WS_WSM) + (size_t)l * WSM_ROWS * 512, DINP, 512};
            SmallOrder S; S.init(F.G, (int)blockIdx.x);
            EpiSmall E{pg8::EpiBf16{WSP(bf16, WS_Q), DQ, WSP(float, WS_RSTD)}, pg8::EpiBf16{WSP(bf16, WS_KV), DKV, WSP(float, WS_RSTD) + MR},
                       EpiGate{WSP(bf16, WS_XR), WSP(unsigned, WS_AB), F.in[17] + (size_t)l * 2 * LRUC, F.in[19] + (size_t)l * 2 * LRUC, WSP(float, WS_SP) + (size_t)l * 2 * LRUC, F.in[15] + (size_t)l * 2 * 4 * LRUC}};
            pg8::gemm_phase<EpiSmall, SmallAB, SmallOrder>(F.lds, ab, 512, S, E);
        }
        SEAM(sb + 2);
        if (IN(sb + 3)) { LAUNDER(); REP(5) { attn_phase(F, need_ctx); __syncthreads(); } REP(6) { hyena_phase(F, l, need_ctx); __syncthreads(); } REP(7) { lru_pass1(F); } }
        SEAM(sb + 3);
        if (IN(sb + 4)) REP(7) { LAUNDER(); lru_pass2(F); }
        SEAM(sb + 4);
        if (IN(sb + 5)) REP(8) { LAUNDER(); mix_finalize(F, l); __syncthreads(); }
        SEAM(sb + 5);
        if (IN(sb + 6)) REP(9) { LAUNDER();
            { pg8::PlainAB ab{WSP(bf16, WS_YMIX), WSP(bf16, WS_WOUT) + (size_t)l * DM * DMIX, DMIX, DMIX}; pg8::LatentOrder S; S.init(32, DM / 256, F.G, (int)blockIdx.x);
              pg8::EpiBf16 E{WSP(bf16, WS_MO), DM, nullptr}; pg8::gemm_phase<pg8::EpiBf16, pg8::PlainAB, pg8::LatentOrder>(F.lds, ab, DMIX, S, E); }
            if (need_ctx) { pg8::PieceAB ab{WSP(bf16, WS_YMIX), WSP(bf16, WS_WOUT) + (size_t)l * DM * DMIX, DMIX, DMIX, 256}; pg8::PieceOrder S; S.init(DM / 256, 8, F.G, (int)blockIdx.x);
              pg8::EpiSlab E{WSP(float, WS_SLAB)}; pg8::gemm_phase<pg8::EpiSlab, pg8::PieceAB, pg8::PieceOrder>(F.lds, ab, 256, S, E); } }
        SEAM(sb + 6);
        if (IN(sb + 7)) { LAUNDER(); if (PROBE_DUP & (1u << 14)) norm_pass(F, 1, l, true); norm_pass(F, 1, l); }
        SEAM(sb + 7);
        if (IN(sb + 8)) REP(10) { LAUNDER(); pg8::PlainAB ab{WSP(bf16, WS_H), WSP(bf16, WS_WUP) + (size_t)l * 2 * DFF * DM, DM, DM}; pg8::StaticOrder S; S.init(MR / 256, 2 * DFF / 256, F.G, (int)blockIdx.x);
            pg8::EpiBf16 E{WSP(bf16, WS_UP), 2 * DFF, nullptr}; pg8::gemm_phase<pg8::EpiBf16, pg8::PlainAB>(F.lds, ab, DM, S, E); }
        SEAM(sb + 8);
        if (IN(sb + 9)) REP(11) { LAUNDER(); conv_gelu(F, l); }
        SEAM(sb + 9);
        if (IN(sb + 10)) REP(12) { LAUNDER();
            { pg8::PlainAB ab{WSP(bf16, WS_ACT), WSP(bf16, WS_WDN) + (size_t)l * DM * DFF, DFF, DFF}; pg8::LatentOrder S; S.init(32, DM / 256, F.G, (int)blockIdx.x);
              pg8::EpiBf16 E{WSP(bf16, WS_MO), DM, nullptr}; pg8::gemm_phase<pg8::EpiBf16, pg8::PlainAB, pg8::LatentOrder>(F.lds, ab, DFF, S, E); }
            if (need_ctx) { pg8::PieceAB ab{WSP(bf16, WS_ACT), WSP(bf16, WS_WDN) + (size_t)l * DM * DFF, DFF, DFF, 512}; pg8::PieceOrder S; S.init(DM / 256, 11, F.G, (int)blockIdx.x);
              pg8::EpiSlab E{WSP(float, WS_SLAB)}; pg8::gemm_phase<pg8::EpiSlab, pg8::PieceAB, pg8::PieceOrder>(F.lds, ab, 512, S, E); } }
        SEAM(sb + 10);
        if (IN(sb + 11)) { LAUNDER(); if (PROBE_DUP & (1u << 14)) norm_pass(F, 2, l, true); norm_pass(F, 2, l); }
        SEAM(sb + 11);
}

__global__ void __launch_bounds__(NTHR, 2) fwd_kernel(Args args) {
    extern __shared__ __attribute__((aligned(16))) unsigned char lds_raw[];
    Frame F;
    F.lds = (LAS unsigned char*)lds_raw; F.ws = args.ws; F.in = args.in; F.out = args.out;
    F.tid = threadIdx.x; F.lane = F.tid & 63; F.wave = __builtin_amdgcn_readfirstlane(F.tid >> 6);
    F.G = gridDim.x; { const int bx = blockIdx.x; F.vcu = (F.G % 8 == 0) ? (bx % 8) * (F.G / 8) + bx / 8 : bx; }
    volatile LAS unsigned* MISC = (volatile LAS unsigned*)(F.lds + MISC_OFF);
    for (int u = F.tid; u < (LDS_BYTES - LDSCTL_OFF) / 4; u += NTHR) ((LAS unsigned*)(F.lds + LDSCTL_OFF))[u] = 0u;
    __syncthreads();
#if MK_MULTI
    const int lo = args.ph_lo, hi = args.ph_hi;
#else
    constexpr int lo = 0, hi = NSTEPS;
#endif
    XcdBarrier bar; bar.bar = (unsigned*)(F.ws + WS_CTL) + CW_BAR; bar.x = 0; bar.st = nullptr;
    if (hi - lo > 1) bar = xcd_barrier_post((unsigned*)(F.ws + WS_CTL) + CW_BAR, MISC + 8);

    if (IN(0)) REP(0) { REP(15) { pro_mod(F); __syncthreads(); } REP(16) { pro_transposes(F); __syncthreads(); } REP(17) { pro_lru_w(F); pro_rope(F); __syncthreads(); } REP(18) { pro_hid(F); __syncthreads(); } }
    SEAM(0);
    if (IN(1)) REP(1) { pro_filter(F); __syncthreads(); norm_pass(F, 0, 0); __syncthreads(); }
    SEAM(1);

    layer_steps<0>(F, bar, lo, hi); layer_steps<1>(F, bar, lo, hi); layer_steps<2>(F, bar, lo, hi); layer_steps<3>(F, bar, lo, hi);
#undef IN
#undef SEAM
}

extern "C" void kernel_launch(void* const* d_in, const int* in_sizes, int n_in, void* d_out, int out_size, void* d_ws, size_t ws_size, hipStream_t stream) {
    static int grid = 0;
    if (grid == 0) {
        if (n_in != 30 || ws_size < WS_END) { fprintf(stderr, "kernel_launch: expected 30 inputs and >= %zu bytes of workspace (got %d, %zu)\n", (size_t)WS_END, n_in, ws_size); grid = -1; return; }
        int dev = 0, cus = 0, per_cu = 0;
        if (hipGetDevice(&dev) != hipSuccess || hipDeviceGetAttribute(&cus, hipDeviceAttributeMultiprocessorCount, dev) != hipSuccess) { grid = -1; return; }
        if (hipFuncSetAttribute((const void*)fwd_kernel, hipFuncAttributeMaxDynamicSharedMemorySize, LDS_BYTES) != hipSuccess) { fprintf(stderr, "kernel_launch: hipFuncSetAttribute failed\n"); grid = -1; return; }
        if (hipOccupancyMaxActiveBlocksPerMultiprocessor(&per_cu, (const void*)fwd_kernel, NTHR, LDS_BYTES) != hipSuccess || per_cu < 1) fprintf(stderr, "kernel_launch: occupancy query says %d\n", per_cu);
        (void)hipGetLastError();
        grid = cus;
    }
    if (grid < 0) return;
    (void)hipMemsetAsync((char*)d_ws + WS_CTL, 0, CTL_ZERO_BYTES, stream);
    Args a{};
    for (int i = 0; i < 30; ++i) a.in[i] = (const float*)d_in[i];
    a.out = (float*)d_out; a.ws = (unsigned char*)d_ws;
#if MK_MULTI
    for (int s = 0; s < NSTEPS; ++s) { a.ph_lo = s; a.ph_hi = s + 1; hipLaunchKernelGGL(fwd_kernel, dim3(grid), dim3(NTHR), LDS_BYTES, stream, a); }
#else
    a.ph_lo = 0; a.ph_hi = NSTEPS; hipLaunchKernelGGL(fwd_kernel, dim3(grid), dim3(NTHR), LDS_BYTES, stream, a);
#endif
}
```

```cpp
#include <hip/hip_runtime.h>
#include <cstdio>
#include <cstdint>

#ifndef PROBE_DUP
#define PROBE_DUP 0x0
#endif
#ifndef MK_MULTI
#define MK_MULTI 0
#endif

constexpr int DM = 2048, NBATCH = 2, SEQ = 4096, CTXL = 256, DEPTH = 4;
constexpr int SEGB = CTXL + SEQ;
constexpr int MR = NBATCH * SEGB;
constexpr int DIN = 3392, DINP = 3584;
constexpr int HYC = 512, LRUC = 512, QRANK = 512, KVRANK = 256, NOPE = 128, ROPED = 64, VD = 128, NH = 8;
constexpr int DQ = NH * (NOPE + ROPED);
constexpr int DKV = NH * (NOPE + VD);
constexpr int DFF = 5632, DMIX = 2048;
constexpr int OFF_LRU_G = 1536, OFF_Q = 2048, OFF_LRU_X = 2560, OFF_KV = 3072, OFF_KR = 3328;
constexpr float EPS = 1e-6f;
constexpr int XR_ROWS = 4364;
constexpr int NCHUNK = MR / 64;
constexpr int HYL = 8192, HYLC = 512;

constexpr size_t MiB = 1u << 20;
constexpr size_t WS_CTL = 0, CTL_ZERO_BYTES = 1 * MiB;
constexpr size_t WS_MOD = 1 * MiB;
constexpr size_t WS_ROPE = 2 * MiB;
constexpr size_t WS_HID = 3 * MiB;
constexpr size_t WS_PART = 8 * MiB;
constexpr size_t WS_RSTD = 9 * MiB;
constexpr size_t WS_SP = 9 * MiB + 256 * 1024;
constexpr size_t WS_CARRY = 10 * MiB;
constexpr size_t WS_SSQ = 12 * MiB;
constexpr size_t WS_G = 16 * MiB;
constexpr size_t WS_GC = 80 * MiB;
constexpr size_t WS_WIN = 96 * MiB;
constexpr size_t WS_WUQ = 152 * MiB;
constexpr size_t WS_WUKV = 158 * MiB;
constexpr size_t WS_WOUT = 162 * MiB;
constexpr size_t WS_WUP = 194 * MiB;
constexpr size_t WS_WDN = 370 * MiB;
constexpr size_t WS_WLRU = 458 * MiB;
constexpr size_t WS_X = 480 * MiB;
constexpr size_t WS_H = 548 * MiB;
constexpr size_t WS_U = 582 * MiB;
constexpr size_t WS_Q = 642 * MiB;
constexpr size_t WS_KV = 668 * MiB;
constexpr size_t WS_KR = 702 * MiB;
constexpr size_t WS_O = 704 * MiB;
constexpr size_t WS_PT = 722 * MiB;
constexpr size_t WS_YT = 748 * MiB;
constexpr size_t WS_XR = 757 * MiB;
constexpr size_t WS_AB = 766 * MiB;
constexpr size_t WS_HF = 834 * MiB;
constexpr size_t WS_YL = 851 * MiB;
constexpr size_t WS_YMIX = 868 * MiB;
constexpr size_t WS_MO = 902 * MiB;
constexpr size_t WS_UP = 936 * MiB;
constexpr size_t WS_ACT = 1123 * MiB;
constexpr size_t WS_SLAB = 1217 * MiB;
constexpr size_t WS_WUKV2 = 1265 * MiB;
constexpr size_t WS_WSM = 1273 * MiB;
constexpr int WSM_ROWS = 1536 + 2048 + 2048;
constexpr size_t WS_END = 1297 * MiB;

constexpr int CW_BAR = 4096;

constexpr int NWAVES = 8, NTHR = 512;
constexpr int RING_BYTES = 131072;
constexpr int LDSCTL_OFF = RING_BYTES, MISC_OFF = LDSCTL_OFF + 320;
constexpr int LDS_BYTES = 147456;

#define GAS __attribute__((address_space(1)))
#define LAS __attribute__((address_space(3)))
#define CAS __attribute__((address_space(4)))
typedef const float CAS cfloat_c;
typedef unsigned short bf16;
typedef unsigned v4u __attribute__((ext_vector_type(4)));
typedef unsigned v2u __attribute__((ext_vector_type(2)));
typedef float f32x4 __attribute__((ext_vector_type(4)));
typedef float f32x2 __attribute__((ext_vector_type(2)));
typedef float f32x16 __attribute__((ext_vector_type(16)));
typedef short bf16x8 __attribute__((ext_vector_type(8)));
typedef short s16x4 __attribute__((ext_vector_type(4)));
typedef GAS unsigned gu32;
#define RLX_AGENT __ATOMIC_RELAXED, __HIP_MEMORY_SCOPE_AGENT
#define LDS_WAIT() asm volatile("s_waitcnt lgkmcnt(0)" ::: "memory")
#define VM_WAIT() asm volatile("s_waitcnt vmcnt(0)" ::: "memory")

__device__ __forceinline__ unsigned cvt_pk_bf16(float lo, float hi) { unsigned r; asm volatile("v_cvt_pk_bf16_f32 %0, %1, %2" : "=v"(r) : "v"(lo), "v"(hi)); return r; }
__device__ __forceinline__ float bf_lo(unsigned w) { return __uint_as_float(w << 16); }
__device__ __forceinline__ float bf_hi(unsigned w) { return __uint_as_float(w & 0xffff0000u); }
__device__ __forceinline__ float bf2f(bf16 v) { return __uint_as_float(((unsigned)v) << 16); }
__device__ __forceinline__ bf16 f2bf(float f) { return (bf16)(cvt_pk_bf16(f, 0.f) & 0xffffu); }
__device__ __forceinline__ float wave_sum(float v) {
#pragma unroll
    for (int o = 1; o < 64; o <<= 1) v += __shfl_xor(v, o);
    return v;
}
__device__ __forceinline__ float sigmoidf_(float x) { return 1.0f / (1.0f + __expf(-x)); }
__device__ __forceinline__ float gelu_tanh(float x) { const float u = 0.7978845608028654f * (x + 0.044715f * x * x * x); return x / (1.0f + __expf(-2.0f * u)); }

#define XB_TMO      128
#define XB_XCNT(j)  (256  + 64 * (j))
#define XB_XSUB(j)  (1280 + 64 * (j))
#define XB_XGEN(j)  (2304 + 64 * (j))
#define XB_TOP      3328
#define XB_TOPGEN   3392
#define XCD_BAR_WORDS 3456
#define XB_SPIN_CAP (1u << 18)
__device__ __forceinline__ unsigned xb_ld(unsigned* p)              { return __hip_atomic_load(p, __ATOMIC_RELAXED, __HIP_MEMORY_SCOPE_AGENT); }
__device__ __forceinline__ unsigned xb_add(unsigned* p, unsigned v) { return __hip_atomic_fetch_add(p, v, __ATOMIC_RELAXED, __HIP_MEMORY_SCOPE_AGENT); }
__device__ __forceinline__ unsigned xb_xcc_id() { return (unsigned)__builtin_amdgcn_s_getreg((3 << 11) | 20) & 0xFu; }
#define XB_SPIN(cond, bar) do { unsigned _sp = 0; while (cond) { __builtin_amdgcn_s_sleep(1); \
    if ((++_sp & 255u) == 0u) { if (xb_ld(&(bar)[XB_TMO])) break; if (_sp > XB_SPIN_CAP) { atomicAdd(&(bar)[XB_TMO], 1u); break; } } } } while (0)
struct XcdBarrier { unsigned* bar; unsigned x; volatile LAS unsigned* st; };
__device__ __forceinline__ XcdBarrier xcd_barrier_post(unsigned* bar, volatile LAS unsigned* st) {
    XcdBarrier b; b.bar = bar; b.x = xb_xcc_id(); b.st = st;
    if (threadIdx.x == 0) (void)xb_add(&bar[XB_XCNT(b.x)], 1u);
    return b;
}
__device__ __forceinline__ void xcd_barrier_complete(unsigned* bar, unsigned x, unsigned& nloc, unsigned& nx) {
    const unsigned G = gridDim.x * gridDim.y * gridDim.z;
    unsigned sum, cnt, mine, sp = 0u;
    for (;;) {
        sum = 0u; cnt = 0u; mine = 0u;
#pragma unroll
        for (unsigned j = 0; j < 16; ++j) { const unsigned c = xb_ld(&bar[XB_XCNT(j)]); sum += c; cnt += (c > 0u) ? 1u : 0u; mine = (j == x) ? c : mine; }
        if (sum == G) break;
        __builtin_amdgcn_s_sleep(1);
        if ((++sp & 255u) == 0u) { if (xb_ld(&bar[XB_TMO])) break; if (sp > XB_SPIN_CAP) { atomicAdd(&bar[XB_TMO], 1u); break; } }
    }
    nloc = mine > 0u ? mine : 1u; nx = cnt > 0u ? cnt : 1u;
}
__device__ __forceinline__ void xcd_barrier(const XcdBarrier& b) {
    asm volatile("s_waitcnt vmcnt(0)" ::: "memory");
    __syncthreads();
    unsigned* bar_l; { unsigned long long w_ = (unsigned long long)b.bar; unsigned wl_ = (unsigned)w_, wh_ = (unsigned)(w_ >> 32); asm volatile("" : "+s"(wl_), "+s"(wh_)); bar_l = (unsigned*)(((unsigned long long)wh_ << 32) | wl_); }
    unsigned x_l = b.x; asm volatile("" : "+s"(x_l));
    if (threadIdx.x == 0) {
        unsigned* bar = bar_l;
        __builtin_amdgcn_s_waitcnt(0);
        unsigned nloc = b.st[0], nx = b.st[1];
        if (nloc == 0u) { xcd_barrier_complete(bar, x_l, nloc, nx); b.st[0] = nloc; b.st[1] = nx; }
        const unsigned old = xb_add(&bar[XB_XSUB(x_l)], 1u);
        const unsigned gen = old / nloc;
        if (old + 1u == (gen + 1u) * nloc) {
            __builtin_amdgcn_fence(__ATOMIC_RELEASE, "agent");
            asm volatile("s_waitcnt vmcnt(0)" ::: "memory");
            const unsigned og = xb_add(&bar[XB_TOP], 1u);
            const unsigned tg = og / nx;
            if (og + 1u == (tg + 1u) * nx) xb_add(&bar[XB_TOPGEN], 1u);
            else XB_SPIN(xb_ld(&bar[XB_TOPGEN]) == tg, bar);
            __builtin_amdgcn_fence(__ATOMIC_ACQUIRE, "agent");
            xb_add(&bar[XB_XGEN(x_l)], 1u);
            asm volatile("s_waitcnt vmcnt(0)" ::: "memory");
        } else {
            XB_SPIN(xb_ld(&bar[XB_XGEN(x_l)]) == gen, bar);
            __builtin_amdgcn_fence(__ATOMIC_ACQUIRE, "agent");
            asm volatile("s_waitcnt vmcnt(0)" ::: "memory");
        }
    }
    __syncthreads();
}

struct Args { const float* in[30]; float* out; unsigned char* ws; int ph_lo, ph_hi; };
struct Frame {
    LAS unsigned char* lds;
    unsigned char* ws;
    const float* const* in;
    float* out;
    int tid, lane, wave, vcu, G;
};
#define WSP(T, off) ((T*)(F.ws + (off)))
__device__ __forceinline__ void row_info(int r, int& b, int& isctx, int& t) { b = r >= SEGB ? 1 : 0; const int j = r - b * SEGB; isctx = j < CTXL ? 1 : 0; t = isctx ? j : j - CTXL; }

namespace pg8 {
constexpr int BM = 256, BK = 64, HALF = 128, HTB = HALF * BK * 2, STAGE_BYTES = 8 * HTB, NXCD = 8, WGM = 8;
__host__ __device__ __forceinline__ int lds_byte(int r, int c) { const int st = (r >> 4) * 2 + (c >> 5), rr = r & 15, cc = c & 31, ob = rr * 64 + cc * 2; return st * 1024 + (ob ^ (((ob >> 9) & 1) << 5)); }
__host__ __device__ __forceinline__ void stage_rc(int b, int& R, int& C) { const int st = b / 1024, sb = b % 1024, swz = sb ^ (((sb >> 9) & 1) << 5); R = (st >> 1) * 16 + swz / 64; C = (st & 1) * 32 + (swz % 64) / 2; }
__host__ __device__ __forceinline__ int perm32(int rho) { const int n = rho >> 4, i = rho & 15; return 8 * (i >> 2) + 4 * n + (i & 3); }
struct Unit { int pm, pn, ks; };
struct StaticOrder {
    int nM, nN, nwg, G, c;
    __host__ __device__ void init(int nM_, int nN_, int G_, int c_) { nM = nM_; nN = nN_; nwg = nM * nN; G = G_; c = c_; }
    __host__ __device__ bool next(int i, Unit& u) const {
        const long L = (long)i * G + c; if (L >= nwg) return false;
        int wgid = (int)L; { const int q = nwg / NXCD, r = nwg % NXCD, xcd = wgid % NXCD, off = wgid / NXCD; wgid = (xcd < r ? xcd * (q + 1) : r * (q + 1) + (xcd - r) * q) + off; }
        const int nig = WGM * nN, gid = wgid / nig, fm = gid * WGM, gsz = (nM - fm) < WGM ? (nM - fm) : WGM;
        u.pm = fm + ((wgid % nig) % gsz); u.pn = (wgid % nig) / gsz; u.ks = 0; return true;
    }
};
struct LatentOrder : StaticOrder {
    __host__ __device__ bool next(int i, Unit& u) const { if (!StaticOrder::next(i, u)) return false; u.pm = u.pm < 16 ? u.pm + 1 : u.pm + 2; return true; }
};
struct PieceOrder {
    int nN, S, n, G, c;
    __host__ __device__ void init(int nN_, int S_, int G_, int c_) { nN = nN_; S = S_; n = 2 * nN_ * S_; G = G_; c = c_; }
    __host__ __device__ bool next(int i, Unit& u) const { const long L = (long)i * G + c; if (L >= n) return false; const int li = (int)L; u.ks = li % S; u.pn = (li / S) % nN; u.pm = (li / (S * nN)) ? 17 : 0; return true; }
};
struct PieceAB {
    static constexpr bool VARK = false;
    const bf16* A; const bf16* Bt; int lda, ldb, Kp;
    __device__ __forceinline__ const char* a_base(const Unit& u) const { return (const char*)(A + (size_t)u.pm * BM * lda + (size_t)u.ks * Kp); }
    __device__ __forceinline__ const char* b_base(const Unit& u) const { return (const char*)(Bt + (size_t)u.pn * BM * ldb + (size_t)u.ks * Kp); }
};
struct EpiSlab {
    static constexpr bool PERM = false;
    float* slab;
    __device__ __forceinline__ void operator()(const f32x4 (&acc)[2][2][4][2], const Unit& u, int wr, int wc, int fr, int fq) const {
        const int row0 = (u.pm ? 256 : 0) + wr * 64 + fr, col0 = u.pn * BM + wc * 32 + 4 * fq; float* base = slab + (size_t)u.ks * (512 * 2048);
#pragma unroll
        for (int ai = 0; ai < 2; ++ai)
#pragma unroll
            for (int m = 0; m < 4; ++m) { float* rowp = base + (size_t)(row0 + ai * HALF + m * 16) * 2048 + col0;
#pragma unroll
                for (int bj = 0; bj < 2; ++bj)
#pragma unroll
                    for (int n = 0; n < 2; ++n) *(f32x4*)(rowp + bj * HALF + n * 16) = acc[ai][bj][m][n]; }
    }
};
struct PlainAB {
    static constexpr bool VARK = false;
    const bf16* A; const bf16* Bt; int lda, ldb;
    __device__ __forceinline__ const char* a_base(const Unit& u) const { return (const char*)(A + (size_t)u.pm * BM * lda); }
    __device__ __forceinline__ const char* b_base(const Unit& u) const { return (const char*)(Bt + (size_t)u.pn * BM * ldb); }
};
struct EpiBf16 {
    static constexpr bool PERM = true;
    bf16* O; int ldc; const float* ssq; int s0, ns; float invk;
    __device__ __forceinline__ void operator()(const f32x4 (&acc)[2][2][4][2], const Unit& u, int wr, int wc, int fr, int fq) const {
        const int row0 = u.pm * BM + wr * 64 + fr; const int col0 = u.pn * BM + wc * 32 + 8 * fq;
#pragma unroll
        for (int ai = 0; ai < 2; ++ai)
#pragma unroll
            for (int m = 0; m < 4; ++m) { const int row = row0 + ai * HALF + m * 16; bf16* rowp = O + (size_t)row * ldc + col0; float sc = 1.0f;
                if (ssq) { float s = 0.f; for (int k = 0; k < ns; ++k) s += ssq[(size_t)row * 12 + s0 + k]; sc = 1.0f / sqrtf(s * invk + 1e-6f); }
                constexpr size_t bjstep = HALF;
#pragma unroll
                for (int bj = 0; bj < 2; ++bj) { const f32x4 v0 = acc[ai][bj][m][0] * sc, v1 = acc[ai][bj][m][1] * sc;
                    v4u w; w.x = cvt_pk_bf16(v0[0], v0[1]); w.y = cvt_pk_bf16(v0[2], v0[3]); w.z = cvt_pk_bf16(v1[0], v1[1]); w.w = cvt_pk_bf16(v1[2], v1[3]);
                    *(v4u*)(rowp + bj * bjstep) = w; } }
    }
};

template <class Epi, class AB, class Sched = StaticOrder, bool ALIGN_EPI = true>
__device__ __forceinline__ void gemm_phase(LAS unsigned char* lds, const AB ab, const int K, const Sched& S, const Epi& E) {
    int tid = threadIdx.x; asm volatile("" : "+v"(tid));
    const int wid = __builtin_amdgcn_readfirstlane(tid >> 6), lane = tid & 63, wr = wid >> 2, wc = wid & 3, fr = lane & 15, fq = lane >> 4;
    int nt = K / BK;
    unsigned voffA[2], voffB[2], voffAn[2]; int stR[2], stC[2];
#pragma unroll
    for (int i = 0; i < 2; ++i) { int R, C; stage_rc(tid * 16 + i * 8192, R, C); const int Rb = Epi::PERM ? ((R & ~31) + perm32(R & 31)) : R; stR[i] = R; stC[i] = C;
        voffA[i] = (unsigned)(R * ab.lda + C) * 2u; voffB[i] = (unsigned)(Rb * ab.ldb + C) * 2u; voffAn[i] = voffA[i]; }
    const size_t kstep = (size_t)(BK * 2);
    size_t hstepA = (size_t)HALF * ab.lda * 2, hstepAn = hstepA; const size_t hstepB = (size_t)HALF * ab.ldb * 2; int ntn = nt;
    const unsigned ldsw = (unsigned)wid * 1024u;
    const int aoff = lds_byte(wr * 64 + fr, fq * 8), boff = lds_byte(wc * 32 + fr, fq * 8);
#define PG8_SA(b, h) (((b) * 2 + (h)) * HTB)
#define PG8_SB(b, h) ((4 + (b) * 2 + (h)) * HTB)
#define PG8_STAGE(bufoff, gbase, voff) do { _Pragma("unroll") for (int _i = 0; _i < 2; ++_i) \
        __builtin_amdgcn_global_load_lds((const unsigned*)((const char*)(gbase) + (voff)[_i]), (LAS unsigned*)(lds + (bufoff) + ldsw + _i * 8192), 16, 0, 0); } while (0)
#define PG8_LDA(dst, b, h) do { _Pragma("unroll") for (int m = 0; m < 4; ++m) _Pragma("unroll") for (int k = 0; k < 2; ++k) dst[m][k] = *(const LAS bf16x8*)(lds + PG8_SA(b, h) + aoff + m * 2048 + k * 1024); } while (0)
#define PG8_LDB(dst, b, h) do { _Pragma("unroll") for (int n = 0; n < 2; ++n) _Pragma("unroll") for (int k = 0; k < 2; ++k) dst[n][k] = *(const LAS bf16x8*)(lds + PG8_SB(b, h) + boff + n * 2048 + k * 1024); } while (0)
#define PG8_MMA(ai, bj, At, Bt) do { __builtin_amdgcn_s_setprio(1); _Pragma("unroll") for (int m = 0; m < 4; ++m) _Pragma("unroll") for (int n = 0; n < 2; ++n) _Pragma("unroll") for (int k = 0; k < 2; ++k) \
        acc[ai][bj][m][n] = __builtin_amdgcn_mfma_f32_16x16x32_bf16(Bt[n][k], At[m][k], acc[ai][bj][m][n], 0, 0, 0); __builtin_amdgcn_s_setprio(0); } while (0)
#define PG8_WAIT_V(n) asm volatile("s_waitcnt vmcnt(" #n ")" ::: "memory")
#define PG8_WAIT_L(n) asm volatile("s_waitcnt lgkmcnt(" #n ")" ::: "memory")
#define PG8_BAR __builtin_amdgcn_s_barrier()
#define PG8_SCHED __builtin_amdgcn_sched_barrier(0)
    Unit cur, nxt; int ui = 0;
    if (!S.next(0, cur)) return;
    f32x4 acc[2][2][4][2];
#pragma unroll
    for (int a = 0; a < 2; ++a)
#pragma unroll
        for (int b = 0; b < 2; ++b)
#pragma unroll
            for (int m = 0; m < 4; ++m)
#pragma unroll
                for (int n = 0; n < 2; ++n) acc[a][b][m][n] = (f32x4){0.f, 0.f, 0.f, 0.f};
    bf16x8 At[4][2], B0[2][2], B1[2][2];
    const char* cA = ab.a_base(cur); const char* cB = ab.b_base(cur);
    if constexpr (AB::VARK) { const int la_ = ab.lda_of(cur); nt = ab.ktiles(cur); hstepA = (size_t)HALF * la_ * 2;
#pragma unroll
        for (int i = 0; i < 2; ++i) voffA[i] = (unsigned)(stR[i] * la_ + stC[i]) * 2u; }
    PG8_STAGE(PG8_SB(0, 0), cB, voffB); PG8_STAGE(PG8_SB(0, 1), cB + hstepB, voffB); PG8_STAGE(PG8_SA(0, 0), cA, voffA); PG8_STAGE(PG8_SA(0, 1), cA + hstepA, voffA);
    if (wr == 1) PG8_BAR;
    PG8_WAIT_V(2); PG8_BAR;
    PG8_STAGE(PG8_SB(1, 0), cB + kstep, voffB); PG8_STAGE(PG8_SA(1, 0), cA + kstep, voffA); PG8_STAGE(PG8_SB(1, 1), cB + hstepB + kstep, voffB);
    PG8_WAIT_V(6); PG8_BAR;
    for (;;) {
        const bool has_next = S.next(ui + 1, nxt);
        const char* nA = has_next ? ab.a_base(nxt) : cA; const char* nB = has_next ? ab.b_base(nxt) : cB;
        if constexpr (AB::VARK) { if (has_next) { const int la_ = ab.lda_of(nxt); ntn = ab.ktiles(nxt); hstepAn = (size_t)HALF * la_ * 2;
#pragma unroll
                for (int i = 0; i < 2; ++i) voffAn[i] = (unsigned)(stR[i] * la_ + stC[i]) * 2u; } else { ntn = nt; hstepAn = hstepA; voffAn[0] = voffA[0]; voffAn[1] = voffA[1]; } }
        for (int t = 0; t < nt; t += 2) {
            const bool last = (t == nt - 2);
            const char* a1 = cA + (size_t)(t + 1) * kstep;
            const char* a2 = last ? nA : cA + (size_t)(t + 2) * kstep; const char* b2 = last ? nB : cB + (size_t)(t + 2) * kstep;
            const char* a3 = a2 + kstep; const char* b3 = b2 + kstep;
            unsigned voffA2[2]; size_t hstepA2;
            if constexpr (AB::VARK) { voffA2[0] = last ? voffAn[0] : voffA[0]; voffA2[1] = last ? voffAn[1] : voffA[1]; hstepA2 = last ? hstepAn : hstepA; }
            else { voffA2[0] = voffA[0]; voffA2[1] = voffA[1]; hstepA2 = hstepA; }
            PG8_LDB(B0, 0, 0); PG8_LDB(B1, 0, 1); PG8_SCHED; PG8_LDA(At, 0, 0); PG8_STAGE(PG8_SA(1, 1), a1 + hstepA, voffA);
            PG8_WAIT_V(8); PG8_WAIT_L(0); PG8_BAR; PG8_MMA(0, 0, At, B0); PG8_MMA(0, 1, At, B1); PG8_BAR; PG8_SCHED;
            PG8_LDA(At, 0, 1); PG8_STAGE(PG8_SB(0, 0), b2, voffB); PG8_STAGE(PG8_SB(0, 1), b2 + hstepB, voffB); PG8_STAGE(PG8_SA(0, 0), a2, voffA2);
            PG8_WAIT_V(8); PG8_WAIT_L(0); PG8_BAR; PG8_MMA(1, 0, At, B0); PG8_MMA(1, 1, At, B1); PG8_BAR; PG8_SCHED;
            PG8_LDB(B0, 1, 0); PG8_LDB(B1, 1, 1); PG8_SCHED; PG8_LDA(At, 1, 0); PG8_STAGE(PG8_SA(0, 1), a2 + hstepA2, voffA2);
            PG8_WAIT_V(8); PG8_WAIT_L(0); PG8_BAR; PG8_MMA(0, 0, At, B0); PG8_MMA(0, 1, At, B1); PG8_BAR; PG8_SCHED;
            PG8_LDA(At, 1, 1); PG8_STAGE(PG8_SB(1, 0), b3, voffB); PG8_STAGE(PG8_SB(1, 1), b3 + hstepB, voffB); PG8_STAGE(PG8_SA(1, 0), a3, voffA2);
            PG8_WAIT_V(8); PG8_WAIT_L(0); PG8_BAR; PG8_MMA(1, 0, At, B0); PG8_MMA(1, 1, At, B1); PG8_BAR; PG8_SCHED;
        }
        if constexpr (ALIGN_EPI) { if (wr == 0) PG8_BAR; }
        E(acc, cur, wr, wc, fr, fq);
        if (!has_next) break;
#pragma unroll
        for (int a = 0; a < 2; ++a)
#pragma unroll
            for (int b = 0; b < 2; ++b)
#pragma unroll
                for (int m = 0; m < 4; ++m)
#pragma unroll
                    for (int n = 0; n < 2; ++n) acc[a][b][m][n] = (f32x4){0.f, 0.f, 0.f, 0.f};
        cur = nxt; cA = nA; cB = nB; ++ui;
        if constexpr (AB::VARK) { nt = ntn; hstepA = hstepAn; voffA[0] = voffAn[0]; voffA[1] = voffAn[1]; }
        if constexpr (ALIGN_EPI) { if (wr == 1) PG8_BAR; }
    }
    PG8_WAIT_V(0);
    if constexpr (!ALIGN_EPI) { if (wr == 0) PG8_BAR; }
    PG8_BAR;
#undef PG8_SA
#undef PG8_SB
#undef PG8_STAGE
#undef PG8_LDA
#undef PG8_LDB
#undef PG8_MMA
#undef PG8_WAIT_V
#undef PG8_WAIT_L
#undef PG8_BAR
#undef PG8_SCHED
}
}

__device__ __forceinline__ void pro_mod(Frame& F) {
    LAS float* sil = (LAS float*)F.lds;
    LAS float* red = (LAS float*)(F.lds + 24576);
    const float* c = F.in[1]; const float* cc = F.in[3];
    for (int i = F.tid; i < 3 * DM; i += NTHR) { const int w = i / DM, k = i - w * DM; const float v = (w < 2) ? c[w * DM + k] : cc[k]; sil[i] = v / (1.0f + expf(-v)); }
    __syncthreads();
    float* MOD = WSP(float, WS_MOD);
    const int k0 = F.wave * 256;
    for (int unit = F.vcu; unit < DEPTH * 192; unit += F.G) {
        const int l = unit / 192, cg = unit - l * 192;
        const float* W = F.in[4] + (size_t)l * DM * (6 * DM) + cg * 64 + F.lane;
        float a0 = 0.f, a1 = 0.f, a2 = 0.f;
#pragma unroll 16
        for (int k = k0; k < k0 + 256; ++k) { const float w = W[(size_t)k * (6 * DM)]; a0 += sil[k] * w; a1 += sil[DM + k] * w; a2 += sil[2 * DM + k] * w; }
        red[(F.wave * 3 + 0) * 64 + F.lane] = a0; red[(F.wave * 3 + 1) * 64 + F.lane] = a1; red[(F.wave * 3 + 2) * 64 + F.lane] = a2;
        __syncthreads();
        if (F.tid < 192) { const int j = F.tid >> 6, ln = F.tid & 63; float s = 0.f;
#pragma unroll
            for (int w = 0; w < 8; ++w) s += red[(w * 3 + j) * 64 + ln];
            MOD[((size_t)l * 3 + j) * (6 * DM) + cg * 64 + ln] = s + F.in[5][(size_t)l * (6 * DM) + cg * 64 + ln]; }
        __syncthreads();
    }
}

__device__ __forceinline__ void tr_tile(const float* __restrict__ W, int K, int N, bf16* __restrict__ WT, const float* kscale, LAS float* scr, int item, int lane, int ldk = 0, int remap_n0 = -1, int remap_add = 0) {
    if (ldk == 0) ldk = K;
    const int nblk = N >> 5, kb = item / nblk, nb = item - kb * nblk, k0 = kb * 64, n0 = nb * 32, nd0 = (n0 == remap_n0) ? n0 + remap_add : n0;
#pragma unroll
    for (int i = 0; i < 8; ++i) { const int kk = 8 * i + (lane >> 3), c4 = (lane & 7) * 4;
        f32x4 v = *(const f32x4*)(W + (size_t)(k0 + kk) * N + n0 + c4); if (kscale) v = v * kscale[k0 + kk];
        scr[kk * 33 + c4 + 0] = v[0]; scr[kk * 33 + c4 + 1] = v[1]; scr[kk * 33 + c4 + 2] = v[2]; scr[kk * 33 + c4 + 3] = v[3]; }
    LDS_WAIT(); asm volatile("" ::: "memory");
    const int c = lane & 7;
#pragma unroll
    for (int j = 0; j < 4; ++j) { const int n = (lane >> 3) + 8 * j; const LAS float* s = scr + (8 * c) * 33 + n;
        v4u o; o.x = cvt_pk_bf16(s[0], s[33]); o.y = cvt_pk_bf16(s[66], s[99]); o.z = cvt_pk_bf16(s[132], s[165]); o.w = cvt_pk_bf16(s[198], s[231]);
        *(v4u*)(WT + (size_t)(nd0 + n) * ldk + k0 + 8 * c) = o; }
    LDS_WAIT(); asm volatile("" ::: "memory");
}
__device__ __forceinline__ void pro_transposes(Frame& F) {
    LAS float* scr = (LAS float*)(F.lds + F.wave * 16384);
    const int gw = F.vcu * NWAVES + F.wave, NGW = F.G * NWAVES;
    constexpr int I0 = 32 * 106, I1 = 8 * 48, I2 = 4 * 64, I3 = 32 * 64, I4 = 32 * 352, I5 = 88 * 64, IL = I0 + I1 + I2 + I3 + I4 + I5;
    for (int it = gw; it < DEPTH * IL; it += NGW) {
        const int l = it / IL; int r = it - l * IL;
        if (r < I0) { tr_tile(F.in[7] + (size_t)l * DM * DIN, DM, DIN, WSP(bf16, WS_WIN) + (size_t)l * DINP * DM, nullptr, scr, r, F.lane, 0, 3360, 96); continue; } r -= I0;
        if (r < I1) { tr_tile(F.in[23] + (size_t)l * QRANK * DQ, QRANK, DQ, WSP(bf16, WS_WSM) + (size_t)l * WSM_ROWS * 512, F.in[21] + l * QRANK, scr, r, F.lane); continue; } r -= I1;
        if (r < I2) { tr_tile(F.in[24] + (size_t)l * KVRANK * DKV, KVRANK, DKV, WSP(bf16, WS_WSM) + ((size_t)l * WSM_ROWS + 3584) * 512, F.in[22] + l * KVRANK, scr, r, F.lane, 512); continue; } r -= I2;
        if (r < I3) { tr_tile(F.in[26] + (size_t)l * DMIX * DM, DMIX, DM, WSP(bf16, WS_WOUT) + (size_t)l * DM * DMIX, nullptr, scr, r, F.lane); continue; } r -= I3;
        if (r < I4) { tr_tile(F.in[27] + (size_t)l * DM * 2 * DFF, DM, 2 * DFF, WSP(bf16, WS_WUP) + (size_t)l * 2 * DFF * DM, nullptr, scr, r, F.lane); continue; } r -= I4;
        tr_tile(F.in[29] + (size_t)l * DFF * DM, DFF, DM, WSP(bf16, WS_WDN) + (size_t)l * DM * DFF, nullptr, scr, r, F.lane);
    }
    { const v4u z = {0u, 0u, 0u, 0u}; constexpr int per = (DINP - DIN) * DM / 8;
      for (int i = F.vcu * NTHR + F.tid; i < DEPTH * per; i += F.G * NTHR) { const int l = i / per, j = i - l * per; const int row = j / (DM / 8), ch = j - row * (DM / 8);
          const int drow = row < 96 ? 3360 + row : 3488 + (row - 96);
          *(v4u*)(WSP(bf16, WS_WIN) + ((size_t)l * DINP + drow) * DM + (size_t)ch * 8) = z; } }
}
__device__ __forceinline__ void pro_lru_w(Frame& F) {
    bf16* WL = WSP(bf16, WS_WLRU);
    constexpr int total = DEPTH * 2 * 4 * 256 * 64;
    for (int i = F.vcu * NTHR + F.tid; i < total; i += F.G * NTHR) {
        const int ch = i & 63, row = (i >> 6) & 255, blk = (i >> 14) & 3, dir = (i >> 16) & 1, l = i >> 17;
        const int g = row >> 7, e = row & 127, j4 = ch >> 4, d0 = (ch & 15) * 8;
        const float* Wsrc = (g ? F.in[18] : F.in[16]) + ((((size_t)l * 2 + dir) * 4 + blk) * 128) * 128;
        const float* cw = F.in[15] + (((size_t)l * 2 + dir) * 4 + j4) * LRUC + blk * 128 + d0;
        float v[8];
#pragma unroll
        for (int j = 0; j < 8; ++j) v[j] = cw[j] * Wsrc[(size_t)(d0 + j) * 128 + e];
        v4u o; o.x = cvt_pk_bf16(v[0], v[1]); o.y = cvt_pk_bf16(v[2], v[3]); o.z = cvt_pk_bf16(v[4], v[5]); o.w = cvt_pk_bf16(v[6], v[7]);
        *(v4u*)(WSP(bf16, WS_WSM) + ((size_t)l * WSM_ROWS + 1536) * 512 + (size_t)(i & ((1 << 17) - 1)) * 8) = o;
    }
}
__device__ __forceinline__ void pro_rope(Frame& F) {
    { float* SP = WSP(float, WS_SP); for (int i = F.vcu * NTHR + F.tid; i < DEPTH * 2 * LRUC; i += F.G * NTHR) SP[i] = log1pf(expf(-F.in[20][i])); }
    float* R = WSP(float, WS_ROPE);
    for (int i = F.vcu * NTHR + F.tid; i < SEQ * 32; i += F.G * NTHR) { const int t = i >> 5, f = i & 31; const float pos = (f < 16) ? (float)(t >> 6) : (float)(t & 63);
        const float inv = powf(10000.0f, -(float)(f & 15) / 16.0f); const float a = pos * inv; R[t * 64 + f] = cosf(a); R[t * 64 + 32 + f] = sinf(a); }
}
__device__ __forceinline__ void pro_hid(Frame& F) {
    LAS float* h1 = (LAS float*)(F.lds + F.wave * 16384);
    float* HID = WSP(float, WS_HID);
    const int gw = F.vcu * NWAVES + F.wave, NGW = F.G * NWAVES;
    const int tl = F.lane & 15, part = F.lane >> 4;
    for (int wi = gw; wi < DEPTH * 272; wi += NGW) {
        const int l = __builtin_amdgcn_readfirstlane(wi / 272), tt = (wi - l * 272) * 16 + tl;
        const int L = tt < 4096 ? 4096 : 256, t = tt < 4096 ? tt : tt - 4096;
        const float tn = (float)t / (float)L;
        float sb[16], cb[16];
#pragma unroll
        for (int b = 0; b < 16; ++b) { const float ang = (6.2831855f * tn) * (float)(b + 1); sb[b] = sinf(ang); cb[b] = cosf(ang); }
        const float* w1p = F.in[9] + (size_t)l * 33 * 64 + part * 16; const float* b1p = F.in[10] + l * 64 + part * 16;
        const float* w2p = F.in[11] + (size_t)l * 64 * 64 + part * 16; const float* b2p = F.in[12] + l * 64 + part * 16;
        for (int dd = 0; dd < 16; ++dd) { float a = b1p[dd] + tn * w1p[dd];
#pragma unroll
            for (int b = 0; b < 16; ++b) a += sb[b] * w1p[(1 + b) * 64 + dd] + cb[b] * w1p[(17 + b) * 64 + dd];
            h1[(part * 16 + dd) * 16 + tl] = sinf(a); }
        LDS_WAIT();
        float* dst = HID + ((size_t)l * 4352 + tt) * 64 + part * 16;
        float acc[16];
#pragma unroll
        for (int ee = 0; ee < 16; ++ee) acc[ee] = b2p[ee];
        for (int d = 0; d < 64; ++d) { const float hv = h1[d * 16 + tl];
#pragma unroll
            for (int ee = 0; ee < 16; ++ee) acc[ee] += hv * w2p[d * 64 + ee]; }
#pragma unroll
        for (int ee = 0; ee < 16; ee += 4) *(f32x4*)(dst + ee) = (f32x4){sinf(acc[ee]), sinf(acc[ee + 1]), sinf(acc[ee + 2]), sinf(acc[ee + 3])};
        LDS_WAIT();
    }
}
__device__ __forceinline__ void pro_filter(Frame& F) {
    const float* HID = WSP(float, WS_HID); float* PART = WSP(float, WS_PART);
    LAS float* red = (LAS float*)F.lds;
    constexpr float dmin = 3.0701134573253945f, dstep = (15.350567286626973f - 3.0701134573253945f) / 511.0f;
    for (int item = F.vcu; item < DEPTH * 9 * 4 * 8; item += F.G) {
        int r = item; const int cg = r & 7; r >>= 3; const int od = r & 3; r >>= 2; const int tc = r % 9; const int l = r / 9;
        const int kind = tc == 8 ? 1 : 0, L = kind ? 256 : 4096, t = (kind ? 0 : tc * 512) + F.tid; const bool valid = t < L;
        const int o = od >> 1, dir = od & 1;
        const float* hp = HID + ((size_t)l * 4352 + (kind ? 4096 : 0) + (valid ? t : 0)) * 64;
        const float tn = (float)t / (float)L;
        const cfloat_c* w3 = (const cfloat_c*)(uintptr_t)(F.in[13] + (size_t)l * 64 * 2048 + o * 1024 + dir * 512 + cg * 64);
        float acc[64];
#pragma unroll
        for (int j = 0; j < 64; ++j) acc[j] = 0.f;
        for (int e4 = 0; e4 < 64; e4 += 4) {
            const f32x4 h4 = *(const f32x4*)(hp + e4);
#pragma unroll
            for (int ee = 0; ee < 4; ++ee) { const cfloat_c* wr = w3 + (size_t)(e4 + ee) * 2048; const float h = h4[ee];
#pragma unroll
                for (int j = 0; j < 64; ++j) acc[j] += h * wr[j]; }
        }
        bf16* gout = kind ? WSP(bf16, WS_GC) + (size_t)l * 512 * 2 * HYLC : WSP(bf16, WS_G) + (size_t)l * 512 * 2 * HYL;
        const int glen = kind ? HYLC : HYL;
        const bool zero0 = (dir == 1 && t == 0); const int idx = zero0 ? 0 : (dir == 0 ? L - t : L + t);
        const float keep = (valid && !zero0) ? 1.0f : 0.0f;
#pragma unroll
        for (int j = 0; j < 64; ++j) { const int c = cg * 64 + j; const float delta = dmin + (float)c * dstep; const float v = acc[j] * __expf(-tn * delta) * keep;
            if (valid) gout[((size_t)c * 2 + o) * glen + idx] = f2bf(v);
            const float a = wave_sum(fabsf(v)); if (F.lane == 0) red[F.wave * 64 + j] = a; }
        __syncthreads();
        if (F.tid < 64) { float s = 0.f;
#pragma unroll
            for (int w = 0; w < 8; ++w) s += red[w * 64 + F.tid];
            PART[((((size_t)l * 2 + kind) * 2 + o) * 2 + dir) * 8 * 512 + (size_t)(kind ? 0 : tc) * 512 + cg * 64 + F.tid] = s; }
        __syncthreads();
    }
}

__device__ __forceinline__ void norm_pass(Frame& F, int mode, int l, bool dry = false) {
    const float* MOD = WSP(float, WS_MOD); float* X = WSP(float, WS_X); bf16* H = dry ? WSP(bf16, WS_UP) : WSP(bf16, WS_H); const bf16* Y = WSP(bf16, WS_MO); float* XO = dry ? WSP(float, WS_ACT) : X;
    const float* ng = F.in[6];
    const int gw = F.vcu * NWAVES + F.wave, NGW = F.G * NWAVES;
    const bool last = (mode == 2 && l == DEPTH - 1);
    for (int r = gw; r < MR; r += NGW) {
        int b, isctx, t; row_info(r, b, isctx, t); const int which = isctx ? 2 : b;
        f32x4 xv[8];
        if (mode == 0) { const float* src = isctx ? F.in[2] + ((size_t)b * CTXL + t) * DM : F.in[0] + ((size_t)b * SEQ + t) * DM;
#pragma unroll
            for (int j = 0; j < 8; ++j) xv[j] = *(const f32x4*)(src + 4 * F.lane + 256 * j);
        } else {
            if (isctx && l == DEPTH - 1) continue;
            const float* src = X + (size_t)r * DM; const bf16* yp = Y + (size_t)r * DM;
            f32x4 yv[8]; float ss = 0.f;
            if (!isctx) {
#pragma unroll
                for (int j = 0; j < 8; ++j) { const v2u w = *(const v2u*)(yp + 4 * F.lane + 256 * j); yv[j] = (f32x4){bf_lo(w.x), bf_hi(w.x), bf_lo(w.y), bf_hi(w.y)}; }
            } else {
                const float* sp_ = WSP(float, WS_SLAB) + (size_t)(b * CTXL + t) * DM; const int ns = (mode == 1) ? 8 : 11;
#pragma unroll
                for (int j = 0; j < 8; ++j) yv[j] = (f32x4){0.f, 0.f, 0.f, 0.f};
                for (int s = 0; s < ns; ++s) {
#pragma unroll
                    for (int j = 0; j < 8; ++j) yv[j] += *(const f32x4*)(sp_ + (size_t)s * (512 * DM) + 4 * F.lane + 256 * j); }
            }
#pragma unroll
            for (int j = 0; j < 8; ++j) { xv[j] = *(const f32x4*)(src + 4 * F.lane + 256 * j);
                ss += (yv[j][0] * yv[j][0] + yv[j][1] * yv[j][1]) + (yv[j][2] * yv[j][2] + yv[j][3] * yv[j][3]); }
            ss = wave_sum(ss); const float rs = 1.0f / sqrtf(ss * (1.0f / DM) + EPS);
            const float* gpost = ng + ((size_t)l * 4 + (mode == 1 ? 1 : 3)) * DM; const float* gate = MOD + ((size_t)l * 3 + which) * (6 * DM) + (mode == 1 ? 2 : 5) * DM;
#pragma unroll
            for (int j = 0; j < 8; ++j) { const f32x4 gp = *(const f32x4*)(gpost + 4 * F.lane + 256 * j), gt = *(const f32x4*)(gate + 4 * F.lane + 256 * j); xv[j] += gt * (yv[j] * rs * gp); }
        }
        if (!last) {
            float* dst = XO + (size_t)r * DM;
#pragma unroll
            for (int j = 0; j < 8; ++j) *(f32x4*)(dst + 4 * F.lane + 256 * j) = xv[j];
        } else { if (!isctx) { float* dst = (dry ? XO : F.out) + ((size_t)b * SEQ + t) * DM;
#pragma unroll
            for (int j = 0; j < 8; ++j) *(f32x4*)(dst + 4 * F.lane + 256 * j) = xv[j]; }
            continue; }
        const int ln = (mode == 2) ? l + 1 : l; const float* gpre = ng + ((size_t)ln * 4 + (mode == 1 ? 2 : 0)) * DM;
        const float* md = MOD + ((size_t)ln * 3 + which) * (6 * DM); const float* sh = md + (mode == 1 ? 3 : 0) * DM; const float* sc = md + (mode == 1 ? 4 : 1) * DM;
        float s2 = 0.f;
#pragma unroll
        for (int j = 0; j < 8; ++j) s2 += (xv[j][0] * xv[j][0] + xv[j][1] * xv[j][1]) + (xv[j][2] * xv[j][2] + xv[j][3] * xv[j][3]);
        s2 = wave_sum(s2); const float rs2 = 1.0f / sqrtf(s2 * (1.0f / DM) + EPS);
        bf16* hp = H + (size_t)r * DM;
#pragma unroll
        for (int j = 0; j < 8; ++j) { const int cidx = 4 * F.lane + 256 * j; const f32x4 gp = *(const f32x4*)(gpre + cidx), s4 = *(const f32x4*)(sc + cidx), h4 = *(const f32x4*)(sh + cidx);
            const f32x4 hv = (xv[j] * rs2 * gp) * (s4 + 1.0f) + h4; v2u w; w.x = cvt_pk_bf16(hv[0], hv[1]); w.y = cvt_pk_bf16(hv[2], hv[3]); *(v2u*)(hp + cidx) = w; }
    }
}

__device__ __forceinline__ bool seg_start(int r) { const int j = r % SEGB; return j == 0 || j == CTXL; }
__device__ __forceinline__ void xr_pad_zero(Frame& F) {
    bf16* XR = WSP(bf16, WS_XR);
    for (int i = F.vcu * NTHR + F.tid; i < 2 * 4 * 12 * 16; i += F.G * NTHR) { const int ch = i & 15, pi = (i >> 4) % 12, bb = (i >> 4) / 12;
        const int prow = pi < 3 ? pi : (pi < 9 ? 256 + pi : 4352 + pi);
        unsigned zz = 0u; asm volatile("" : "+v"(zz));
        const v4u z = {zz, zz, zz, zz}; *(v4u*)(XR + ((size_t)bb * XR_ROWS + prow) * 128 + ch * 8) = z; }
}
struct EpiU {
    static constexpr bool PERM = true;
    bf16* U; bf16* UH; bf16* XR; bf16* KR; const float* ROPE; float* SSQ;
    __device__ __forceinline__ void operator()(const f32x4 (&acc)[2][2][4][2], const pg8::Unit& u, int wr, int wc, int fr, int fq) const {
        asm volatile("" : "+v"(fr), "+v"(fq));
        const int row0 = u.pm * 256 + wr * 64 + fr, pn = u.pn;
        if (pn == 13) {
            if (wc == 0) {
#pragma unroll
                for (int ai = 0; ai < 2; ++ai)
#pragma unroll
                    for (int m = 0; m < 4; ++m) { const int row = row0 + ai * 128 + m * 16; int b, isctx, t; row_info(row, b, isctx, t);
#pragma unroll
                        for (int n = 0; n < 2; ++n) { const int i0 = 8 * fq + 4 * n; const f32x4 x1 = acc[ai][0][m][n], x2 = acc[ai][1][m][n];
                            f32x4 cs = {1.f, 1.f, 1.f, 1.f}, sn = {0.f, 0.f, 0.f, 0.f};
                            if (!isctx) { cs = *(const f32x4*)(ROPE + (size_t)t * 64 + i0); sn = *(const f32x4*)(ROPE + (size_t)t * 64 + 32 + i0); }
                            const f32x4 o1 = x1 * cs - x2 * sn, o2 = x2 * cs + x1 * sn;
                            v2u w1, w2; w1.x = cvt_pk_bf16(o1[0], o1[1]); w1.y = cvt_pk_bf16(o1[2], o1[3]); w2.x = cvt_pk_bf16(o2[0], o2[1]); w2.y = cvt_pk_bf16(o2[2], o2[3]);
                            *(v2u*)(KR + (size_t)row * 64 + i0) = w1; *(v2u*)(KR + (size_t)row * 64 + 32 + i0) = w2; }
                        asm volatile("" ::: "memory"); }
            }
            return;
        }
        if (pn == 10 || pn == 11) {
#pragma unroll
            for (int ai = 0; ai < 2; ++ai)
#pragma unroll
                for (int m = 0; m < 4; ++m) { const int row = row0 + ai * 128 + m * 16; const int b = row >= SEGB ? 1 : 0, j = row - b * SEGB, prow = j < CTXL ? 3 + j : j + 9;
#pragma unroll
                    for (int bj = 0; bj < 2; ++bj) { const int blk = 2 * (pn - 10) + bj; const f32x4 v0 = acc[ai][bj][m][0], v1 = acc[ai][bj][m][1];
                        v4u w; w.x = cvt_pk_bf16(v0[0], v0[1]); w.y = cvt_pk_bf16(v0[2], v0[3]); w.z = cvt_pk_bf16(v1[0], v1[1]); w.w = cvt_pk_bf16(v1[2], v1[3]);
                        *(v4u*)(XR + (((size_t)b * 4 + blk) * XR_ROWS + prow) * 128 + wc * 32 + 8 * fq) = w; } }
            return;
        }
        const bool grp = pn < 6, doq = (pn == 8 || pn == 9), dokv = (pn == 12);
        const int col0 = pn * 256 + wc * 32 + 8 * fq, slot = doq ? (pn - 8) * 4 + wc : 8 + wc;
#pragma unroll
        for (int ai = 0; ai < 2; ++ai)
#pragma unroll
            for (int m = 0; m < 4; ++m) { const int row = row0 + ai * 128 + m * 16; bf16* rowp = grp ? UH + ((size_t)(col0 >> 3) * MR + row) * 8 : U + (size_t)row * DINP + col0;
                const size_t bjstep = grp ? (size_t)16 * MR * 8 : (size_t)128; float ss = 0.f;
#pragma unroll
                for (int bj = 0; bj < 2; ++bj) { const f32x4 v0 = acc[ai][bj][m][0], v1 = acc[ai][bj][m][1];
                    ss += (v0[0] * v0[0] + v0[1] * v0[1]) + (v0[2] * v0[2] + v0[3] * v0[3]) + (v1[0] * v1[0] + v1[1] * v1[1]) + (v1[2] * v1[2] + v1[3] * v1[3]);
                    v4u w; w.x = cvt_pk_bf16(v0[0], v0[1]); w.y = cvt_pk_bf16(v0[2], v0[3]); w.z = cvt_pk_bf16(v1[0], v1[1]); w.w = cvt_pk_bf16(v1[2], v1[3]);
                    *(v4u*)(rowp + bj * bjstep) = w; }
                if (doq || dokv) { ss += __shfl_xor(ss, 16); ss += __shfl_xor(ss, 32); if (fq == 0) SSQ[(size_t)row * 12 + slot] = ss; } }
    }
};
__device__ __forceinline__ void conv_gelu(Frame& F, int l) {
    const bf16* UP = WSP(bf16, WS_UP); bf16* ACT = WSP(bf16, WS_ACT);
    const float* cw = F.in[28] + (size_t)l * 3 * 2 * DFF;
    const int gw = F.vcu * NWAVES + F.wave, NGW = F.G * NWAVES;
    for (int wi = gw; wi < (MR / 8) * 11; wi += NGW) {
        const int rc = wi / 11, fc = wi - rc * 11, r0 = rc * 8, f0 = fc * 512 + 8 * F.lane;
        const bool has_prev = !seg_start(r0), has_next = !seg_start(r0 + 8) && (r0 + 8 < MR);
        v4u g[10], v[10];
#pragma unroll
        for (int i = 0; i < 10; ++i) { const int r = r0 - 1 + i; const bool ok = (i == 0) ? has_prev : (i == 9 ? has_next : true);
            g[i] = (v4u){0u, 0u, 0u, 0u}; v[i] = (v4u){0u, 0u, 0u, 0u};
            if (ok) { g[i] = *(const v4u*)(UP + (size_t)r * (2 * DFF) + f0); v[i] = *(const v4u*)(UP + (size_t)r * (2 * DFF) + DFF + f0); } }
        float wg[3][8], wv[3][8];
#pragma unroll
        for (int j = 0; j < 3; ++j) { const f32x4 a = *(const f32x4*)(cw + (size_t)j * 2 * DFF + f0), b2 = *(const f32x4*)(cw + (size_t)j * 2 * DFF + f0 + 4);
            const f32x4 c2 = *(const f32x4*)(cw + (size_t)j * 2 * DFF + DFF + f0), d2 = *(const f32x4*)(cw + (size_t)j * 2 * DFF + DFF + f0 + 4);
#pragma unroll
            for (int q = 0; q < 4; ++q) { wg[j][q] = a[q]; wg[j][4 + q] = b2[q]; wv[j][q] = c2[q]; wv[j][4 + q] = d2[q]; } }
#pragma unroll
        for (int i = 0; i < 8; ++i) { float o[8];
#pragma unroll
            for (int q = 0; q < 4; ++q) {
                const float ga = wg[0][2 * q] * bf_lo(g[i][q]) + wg[1][2 * q] * bf_lo(g[i + 1][q]) + wg[2][2 * q] * bf_lo(g[i + 2][q]);
                const float gb = wg[0][2 * q + 1] * bf_hi(g[i][q]) + wg[1][2 * q + 1] * bf_hi(g[i + 1][q]) + wg[2][2 * q + 1] * bf_hi(g[i + 2][q]);
                const float va = wv[0][2 * q] * bf_lo(v[i][q]) + wv[1][2 * q] * bf_lo(v[i + 1][q]) + wv[2][2 * q] * bf_lo(v[i + 2][q]);
                const float vb = wv[0][2 * q + 1] * bf_hi(v[i][q]) + wv[1][2 * q + 1] * bf_hi(v[i + 1][q]) + wv[2][2 * q + 1] * bf_hi(v[i + 2][q]);
                o[2 * q] = gelu_tanh(ga) * va; o[2 * q + 1] = gelu_tanh(gb) * vb; }
            v4u w; w.x = cvt_pk_bf16(o[0], o[1]); w.y = cvt_pk_bf16(o[2], o[3]); w.z = cvt_pk_bf16(o[4], o[5]); w.w = cvt_pk_bf16(o[6], o[7]);
            *(v4u*)(ACT + (size_t)(r0 + i) * DFF + f0) = w; }
    }
}

__device__ __forceinline__ void mix_finalize(Frame& F, int l) {
    const bf16* YT = WSP(bf16, WS_YT); const float* YL = WSP(float, WS_YL); const bf16* O = WSP(bf16, WS_O); bf16* YM = WSP(bf16, WS_YMIX);
    const float* hg = F.in[25] + (size_t)l * DMIX;
    const int gw = F.vcu * NWAVES + F.wave, NGW = F.G * NWAVES;
    LAS bf16* st = (LAS bf16*)(F.lds + F.wave * 16384);
    constexpr int NHY = (MR / 32) * 4, NLR = (MR / 64) * 4, NAT = (MR / 64) * 8;
    for (int wi = gw; wi < NHY + NLR + NAT; wi += NGW) {
        if (wi < NHY) {
            const int rt = wi >> 2, hd = wi & 3, r0 = rt * 32, cs = F.lane >> 2, rc = F.lane & 3;
            const bf16* src = YT + (size_t)(hd * 128 + cs) * MR + r0 + 8 * rc;
            v4u v[8]; float ss[8];
#pragma unroll
            for (int k = 0; k < 8; ++k) ss[k] = 0.f;
#pragma unroll
            for (int i = 0; i < 8; ++i) { v[i] = *(const v4u*)(src + (size_t)(16 * i) * MR);
#pragma unroll
                for (int k = 0; k < 4; ++k) { const float a = bf_lo(v[i][k]), b2 = bf_hi(v[i][k]); ss[2 * k] += a * a; ss[2 * k + 1] += b2 * b2; } }
#pragma unroll
            for (int k = 0; k < 8; ++k) { float s = ss[k]; s += __shfl_xor(s, 4); s += __shfl_xor(s, 8); s += __shfl_xor(s, 16); s += __shfl_xor(s, 32); ss[k] = 1.0f / sqrtf(s * (1.0f / 128.0f) + EPS); }
#pragma unroll
            for (int i = 0; i < 8; ++i) { const int c = 16 * i + cs; const float g = hg[hd * 128 + c];
#pragma unroll
                for (int k = 0; k < 4; ++k) { st[(8 * rc + 2 * k) * 130 + c] = f2bf(bf_lo(v[i][k]) * ss[2 * k] * g); st[(8 * rc + 2 * k + 1) * 130 + c] = f2bf(bf_hi(v[i][k]) * ss[2 * k + 1] * g); } }
            LDS_WAIT();
#pragma unroll 8
            for (int row = 0; row < 32; ++row) { const unsigned w = *(const LAS unsigned*)(st + row * 130 + 2 * F.lane);
                *(unsigned*)(YM + (size_t)(r0 + row) * DMIX + hd * 128 + 2 * F.lane) = w; }
            LDS_WAIT();
        } else if (wi < NHY + NLR) {
            const int w2 = wi - NHY, rt = w2 >> 2, hd = w2 & 3, r0 = rt * 64, q = F.lane & 3;
            for (int ps = 0; ps < 4; ++ps) { const int row = r0 + ps * 16 + (F.lane >> 2);
                const float* src = YL + (size_t)row * LRUC + hd * 128 + q * 32; f32x4 v[8]; float ss = 0.f;
#pragma unroll
                for (int j = 0; j < 8; ++j) { v[j] = *(const f32x4*)(src + 4 * j); ss += (v[j][0] * v[j][0] + v[j][1] * v[j][1]) + (v[j][2] * v[j][2] + v[j][3] * v[j][3]); }
                ss += __shfl_xor(ss, 1); ss += __shfl_xor(ss, 2); const float rs = 1.0f / sqrtf(ss * (1.0f / 128.0f) + EPS);
                const float* g = hg + (4 + hd) * 128 + q * 32; bf16* dst = YM + (size_t)row * DMIX + (4 + hd) * 128 + q * 32;
#pragma unroll
                for (int j = 0; j < 4; ++j) { const f32x4 g0 = *(const f32x4*)(g + 8 * j), g1 = *(const f32x4*)(g + 8 * j + 4); const f32x4 a = v[2 * j] * rs * g0, b2 = v[2 * j + 1] * rs * g1;
                    v4u w; w.x = cvt_pk_bf16(a[0], a[1]); w.y = cvt_pk_bf16(a[2], a[3]); w.z = cvt_pk_bf16(b2[0], b2[1]); w.w = cvt_pk_bf16(b2[2], b2[3]); *(v4u*)(dst + 8 * j) = w; } }
        } else {
            const int w2 = wi - NHY - NLR, rt = w2 >> 3, hd = w2 & 7, r0 = rt * 64, q = F.lane & 3;
            for (int ps = 0; ps < 4; ++ps) { const int row = r0 + ps * 16 + (F.lane >> 2);
                const bf16* src = O + (size_t)row * (NH * VD) + hd * 128 + q * 32; v4u v[4]; float ss = 0.f;
#pragma unroll
                for (int j = 0; j < 4; ++j) { v[j] = *(const v4u*)(src + 8 * j);
#pragma unroll
                    for (int k = 0; k < 4; ++k) { const float a = bf_lo(v[j][k]), b2 = bf_hi(v[j][k]); ss += a * a + b2 * b2; } }
                ss += __shfl_xor(ss, 1); ss += __shfl_xor(ss, 2); const float rs = 1.0f / sqrtf(ss * (1.0f / 128.0f) + EPS);
                const float* g = hg + (8 + hd) * 128 + q * 32; bf16* dst = YM + (size_t)row * DMIX + (8 + hd) * 128 + q * 32;
#pragma unroll
                for (int j = 0; j < 4; ++j) { const f32x4 g0 = *(const f32x4*)(g + 8 * j), g1 = *(const f32x4*)(g + 8 * j + 4);
                    v4u w; w.x = cvt_pk_bf16(bf_lo(v[j][0]) * rs * g0[0], bf_hi(v[j][0]) * rs * g0[1]); w.y = cvt_pk_bf16(bf_lo(v[j][1]) * rs * g0[2], bf_hi(v[j][1]) * rs * g0[3]);
                    w.z = cvt_pk_bf16(bf_lo(v[j][2]) * rs * g1[0], bf_hi(v[j][2]) * rs * g1[1]); w.w = cvt_pk_bf16(bf_lo(v[j][3]) * rs * g1[2], bf_hi(v[j][3]) * rs * g1[3]); *(v4u*)(dst + 8 * j) = w; } }
        }
    }
}

namespace att {
constexpr int NW = 8, QBLK = 32, KVBLK = 64;
constexpr float SCALE = 0.07216878364870323f;
constexpr float THR = 8.f;
constexpr int LDQ = DQ, LDK = DKV, LDR = ROPED, LDO = NH * VD;
constexpr int SHM_V = KVBLK * 128 * 2, SHM_K = KVBLK * 128 * 2, SHM_R = KVBLK * 64 * 2;
constexpr int OFF_V = 0, OFF_K = 2 * SHM_V, OFF_R = OFF_K + 2 * SHM_K, OFF_WS = OFF_R + 2 * SHM_R, OFF_QR = OFF_WS + NW * 64 * 4, SHM_ATTN = OFF_QR + NW * 4096;
#define KSWZ(row, colB) ((row) * 256 + ((colB) ^ (((row) & 7) << 4)))
#define RSWZ(row, colB) ((row) * 128 + ((colB) ^ (((row) & 7) << 4)))
#define SBAR() __builtin_amdgcn_sched_barrier(0)
__device__ __forceinline__ int crow(int r, int hi) { return (r & 3) + 8 * (r >> 2) + 4 * hi; }
__device__ __forceinline__ void partialSM(f32x16& p0, f32x16& p1, float& m_reg, float& mn, float& alpha) {
  constexpr float C = SCALE * 1.4426950408889634f;
  float pmax = p0[0]; for (int r = 1; r < 16; ++r) pmax = fmaxf(pmax, p0[r]); for (int r = 0; r < 16; ++r) pmax = fmaxf(pmax, p1[r]);
  { auto rr = __builtin_amdgcn_permlane32_swap(__float_as_uint(pmax), __float_as_uint(pmax), false, false);
    pmax = fmaxf(__uint_as_float(rr[0]), __uint_as_float(rr[1])); }
  if (__builtin_expect(__all(pmax - m_reg <= THR / SCALE), 1)) { mn = m_reg; alpha = 1.f; }
  else { mn = fmaxf(m_reg, pmax); alpha = __builtin_amdgcn_exp2f((m_reg - mn) * C); m_reg = mn; }
  float mnC = -mn * C;
  for (int r = 0; r < 16; ++r) p0[r] = fmaf(p0[r], C, mnC); for (int r = 0; r < 16; ++r) p1[r] = fmaf(p1[r], C, mnC);
  for (int r = 0; r < 16; ++r) p0[r] = __builtin_amdgcn_exp2f(p0[r]);
}
__device__ __forceinline__ void finishSM(f32x16& p0, f32x16& p1, float alpha, float& l_reg, bf16x8& pa0, bf16x8& pa1, bf16x8& pa2, bf16x8& pa3) {
  for (int r = 0; r < 16; ++r) p1[r] = __builtin_amdgcn_exp2f(p1[r]);
  float ps = 0; for (int r = 0; r < 16; ++r) ps += p0[r]; for (int r = 0; r < 16; ++r) ps += p1[r];
  { auto rr = __builtin_amdgcn_permlane32_swap(__float_as_uint(ps), __float_as_uint(ps), false, false);
    ps = __uint_as_float(rr[0]) + __uint_as_float(rr[1]); }
  l_reg = l_reg * alpha + ps;
#define PK4(P, BASE, OUT) do { unsigned a0 = cvt_pk_bf16(P[BASE + 0], P[BASE + 1]), a1 = cvt_pk_bf16(P[BASE + 2], P[BASE + 3]);   \
    unsigned b0 = cvt_pk_bf16(P[BASE + 4], P[BASE + 5]), b1 = cvt_pk_bf16(P[BASE + 6], P[BASE + 7]);                              \
    auto r0 = __builtin_amdgcn_permlane32_swap(a0, b0, false, false); auto r1 = __builtin_amdgcn_permlane32_swap(a1, b1, false, false); \
    v4u w = {r0[0], r1[0], r0[1], r1[1]}; OUT = *reinterpret_cast<bf16x8*>(&w); } while (0)
  PK4(p0, 0, pa0); PK4(p0, 8, pa1); PK4(p1, 0, pa2); PK4(p1, 8, pa3);
#undef PK4
}
__device__ __forceinline__ void qkt(f32x16& p0, f32x16& p1, const LAS char* Ks, const LAS char* Rs, const bf16x8* qr, const LAS char* qrl, int r32, int hi) {
  p0 = f32x16{}; p1 = f32x16{};
#pragma unroll
  for (int d0 = 0; d0 < 8; ++d0) { const int cb = (d0 * 16 + hi * 8) * 2;
    bf16x8 b0 = *(const LAS bf16x8*)(Ks + KSWZ(r32, cb));
    bf16x8 b1 = *(const LAS bf16x8*)(Ks + KSWZ(32 + r32, cb));
    p0 = __builtin_amdgcn_mfma_f32_32x32x16_bf16(b0, qr[d0], p0, 0, 0, 0);
    p1 = __builtin_amdgcn_mfma_f32_32x32x16_bf16(b1, qr[d0], p1, 0, 0, 0); }
#pragma unroll
  for (int d0 = 0; d0 < 4; ++d0) { const int cb = (d0 * 16 + hi * 8) * 2;
    bf16x8 b0 = *(const LAS bf16x8*)(Rs + RSWZ(r32, cb));
    bf16x8 b1 = *(const LAS bf16x8*)(Rs + RSWZ(32 + r32, cb));
    const bf16x8 qf = *(const LAS bf16x8*)(qrl + d0 * 1024);
    p0 = __builtin_amdgcn_mfma_f32_32x32x16_bf16(b0, qf, p0, 0, 0, 0);
    p1 = __builtin_amdgcn_mfma_f32_32x32x16_bf16(b1, qf, p1, 0, 0, 0); }
}
__device__ __forceinline__ int v_st(int k, int c) { const int kk = (k & ~0xC) | ((k & 4) << 1) | ((k & 8) >> 1); return ((kk >> 3) * 4 + (c >> 5)) * 512 + ((kk & 7) * 32 + (c & 31)) * 2; }
__device__ __forceinline__ int v_rd_base(int lane) { return ((lane & 3) << 3) | (((lane >> 2) & 3) << 6) | (((lane >> 4) & 1) << 5) | (((lane >> 5) & 1) << 8); }
constexpr int v_rd_off(int d0, int ks, int half) { return d0 * 512 + ks * 4096 + half * 2048; }
template <int OFF> __device__ __forceinline__ s16x4 tr_read(int vb) {
  s16x4 r; asm volatile("ds_read_b64_tr_b16 %0, %1 offset:%2" : "=&v"(r) : "v"(vb), "i"(OFF) : "memory"); return r;
}
template <int D0> __device__ __forceinline__ void pv_one(f32x16& od, int vb, bf16x8 pa0, bf16x8 pa1, bf16x8 pa2, bf16x8 pa3) {
  const s16x4 l0 = tr_read<v_rd_off(D0, 0, 0)>(vb), h0 = tr_read<v_rd_off(D0, 0, 1)>(vb), l1 = tr_read<v_rd_off(D0, 1, 0)>(vb), h1 = tr_read<v_rd_off(D0, 1, 1)>(vb);
  const s16x4 l2 = tr_read<v_rd_off(D0, 2, 0)>(vb), h2 = tr_read<v_rd_off(D0, 2, 1)>(vb), l3 = tr_read<v_rd_off(D0, 3, 0)>(vb), h3 = tr_read<v_rd_off(D0, 3, 1)>(vb);
  asm volatile("s_waitcnt lgkmcnt(0)" ::: "memory"); SBAR();
#define PK(L, H) (bf16x8){L[0], L[1], L[2], L[3], H[0], H[1], H[2], H[3]}
  od = __builtin_amdgcn_mfma_f32_32x32x16_bf16(pa0, PK(l0, h0), od, 0, 0, 0);
  od = __builtin_amdgcn_mfma_f32_32x32x16_bf16(pa1, PK(l1, h1), od, 0, 0, 0);
  od = __builtin_amdgcn_mfma_f32_32x32x16_bf16(pa2, PK(l2, h2), od, 0, 0, 0);
  od = __builtin_amdgcn_mfma_f32_32x32x16_bf16(pa3, PK(l3, h3), od, 0, 0, 0);
#undef PK
}
__device__ __forceinline__ void pv_d0(f32x16* o, int vb, bf16x8 pa0, bf16x8 pa1, bf16x8 pa2, bf16x8 pa3) {
  pv_one<0>(o[0], vb, pa0, pa1, pa2, pa3); pv_one<1>(o[1], vb, pa0, pa1, pa2, pa3); pv_one<2>(o[2], vb, pa0, pa1, pa2, pa3); pv_one<3>(o[3], vb, pa0, pa1, pa2, pa3);
}
__device__ __forceinline__ void attn_body(const bf16* __restrict__ Qb, const bf16* __restrict__ Kh, const bf16* __restrict__ Vh, const bf16* __restrict__ Rh,
                                          bf16* __restrict__ Ob, int seq, const float* rope_tab, LAS char* lds) {
  int tid = threadIdx.x; asm volatile("" : "+v"(tid));
  const int wid = __builtin_amdgcn_readfirstlane(tid >> 6), lane = tid & 63, r32 = lane & 31, hi = lane >> 5;
  LAS char* V_lds = lds + OFF_V; LAS char* K_lds = lds + OFF_K; LAS char* R_lds = lds + OFF_R;
  LAS float* ws = (LAS float*)(lds + OFF_WS) + wid * 64; LAS float* li_l = ws; LAS float* al_l = ws + 32;
  float m_reg = -1e30f, l_reg = 0; f32x16 o[4] = {}; bf16x8 qr[12];
  LAS char* qrl = lds + OFF_QR + wid * 4096 + lane * 16;
  const bf16* Qw = Qb + (long)(wid * QBLK + r32) * LDQ + hi * 8;
#pragma unroll
  for (int d0 = 0; d0 < 12; ++d0) qr[d0] = *reinterpret_cast<const bf16x8*>(Qw + d0 * 16);
  if (rope_tab) {
    const float* rt = rope_tab + (long)(wid * QBLK + r32) * 64;
#pragma unroll
    for (int p = 0; p < 2; ++p) {
      const float* cs = rt + p * 16 + hi * 8; const f32x4 c0 = *(const f32x4*)cs, c1 = *(const f32x4*)(cs + 4), s0 = *(const f32x4*)(cs + 32), s1 = *(const f32x4*)(cs + 36);
      const v4u x1 = *reinterpret_cast<v4u*>(&qr[8 + p]), x2 = *reinterpret_cast<v4u*>(&qr[10 + p]); v4u y1, y2;
#pragma unroll
      for (int k = 0; k < 4; ++k) { const float ca = k < 2 ? c0[2 * k] : c1[2 * k - 4], cbv = k < 2 ? c0[2 * k + 1] : c1[2 * k - 3], sa = k < 2 ? s0[2 * k] : s1[2 * k - 4], sb = k < 2 ? s0[2 * k + 1] : s1[2 * k - 3];
        const float a1 = bf_lo(x1[k]), b1 = bf_hi(x1[k]), a2 = bf_lo(x2[k]), b2 = bf_hi(x2[k]);
        y1[k] = cvt_pk_bf16(a1 * ca - a2 * sa, b1 * cbv - b2 * sb); y2[k] = cvt_pk_bf16(a2 * ca + a1 * sa, b2 * cbv + b1 * sb); }
      qr[8 + p] = *reinterpret_cast<bf16x8*>(&y1); qr[10 + p] = *reinterpret_cast<bf16x8*>(&y2); }
  }
#pragma unroll
  for (int d0 = 0; d0 < 4; ++d0) *(LAS bf16x8*)(qrl + d0 * 1024) = qr[8 + d0];
  const int sr = tid >> 4, sc = (tid & 15) * 8, vst0 = v_st(sr, sc), vst1 = v_st(32 + sr, sc);
  const int rr_ = tid >> 3, rc_ = (tid & 7) * 8;
  const int vb0 = (int)(uintptr_t)V_lds + v_rd_base(lane);
  constexpr int SDEPTH = 1;
  struct { bf16x8 vs0, vs1, ks0, ks1, rs; } sr_[SDEPTH];
  const unsigned offk0 = (unsigned)(sr * LDK + sc), offk1 = (unsigned)((32 + sr) * LDK + sc), offr = (unsigned)(rr_ * LDR + rc_);
#define SLOAD(i, k0) do { const bf16* vt_ = Vh + (size_t)(k0) * LDK; const bf16* kt_ = Kh + (size_t)(k0) * LDK; const bf16* rt_ = Rh + (size_t)(k0) * LDR; \
    sr_[i].vs0 = *(const bf16x8*)(vt_ + offk0); sr_[i].vs1 = *(const bf16x8*)(vt_ + offk1); \
    sr_[i].ks0 = *(const bf16x8*)(kt_ + offk0); sr_[i].ks1 = *(const bf16x8*)(kt_ + offk1); \
    sr_[i].rs = *(const bf16x8*)(rt_ + offr); } while (0)
#define SWRITE(b, i) do { *(LAS bf16x8*)(V_lds + (b) * SHM_V + vst0) = sr_[i].vs0;          \
    *(LAS bf16x8*)(V_lds + (b) * SHM_V + vst1) = sr_[i].vs1; int kc = sc * 2;               \
    *(LAS bf16x8*)(K_lds + (b) * SHM_K + KSWZ(sr, kc)) = sr_[i].ks0;                       \
    *(LAS bf16x8*)(K_lds + (b) * SHM_K + KSWZ(32 + sr, kc)) = sr_[i].ks1;                  \
    *(LAS bf16x8*)(R_lds + (b) * SHM_R + RSWZ(rr_, rc_ * 2)) = sr_[i].rs; } while (0)
#define SWAIT() do { if constexpr (SDEPTH == 2) asm volatile("s_waitcnt vmcnt(5)" ::: "memory"); else asm volatile("s_waitcnt vmcnt(0)" ::: "memory"); } while (0)
#define RESC(a) do { if (__any((a) < 1.f)) { if (hi == 0) al_l[r32] = (a); asm volatile("s_waitcnt lgkmcnt(0)" ::: "memory"); \
    for (int d = 0; d < 4; ++d) for (int r = 0; r < 16; ++r) o[d][r] *= al_l[crow(r, hi)]; } } while (0)
  f32x16 pA0, pA1, pB0, pB1; float mnA, mnB, alA, alB; bf16x8 pa0, pa1, pa2, pa3; const int NT = seq / KVBLK;
  constexpr int SE = 0, SO = SDEPTH - 1;
  SLOAD(SE, 0); asm volatile("s_waitcnt vmcnt(0)" ::: "memory"); SWRITE(0, SE); __syncthreads();
  qkt(pA0, pA1, K_lds, R_lds, qr, qrl, r32, hi); partialSM(pA0, pA1, m_reg, mnA, alA);
  SLOAD(SO, KVBLK); if constexpr (SDEPTH == 2) { if (2 < NT) SLOAD(SE, 2 * KVBLK); }
  SWAIT(); SWRITE(1, SO); __syncthreads();
  for (int j = 1; j + 1 < NT; j += 2) {
    SBAR(); qkt(pB0, pB1, K_lds + SHM_K, R_lds + SHM_R, qr, qrl, r32, hi);
    finishSM(pA0, pA1, alA, l_reg, pa0, pa1, pa2, pa3); SBAR();
    SLOAD(SO, (j + SDEPTH) * KVBLK); SBAR();
    pv_d0(o, vb0, pa0, pa1, pa2, pa3); partialSM(pB0, pB1, m_reg, mnB, alB);
    __syncthreads(); SWAIT(); SWRITE(0, SE);
    RESC(alB); __syncthreads();
    SBAR(); qkt(pA0, pA1, K_lds, R_lds, qr, qrl, r32, hi);
    finishSM(pB0, pB1, alB, l_reg, pa0, pa1, pa2, pa3); SBAR();
    if (SDEPTH == 1 || j + 3 < NT) SLOAD(SE, (j + 1 + SDEPTH) * KVBLK); SBAR();
    pv_d0(o, vb0 + SHM_V, pa0, pa1, pa2, pa3); partialSM(pA0, pA1, m_reg, mnA, alA);
    __syncthreads(); SWAIT(); SWRITE(1, SO);
    RESC(alA); __syncthreads();
  }
  SBAR(); qkt(pB0, pB1, K_lds + SHM_K, R_lds + SHM_R, qr, qrl, r32, hi);
  finishSM(pA0, pA1, alA, l_reg, pa0, pa1, pa2, pa3); SBAR();
  pv_d0(o, vb0, pa0, pa1, pa2, pa3); partialSM(pB0, pB1, m_reg, mnB, alB);
  __syncthreads(); RESC(alB);
  finishSM(pB0, pB1, alB, l_reg, pa0, pa1, pa2, pa3); SBAR();
  pv_d0(o, vb0 + SHM_V, pa0, pa1, pa2, pa3);
  if (hi == 0) li_l[r32] = l_reg; asm volatile("s_waitcnt lgkmcnt(0)" ::: "memory");
  float rli[16];
#pragma unroll
  for (int r = 0; r < 16; ++r) rli[r] = __builtin_amdgcn_rcpf(li_l[crow(r, hi)]);
  bf16* Ow = Ob + (long)(wid * QBLK) * LDO;
#pragma unroll
  for (int r = 0; r < 16; ++r) { const int orow = crow(r, hi);
#pragma unroll
    for (int d0 = 0; d0 < 4; ++d0) Ow[(long)orow * LDO + d0 * 32 + r32] = f2bf(o[d0][r] * rli[r]); }
  __syncthreads();
#undef SLOAD
#undef SWRITE
#undef SWAIT
#undef RESC
}
}

__device__ __forceinline__ void attn_phase(Frame& F, bool need_ctx) {
    const bf16* Q = WSP(bf16, WS_Q); const bf16* KV = WSP(bf16, WS_KV); const bf16* KR = WSP(bf16, WS_KR); bf16* O = WSP(bf16, WS_O); const float* ROPE = WSP(float, WS_ROPE);
    const int nunits = 256 + (need_ctx ? 16 : 0);
    for (int u = F.vcu; u < nunits; u += F.G) {
        if (u < 256) { const int b = u >> 7, h = (u >> 4) & 7, qb = u & 15; const size_t kb = (size_t)b * SEGB, row0 = kb + CTXL + qb * 256;
            att::attn_body(Q + row0 * DQ + h * 192, KV + kb * DKV + h * 256, KV + kb * DKV + h * 256 + 128, KR + kb * ROPED, O + row0 * (NH * VD) + h * 128, SEGB, ROPE + (size_t)qb * 256 * 64, (LAS char*)F.lds);
        } else { const int b = (u - 256) >> 3, h = (u - 256) & 7; const size_t kb = (size_t)b * SEGB;
            att::attn_body(Q + kb * DQ + h * 192, KV + kb * DKV + h * 256, KV + kb * DKV + h * 256 + 128, KR + kb * ROPED, O + kb * (NH * VD) + h * 128, CTXL, nullptr, (LAS char*)F.lds);
        }
    }
}

struct LruAB {
    static constexpr bool VARK = false;
    const bf16* XR; const bf16* Bt; int lda, ldb;
    __device__ __forceinline__ static int prow0(int pm) { const int jt = pm % 17; return jt == 0 ? 3 : 265 + (jt - 1) * 256; }
    __device__ __forceinline__ const char* a_base(const pg8::Unit& u) const { const int b = u.pm / 17, dir = u.pn >> 2, blk = u.pn & 3;
        return (const char*)(XR + (((size_t)b * 4 + blk) * XR_ROWS + prow0(u.pm) - (dir ? 0 : 3)) * 128); }
    __device__ __forceinline__ const char* b_base(const pg8::Unit& u) const { return (const char*)(Bt + (size_t)u.pn * 256 * 512); }
};
struct EpiGate {
    static constexpr bool PERM = true;
    const bf16* XR; unsigned* AB; const float* ba; const float* bx; const float* sp; const float* cw;
    __device__ __forceinline__ void operator()(const f32x4 (&acc)[2][2][4][2], const pg8::Unit& u, int wr, int wc, int fr, int fq) const {
        asm volatile("" : "+v"(fr), "+v"(fq));
        const int dir = u.pn >> 2, blk = u.pn & 3, b = u.pm / 17, p0 = LruAB::prow0(u.pm);
        const bf16* xb = XR + ((size_t)b * 4 + blk) * XR_ROWS * 128;
        unsigned* abb = AB + (size_t)dir * MR * LRUC;
#pragma unroll 1
        for (int n = 0; n < 2; ++n) { const int cl = wc * 32 + 8 * fq + 4 * n, ch = blk * 128 + cl;
            const f32x4 ba4 = *(const f32x4*)(ba + dir * LRUC + ch), bx4 = *(const f32x4*)(bx + dir * LRUC + ch), sp4 = *(const f32x4*)(sp + dir * LRUC + ch) * -8.0f;
            f32x4 cw4[4];
#pragma unroll
            for (int j = 0; j < 4; ++j) cw4[j] = *(const f32x4*)(cw + ((size_t)dir * 4 + j) * LRUC + ch);
#pragma unroll
            for (int ai = 0; ai < 2; ++ai)
#pragma unroll
                for (int m = 0; m < 4; ++m) { const int rl = ai * 128 + wr * 64 + m * 16 + fr, row = u.pm * 256 + rl, pr = p0 + rl + (dir ? 0 : -3);
                    f32x4 xc = {0.f, 0.f, 0.f, 0.f};
#pragma unroll
                    for (int j = 0; j < 4; ++j) { const v2u w = *(const v2u*)(xb + (unsigned)((pr + j) * 128 + cl)); xc[0] += cw4[j][0] * bf_lo(w.x); xc[1] += cw4[j][1] * bf_hi(w.x); xc[2] += cw4[j][2] * bf_lo(w.y); xc[3] += cw4[j][3] * bf_hi(w.y); }
                    const f32x4 rp = (n == 0 ? acc[ai][0][m][0] : acc[ai][0][m][1]) + ba4, ip = (n == 0 ? acc[ai][1][m][0] : acc[ai][1][m][1]) + bx4;
                    v4u o;
#pragma unroll
                    for (int j = 0; j < 4; ++j) { const float rg = sigmoidf_(rp[j]), ig = sigmoidf_(ip[j]); const float la = rg * sp4[j];
                        const float x = 2.0f * la;
                        const float ser = -x * (1.0f + x * (0.5f + x * (0.16666667f + x * (0.041666668f + x * (0.008333334f + x * 0.0013888889f)))));
                        const float om = (x > -0.25f) ? ser : (1.0f - __expf(x));
                        const float bb = sqrtf(om) * (ig * xc[j]); o[j] = cvt_pk_bf16(la, bb); }
                    *(v4u*)(abb + (unsigned)(row * LRUC + ch)) = o;
                    asm volatile("" ::: "memory"); }
        }
    }
};
__device__ __forceinline__ void lru_pass1(Frame& F) {
    const unsigned* AB = WSP(unsigned, WS_AB); f32x2* CARRY = WSP(f32x2, WS_CARRY);
    const int gw = ((F.vcu + F.G - 80 % F.G) % F.G) * NWAVES + F.wave, NGW = F.G * NWAVES;
    for (int wi = gw; wi < 2 * NCHUNK * 8; wi += NGW) {
        const int chg = wi & 7, cg = (wi >> 3) % NCHUNK, dir = wi / (8 * NCHUNK), ch = chg * 64 + F.lane;
        const unsigned* base = AB + ((size_t)dir * MR + cg * 64) * LRUC + ch;
        float h = 0.f, S = 0.f;
#pragma unroll 16
        for (int i = 0; i < 64; ++i) { const int rr = dir ? 63 - i : i; const unsigned w = base[(size_t)rr * LRUC]; const float la = bf_lo(w); h = __expf(la) * h + bf_hi(w); S += la; }
        CARRY[((size_t)dir * NCHUNK + cg) * LRUC + ch] = (f32x2){__expf(S), h};
    }
}
__device__ __forceinline__ void lru_pass2(Frame& F) {
    const unsigned* AB = WSP(unsigned, WS_AB); const f32x2* CARRY = WSP(f32x2, WS_CARRY); const bf16* U = WSP(bf16, WS_U); float* YL = WSP(float, WS_YL);
    const int gw = F.vcu * NWAVES + F.wave, NGW = F.G * NWAVES;
    for (int wi = gw; wi < NCHUNK * 8; wi += NGW) {
        const int chg = wi & 7, cg = wi >> 3, b = cg / 68, jc = cg - b * 68, ch = chg * 64 + F.lane;
        float hf = 0.f, hb = 0.f;
        const f32x2* cf = CARRY + ((size_t)0 * NCHUNK + b * 68) * LRUC + ch; const f32x2* cbk = CARRY + ((size_t)1 * NCHUNK + b * 68) * LRUC + ch;
        for (int k = 0; k < jc; ++k) { const f32x2 c = cf[(size_t)k * LRUC]; hf = c.x * hf + c.y; }
        if (jc < 4) { for (int k = 3; k > jc; --k) { const f32x2 c = cbk[(size_t)k * LRUC]; hb = c.x * hb + c.y; } }
        else { for (int k = 3; k >= 0; --k) { const f32x2 c = cbk[(size_t)k * LRUC]; hb = c.x * hb + c.y; }
               for (int k = 67; k > jc; --k) { const f32x2 c = cbk[(size_t)k * LRUC]; hb = c.x * hb + c.y; } }
        float hfv[64];
        const unsigned* bf_ = AB + ((size_t)0 * MR + cg * 64) * LRUC + ch; const unsigned* bb_ = AB + ((size_t)1 * MR + cg * 64) * LRUC + ch;
#pragma unroll
        for (int i = 0; i < 64; ++i) { const unsigned w = bf_[(size_t)i * LRUC]; hf = __expf(bf_lo(w)) * hf + bf_hi(w); hfv[i] = hf; }
#pragma unroll
        for (int i = 63; i >= 0; --i) { const unsigned w = bb_[(size_t)i * LRUC]; hb = __expf(bf_lo(w)) * hb + bf_hi(w); const size_t row = (size_t)cg * 64 + i;
            const float g = bf2f(U[row * DINP + OFF_LRU_G + ch]); YL[row * LRUC + ch] = gelu_tanh(g) * (hfv[i] + hb); }
    }
}

template <int NBLK, int NCH, int WPC>
__device__ __forceinline__ void hyena_item(Frame& F, int l, int item) {
    constexpr int L = 128 * NBLK, GLEN = 2 * L, ZB = NBLK * 136 + 64, ZSZ = 2 * ZB;
    constexpr int CH_BYTES = (GLEN + 2 * ZSZ) * 2 + 64;
    static_assert(CH_BYTES % 16 == 0 && NCH * CH_BYTES <= RING_BYTES && NCH * WPC == NWAVES && (NCH == 2 || NCH == 8), "hyena LDS map");
    constexpr int TT = WPC * 64;
#define HY_G(s)  ((LAS bf16*)(F.lds + (s) * CH_BYTES))
#define HY_ZA(s) (HY_G(s) + GLEN)
#define HY_ZB_(s) (HY_G(s) + GLEN + ZSZ)
#define HY_ZO(t) ((((t) >> 7) * 136) + ((t) & 127))
    const int cs = F.wave / WPC, q = F.wave % WPC, c0 = item * NCH, c = c0 + cs, tl = F.tid % TT;
    LAS bf16* Gs = HY_G(cs); LAS bf16* Zc = HY_ZA(cs); LAS bf16* Zn = HY_ZB_(cs); LAS bf16* zero = Zn + ZSZ;
    const bf16* UH = WSP(bf16, WS_PT); bf16* YT = WSP(bf16, WS_YT);
    const bf16* Gg = (NBLK == 32) ? WSP(bf16, WS_G) + ((size_t)l * 512 + c) * 2 * HYL : WSP(bf16, WS_GC) + ((size_t)l * 512 + c) * 2 * HYLC;
    const int rb0 = (NBLK == 32) ? CTXL : 0;
    const float* cwp = F.in[8] + (size_t)l * 3 * 1536;
    const int sub = (c0 & 7) >> 1;
    for (int i = F.tid; i < 2 * L; i += NTHR) { const int b = i / L, t = i - b * L; const v4u w = *(const v4u*)(UH + ((size_t)(c0 >> 3) * MR + b * SEGB + rb0 + t) * 8); const int zo = b * ZB + HY_ZO(t);
        if constexpr (NCH == 2) { const unsigned ww = w[sub]; HY_ZB_(0)[zo] = (bf16)(ww & 0xffffu); HY_ZB_(1)[zo] = (bf16)(ww >> 16); }
        else {
#pragma unroll
            for (int s = 0; s < 8; ++s) HY_ZB_(s)[zo] = (bf16)((s & 1) ? (w[s >> 1] >> 16) : (w[s >> 1] & 0xffffu)); } }
    if (tl < 16) ((LAS unsigned*)zero)[tl] = 0u;
    __syncthreads();
    for (int i = F.tid; i < NCH * 2 * L / 8; i += NTHR) { const int s = i / (2 * L / 8), rem = i - s * (2 * L / 8), b = rem / (L / 8), t0 = (rem - b * (L / 8)) * 8;
        const LAS bf16* zr = HY_ZB_(s) + b * ZB; const float w0 = cwp[c0 + s], w1 = cwp[1536 + c0 + s], w2 = cwp[2 * 1536 + c0 + s];
        const v4u xw = *(const LAS v4u*)(zr + HY_ZO(t0)); float x[10];
        x[0] = t0 > 0 ? bf2f(zr[HY_ZO(t0 - 1)]) : 0.f; x[9] = (t0 + 8 < L) ? bf2f(zr[HY_ZO(t0 + 8)]) : 0.f;
#pragma unroll
        for (int k = 0; k < 4; ++k) { x[1 + 2 * k] = bf_lo(xw[k]); x[2 + 2 * k] = bf_hi(xw[k]); }
        v4u ow;
#pragma unroll
        for (int k = 0; k < 4; ++k) ow[k] = cvt_pk_bf16(w0 * x[2 * k] + w1 * x[2 * k + 1] + w2 * x[2 * k + 2], w0 * x[2 * k + 1] + w1 * x[2 * k + 2] + w2 * x[2 * k + 3]);
        *(LAS v4u*)(HY_ZA(s) + b * ZB + HY_ZO(t0)) = ow; }
    const int i16 = F.lane & 15, h4 = F.lane >> 4, nb = i16 >> 3, a = 8 * q + (i16 & 7);
    const int mlo = (8 * q - (NBLK - 1)) > -(NBLK - 1) ? (8 * q - (NBLK - 1)) : -(NBLK - 1), mhi = (8 * q + 7) < (NBLK - 1) ? (8 * q + 7) : (NBLK - 1);
    const float* hb = F.in[14] + (size_t)l * 2 * HYC;
    for (int o = 0; o < 2; ++o) {
        for (int i = tl; i < GLEN / 8; i += TT) *(LAS v4u*)(Gs + 8 * i) = *(const v4u*)(Gg + (size_t)o * GLEN + 8 * i);
        __syncthreads();
        f32x4 acc[8];
#pragma unroll
        for (int r = 0; r < 8; ++r) acc[r] = (f32x4){0.f, 0.f, 0.f, 0.f};
        for (int m = mlo; m <= mhi; ++m) {
            const int blk_in = a - m; const bool valid = (a < NBLK) && blk_in >= 0 && blk_in < NBLK;
            const LAS bf16* zp = valid ? (Zc + nb * ZB + blk_in * 136 + 8 * h4) : zero;
            const int zk = valid ? 1 : 0;
            const LAS bf16* gp = Gs + (L - 128 * m + 8 * (h4 - i16));
#pragma unroll
            for (int k0 = 0; k0 < 128; k0 += 32) {
                const bf16x8 zf = *(const LAS bf16x8*)(zp + zk * k0);
                const v4u lo = *(const LAS v4u*)(gp + k0 - 8), hi = *(const LAS v4u*)(gp + k0);
                const unsigned c0_ = lo.x, c1 = lo.y, c2 = lo.z, c3 = lo.w, c4 = hi.x, c5 = hi.y, c6 = hi.z, c7 = hi.w;
                const unsigned s0 = __builtin_amdgcn_alignbit(c1, c0_, 16), s1 = __builtin_amdgcn_alignbit(c2, c1, 16), s2 = __builtin_amdgcn_alignbit(c3, c2, 16), s3 = __builtin_amdgcn_alignbit(c4, c3, 16),
                               s4 = __builtin_amdgcn_alignbit(c5, c4, 16), s5 = __builtin_amdgcn_alignbit(c6, c5, 16), s6 = __builtin_amdgcn_alignbit(c7, c6, 16);
#define HYF(x0, x1, x2, x3) __builtin_bit_cast(bf16x8, (v4u){x0, x1, x2, x3})
                acc[0] = __builtin_amdgcn_mfma_f32_16x16x32_bf16(HYF(c4, c5, c6, c7), zf, acc[0], 0, 0, 0);
                acc[1] = __builtin_amdgcn_mfma_f32_16x16x32_bf16(HYF(s3, s4, s5, s6), zf, acc[1], 0, 0, 0);
                acc[2] = __builtin_amdgcn_mfma_f32_16x16x32_bf16(HYF(c3, c4, c5, c6), zf, acc[2], 0, 0, 0);
                acc[3] = __builtin_amdgcn_mfma_f32_16x16x32_bf16(HYF(s2, s3, s4, s5), zf, acc[3], 0, 0, 0);
                acc[4] = __builtin_amdgcn_mfma_f32_16x16x32_bf16(HYF(c2, c3, c4, c5), zf, acc[4], 0, 0, 0);
                acc[5] = __builtin_amdgcn_mfma_f32_16x16x32_bf16(HYF(s1, s2, s3, s4), zf, acc[5], 0, 0, 0);
                acc[6] = __builtin_amdgcn_mfma_f32_16x16x32_bf16(HYF(c1, c2, c3, c4), zf, acc[6], 0, 0, 0);
                acc[7] = __builtin_amdgcn_mfma_f32_16x16x32_bf16(HYF(s0, s1, s2, s3), zf, acc[7], 0, 0, 0);
#undef HYF
            }
        }
        __syncthreads();
        for (int i = F.tid; i < 2 * L; i += NTHR) { const v4u w = *(const v4u*)(UH + ((size_t)((512 * (o + 1) + c0) >> 3) * MR + (i / L) * SEGB + rb0 + (i % L)) * 8);
            if constexpr (NCH == 2) { const unsigned ww = w[sub]; HY_G(0)[i] = (bf16)(ww & 0xffffu); HY_G(1)[i] = (bf16)(ww >> 16); }
            else {
#pragma unroll
                for (int s = 0; s < 8; ++s) HY_G(s)[i] = (bf16)((s & 1) ? (w[s >> 1] >> 16) : (w[s >> 1] & 0xffffu)); } }
        __syncthreads();
        if (a < NBLK) {
            const float bias = hb[o * HYC + c];
            float nrm = 0.f; { const float* pb = WSP(float, WS_PART) + ((((size_t)l * 2 + (NBLK == 32 ? 0 : 1)) * 2 + o) * 2) * 8 * 512 + c;
#pragma unroll
                for (int k = 0; k < (NBLK == 32 ? 8 : 1); ++k) nrm += pb[k * 512] + pb[(8 + k) * 512]; }
            const float invn = 1.0f / nrm;
            const int t0 = a * 128 + 32 * h4;
            const float w0 = cwp[512 * (o + 1) + c], w1 = cwp[1536 + 512 * (o + 1) + c], w2 = cwp[2 * 1536 + 512 * (o + 1) + c];
            const LAS bf16* pr = Gs + nb * L + t0;
            const LAS bf16* zz = Zc + nb * ZB + a * 136 + 32 * h4;
            const size_t grow = (size_t)nb * SEGB + rb0 + t0;
            float xprev = t0 > 0 ? bf2f(pr[-1]) : 0.f;
#pragma unroll
            for (int jj = 0; jj < 4; ++jj) { const v4u pw = *(const LAS v4u*)(pr + 8 * jj); const v4u zw = *(const LAS v4u*)(zz + 8 * jj); v4u ow;
                float x[10]; x[0] = xprev;
#pragma unroll
                for (int k = 0; k < 4; ++k) { x[1 + 2 * k] = bf_lo(pw[k]); x[2 + 2 * k] = bf_hi(pw[k]); }
                x[9] = (t0 + 8 * jj + 8 < L) ? bf2f(pr[8 * jj + 8]) : 0.f; xprev = x[8];
#pragma unroll
                for (int k = 0; k < 4; ++k) { const float y0 = acc[2 * k][jj] * invn, y1 = acc[2 * k + 1][jj] * invn;
                    const float p0 = w0 * x[2 * k] + w1 * x[2 * k + 1] + w2 * x[2 * k + 2], p1 = w0 * x[2 * k + 1] + w1 * x[2 * k + 2] + w2 * x[2 * k + 3];
                    const float r0 = p0 * (y0 + bf_lo(zw[k]) * bias), r1 = p1 * (y1 + bf_hi(zw[k]) * bias); ow[k] = cvt_pk_bf16(r0, r1); }
                if (o == 0) *(LAS v4u*)(Zn + nb * ZB + a * 136 + 32 * h4 + 8 * jj) = ow;
                else *(v4u*)(YT + (size_t)c * MR + grow + 8 * jj) = ow; }
        }
        __syncthreads();
        { LAS bf16* t_ = Zc; Zc = Zn; Zn = t_; }
    }
#undef HY_G
#undef HY_ZA
#undef HY_ZB_
#undef HY_ZO
}
__device__ __forceinline__ void hyena_phase(Frame& F, int l, bool need_ctx) {
    for (int item = F.vcu; item < HYC / 2; item += F.G) hyena_item<32, 2, 4>(F, l, item);
    if (need_ctx) for (int item = (F.vcu + F.G - 16 % F.G) % F.G; item < HYC / 8; item += F.G) hyena_item<2, 8, 1>(F, l, item);
}

struct SmallOrder {
    int G, c;
    __host__ __device__ void init(int G_, int c_) { G = G_; c = c_; }
    __host__ __device__ bool next(int i, pg8::Unit& u) const { const long L = (long)i * G + c; if (L >= 204 + 272 + 272) return false; int li = (int)L;
        if (li < 204) { u.ks = 0; u.pm = li / 6; u.pn = li % 6; } else if (li < 476) { li -= 204; u.ks = 1; u.pm = li >> 3; u.pn = li & 7; } else { li -= 476; u.ks = 2; u.pm = li >> 3; u.pn = li & 7; } return true; }
};
struct SmallAB {
    static constexpr bool VARK = true;
    const bf16* U; const bf16* XR; const bf16* W; int lda, ldb;
    __device__ __forceinline__ int lda_of(const pg8::Unit& u) const { return u.ks == 1 ? 128 : DINP; }
    __device__ __forceinline__ int ktiles(const pg8::Unit& u) const { return u.ks == 2 ? 4 : 8; }
    __device__ __forceinline__ const char* a_base(const pg8::Unit& u) const {
        if (u.ks == 1) { const int b = u.pm / 17, dir = u.pn >> 2, blk = u.pn & 3; return (const char*)(XR + (((size_t)b * 4 + blk) * XR_ROWS + LruAB::prow0(u.pm) - (dir ? 0 : 3)) * 128); }
        return (const char*)(U + (size_t)u.pm * 256 * DINP + (u.ks == 0 ? OFF_Q : OFF_KV)); }
    __device__ __forceinline__ const char* b_base(const pg8::Unit& u) const { const int r0 = (u.ks == 0 ? 0 : (u.ks == 1 ? 1536 : 3584)) + u.pn * 256; return (const char*)(W + (size_t)r0 * 512); }
};
struct EpiSmall {
    static constexpr bool PERM = true;
    pg8::EpiBf16 eq, ekv; EpiGate eg;
    __device__ __forceinline__ void operator()(const f32x4 (&acc)[2][2][4][2], const pg8::Unit& u, int wr, int wc, int fr, int fq) const {
        if (u.ks == 1) eg(acc, u, wr, wc, fr, fq); else if (u.ks == 0) eq(acc, u, wr, wc, fr, fq); else ekv(acc, u, wr, wc, fr, fq); }
};

constexpr int NSTEPS = 2 + 11 * DEPTH;
#define REP(bit) for (int rep_ = 0; rep_ < (int)((PROBE_DUP >> (bit)) & 1) + 1; ++rep_)
#define LAUNDER() do { asm volatile("" : "+v"(F.tid), "+v"(F.lane)); asm volatile("" : "+s"(F.wave), "+s"(F.vcu)); asm volatile("" : "+s"(l)); \
    { unsigned long long w_ = (unsigned long long)F.ws; unsigned wl_ = (unsigned)w_, wh_ = (unsigned)(w_ >> 32); asm volatile("" : "+s"(wl_), "+s"(wh_)); F.ws = (unsigned char*)(((unsigned long long)wh_ << 32) | wl_); } } while (0)
#define IN(k) (lo <= (k) && (k) < hi)
#define SEAM(k) do { if (IN(k) && IN((k) + 1)) { xcd_barrier(bar); if (PROBE_DUP & (1u << 13)) xcd_barrier(bar); } } while (0)

template <int LI> __device__ __forceinline__ void layer_steps(Frame& F, const XcdBarrier& bar, const int lo, const int hi) {
        int l = LI; constexpr int li = LI;
        constexpr int sb = 2 + 11 * li; constexpr bool need_ctx = li < DEPTH - 1;
        if (IN(sb + 0)) REP(2) { LAUNDER(); pg8::PlainAB ab{WSP(bf16, WS_H), WSP(bf16, WS_WIN) + (size_t)l * DINP * DM, DM, DM}; pg8::StaticOrder S; S.init(MR / 256, DINP / 256, F.G, (int)blockIdx.x);
            EpiU E{WSP(bf16, WS_U), WSP(bf16, WS_PT), WSP(bf16, WS_XR), WSP(bf16, WS_KR), WSP(float, WS_ROPE), WSP(float, WS_SSQ)}; xr_pad_zero(F); pg8::gemm_phase<EpiU, pg8::PlainAB>(F.lds, ab, DM, S, E); }
        SEAM(sb + 0);
        if (IN(sb + 1)) REP(4) { LAUNDER();
            SmallAB ab{WSP(bf16, WS_U), WSP(bf16, WS_XR), WSP(bf16, WS_WSM) + (size_t)l * WSM_ROWS * 512, DINP, 512};
            SmallOrder S; S.init(F.G, (int)blockIdx.x);
            EpiSmall E{pg8::EpiBf16{WSP(bf16, WS_Q), DQ, WSP(float, WS_SSQ), 0, 8, 1.0f / QRANK}, pg8::EpiBf16{WSP(bf16, WS_KV), DKV, WSP(float, WS_SSQ), 8, 4, 1.0f / KVRANK},
                       EpiGate{WSP(bf16, WS_XR), WSP(unsigned, WS_AB), F.in[17] + (size_t)l * 2 * LRUC, F.in[19] + (size_t)l * 2 * LRUC, WSP(float, WS_SP) + (size_t)l * 2 * LRUC, F.in[15] + (size_t)l * 2 * 4 * LRUC}};
            pg8::gemm_phase<EpiSmall, SmallAB, SmallOrder>(F.lds, ab, 512, S, E);
        }
        SEAM(sb + 1);
        if (IN(sb + 2)) { LAUNDER(); REP(5) { attn_phase(F, need_ctx); __syncthreads(); } REP(6) { hyena_phase(F, l, need_ctx); __syncthreads(); } REP(7) { lru_pass1(F); } }
        SEAM(sb + 2);
        if (IN(sb + 3)) REP(7) { LAUNDER(); lru_pass2(F); }
        SEAM(sb + 3);
        if (IN(sb + 4)) REP(8) { LAUNDER(); mix_finalize(F, l); __syncthreads(); }
        SEAM(sb + 4);
        if (IN(sb + 5)) REP(9) { LAUNDER();
            { pg8::PlainAB ab{WSP(bf16, WS_YMIX), WSP(bf16, WS_WOUT) + (size_t)l * DM * DMIX, DMIX, DMIX}; pg8::LatentOrder S; S.init(32, DM / 256, F.G, (int)blockIdx.x);
              pg8::EpiBf16 E{WSP(bf16, WS_MO), DM, nullptr, 0, 0, 0.f}; pg8::gemm_phase<pg8::EpiBf16, pg8::PlainAB, pg8::LatentOrder>(F.lds, ab, DMIX, S, E); }
            if (need_ctx) { pg8::PieceAB ab{WSP(bf16, WS_YMIX), WSP(bf16, WS_WOUT) + (size_t)l * DM * DMIX, DMIX, DMIX, 256}; pg8::PieceOrder S; S.init(DM / 256, 8, F.G, (int)blockIdx.x);
              pg8::EpiSlab E{WSP(float, WS_SLAB)}; pg8::gemm_phase<pg8::EpiSlab, pg8::PieceAB, pg8::PieceOrder>(F.lds, ab, 256, S, E); } }
        SEAM(sb + 5);
        if (IN(sb + 6)) { LAUNDER(); if (PROBE_DUP & (1u << 14)) norm_pass(F, 1, l, true); norm_pass(F, 1, l); }
        SEAM(sb + 6);
        if (IN(sb + 7)) REP(10) { LAUNDER(); pg8::PlainAB ab{WSP(bf16, WS_H), WSP(bf16, WS_WUP) + (size_t)l * 2 * DFF * DM, DM, DM}; pg8::StaticOrder S; S.init(MR / 256, 2 * DFF / 256, F.G, (int)blockIdx.x);
            pg8::EpiBf16 E{WSP(bf16, WS_UP), 2 * DFF, nullptr, 0, 0, 0.f}; pg8::gemm_phase<pg8::EpiBf16, pg8::PlainAB>(F.lds, ab, DM, S, E); }
        SEAM(sb + 7);
        if (IN(sb + 8)) REP(11) { LAUNDER(); conv_gelu(F, l); }
        SEAM(sb + 8);
        if (IN(sb + 9)) REP(12) { LAUNDER();
            { pg8::PlainAB ab{WSP(bf16, WS_ACT), WSP(bf16, WS_WDN) + (size_t)l * DM * DFF, DFF, DFF}; pg8::LatentOrder S; S.init(32, DM / 256, F.G, (int)blockIdx.x);
              pg8::EpiBf16 E{WSP(bf16, WS_MO), DM, nullptr, 0, 0, 0.f}; pg8::gemm_phase<pg8::EpiBf16, pg8::PlainAB, pg8::LatentOrder>(F.lds, ab, DFF, S, E); }
            if (need_ctx) { pg8::PieceAB ab{WSP(bf16, WS_ACT), WSP(bf16, WS_WDN) + (size_t)l * DM * DFF, DFF, DFF, 512}; pg8::PieceOrder S; S.init(DM / 256, 11, F.G, (int)blockIdx.x);
              pg8::EpiSlab E{WSP(float, WS_SLAB)}; pg8::gemm_phase<pg8::EpiSlab, pg8::PieceAB, pg8::PieceOrder>(F.lds, ab, 512, S, E); } }
        SEAM(sb + 9);
        if (IN(sb + 10)) { LAUNDER(); if (PROBE_DUP & (1u << 14)) norm_pass(F, 2, l, true); norm_pass(F, 2, l); }
        SEAM(sb + 10);
}

__global__ void __launch_bounds__(NTHR, 2) fwd_kernel(Args args) {
    extern __shared__ __attribute__((aligned(16))) unsigned char lds_raw[];
    Frame F;
    F.lds = (LAS unsigned char*)lds_raw; F.ws = args.ws; F.in = args.in; F.out = args.out;
    F.tid = threadIdx.x; F.lane = F.tid & 63; F.wave = __builtin_amdgcn_readfirstlane(F.tid >> 6);
    F.G = gridDim.x; { const int bx = blockIdx.x; F.vcu = (F.G % 8 == 0) ? (bx % 8) * (F.G / 8) + bx / 8 : bx; }
    volatile LAS unsigned* MISC = (volatile LAS unsigned*)(F.lds + MISC_OFF);
    for (int u = F.tid; u < (LDS_BYTES - LDSCTL_OFF) / 4; u += NTHR) ((LAS unsigned*)(F.lds + LDSCTL_OFF))[u] = 0u;
    __syncthreads();
#if MK_MULTI
    const int lo = args.ph_lo, hi = args.ph_hi;
#else
    constexpr int lo = 0, hi = NSTEPS;
#endif
    XcdBarrier bar; bar.bar = (unsigned*)(F.ws + WS_CTL) + CW_BAR; bar.x = 0; bar.st = nullptr;
    if (hi - lo > 1) bar = xcd_barrier_post((unsigned*)(F.ws + WS_CTL) + CW_BAR, MISC + 8);

    if (IN(0)) REP(0) { REP(15) { pro_mod(F); __syncthreads(); } REP(16) { pro_transposes(F); __syncthreads(); } REP(17) { pro_lru_w(F); pro_rope(F); __syncthreads(); } REP(18) { pro_hid(F); __syncthreads(); } }
    SEAM(0);
    if (IN(1)) REP(1) { pro_filter(F); __syncthreads(); norm_pass(F, 0, 0); __syncthreads(); }
    SEAM(1);

    layer_steps<0>(F, bar, lo, hi); layer_steps<1>(F, bar, lo, hi); layer_steps<2>(F, bar, lo, hi); layer_steps<3>(F, bar, lo, hi);
#undef IN
#undef SEAM
}

extern "C" void kernel_launch(void* const* d_in, const int* in_sizes, int n_in, void* d_out, int out_size, void* d_ws, size_t ws_size, hipStream_t stream) {
    static int grid = 0;
    if (grid == 0) {
        if (n_in != 30 || ws_size < WS_END) { fprintf(stderr, "kernel_launch: expected 30 inputs and >= %zu bytes of workspace (got %d, %zu)\n", (size_t)WS_END, n_in, ws_size); grid = -1; return; }
        int dev = 0, cus = 0, per_cu = 0;
        if (hipGetDevice(&dev) != hipSuccess || hipDeviceGetAttribute(&cus, hipDeviceAttributeMultiprocessorCount, dev) != hipSuccess) { grid = -1; return; }
        if (hipFuncSetAttribute((const void*)fwd_kernel, hipFuncAttributeMaxDynamicSharedMemorySize, LDS_BYTES) != hipSuccess) { fprintf(stderr, "kernel_launch: hipFuncSetAttribute failed\n"); grid = -1; return; }
        if (hipOccupancyMaxActiveBlocksPerMultiprocessor(&per_cu, (const void*)fwd_kernel, NTHR, LDS_BYTES) != hipSuccess || per_cu < 1) fprintf(stderr, "kernel_launch: occupancy query says %d\n", per_cu);
        (void)hipGetLastError();
        grid = cus;
    }
    if (grid < 0) return;
    (void)hipMemsetAsync((char*)d_ws + WS_CTL, 0, CTL_ZERO_BYTES, stream);
    Args a{};
    for (int i = 0; i < 30; ++i) a.in[i] = (const float*)d_in[i];
    a.out = (float*)d_out; a.ws = (unsigned char*)d_ws;
#if MK_MULTI
    for (int s = 0; s < NSTEPS; ++s) { a.ph_lo = s; a.ph_hi = s + 1; hipLaunchKernelGGL(fwd_kernel, dim3(grid), dim3(NTHR), LDS_BYTES, stream, a); }
#else
    a.ph_lo = 0; a.ph_hi = NSTEPS; hipLaunchKernelGGL(fwd_kernel, dim3(grid), dim3(NTHR), LDS_BYTES, stream, a);
#endif
}
```

```cpp
#include <hip/hip_runtime.h>
#include <cstdio>
#include <cstdint>

#ifndef PROBE_DUP
#define PROBE_DUP 0x0
#endif
#ifndef PROBE_TIME
#define PROBE_TIME -1
#endif
#ifndef PROBE_SCALE
#define PROBE_SCALE 3e-9f
#endif
#ifndef X_BF16
#define X_BF16 1
#endif
#ifndef MK_MULTI
#define MK_MULTI 0
#endif

constexpr int DM = 2048, NBATCH = 2, SEQ = 4096, CTXL = 256, DEPTH = 4;
constexpr int SEGB = CTXL + SEQ;
constexpr int MR = NBATCH * SEGB;
constexpr int DIN = 3392, DINP = 3584;
constexpr int HYC = 512, LRUC = 512, QRANK = 512, KVRANK = 256, NOPE = 128, ROPED = 64, VD = 128, NH = 8;
constexpr int DQ = NH * (NOPE + ROPED);
constexpr int DKV = NH * (NOPE + VD);
constexpr int DFF = 5632, DMIX = 2048;
constexpr int OFF_LRU_G = 1536, OFF_Q = 2048, OFF_LRU_X = 2560, OFF_KV = 3072, OFF_KR = 3328;
constexpr float EPS = 1e-6f;
constexpr int XR_ROWS = 4364;
constexpr int NCHUNK = MR / 64;
constexpr int HYL = 8192, HYLC = 512;

constexpr size_t MiB = 1u << 20;
constexpr size_t WS_CTL = 0, CTL_ZERO_BYTES = 32768;
constexpr size_t WS_MOD = 1 * MiB;
constexpr size_t WS_ROPE = 2 * MiB;
constexpr size_t WS_HID = 3 * MiB;
constexpr size_t WS_PART = 8 * MiB;
constexpr size_t WS_RSTD = 9 * MiB;
constexpr size_t WS_SP = 9 * MiB + 256 * 1024;
constexpr size_t WS_CARRY = 10 * MiB;
constexpr size_t WS_SSQ = 12 * MiB;
constexpr size_t WS_G = 16 * MiB;
constexpr size_t WS_GC = 80 * MiB;
constexpr size_t WS_WIN = 96 * MiB;
constexpr size_t WS_WUQ = 152 * MiB;
constexpr size_t WS_WUKV = 158 * MiB;
constexpr size_t WS_WOUT = 162 * MiB;
constexpr size_t WS_WUP = 194 * MiB;
constexpr size_t WS_WDN = 370 * MiB;
constexpr size_t WS_WLRU = 458 * MiB;
constexpr size_t WS_X = 480 * MiB;
constexpr size_t WS_H = 548 * MiB;
constexpr size_t WS_U = 582 * MiB;
constexpr size_t WS_Q = 642 * MiB;
constexpr size_t WS_KV = 668 * MiB;
constexpr size_t WS_KR = 702 * MiB;
constexpr size_t WS_O = 704 * MiB;
constexpr size_t WS_PT = 722 * MiB;
constexpr size_t WS_YT = 748 * MiB;
constexpr size_t WS_XR = 757 * MiB;
constexpr size_t WS_AB = 766 * MiB;
constexpr size_t WS_HF = 834 * MiB;
constexpr size_t WS_YL = 851 * MiB;
constexpr size_t WS_YMIX = 868 * MiB;
constexpr size_t WS_MO = 902 * MiB;
constexpr size_t WS_UP = 936 * MiB;
constexpr size_t WS_ACT = 1123 * MiB;
constexpr size_t WS_SLAB = 1217 * MiB;
constexpr size_t WS_WUKV2 = 1265 * MiB;
constexpr size_t WS_WSM = 1273 * MiB;
constexpr int WSM_ROWS = 1536 + 2048 + 2048;
constexpr size_t WS_END = 1297 * MiB;

constexpr int CW_BAR = 4096, CW_PROBE = 64;
static_assert((CW_BAR + 3456) * 4 <= (int)CTL_ZERO_BYTES, "barrier words inside the per-call memset");

constexpr int NWAVES = 8, NTHR = 512;
constexpr int RING_BYTES = 131072;
constexpr int LDSCTL_OFF = RING_BYTES, MISC_OFF = LDSCTL_OFF + 320;
constexpr int LDS_BYTES = 147456;

#define GAS __attribute__((address_space(1)))
#define LAS __attribute__((address_space(3)))
#define CAS __attribute__((address_space(4)))
typedef const float CAS cfloat_c;
typedef unsigned short bf16;
typedef unsigned v4u __attribute__((ext_vector_type(4)));
typedef unsigned v2u __attribute__((ext_vector_type(2)));
typedef float f32x4 __attribute__((ext_vector_type(4)));
typedef float f32x2 __attribute__((ext_vector_type(2)));
typedef float f32x16 __attribute__((ext_vector_type(16)));
typedef short bf16x8 __attribute__((ext_vector_type(8)));
typedef short s16x4 __attribute__((ext_vector_type(4)));
typedef GAS unsigned gu32;
#define RLX_AGENT __ATOMIC_RELAXED, __HIP_MEMORY_SCOPE_AGENT
#define LDS_WAIT() asm volatile("s_waitcnt lgkmcnt(0)" ::: "memory")
#define VM_WAIT() asm volatile("s_waitcnt vmcnt(0)" ::: "memory")

__device__ __forceinline__ unsigned cvt_pk_bf16(float lo, float hi) { unsigned r; asm volatile("v_cvt_pk_bf16_f32 %0, %1, %2" : "=v"(r) : "v"(lo), "v"(hi)); return r; }
__device__ __forceinline__ float bf_lo(unsigned w) { return __uint_as_float(w << 16); }
__device__ __forceinline__ float bf_hi(unsigned w) { return __uint_as_float(w & 0xffff0000u); }
__device__ __forceinline__ float bf2f(bf16 v) { return __uint_as_float(((unsigned)v) << 16); }
__device__ __forceinline__ bf16 f2bf(float f) { return (bf16)(cvt_pk_bf16(f, 0.f) & 0xffffu); }
__device__ __forceinline__ float wave_sum(float v) {
#pragma unroll
    for (int o = 1; o < 64; o <<= 1) v += __shfl_xor(v, o);
    return v;
}
__device__ __forceinline__ float sigmoidf_(float x) { return __builtin_amdgcn_rcpf(1.0f + __builtin_amdgcn_exp2f(-1.4426950408889634f * x)); }
__device__ __forceinline__ float gelu_tanh(float x) { const float x2 = x * x; const float t = x * (-2.302208198f - 0.1029432397f * x2);
    return x * __builtin_amdgcn_rcpf(1.0f + __builtin_amdgcn_exp2f(t)); }

#define XB_TMO      128
#define XB_XCNT(j)  (256  + 64 * (j))
#define XB_XSUB(j)  (1280 + 64 * (j))
#define XB_XGEN(j)  (2304 + 64 * (j))
#define XB_TOP      3328
#define XB_TOPGEN   3392
#define XCD_BAR_WORDS 3456
#define XB_SPIN_CAP (1u << 18)
__device__ __forceinline__ unsigned xb_ld(unsigned* p)              { return __hip_atomic_load(p, __ATOMIC_RELAXED, __HIP_MEMORY_SCOPE_AGENT); }
__device__ __forceinline__ unsigned xb_add(unsigned* p, unsigned v) { return __hip_atomic_fetch_add(p, v, __ATOMIC_RELAXED, __HIP_MEMORY_SCOPE_AGENT); }
__device__ __forceinline__ unsigned xb_xcc_id() { return (unsigned)__builtin_amdgcn_s_getreg((3 << 11) | 20) & 0xFu; }
#define XB_SPIN(cond, bar) do { unsigned _sp = 0; while (cond) { __builtin_amdgcn_s_sleep(1); \
    if ((++_sp & 255u) == 0u) { if (xb_ld(&(bar)[XB_TMO])) break; if (_sp > XB_SPIN_CAP) { atomicAdd(&(bar)[XB_TMO], 1u); break; } } } } while (0)
struct XcdBarrier { unsigned* bar; unsigned x; volatile LAS unsigned* st; };
__device__ __forceinline__ XcdBarrier xcd_barrier_post(unsigned* bar, volatile LAS unsigned* st) {
    XcdBarrier b; b.bar = bar; b.x = xb_xcc_id(); b.st = st;
    if (threadIdx.x == 0) (void)xb_add(&bar[XB_XCNT(b.x)], 1u);
    return b;
}
__device__ __forceinline__ void xcd_barrier_complete(unsigned* bar, unsigned x, unsigned& nloc, unsigned& nx) {
    const unsigned G = gridDim.x * gridDim.y * gridDim.z;
    unsigned sum, cnt, mine, sp = 0u;
    for (;;) {
        sum = 0u; cnt = 0u; mine = 0u;
#pragma unroll
        for (unsigned j = 0; j < 16; ++j) { const unsigned c = xb_ld(&bar[XB_XCNT(j)]); sum += c; cnt += (c > 0u) ? 1u : 0u; mine = (j == x) ? c : mine; }
        if (sum == G) break;
        __builtin_amdgcn_s_sleep(1);
        if ((++sp & 255u) == 0u) { if (xb_ld(&bar[XB_TMO])) break; if (sp > XB_SPIN_CAP) { atomicAdd(&bar[XB_TMO], 1u); break; } }
    }
    nloc = mine > 0u ? mine : 1u; nx = cnt > 0u ? cnt : 1u;
}
__device__ __forceinline__ void xcd_barrier(const XcdBarrier& b) {
    asm volatile("s_waitcnt vmcnt(0)" ::: "memory");
    __syncthreads();
    unsigned* bar_l; { unsigned long long w_ = (unsigned long long)b.bar; unsigned wl_ = (unsigned)w_, wh_ = (unsigned)(w_ >> 32); asm volatile("" : "+s"(wl_), "+s"(wh_)); bar_l = (unsigned*)(((unsigned long long)wh_ << 32) | wl_); }
    unsigned x_l = b.x; asm volatile("" : "+s"(x_l));
    if (threadIdx.x == 0) {
        unsigned* bar = bar_l;
        __builtin_amdgcn_s_waitcnt(0);
        unsigned nloc = b.st[0], nx = b.st[1];
        if (nloc == 0u) { xcd_barrier_complete(bar, x_l, nloc, nx); b.st[0] = nloc; b.st[1] = nx; }
        const unsigned old = xb_add(&bar[XB_XSUB(x_l)], 1u);
        const unsigned gen = old / nloc;
        if (old + 1u == (gen + 1u) * nloc) {
            __builtin_amdgcn_fence(__ATOMIC_RELEASE, "agent");
            asm volatile("s_waitcnt vmcnt(0)" ::: "memory");
            const unsigned og = xb_add(&bar[XB_TOP], 1u);
            const unsigned tg = og / nx;
            if (og + 1u == (tg + 1u) * nx) xb_add(&bar[XB_TOPGEN], 1u);
            else XB_SPIN(xb_ld(&bar[XB_TOPGEN]) == tg, bar);
            __builtin_amdgcn_fence(__ATOMIC_ACQUIRE, "agent");
            xb_add(&bar[XB_XGEN(x_l)], 1u);
            asm volatile("s_waitcnt vmcnt(0)" ::: "memory");
        } else {
            XB_SPIN(xb_ld(&bar[XB_XGEN(x_l)]) == gen, bar);
            __builtin_amdgcn_fence(__ATOMIC_ACQUIRE, "agent");
            asm volatile("s_waitcnt vmcnt(0)" ::: "memory");
        }
    }
    __syncthreads();
}

struct Args { const float* in[30]; float* out; unsigned char* ws; int ph_lo, ph_hi; };
struct Frame {
    LAS unsigned char* lds;
    unsigned char* ws;
    const float* const* in;
    float* out;
    int tid, lane, wave, vcu, G;
};
#define WSP(T, off) ((T*)(F.ws + (off)))
__device__ __forceinline__ void row_info(int r, int& b, int& isctx, int& t) { b = r >= SEGB ? 1 : 0; const int j = r - b * SEGB; isctx = j < CTXL ? 1 : 0; t = isctx ? j : j - CTXL; }

namespace pg8 {
constexpr int BM = 256, BK = 64, HALF = 128, HTB = HALF * BK * 2, STAGE_BYTES = 8 * HTB, NXCD = 8, WGM = 8;
__host__ __device__ __forceinline__ int lds_byte(int r, int c) { const int st = (r >> 4) * 2 + (c >> 5), rr = r & 15, cc = c & 31, ob = rr * 64 + cc * 2; return st * 1024 + (ob ^ (((ob >> 9) & 1) << 5)); }
__host__ __device__ __forceinline__ void stage_rc(int b, int& R, int& C) { const int st = b / 1024, sb = b % 1024, swz = sb ^ (((sb >> 9) & 1) << 5); R = (st >> 1) * 16 + swz / 64; C = (st & 1) * 32 + (swz % 64) / 2; }
__host__ __device__ __forceinline__ int perm32(int rho) { const int n = rho >> 4, i = rho & 15; return 8 * (i >> 2) + 4 * n + (i & 3); }
struct Unit { int pm, pn, ks; };
struct StaticOrder {
    int nM, nN, nwg, G, c;
    __host__ __device__ void init(int nM_, int nN_, int G_, int c_) { nM = nM_; nN = nN_; nwg = nM * nN; G = G_; c = c_; }
    __host__ __device__ bool next(int i, Unit& u) const {
        const long L = (long)i * G + c; if (L >= nwg) return false;
        int wgid = (int)L; { const int q = nwg / NXCD, r = nwg % NXCD, xcd = wgid % NXCD, off = wgid / NXCD; wgid = (xcd < r ? xcd * (q + 1) : r * (q + 1) + (xcd - r) * q) + off; }
        const int nig = WGM * nN, gid = wgid / nig, fm = gid * WGM, gsz = (nM - fm) < WGM ? (nM - fm) : WGM;
        u.pm = fm + ((wgid % nig) % gsz); u.pn = (wgid % nig) / gsz; u.ks = 0; return true;
    }
};
struct LatentOrder : StaticOrder {
    __host__ __device__ bool next(int i, Unit& u) const { if (!StaticOrder::next(i, u)) return false; u.pm = u.pm < 16 ? u.pm + 1 : u.pm + 2; return true; }
};
struct PieceOrder {
    int nN, S, n, G, c;
    __host__ __device__ void init(int nN_, int S_, int G_, int c_) { nN = nN_; S = S_; n = 2 * nN_ * S_; G = G_; c = c_; }
    __host__ __device__ bool next(int i, Unit& u) const { const long L = (long)i * G + c; if (L >= n) return false; const int li = (int)L; u.ks = li % S; u.pn = (li / S) % nN; u.pm = (li / (S * nN)) ? 17 : 0; return true; }
};
struct PieceAB {
    static constexpr bool VARK = false;
    const bf16* A; const bf16* Bt; int lda, ldb, Kp;
    __device__ __forceinline__ const char* a_base(const Unit& u) const { return (const char*)(A + (size_t)u.pm * BM * lda + (size_t)u.ks * Kp); }
    __device__ __forceinline__ const char* b_base(const Unit& u) const { return (const char*)(Bt + (size_t)u.pn * BM * ldb + (size_t)u.ks * Kp); }
};
#if X_BF16
typedef bf16 slab_t;
#else
typedef float slab_t;
#endif
struct EpiSlab {
    static constexpr bool PERM = false;
    slab_t* slab;
    __device__ __forceinline__ void operator()(const f32x4 (&acc)[2][2][4][2], const Unit& u, int wr, int wc, int fr, int fq) const {
        const int row0 = (u.pm ? 256 : 0) + wr * 64 + fr, col0 = u.pn * BM + wc * 32 + 4 * fq; slab_t* base = slab + (size_t)u.ks * (512 * 2048);
#pragma unroll
        for (int ai = 0; ai < 2; ++ai)
#pragma unroll
            for (int m = 0; m < 4; ++m) { slab_t* rowp = base + (size_t)(row0 + ai * HALF + m * 16) * 2048 + col0;
#pragma unroll
                for (int bj = 0; bj < 2; ++bj)
#pragma unroll
                    for (int n = 0; n < 2; ++n) {
#if X_BF16
                        const f32x4 a = acc[ai][bj][m][n]; *(v2u*)(rowp + bj * HALF + n * 16) = (v2u){cvt_pk_bf16(a[0], a[1]), cvt_pk_bf16(a[2], a[3])};
#else
                        *(f32x4*)(rowp + bj * HALF + n * 16) = acc[ai][bj][m][n];
#endif
                    } }
    }
};
struct PlainAB {
    static constexpr bool VARK = false;
    const bf16* A; const bf16* Bt; int lda, ldb;
    __device__ __forceinline__ const char* a_base(const Unit& u) const { return (const char*)(A + (size_t)u.pm * BM * lda); }
    __device__ __forceinline__ const char* b_base(const Unit& u) const { return (const char*)(Bt + (size_t)u.pn * BM * ldb); }
};
struct EpiBf16 {
    static constexpr bool PERM = true;
    bf16* O; int ldc; const float* ssq; int s0, ns; float invk; float postmul = 1.0f;
    __device__ __forceinline__ void operator()(const f32x4 (&acc)[2][2][4][2], const Unit& u, int wr, int wc, int fr, int fq) const {
        const int row0 = u.pm * BM + wr * 64 + fr; const int col0 = u.pn * BM + wc * 32 + 8 * fq;
        float scs[2][4];
#pragma unroll
        for (int ai = 0; ai < 2; ++ai)
#pragma unroll
            for (int m = 0; m < 4; ++m) scs[ai][m] = 1.0f;
        if (ssq) {
            f32x4 pa[2][4], pb[2][4];
#pragma unroll
            for (int ai = 0; ai < 2; ++ai)
#pragma unroll
                for (int m = 0; m < 4; ++m) { const float* p = ssq + (size_t)(row0 + ai * HALF + m * 16) * 12 + s0; pa[ai][m] = *(const f32x4*)p; pb[ai][m] = (ns > 4) ? *(const f32x4*)(p + 4) : (f32x4){0.f, 0.f, 0.f, 0.f}; }
#pragma unroll
            for (int ai = 0; ai < 2; ++ai)
#pragma unroll
                for (int m = 0; m < 4; ++m) { const f32x4 t = pa[ai][m] + pb[ai][m]; scs[ai][m] = postmul / sqrtf(((t[0] + t[1]) + (t[2] + t[3])) * invk + 1e-6f); }
        }
#pragma unroll
        for (int ai = 0; ai < 2; ++ai)
#pragma unroll
            for (int m = 0; m < 4; ++m) { const int row = row0 + ai * HALF + m * 16; bf16* rowp = O + (size_t)row * ldc + col0; const float sc = scs[ai][m];
                constexpr size_t bjstep = HALF;
#pragma unroll
                for (int bj = 0; bj < 2; ++bj) { const f32x4 v0 = acc[ai][bj][m][0] * sc, v1 = acc[ai][bj][m][1] * sc;
                    v4u w; w.x = cvt_pk_bf16(v0[0], v0[1]); w.y = cvt_pk_bf16(v0[2], v0[3]); w.z = cvt_pk_bf16(v1[0], v1[1]); w.w = cvt_pk_bf16(v1[2], v1[3]);
                    *(v4u*)(rowp + bj * bjstep) = w; } }
    }
};

#ifndef GEMM_SP2
#define GEMM_SP2 true
#endif
#ifndef GEMM_ALIGN
#define GEMM_ALIGN true
#endif
template <class Epi, class AB, class Sched = StaticOrder, bool ALIGN_EPI = GEMM_ALIGN, bool SP2 = GEMM_SP2>
__device__ __forceinline__ void gemm_phase(LAS unsigned char* lds, const AB ab, const int K, const Sched& S, const Epi& E) {
    int tid = threadIdx.x; asm volatile("" : "+v"(tid));
    const int wid = __builtin_amdgcn_readfirstlane(tid >> 6), lane = tid & 63, wr = wid >> 2, wc = wid & 3, fr = lane & 15, fq = lane >> 4;
    int nt = K / BK;
    unsigned voffA[2], voffB[2], voffAn[2]; int stR[2], stC[2];
#pragma unroll
    for (int i = 0; i < 2; ++i) { int R, C; stage_rc(tid * 16 + i * 8192, R, C); const int Rb = Epi::PERM ? ((R & ~31) + perm32(R & 31)) : R; stR[i] = R; stC[i] = C;
        voffA[i] = (unsigned)(R * ab.lda + C) * 2u; voffB[i] = (unsigned)(Rb * ab.ldb + C) * 2u; voffAn[i] = voffA[i]; }
    const size_t kstep = (size_t)(BK * 2);
    size_t hstepA = (size_t)HALF * ab.lda * 2, hstepAn = hstepA; const size_t hstepB = (size_t)HALF * ab.ldb * 2; int ntn = nt;
    const unsigned ldsw = (unsigned)wid * 1024u;
    const int aoff = lds_byte(wr * 64 + fr, fq * 8), boff = lds_byte(wc * 32 + fr, fq * 8);
#define PG8_SA(b, h) (((b) * 2 + (h)) * HTB)
#define PG8_SB(b, h) ((4 + (b) * 2 + (h)) * HTB)
#define PG8_STAGE(bufoff, gbase, voff) do { _Pragma("unroll") for (int _i = 0; _i < 2; ++_i) \
        __builtin_amdgcn_global_load_lds((const unsigned*)((const char*)(gbase) + (voff)[_i]), (LAS unsigned*)(lds + (bufoff) + ldsw + _i * 8192), 16, 0, 0); } while (0)
#define PG8_LDA(dst, b, h) do { _Pragma("unroll") for (int m = 0; m < 4; ++m) _Pragma("unroll") for (int k = 0; k < 2; ++k) dst[m][k] = *(const LAS bf16x8*)(lds + PG8_SA(b, h) + aoff + m * 2048 + k * 1024); } while (0)
#define PG8_LDB(dst, b, h) do { _Pragma("unroll") for (int n = 0; n < 2; ++n) _Pragma("unroll") for (int k = 0; k < 2; ++k) dst[n][k] = *(const LAS bf16x8*)(lds + PG8_SB(b, h) + boff + n * 2048 + k * 1024); } while (0)
#define PG8_MMA(ai, bj, At, Bt) do { __builtin_amdgcn_s_setprio(1); _Pragma("unroll") for (int m = 0; m < 4; ++m) _Pragma("unroll") for (int n = 0; n < 2; ++n) _Pragma("unroll") for (int k = 0; k < 2; ++k) \
        acc[ai][bj][m][n] = __builtin_amdgcn_mfma_f32_16x16x32_bf16(Bt[n][k], At[m][k], acc[ai][bj][m][n], 0, 0, 0); __builtin_amdgcn_s_setprio(0); } while (0)
#define PG8_WAIT_V(n) asm volatile("s_waitcnt vmcnt(" #n ")" ::: "memory")
#define PG8_WAIT_L(n) asm volatile("s_waitcnt lgkmcnt(" #n ")" ::: "memory")
#define PG8_BAR __builtin_amdgcn_s_barrier()
#define PG8_SCHED __builtin_amdgcn_sched_barrier(0)
    Unit cur, nxt; int ui = 0;
    if (!S.next(0, cur)) return;
    f32x4 acc[2][2][4][2];
#pragma unroll
    for (int a = 0; a < 2; ++a)
#pragma unroll
        for (int b = 0; b < 2; ++b)
#pragma unroll
            for (int m = 0; m < 4; ++m)
#pragma unroll
                for (int n = 0; n < 2; ++n) acc[a][b][m][n] = (f32x4){0.f, 0.f, 0.f, 0.f};
    bf16x8 At[4][2], B0[2][2], B1[2][2];
    const char* cA = ab.a_base(cur); const char* cB = ab.b_base(cur);
    if constexpr (AB::VARK) { const int la_ = ab.lda_of(cur); nt = ab.ktiles(cur); hstepA = (size_t)HALF * la_ * 2;
#pragma unroll
        for (int i = 0; i < 2; ++i) voffA[i] = (unsigned)(stR[i] * la_ + stC[i]) * 2u; }
    if constexpr (SP2) {
    PG8_STAGE(PG8_SB(0, 0), cB, voffB); PG8_STAGE(PG8_SB(0, 1), cB + hstepB, voffB); PG8_STAGE(PG8_SA(0, 0), cA, voffA); PG8_STAGE(PG8_SA(0, 1), cA + hstepA, voffA);
    if (wr == 1) PG8_BAR;
    PG8_WAIT_V(2); PG8_BAR;
    PG8_STAGE(PG8_SB(1, 0), cB + kstep, voffB); PG8_STAGE(PG8_SA(1, 0), cA + kstep, voffA); PG8_STAGE(PG8_SB(1, 1), cB + hstepB + kstep, voffB);
    PG8_WAIT_V(6); PG8_BAR;
    } else {
    PG8_STAGE(PG8_SB(0, 0), cB, voffB); PG8_STAGE(PG8_SA(0, 0), cA, voffA); PG8_STAGE(PG8_SB(0, 1), cB + hstepB, voffB); PG8_STAGE(PG8_SA(0, 1), cA + hstepA, voffA);
    if (wr == 1) PG8_BAR;
    PG8_WAIT_V(4); PG8_BAR;
    PG8_STAGE(PG8_SB(1, 0), cB + kstep, voffB); PG8_STAGE(PG8_SA(1, 0), cA + kstep, voffA); PG8_STAGE(PG8_SB(1, 1), cB + hstepB + kstep, voffB);
    PG8_WAIT_V(6); PG8_BAR;
    }
    for (;;) {
        const bool has_next = S.next(ui + 1, nxt);
        const char* nA = has_next ? ab.a_base(nxt) : cA; const char* nB = has_next ? ab.b_base(nxt) : cB;
        if constexpr (AB::VARK) { if (has_next) { const int la_ = ab.lda_of(nxt); ntn = ab.ktiles(nxt); hstepAn = (size_t)HALF * la_ * 2;
#pragma unroll
                for (int i = 0; i < 2; ++i) voffAn[i] = (unsigned)(stR[i] * la_ + stC[i]) * 2u; } else { ntn = nt; hstepAn = hstepA; voffAn[0] = voffA[0]; voffAn[1] = voffA[1]; } }
        for (int t = 0; t < nt; t += 2) {
            const bool last = (t == nt - 2);
            const char* a1 = cA + (size_t)(t + 1) * kstep;
            const char* a2 = last ? nA : cA + (size_t)(t + 2) * kstep; const char* b2 = last ? nB : cB + (size_t)(t + 2) * kstep;
            const char* a3 = a2 + kstep; const char* b3 = b2 + kstep;
            unsigned voffA2[2]; size_t hstepA2;
            if constexpr (AB::VARK) { voffA2[0] = last ? voffAn[0] : voffA[0]; voffA2[1] = last ? voffAn[1] : voffA[1]; hstepA2 = last ? hstepAn : hstepA; }
            else { voffA2[0] = voffA[0]; voffA2[1] = voffA[1]; hstepA2 = hstepA; }
            if constexpr (SP2) {
            PG8_LDB(B0, 0, 0); PG8_LDB(B1, 0, 1); PG8_SCHED; PG8_LDA(At, 0, 0); PG8_STAGE(PG8_SA(1, 1), a1 + hstepA, voffA);
            PG8_WAIT_V(8); PG8_WAIT_L(0); PG8_BAR; PG8_MMA(0, 0, At, B0); PG8_MMA(0, 1, At, B1); PG8_BAR; PG8_SCHED;
            PG8_LDA(At, 0, 1); PG8_STAGE(PG8_SB(0, 0), b2, voffB); PG8_STAGE(PG8_SB(0, 1), b2 + hstepB, voffB); PG8_STAGE(PG8_SA(0, 0), a2, voffA2);
            PG8_WAIT_V(8); PG8_WAIT_L(0); PG8_BAR; PG8_MMA(1, 0, At, B0); PG8_MMA(1, 1, At, B1); PG8_BAR; PG8_SCHED;
            PG8_LDB(B0, 1, 0); PG8_LDB(B1, 1, 1); PG8_SCHED; PG8_LDA(At, 1, 0); PG8_STAGE(PG8_SA(0, 1), a2 + hstepA2, voffA2);
            PG8_WAIT_V(8); PG8_WAIT_L(0); PG8_BAR; PG8_MMA(0, 0, At, B0); PG8_MMA(0, 1, At, B1); PG8_BAR; PG8_SCHED;
            PG8_LDA(At, 1, 1); PG8_STAGE(PG8_SB(1, 0), b3, voffB); PG8_STAGE(PG8_SB(1, 1), b3 + hstepB, voffB); PG8_STAGE(PG8_SA(1, 0), a3, voffA2);
            PG8_WAIT_V(8); PG8_WAIT_L(0); PG8_BAR; PG8_MMA(1, 0, At, B0); PG8_MMA(1, 1, At, B1); PG8_BAR; PG8_SCHED;
            } else {
            PG8_LDB(B0, 0, 0); PG8_SCHED; PG8_LDA(At, 0, 0); PG8_STAGE(PG8_SA(1, 1), a1 + hstepA, voffA);
            PG8_WAIT_L(8); PG8_BAR; PG8_WAIT_L(0); PG8_MMA(0, 0, At, B0); PG8_BAR; PG8_SCHED;
            PG8_LDB(B1, 0, 1); PG8_STAGE(PG8_SB(0, 0), b2, voffB);
            PG8_BAR; PG8_WAIT_L(0); PG8_MMA(0, 1, At, B1); PG8_BAR;
            PG8_LDA(At, 0, 1); PG8_STAGE(PG8_SA(0, 0), a2, voffA2);
            PG8_BAR; PG8_WAIT_L(0); PG8_MMA(1, 0, At, B0); PG8_BAR; PG8_SCHED;
            PG8_STAGE(PG8_SB(0, 1), b2 + hstepB, voffB);
            PG8_WAIT_V(6); PG8_BAR; PG8_MMA(1, 1, At, B1); PG8_BAR;
            PG8_LDB(B0, 1, 0); PG8_SCHED; PG8_LDA(At, 1, 0); PG8_STAGE(PG8_SA(0, 1), a2 + hstepA2, voffA2);
            PG8_WAIT_L(8); PG8_BAR; PG8_WAIT_L(0); PG8_MMA(0, 0, At, B0); PG8_BAR; PG8_SCHED;
            PG8_LDB(B1, 1, 1); PG8_STAGE(PG8_SB(1, 0), b3, voffB);
            PG8_BAR; PG8_WAIT_L(0); PG8_MMA(0, 1, At, B1); PG8_BAR;
            PG8_LDA(At, 1, 1); PG8_STAGE(PG8_SA(1, 0), a3, voffA2);
            PG8_BAR; PG8_WAIT_L(0); PG8_MMA(1, 0, At, B0); PG8_BAR; PG8_SCHED;
            PG8_STAGE(PG8_SB(1, 1), b3 + hstepB, voffB);
            PG8_WAIT_V(6); PG8_BAR; PG8_MMA(1, 1, At, B1); PG8_BAR;
            }
        }
        if constexpr (ALIGN_EPI) { if (wr == 0) PG8_BAR; }
        E(acc, cur, wr, wc, fr, fq);
        if (!has_next) break;
#pragma unroll
        for (int a = 0; a < 2; ++a)
#pragma unroll
            for (int b = 0; b < 2; ++b)
#pragma unroll
                for (int m = 0; m < 4; ++m)
#pragma unroll
                    for (int n = 0; n < 2; ++n) acc[a][b][m][n] = (f32x4){0.f, 0.f, 0.f, 0.f};
        cur = nxt; cA = nA; cB = nB; ++ui;
        if constexpr (AB::VARK) { nt = ntn; hstepA = hstepAn; voffA[0] = voffAn[0]; voffA[1] = voffAn[1]; }
        if constexpr (ALIGN_EPI) { if (wr == 1) PG8_BAR; }
    }
    PG8_WAIT_V(0);
    if constexpr (!ALIGN_EPI) { if (wr == 0) PG8_BAR; }
    PG8_BAR;
#undef PG8_SA
#undef PG8_SB
#undef PG8_STAGE
#undef PG8_LDA
#undef PG8_LDB
#undef PG8_MMA
#undef PG8_WAIT_V
#undef PG8_WAIT_L
#undef PG8_BAR
#undef PG8_SCHED
}
}

__device__ __forceinline__ void pro_mod(Frame& F) {
    LAS float* sil = (LAS float*)F.lds;
    LAS float* red = (LAS float*)(F.lds + 24576);
    const float* c = F.in[1]; const float* cc = F.in[3];
    for (int i = F.tid; i < 3 * DM; i += NTHR) { const int w = i / DM, k = i - w * DM; const float v = (w < 2) ? c[w * DM + k] : cc[k]; sil[i] = v / (1.0f + expf(-v)); }
    __syncthreads();
    float* MOD = WSP(float, WS_MOD);
    const int k0 = F.wave * 256;
    for (int unit = F.vcu; unit < DEPTH * 192; unit += F.G) {
        const int l = unit / 192, cg = unit - l * 192;
        const float* W = F.in[4] + (size_t)l * DM * (6 * DM) + cg * 64 + F.lane;
        float a0 = 0.f, a1 = 0.f, a2 = 0.f;
#pragma unroll 16
        for (int k = k0; k < k0 + 256; ++k) { const float w = __builtin_nontemporal_load(W + (size_t)k * (6 * DM)); a0 += sil[k] * w; a1 += sil[DM + k] * w; a2 += sil[2 * DM + k] * w; }
        red[(F.wave * 3 + 0) * 64 + F.lane] = a0; red[(F.wave * 3 + 1) * 64 + F.lane] = a1; red[(F.wave * 3 + 2) * 64 + F.lane] = a2;
        __syncthreads();
        if (F.tid < 192) { const int j = F.tid >> 6, ln = F.tid & 63; float s = 0.f;
#pragma unroll
            for (int w = 0; w < 8; ++w) s += red[(w * 3 + j) * 64 + ln];
            MOD[((size_t)l * 3 + j) * (6 * DM) + cg * 64 + ln] = s + F.in[5][(size_t)l * (6 * DM) + cg * 64 + ln]; }
        __syncthreads();
    }
}

__device__ __forceinline__ void tr_tile(const float* __restrict__ W, int K, int N, bf16* __restrict__ WT, const float* kscale, LAS float* scr, int item, int lane, int ldk = 0, int remap_n0 = -1, int remap_add = 0) {
    if (ldk == 0) ldk = K;
    const int nblk = N >> 5, kb = item / nblk, nb = item - kb * nblk, k0 = kb * 64, n0 = nb * 32, nd0 = (n0 == remap_n0) ? n0 + remap_add : n0;
#pragma unroll
    for (int i = 0; i < 8; ++i) { const int kk = 8 * i + (lane >> 3), c4 = (lane & 7) * 4;
        f32x4 v = __builtin_nontemporal_load((const f32x4*)(W + (size_t)(k0 + kk) * N + n0 + c4)); if (kscale) v = v * kscale[k0 + kk];
        scr[kk * 33 + c4 + 0] = v[0]; scr[kk * 33 + c4 + 1] = v[1]; scr[kk * 33 + c4 + 2] = v[2]; scr[kk * 33 + c4 + 3] = v[3]; }
    LDS_WAIT(); asm volatile("" ::: "memory");
    const int c = lane & 7;
#pragma unroll
    for (int j = 0; j < 4; ++j) { const int n = (lane >> 3) + 8 * j; const LAS float* s = scr + (8 * c) * 33 + n;
        v4u o; o.x = cvt_pk_bf16(s[0], s[33]); o.y = cvt_pk_bf16(s[66], s[99]); o.z = cvt_pk_bf16(s[132], s[165]); o.w = cvt_pk_bf16(s[198], s[231]);
        *(v4u*)(WT + (size_t)(nd0 + n) * ldk + k0 + 8 * c) = o; }
    LDS_WAIT(); asm volatile("" ::: "memory");
}
__device__ __forceinline__ void pro_transposes(Frame& F) {
    LAS float* scr = (LAS float*)(F.lds + F.wave * 16384);
    const int gw = F.vcu * NWAVES + F.wave, NGW = F.G * NWAVES;
    constexpr int I0 = 32 * 106, I1 = 8 * 48, I2 = 4 * 64, I3 = 32 * 64, I4 = 32 * 352, I5 = 88 * 64, IL = I0 + I1 + I2 + I3 + I4 + I5;
    for (int it = gw; it < DEPTH * IL; it += NGW) {
        const int l = DEPTH - 1 - it / IL; int r = it - (it / IL) * IL;
        if (r < I0) { tr_tile(F.in[7] + (size_t)l * DM * DIN, DM, DIN, WSP(bf16, WS_WIN) + (size_t)l * DINP * DM, nullptr, scr, r, F.lane, 0, 3360, 96); continue; } r -= I0;
        if (r < I1) { tr_tile(F.in[23] + (size_t)l * QRANK * DQ, QRANK, DQ, WSP(bf16, WS_WSM) + (size_t)l * WSM_ROWS * 512, F.in[21] + l * QRANK, scr, r, F.lane); continue; } r -= I1;
        if (r < I2) { tr_tile(F.in[24] + (size_t)l * KVRANK * DKV, KVRANK, DKV, WSP(bf16, WS_WSM) + ((size_t)l * WSM_ROWS + 3584) * 512, F.in[22] + l * KVRANK, scr, r, F.lane, 512); continue; } r -= I2;
        if (r < I3) { tr_tile(F.in[26] + (size_t)l * DMIX * DM, DMIX, DM, WSP(bf16, WS_WOUT) + (size_t)l * DM * DMIX, nullptr, scr, r, F.lane); continue; } r -= I3;
        if (r < I4) { tr_tile(F.in[27] + (size_t)l * DM * 2 * DFF, DM, 2 * DFF, WSP(bf16, WS_WUP) + (size_t)l * 2 * DFF * DM, nullptr, scr, r, F.lane); continue; } r -= I4;
        tr_tile(F.in[29] + (size_t)l * DFF * DM, DFF, DM, WSP(bf16, WS_WDN) + (size_t)l * DM * DFF, nullptr, scr, r, F.lane);
    }
    { const v4u z = {0u, 0u, 0u, 0u}; constexpr int per = (DINP - DIN) * DM / 8;
      for (int i = F.vcu * NTHR + F.tid; i < DEPTH * per; i += F.G * NTHR) { const int l = i / per, j = i - l * per; const int row = j / (DM / 8), ch = j - row * (DM / 8);
          const int drow = row < 96 ? 3360 + row : 3488 + (row - 96);
          *(v4u*)(WSP(bf16, WS_WIN) + ((size_t)l * DINP + drow) * DM + (size_t)ch * 8) = z; } }
}
__device__ __forceinline__ void pro_lru_w(Frame& F) {
    bf16* WL = WSP(bf16, WS_WLRU);
    constexpr int total = DEPTH * 2 * 4 * 256 * 64;
    for (int i = F.vcu * NTHR + F.tid; i < total; i += F.G * NTHR) {
        const int ch = i & 63, row = (i >> 6) & 255, blk = (i >> 14) & 3, dir = (i >> 16) & 1, l = i >> 17;
        const int g = row >> 7, e = row & 127, j4 = ch >> 4, d0 = (ch & 15) * 8;
        const float* Wsrc = (g ? F.in[18] : F.in[16]) + ((((size_t)l * 2 + dir) * 4 + blk) * 128) * 128;
        const float* cw = F.in[15] + (((size_t)l * 2 + dir) * 4 + j4) * LRUC + blk * 128 + d0;
        float v[8];
#pragma unroll
        for (int j = 0; j < 8; ++j) v[j] = cw[j] * Wsrc[(size_t)(d0 + j) * 128 + e];
        v4u o; o.x = cvt_pk_bf16(v[0], v[1]); o.y = cvt_pk_bf16(v[2], v[3]); o.z = cvt_pk_bf16(v[4], v[5]); o.w = cvt_pk_bf16(v[6], v[7]);
        *(v4u*)(WSP(bf16, WS_WSM) + ((size_t)l * WSM_ROWS + 1536) * 512 + (size_t)(i & ((1 << 17) - 1)) * 8) = o;
    }
}
__device__ __forceinline__ void pro_rope(Frame& F) {
    { float* SP = WSP(float, WS_SP); for (int i = F.vcu * NTHR + F.tid; i < DEPTH * 2 * LRUC; i += F.G * NTHR) SP[i] = log1pf(expf(-F.in[20][i])); }
    float* R = WSP(float, WS_ROPE);
    for (int i = F.vcu * NTHR + F.tid; i < SEQ * 32; i += F.G * NTHR) { const int t = i >> 5, f = i & 31; const float pos = (f < 16) ? (float)(t >> 6) : (float)(t & 63);
        const float inv = powf(10000.0f, -(float)(f & 15) / 16.0f); const float a = pos * inv; R[t * 64 + f] = cosf(a); R[t * 64 + 32 + f] = sinf(a); }
}
__device__ __forceinline__ void pro_hid(Frame& F) {
    LAS float* h1 = (LAS float*)(F.lds + F.wave * 16384);
    float* HID = WSP(float, WS_HID);
    const int gw = F.vcu * NWAVES + F.wave, NGW = F.G * NWAVES;
    const int tl = F.lane & 15, part = F.lane >> 4;
    for (int wi = gw; wi < DEPTH * 272; wi += NGW) {
        const int l = __builtin_amdgcn_readfirstlane(wi / 272), tt = (wi - l * 272) * 16 + tl;
        const int L = tt < 4096 ? 4096 : 256, t = tt < 4096 ? tt : tt - 4096;
        const float tn = (float)t / (float)L;
        float sb[16], cb[16];
#pragma unroll
        for (int b = 0; b < 16; ++b) { const float ang = (6.2831855f * tn) * (float)(b + 1); sb[b] = sinf(ang); cb[b] = cosf(ang); }
        const float* w1p = F.in[9] + (size_t)l * 33 * 64 + part * 16; const float* b1p = F.in[10] + l * 64 + part * 16;
        const float* w2p = F.in[11] + (size_t)l * 64 * 64 + part * 16; const float* b2p = F.in[12] + l * 64 + part * 16;
        for (int dd = 0; dd < 16; ++dd) { float a = b1p[dd] + tn * w1p[dd];
#pragma unroll
            for (int b = 0; b < 16; ++b) a += sb[b] * w1p[(1 + b) * 64 + dd] + cb[b] * w1p[(17 + b) * 64 + dd];
            h1[(part * 16 + dd) * 16 + tl] = sinf(a); }
        LDS_WAIT();
        float* dst = HID + ((size_t)l * 4352 + tt) * 64 + part * 16;
        float acc[16];
#pragma unroll
        for (int ee = 0; ee < 16; ++ee) acc[ee] = b2p[ee];
        for (int d = 0; d < 64; ++d) { const float hv = h1[d * 16 + tl];
#pragma unroll
            for (int ee = 0; ee < 16; ++ee) acc[ee] += hv * w2p[d * 64 + ee]; }
#pragma unroll
        for (int ee = 0; ee < 16; ee += 4) *(f32x4*)(dst + ee) = (f32x4){sinf(acc[ee]), sinf(acc[ee + 1]), sinf(acc[ee + 2]), sinf(acc[ee + 3])};
        LDS_WAIT();
    }
}
__device__ __forceinline__ void split8(const f32x4 x0, const f32x4 x1, bf16x8& h, bf16x8& l) {
    v4u hw, lw;
    hw.x = cvt_pk_bf16(x0[0], x0[1]); hw.y = cvt_pk_bf16(x0[2], x0[3]); hw.z = cvt_pk_bf16(x1[0], x1[1]); hw.w = cvt_pk_bf16(x1[2], x1[3]);
    lw.x = cvt_pk_bf16(x0[0] - bf_lo(hw.x), x0[1] - bf_hi(hw.x)); lw.y = cvt_pk_bf16(x0[2] - bf_lo(hw.y), x0[3] - bf_hi(hw.y));
    lw.z = cvt_pk_bf16(x1[0] - bf_lo(hw.z), x1[1] - bf_hi(hw.z)); lw.w = cvt_pk_bf16(x1[2] - bf_lo(hw.w), x1[3] - bf_hi(hw.w));
    h = __builtin_bit_cast(bf16x8, hw); l = __builtin_bit_cast(bf16x8, lw);
}
__device__ __forceinline__ void pro_filter(Frame& F) {
    const float* HID = WSP(float, WS_HID); float* PART = WSP(float, WS_PART);
    LAS float* wt = (LAS float*)F.lds;
    LAS float* red = (LAS float*)(F.lds + 16384);
    constexpr float dmin = 3.0701134573253945f, dstep = (15.350567286626973f - 3.0701134573253945f) / 511.0f;
    const int r32 = F.lane & 31, hi = F.lane >> 5;
    for (int item = F.vcu; item < DEPTH * 9 * 4 * 8; item += F.G) {
        int r = item; const int cg = r & 7; r >>= 3; const int od = r & 3; r >>= 2; const int tc = r % 9; const int l = r / 9;
        const int kind = tc == 8 ? 1 : 0, L = kind ? 256 : 4096, tb = (kind ? 0 : tc * 512) + F.wave * 64; const bool active = tb < L;
        const int o = od >> 1, dir = od & 1;
        { const int e = F.tid >> 3, c8 = (F.tid & 7) * 8; const float* src = F.in[13] + (size_t)l * 64 * 2048 + (size_t)e * 2048 + o * 1024 + dir * 512 + cg * 64 + c8;
          const f32x4 a = *(const f32x4*)src, b2 = *(const f32x4*)(src + 4); *(LAS f32x4*)(wt + e * 64 + c8) = a; *(LAS f32x4*)(wt + e * 64 + c8 + 4) = b2; }
        __syncthreads();
        f32x16 acc[2][2];
#pragma unroll
        for (int ct = 0; ct < 2; ++ct)
#pragma unroll
            for (int tt = 0; tt < 2; ++tt) acc[ct][tt] = f32x16{};
        if (active) {
            const float* hrow = HID + ((size_t)l * 4352 + (kind ? 4096 : 0) + tb + r32) * 64 + hi * 8;
#pragma unroll
            for (int ks = 0; ks < 4; ++ks) {
                bf16x8 bh[2], bl[2], ah[2], al[2];
#pragma unroll
                for (int tt = 0; tt < 2; ++tt) { const float* hp = hrow + (size_t)tt * 32 * 64 + ks * 16; split8(*(const f32x4*)hp, *(const f32x4*)(hp + 4), bh[tt], bl[tt]); }
#pragma unroll
                for (int ct = 0; ct < 2; ++ct) { const LAS float* wp = wt + (ks * 16 + hi * 8) * 64 + ct * 32 + r32;
                    const f32x4 x0 = {wp[0], wp[64], wp[128], wp[192]}, x1 = {wp[256], wp[320], wp[384], wp[448]}; split8(x0, x1, ah[ct], al[ct]); }
#pragma unroll
                for (int ct = 0; ct < 2; ++ct)
#pragma unroll
                    for (int tt = 0; tt < 2; ++tt) {
                        acc[ct][tt] = __builtin_amdgcn_mfma_f32_32x32x16_bf16(ah[ct], bh[tt], acc[ct][tt], 0, 0, 0);
                        acc[ct][tt] = __builtin_amdgcn_mfma_f32_32x32x16_bf16(ah[ct], bl[tt], acc[ct][tt], 0, 0, 0);
                        acc[ct][tt] = __builtin_amdgcn_mfma_f32_32x32x16_bf16(al[ct], bh[tt], acc[ct][tt], 0, 0, 0); }
            }
            bf16* gout = kind ? WSP(bf16, WS_GC) + (size_t)l * 512 * 2 * HYLC : WSP(bf16, WS_G) + (size_t)l * 512 * 2 * HYL;
            const int glen = kind ? HYLC : HYL;
            float tnv[2], keep[2]; int idx[2];
#pragma unroll
            for (int tt = 0; tt < 2; ++tt) { const int t = tb + tt * 32 + r32; tnv[tt] = (float)t / (float)L; const bool zero0 = (dir == 1 && t == 0); keep[tt] = zero0 ? 0.f : 1.f; idx[tt] = zero0 ? 0 : (dir == 0 ? L - t : L + t); }
#pragma unroll
            for (int ct = 0; ct < 2; ++ct)
#pragma unroll
                for (int rr = 0; rr < 16; ++rr) { const int cl = ct * 32 + (rr & 3) + 8 * (rr >> 2) + 4 * hi, c = cg * 64 + cl; const float delta = dmin + (float)c * dstep;
                    float asum = 0.f;
#pragma unroll
                    for (int tt = 0; tt < 2; ++tt) { const float v = acc[ct][tt][rr] * __expf(-tnv[tt] * delta) * keep[tt]; gout[((size_t)c * 2 + o) * glen + idx[tt]] = f2bf(v); asum += fabsf(v); }
                    asum += __shfl_xor(asum, 1); asum += __shfl_xor(asum, 2); asum += __shfl_xor(asum, 4); asum += __shfl_xor(asum, 8); asum += __shfl_xor(asum, 16);
                    if (r32 == 0) red[F.wave * 64 + cl] = asum; }
        } else red[F.wave * 64 + F.lane] = 0.f;
        __syncthreads();
        if (F.tid < 64) { float s = 0.f;
#pragma unroll
            for (int w = 0; w < 8; ++w) s += red[w * 64 + F.tid];
            PART[((((size_t)l * 2 + kind) * 2 + o) * 2 + dir) * 8 * 512 + (size_t)(kind ? 0 : tc) * 512 + cg * 64 + F.tid] = s; }
        __syncthreads();
    }
}

__device__ __forceinline__ void norm_pass(Frame& F, int mode, int l, bool dry = false) {
    const float* MOD = WSP(float, WS_MOD); float* X = WSP(float, WS_X); bf16* H = dry ? WSP(bf16, WS_UP) : WSP(bf16, WS_H); const bf16* Y = WSP(bf16, WS_MO); float* XO = dry ? WSP(float, WS_ACT) : X;
    const float* ng = F.in[6];
    const int gw = F.vcu * NWAVES + F.wave, NGW = F.G * NWAVES;
    const bool last = (mode == 2 && l == DEPTH - 1);
    const int co = 4 * F.lane;
    const int nfull = MR / NGW, rem = MR - nfull * NGW, spread = rem > 0 ? NGW / rem : 1;
    const int nmine = nfull + ((rem > 0 && gw % spread == 0 && gw / spread < rem) ? 1 : 0);
    for (int it = 0; it < nmine; ++it) { const int r = it < nfull ? gw + it * NGW : nfull * NGW + gw / spread;
        int b, isctx, t; row_info(r, b, isctx, t); const int which = isctx ? 2 : b;
        f32x4 xv[8];
        if (mode == 0) { const float* src = isctx ? F.in[2] + ((size_t)b * CTXL + t) * DM : F.in[0] + ((size_t)b * SEQ + t) * DM;
#pragma unroll
            for (int j = 0; j < 8; ++j) xv[j] = *(const f32x4*)(src + co + 256 * j);
        } else {
            if (isctx && l == DEPTH - 1) continue;
            const float* src = X + (size_t)r * DM; const bf16* yp = Y + (size_t)r * DM;
            const float* gpost = ng + ((size_t)l * 4 + (mode == 1 ? 1 : 3)) * DM; const float* gate = MOD + ((size_t)l * 3 + which) * (6 * DM) + (mode == 1 ? 2 : 5) * DM;
            f32x4 yv[8], gp[8], gt[8];
#pragma unroll
            for (int j = 0; j < 8; ++j) {
#if X_BF16
                { const v2u xw = __builtin_nontemporal_load((const v2u*)((const bf16*)X + (size_t)r * DM + co + 256 * j)); xv[j] = (f32x4){bf_lo(xw.x), bf_hi(xw.x), bf_lo(xw.y), bf_hi(xw.y)}; }
#else
                xv[j] = __builtin_nontemporal_load((const f32x4*)(src + co + 256 * j));
#endif
                gp[j] = *(const f32x4*)(gpost + co + 256 * j); gt[j] = *(const f32x4*)(gate + co + 256 * j); }
            if (!isctx) { v2u yw[8];
#pragma unroll
                for (int j = 0; j < 8; ++j) yw[j] = __builtin_nontemporal_load((const v2u*)(yp + co + 256 * j));
                __builtin_amdgcn_sched_barrier(0);
#pragma unroll
                for (int j = 0; j < 8; ++j) yv[j] = (f32x4){bf_lo(yw[j].x), bf_hi(yw[j].x), bf_lo(yw[j].y), bf_hi(yw[j].y)};
            } else {
                const float* sp_ = WSP(float, WS_SLAB) + (size_t)(b * CTXL + t) * DM; const int ns = (mode == 1) ? 8 : 11;
#pragma unroll
                for (int j = 0; j < 8; ++j) yv[j] = (f32x4){0.f, 0.f, 0.f, 0.f};
                for (int s = 0; s < ns; ++s) { f32x4 tv[8];
#pragma unroll
                    for (int j = 0; j < 8; ++j) tv[j] = __builtin_nontemporal_load((const f32x4*)(sp_ + (size_t)s * (512 * DM) + co + 256 * j));
                    __builtin_amdgcn_sched_barrier(0);
#pragma unroll
                    for (int j = 0; j < 8; ++j) yv[j] += tv[j]; }
            }
            float ss = 0.f;
#pragma unroll
            for (int j = 0; j < 8; ++j) ss += (yv[j][0] * yv[j][0] + yv[j][1] * yv[j][1]) + (yv[j][2] * yv[j][2] + yv[j][3] * yv[j][3]);
            ss = wave_sum(ss); const float rs = 1.0f / sqrtf(ss * (1.0f / DM) + EPS);
#pragma unroll
            for (int j = 0; j < 8; ++j) xv[j] += gt[j] * (yv[j] * rs * gp[j]);
        }
        if (!last) {
            float* dst = XO + (size_t)r * DM;
#pragma unroll
            for (int j = 0; j < 8; ++j) {
#if X_BF16
                { v2u w; w.x = cvt_pk_bf16(xv[j][0], xv[j][1]); w.y = cvt_pk_bf16(xv[j][2], xv[j][3]); __builtin_nontemporal_store(w, (v2u*)((bf16*)XO + (size_t)r * DM + co + 256 * j)); }
#else
                __builtin_nontemporal_store(xv[j], (f32x4*)(dst + co + 256 * j));
#endif
            }
        } else { if (!isctx) { float* dst = (dry ? XO : F.out) + ((size_t)b * SEQ + t) * DM;
#if PROBE_TIME != -1
            { const unsigned ticks = *(const volatile unsigned*)(F.ws + WS_CTL + 4 * CW_PROBE); const float eps = (PROBE_TIME == -2) ? 0.01f : sqrtf(PROBE_SCALE * (float)ticks);
#pragma unroll
              for (int j = 0; j < 8; ++j) xv[j] += (f32x4){eps, -eps, eps, -eps}; }
#endif
#pragma unroll
            for (int j = 0; j < 8; ++j) *(f32x4*)(dst + co + 256 * j) = xv[j]; }
            continue; }
        const int ln = (mode == 2) ? l + 1 : l; const float* gpre = ng + ((size_t)ln * 4 + (mode == 1 ? 2 : 0)) * DM;
        const float* md = MOD + ((size_t)ln * 3 + which) * (6 * DM); const float* sh = md + (mode == 1 ? 3 : 0) * DM; const float* sc = md + (mode == 1 ? 4 : 1) * DM;
        f32x4 gq[8], s4[8], h4[8];
#pragma unroll
        for (int j = 0; j < 8; ++j) { gq[j] = *(const f32x4*)(gpre + co + 256 * j); s4[j] = *(const f32x4*)(sc + co + 256 * j); h4[j] = *(const f32x4*)(sh + co + 256 * j); }
        __builtin_amdgcn_sched_barrier(0);
        float s2 = 0.f;
#pragma unroll
        for (int j = 0; j < 8; ++j) s2 += (xv[j][0] * xv[j][0] + xv[j][1] * xv[j][1]) + (xv[j][2] * xv[j][2] + xv[j][3] * xv[j][3]);
        s2 = wave_sum(s2); const float rs2 = 1.0f / sqrtf(s2 * (1.0f / DM) + EPS);
        bf16* hp = H + (size_t)r * DM;
#pragma unroll
        for (int j = 0; j < 8; ++j) { const f32x4 hv = (xv[j] * rs2 * gq[j]) * (s4[j] + 1.0f) + h4[j]; v2u w; w.x = cvt_pk_bf16(hv[0], hv[1]); w.y = cvt_pk_bf16(hv[2], hv[3]); *(v2u*)(hp + co + 256 * j) = w; }
    }
}


#if X_BF16
__device__ __forceinline__ void norm_pass_pipe(Frame& F, int mode, int l) {
    const float* MOD = WSP(float, WS_MOD); bf16* X = WSP(bf16, WS_X); bf16* H = WSP(bf16, WS_H); const bf16* Y = WSP(bf16, WS_MO);
    const float* ng = F.in[6];
    const bool last = (mode == 2 && l == DEPTH - 1);
    const int ln = (mode == 2) ? l + 1 : l;
    LAS float* P = (LAS float*)F.lds;
    for (int i = F.tid; i < 3 * DM; i += NTHR) { const int w = i / DM, c = i - w * DM;
        const float gpost = ng[((size_t)l * 4 + (mode == 1 ? 1 : 3)) * DM + c], gate = MOD[((size_t)l * 3 + w) * (6 * DM) + (mode == 1 ? 2 : 5) * DM + c];
        P[(w * 3 + 0) * DM + c] = gate * gpost;
        if (!last) { const float gpre = ng[((size_t)ln * 4 + (mode == 1 ? 2 : 0)) * DM + c]; const float* md = MOD + ((size_t)ln * 3 + w) * (6 * DM);
            P[(w * 3 + 1) * DM + c] = gpre * (1.0f + md[(mode == 1 ? 4 : 1) * DM + c]); P[(w * 3 + 2) * DM + c] = md[(mode == 1 ? 3 : 0) * DM + c]; } }
    __syncthreads();
    const int gw = F.vcu * NWAVES + F.wave, NGW = F.G * NWAVES, co = 4 * F.lane;
    const int nfull = MR / NGW, rem = MR - nfull * NGW, spread = rem > 0 ? NGW / rem : 1;
    const bool bal = (NGW == 2048), cwv = (gw & 3) == 0; const int kq = gw >> 2, oq = gw - kq - 1;
    const bool lastl = (l == DEPTH - 1);
    const int nmine = bal ? (lastl ? 4 : (cwv ? 2 : 5)) : nfull + ((rem > 0 && gw % spread == 0 && gw / spread < rem) ? 1 : 0);
#define NP_LAT(q_) (((q_) >> 12) * SEGB + CTXL + ((q_) & 4095))
#define NP_ROWOF(it_) (bal ? (lastl ? NP_LAT(gw + (it_) * 2048) : cwv ? ((it_) == 0 ? (kq >> 8) * SEGB + (kq & 255) : NP_LAT(kq)) : NP_LAT(512 + oq + (it_) * 1536)) : ((it_) < nfull ? gw + (it_) * NGW : nfull * NGW + gw / spread))
#define NP_PREFETCH(rn_) do { int b_, c_, t_; row_info((rn_), b_, c_, t_); if (!(c_ && l == DEPTH - 1)) { \
        _Pragma("unroll") for (int j = 0; j < 8; ++j) nx[j] = __builtin_nontemporal_load((const v2u*)(X + (size_t)(rn_) * DM + co + 256 * j)); \
        if (!c_) { _Pragma("unroll") for (int j = 0; j < 8; ++j) ny[j] = __builtin_nontemporal_load((const v2u*)(Y + (size_t)(rn_) * DM + co + 256 * j)); } } } while (0)
    v2u nx[8], ny[8];
#pragma unroll
    for (int j = 0; j < 8; ++j) { nx[j] = (v2u){0u, 0u}; ny[j] = (v2u){0u, 0u}; }
    if (nmine > 0) NP_PREFETCH(NP_ROWOF(0));
    for (int it = 0; it < nmine; ++it) { const int r = NP_ROWOF(it);
        v2u cx[8], cy[8];
#pragma unroll
        for (int j = 0; j < 8; ++j) { cx[j] = nx[j]; cy[j] = ny[j]; }
        if (it + 1 < nmine) NP_PREFETCH(NP_ROWOF(it + 1));
        __builtin_amdgcn_sched_barrier(0);
        int b, isctx, t; row_info(r, b, isctx, t); const int which = isctx ? 2 : b;
        if (isctx && l == DEPTH - 1) continue;
        f32x4 xv[8], yv[8];
#pragma unroll
        for (int j = 0; j < 8; ++j) xv[j] = (f32x4){bf_lo(cx[j].x), bf_hi(cx[j].x), bf_lo(cx[j].y), bf_hi(cx[j].y)};
        if (!isctx) {
#pragma unroll
            for (int j = 0; j < 8; ++j) yv[j] = (f32x4){bf_lo(cy[j].x), bf_hi(cy[j].x), bf_lo(cy[j].y), bf_hi(cy[j].y)};
        } else {
            const bf16* sp_ = WSP(bf16, WS_SLAB) + (size_t)(b * CTXL + t) * DM; const int ns = (mode == 1) ? 8 : 11;
#pragma unroll
            for (int j = 0; j < 8; ++j) yv[j] = (f32x4){0.f, 0.f, 0.f, 0.f};
#pragma unroll 1
            for (int s0 = 0; s0 < ns; s0 += 4) { v2u tv[4][8];
#pragma unroll
                for (int q = 0; q < 4; ++q) { const int s = (s0 + q < ns) ? s0 + q : s0;
#pragma unroll
                    for (int j = 0; j < 8; ++j) tv[q][j] = __builtin_nontemporal_load((const v2u*)(sp_ + (size_t)s * (512 * DM) + co + 256 * j)); }
                __builtin_amdgcn_sched_barrier(0);
#pragma unroll
                for (int q = 0; q < 4; ++q) if (s0 + q < ns) {
#pragma unroll
                    for (int j = 0; j < 8; ++j) yv[j] += (f32x4){bf_lo(tv[q][j].x), bf_hi(tv[q][j].x), bf_lo(tv[q][j].y), bf_hi(tv[q][j].y)}; } }
        }
        float ss = 0.f;
#pragma unroll
        for (int j = 0; j < 8; ++j) ss += (yv[j][0] * yv[j][0] + yv[j][1] * yv[j][1]) + (yv[j][2] * yv[j][2] + yv[j][3] * yv[j][3]);
        ss = wave_sum(ss); const float rs = 1.0f / sqrtf(ss * (1.0f / DM) + EPS);
        const LAS float* pw = P + (which * 3) * DM + co;
#pragma unroll
        for (int j = 0; j < 8; ++j) { const f32x4 c1 = *(const LAS f32x4*)(pw + 256 * j); xv[j] += c1 * (yv[j] * rs); }
        if (!last) {
#pragma unroll
            for (int j = 0; j < 8; ++j) { v2u w; w.x = cvt_pk_bf16(xv[j][0], xv[j][1]); w.y = cvt_pk_bf16(xv[j][2], xv[j][3]); __builtin_nontemporal_store(w, (v2u*)(X + (size_t)r * DM + co + 256 * j)); }
        } else { if (!isctx) { float* dst = F.out + ((size_t)b * SEQ + t) * DM;
#if PROBE_TIME != -1
            { const unsigned ticks = *(const volatile unsigned*)(F.ws + WS_CTL + 4 * CW_PROBE); const float eps = (PROBE_TIME == -2) ? 0.01f : sqrtf(PROBE_SCALE * (float)ticks);
#pragma unroll
              for (int j = 0; j < 8; ++j) xv[j] += (f32x4){eps, -eps, eps, -eps}; }
#endif
#pragma unroll
            for (int j = 0; j < 8; ++j) *(f32x4*)(dst + co + 256 * j) = xv[j]; }
            continue; }
        float s2 = 0.f;
#pragma unroll
        for (int j = 0; j < 8; ++j) s2 += (xv[j][0] * xv[j][0] + xv[j][1] * xv[j][1]) + (xv[j][2] * xv[j][2] + xv[j][3] * xv[j][3]);
        s2 = wave_sum(s2); const float rs2 = 1.0f / sqrtf(s2 * (1.0f / DM) + EPS);
        bf16* hp = H + (size_t)r * DM;
#pragma unroll
        for (int j = 0; j < 8; ++j) { const f32x4 c2 = *(const LAS f32x4*)(pw + DM + 256 * j), c3 = *(const LAS f32x4*)(pw + 2 * DM + 256 * j);
            const f32x4 hv = (xv[j] * rs2) * c2 + c3; v2u w; w.x = cvt_pk_bf16(hv[0], hv[1]); w.y = cvt_pk_bf16(hv[2], hv[3]); *(v2u*)(hp + co + 256 * j) = w; }
    }
#undef NP_ROWOF
#undef NP_PREFETCH
    __syncthreads();
}
#endif

__device__ __forceinline__ bool seg_start(int r) { const int j = r % SEGB; return j == 0 || j == CTXL; }
__device__ __forceinline__ void xr_pad_zero(Frame& F) {
    bf16* XR = WSP(bf16, WS_XR);
    for (int i = F.vcu * NTHR + F.tid; i < 2 * 4 * 12 * 16; i += F.G * NTHR) { const int ch = i & 15, pi = (i >> 4) % 12, bb = (i >> 4) / 12;
        const int prow = pi < 3 ? pi : (pi < 9 ? 256 + pi : 4352 + pi);
        unsigned zz = 0u; asm volatile("" : "+v"(zz));
        const v4u z = {zz, zz, zz, zz}; *(v4u*)(XR + ((size_t)bb * XR_ROWS + prow) * 128 + ch * 8) = z; }
}
struct EpiU {
    static constexpr bool PERM = true;
    bf16* U; bf16* UH; bf16* XR; bf16* KR; const float* ROPE; float* SSQ;
    __device__ __forceinline__ void operator()(const f32x4 (&acc)[2][2][4][2], const pg8::Unit& u, int wr, int wc, int fr, int fq) const {
        asm volatile("" : "+v"(fr), "+v"(fq));
        const int row0 = u.pm * 256 + wr * 64 + fr, pn = u.pn;
        if (pn == 13) {
            if (wc == 0) {
#pragma unroll
                for (int ai = 0; ai < 2; ++ai)
#pragma unroll
                    for (int m = 0; m < 4; ++m) { const int row = row0 + ai * 128 + m * 16; int b, isctx, t; row_info(row, b, isctx, t);
#pragma unroll
                        for (int n = 0; n < 2; ++n) { const int i0 = 8 * fq + 4 * n; const f32x4 x1 = acc[ai][0][m][n], x2 = acc[ai][1][m][n];
                            f32x4 cs = {1.f, 1.f, 1.f, 1.f}, sn = {0.f, 0.f, 0.f, 0.f};
                            if (!isctx) { cs = *(const f32x4*)(ROPE + (size_t)t * 64 + i0); sn = *(const f32x4*)(ROPE + (size_t)t * 64 + 32 + i0); }
                            const f32x4 o1 = x1 * cs - x2 * sn, o2 = x2 * cs + x1 * sn;
                            v2u w1, w2; w1.x = cvt_pk_bf16(o1[0], o1[1]); w1.y = cvt_pk_bf16(o1[2], o1[3]); w2.x = cvt_pk_bf16(o2[0], o2[1]); w2.y = cvt_pk_bf16(o2[2], o2[3]);
                            *(v2u*)(KR + (size_t)row * 64 + i0) = w1; *(v2u*)(KR + (size_t)row * 64 + 32 + i0) = w2; }
                        asm volatile("" ::: "memory"); }
            }
            return;
        }
        if (pn == 10 || pn == 11) {
#pragma unroll
            for (int ai = 0; ai < 2; ++ai)
#pragma unroll
                for (int m = 0; m < 4; ++m) { const int row = row0 + ai * 128 + m * 16; const int b = row >= SEGB ? 1 : 0, j = row - b * SEGB, prow = j < CTXL ? 3 + j : j + 9;
#pragma unroll
                    for (int bj = 0; bj < 2; ++bj) { const int blk = 2 * (pn - 10) + bj; const f32x4 v0 = acc[ai][bj][m][0], v1 = acc[ai][bj][m][1];
                        v4u w; w.x = cvt_pk_bf16(v0[0], v0[1]); w.y = cvt_pk_bf16(v0[2], v0[3]); w.z = cvt_pk_bf16(v1[0], v1[1]); w.w = cvt_pk_bf16(v1[2], v1[3]);
                        *(v4u*)(XR + (((size_t)b * 4 + blk) * XR_ROWS + prow) * 128 + wc * 32 + 8 * fq) = w; } }
            return;
        }
        const bool grp = pn < 6, doq = (pn == 8 || pn == 9), dokv = (pn == 12);
        const int col0 = pn * 256 + wc * 32 + 8 * fq, slot = doq ? (pn - 8) * 4 + wc : 8 + wc;
#pragma unroll
        for (int ai = 0; ai < 2; ++ai)
#pragma unroll
            for (int m = 0; m < 4; ++m) { const int row = row0 + ai * 128 + m * 16; bf16* rowp = grp ? UH + ((size_t)(col0 >> 3) * MR + row) * 8 : U + (size_t)row * DINP + col0;
                const size_t bjstep = grp ? (size_t)16 * MR * 8 : (size_t)128; float ss = 0.f;
#pragma unroll
                for (int bj = 0; bj < 2; ++bj) { const f32x4 v0 = acc[ai][bj][m][0], v1 = acc[ai][bj][m][1];
                    ss += (v0[0] * v0[0] + v0[1] * v0[1]) + (v0[2] * v0[2] + v0[3] * v0[3]) + (v1[0] * v1[0] + v1[1] * v1[1]) + (v1[2] * v1[2] + v1[3] * v1[3]);
                    v4u w; w.x = cvt_pk_bf16(v0[0], v0[1]); w.y = cvt_pk_bf16(v0[2], v0[3]); w.z = cvt_pk_bf16(v1[0], v1[1]); w.w = cvt_pk_bf16(v1[2], v1[3]);
                    *(v4u*)(rowp + bj * bjstep) = w; }
                if (doq || dokv) { ss += __shfl_xor(ss, 16); ss += __shfl_xor(ss, 32); if (fq == 0) SSQ[(size_t)row * 12 + slot] = ss; } }
    }
};
__device__ __forceinline__ void conv_gelu(Frame& F, int l) {
    const bf16* UP = WSP(bf16, WS_UP); bf16* ACT = WSP(bf16, WS_ACT);
    const float* cw = F.in[28] + (size_t)l * 3 * 2 * DFF;
    const int gw = F.vcu * NWAVES + F.wave, NGW = F.G * NWAVES;
    for (int wi = gw; wi < (MR / 8) * 11; wi += NGW) {
        const int rc = wi / 11, fc = wi - rc * 11, r0 = rc * 8, f0 = fc * 512 + 8 * F.lane;
        const bool has_prev = !seg_start(r0), has_next = !seg_start(r0 + 8) && (r0 + 8 < MR);
        v4u g[10], v[10];
#pragma unroll
        for (int i = 0; i < 10; ++i) { const int r = r0 - 1 + i; const bool ok = (i == 0) ? has_prev : (i == 9 ? has_next : true);
            g[i] = (v4u){0u, 0u, 0u, 0u}; v[i] = (v4u){0u, 0u, 0u, 0u};
            if (ok) { g[i] = __builtin_nontemporal_load((const v4u*)(UP + (size_t)r * (2 * DFF) + f0)); v[i] = __builtin_nontemporal_load((const v4u*)(UP + (size_t)r * (2 * DFF) + DFF + f0)); } }
        float wg[3][8], wv[3][8];
#pragma unroll
        for (int j = 0; j < 3; ++j) { const f32x4 a = *(const f32x4*)(cw + (size_t)j * 2 * DFF + f0), b2 = *(const f32x4*)(cw + (size_t)j * 2 * DFF + f0 + 4);
            const f32x4 c2 = *(const f32x4*)(cw + (size_t)j * 2 * DFF + DFF + f0), d2 = *(const f32x4*)(cw + (size_t)j * 2 * DFF + DFF + f0 + 4);
#pragma unroll
            for (int q = 0; q < 4; ++q) { wg[j][q] = a[q]; wg[j][4 + q] = b2[q]; wv[j][q] = c2[q]; wv[j][4 + q] = d2[q]; } }
#pragma unroll
        for (int i = 0; i < 8; ++i) { float o[8];
#pragma unroll
            for (int q = 0; q < 4; ++q) {
                const float ga = wg[0][2 * q] * bf_lo(g[i][q]) + wg[1][2 * q] * bf_lo(g[i + 1][q]) + wg[2][2 * q] * bf_lo(g[i + 2][q]);
                const float gb = wg[0][2 * q + 1] * bf_hi(g[i][q]) + wg[1][2 * q + 1] * bf_hi(g[i + 1][q]) + wg[2][2 * q + 1] * bf_hi(g[i + 2][q]);
                const float va = wv[0][2 * q] * bf_lo(v[i][q]) + wv[1][2 * q] * bf_lo(v[i + 1][q]) + wv[2][2 * q] * bf_lo(v[i + 2][q]);
                const float vb = wv[0][2 * q + 1] * bf_hi(v[i][q]) + wv[1][2 * q + 1] * bf_hi(v[i + 1][q]) + wv[2][2 * q + 1] * bf_hi(v[i + 2][q]);
                o[2 * q] = gelu_tanh(ga) * va; o[2 * q + 1] = gelu_tanh(gb) * vb; }
            v4u w; w.x = cvt_pk_bf16(o[0], o[1]); w.y = cvt_pk_bf16(o[2], o[3]); w.z = cvt_pk_bf16(o[4], o[5]); w.w = cvt_pk_bf16(o[6], o[7]);
            *(v4u*)(ACT + (size_t)(r0 + i) * DFF + f0) = w; }
    }
}

__device__ __forceinline__ void mix_heads(Frame& F, int l, int first_wg) {
    const bf16* YT = WSP(bf16, WS_YT); const bf16* O = WSP(bf16, WS_O); bf16* YM = WSP(bf16, WS_YMIX);
    const float* hg = F.in[25] + (size_t)l * DMIX;
    const bool only_free = (first_wg > 0 && F.G - first_wg >= 64);
    if (only_free && F.vcu < first_wg) return;
    const int gw = only_free ? (F.vcu - first_wg) * NWAVES + F.wave : ((F.vcu + F.G - first_wg % F.G) % F.G) * NWAVES + F.wave, NGW = only_free ? (F.G - first_wg) * NWAVES : F.G * NWAVES;
    LAS bf16* st = (LAS bf16*)(F.lds + F.wave * 16384);
    constexpr int NHY = (MR / 32) * 4, NLR = 0, NAT = (MR / 64) * 8;
    for (int wi = gw; wi < NHY + NLR + NAT; wi += NGW) {
        if (wi < NHY) {
            const int rt = wi >> 2, hd = wi & 3, r0 = rt * 32, cs = F.lane >> 2, rc = F.lane & 3;
            const bf16* src = YT + (size_t)(hd * 128 + cs) * MR + r0 + 8 * rc;
            v4u v[8]; float ss[8], gv[8];
#pragma unroll
            for (int k = 0; k < 8; ++k) ss[k] = 0.f;
#pragma unroll
            for (int i = 0; i < 8; ++i) { v[i] = *(const v4u*)(src + (size_t)(16 * i) * MR); gv[i] = hg[hd * 128 + 16 * i + cs]; }
            __builtin_amdgcn_sched_barrier(0);
#pragma unroll
            for (int i = 0; i < 8; ++i) {
#pragma unroll
                for (int k = 0; k < 4; ++k) { const float a = bf_lo(v[i][k]), b2 = bf_hi(v[i][k]); ss[2 * k] += a * a; ss[2 * k + 1] += b2 * b2; } }
#pragma unroll
            for (int k = 0; k < 8; ++k) { float s = ss[k]; s += __shfl_xor(s, 4); s += __shfl_xor(s, 8); s += __shfl_xor(s, 16); s += __shfl_xor(s, 32); ss[k] = 1.0f / sqrtf(s * (1.0f / 128.0f) + EPS); }
#pragma unroll
            for (int i = 0; i < 8; ++i) { const int c = 16 * i + cs; const float g = gv[i];
#pragma unroll
                for (int k = 0; k < 4; ++k) { st[(8 * rc + 2 * k) * 130 + c] = f2bf(bf_lo(v[i][k]) * ss[2 * k] * g); st[(8 * rc + 2 * k + 1) * 130 + c] = f2bf(bf_hi(v[i][k]) * ss[2 * k + 1] * g); } }
            LDS_WAIT();
#pragma unroll 8
            for (int row = 0; row < 32; ++row) { const unsigned w = *(const LAS unsigned*)(st + row * 130 + 2 * F.lane);
                *(unsigned*)(YM + (size_t)(r0 + row) * DMIX + hd * 128 + 2 * F.lane) = w; }
            LDS_WAIT();
        } else {
            const int w2 = wi - NHY - NLR, rt = w2 >> 3, hd = w2 & 7, r0 = rt * 64, q = F.lane & 3;
            const float* g = hg + (8 + hd) * 128 + q * 32;
            v4u v[4][4]; f32x4 g0[4], g1[4];
#pragma unroll
            for (int ps = 0; ps < 4; ++ps) { const int row = r0 + ps * 16 + (F.lane >> 2); const bf16* src = O + (size_t)row * (NH * VD) + hd * 128 + q * 32;
#pragma unroll
                for (int j = 0; j < 4; ++j) v[ps][j] = *(const v4u*)(src + 8 * j); }
#pragma unroll
            for (int j = 0; j < 4; ++j) { g0[j] = *(const f32x4*)(g + 8 * j); g1[j] = *(const f32x4*)(g + 8 * j + 4); }
            __builtin_amdgcn_sched_barrier(0);
#pragma unroll
            for (int ps = 0; ps < 4; ++ps) { const int row = r0 + ps * 16 + (F.lane >> 2); float ss = 0.f;
#pragma unroll
                for (int j = 0; j < 4; ++j)
#pragma unroll
                    for (int k = 0; k < 4; ++k) { const float a = bf_lo(v[ps][j][k]), b2 = bf_hi(v[ps][j][k]); ss += a * a + b2 * b2; }
                ss += __shfl_xor(ss, 1); ss += __shfl_xor(ss, 2); const float rs = 1.0f / sqrtf(ss * (1.0f / 128.0f) + EPS);
                bf16* dst = YM + (size_t)row * DMIX + (8 + hd) * 128 + q * 32;
#pragma unroll
                for (int j = 0; j < 4; ++j) {
                    v4u w; w.x = cvt_pk_bf16(bf_lo(v[ps][j][0]) * rs * g0[j][0], bf_hi(v[ps][j][0]) * rs * g0[j][1]); w.y = cvt_pk_bf16(bf_lo(v[ps][j][1]) * rs * g0[j][2], bf_hi(v[ps][j][1]) * rs * g0[j][3]);
                    w.z = cvt_pk_bf16(bf_lo(v[ps][j][2]) * rs * g1[j][0], bf_hi(v[ps][j][2]) * rs * g1[j][1]); w.w = cvt_pk_bf16(bf_lo(v[ps][j][3]) * rs * g1[j][2], bf_hi(v[ps][j][3]) * rs * g1[j][3]); *(v4u*)(dst + 8 * j) = w; } }
        }
    }
}

namespace att {
constexpr int NW = 8, QBLK = 32, KVBLK = 64;
constexpr float SCALE = 0.07216878364870323f;
constexpr float THR = 8.f;
constexpr int LDQ = DQ, LDK = DKV, LDR = ROPED, LDO = NH * VD;
constexpr int SHM_V = KVBLK * 128 * 2, SHM_K = KVBLK * 128 * 2, SHM_R = KVBLK * 64 * 2;
constexpr int OFF_V = 0, OFF_K = 2 * SHM_V, OFF_R = OFF_K + 2 * SHM_K, OFF_WS = OFF_R + 2 * SHM_R, OFF_QR = OFF_WS + NW * 64 * 4, SHM_ATTN = OFF_QR + NW * 4096;
#define KSWZ(row, colB) ((row) * 256 + ((colB) ^ (((row) & 15) << 4)))
#define RSWZ(row, colB) ((row) * 128 + ((colB) ^ ((((row) >> 1) & 7) << 4)))
#define SBAR() __builtin_amdgcn_sched_barrier(0)
__device__ __forceinline__ int crow(int r, int hi) { return (r & 3) + 8 * (r >> 2) + 4 * hi; }
template <bool FIRST> __device__ __forceinline__ void partialSM(f32x16& p0, f32x16& p1, float& m_reg, float& alpha) {
  constexpr float THRL = THR * 1.4426950408889634f;
  float pmax = p0[0]; for (int r = 1; r < 16; ++r) pmax = fmaxf(pmax, p0[r]); for (int r = 0; r < 16; ++r) pmax = fmaxf(pmax, p1[r]);
  { auto rr = __builtin_amdgcn_permlane32_swap(__float_as_uint(pmax), __float_as_uint(pmax), false, false);
    pmax = fmaxf(__uint_as_float(rr[0]), __uint_as_float(rr[1])); }
  if (!FIRST && __builtin_expect(__all(pmax <= THRL), 1)) { alpha = 1.f; }
  else { const float d = FIRST ? pmax : fmaxf(pmax, 0.f); alpha = FIRST ? 1.f : __builtin_amdgcn_exp2f(-d); m_reg += d;
    for (int r = 0; r < 16; ++r) p0[r] -= d; for (int r = 0; r < 16; ++r) p1[r] -= d; }
  for (int r = 0; r < 16; ++r) p0[r] = __builtin_amdgcn_exp2f(p0[r]);
}
__device__ __forceinline__ void finishSM(f32x16& p0, f32x16& p1, bf16x8& pa0, bf16x8& pa1, bf16x8& pa2, bf16x8& pa3) {
  for (int r = 0; r < 16; ++r) p1[r] = __builtin_amdgcn_exp2f(p1[r]);
#define PK4(P, BASE, OUT) do { unsigned a0 = cvt_pk_bf16(P[BASE + 0], P[BASE + 1]), a1 = cvt_pk_bf16(P[BASE + 2], P[BASE + 3]);   \
    unsigned b0 = cvt_pk_bf16(P[BASE + 4], P[BASE + 5]), b1 = cvt_pk_bf16(P[BASE + 6], P[BASE + 7]);                              \
    auto r0 = __builtin_amdgcn_permlane32_swap(a0, b0, false, false); auto r1 = __builtin_amdgcn_permlane32_swap(a1, b1, false, false); \
    v4u w = {r0[0], r1[0], r0[1], r1[1]}; OUT = *reinterpret_cast<bf16x8*>(&w); } while (0)
  PK4(p0, 0, pa0); PK4(p0, 8, pa1); PK4(p1, 0, pa2); PK4(p1, 8, pa3);
#undef PK4
}
__device__ __forceinline__ void qkt(f32x16& p0, f32x16& p1, const LAS char* Ks, const LAS char* Rs, const bf16x8* qr, const LAS char* qrl, int r32, int hi, float negm) {
  for (int r = 0; r < 16; ++r) { p0[r] = negm; p1[r] = negm; }
#pragma unroll
  for (int d0 = 0; d0 < 8; ++d0) { const int cb = (d0 * 16 + hi * 8) * 2;
    bf16x8 b0 = *(const LAS bf16x8*)(Ks + KSWZ(r32, cb));
    bf16x8 b1 = *(const LAS bf16x8*)(Ks + KSWZ(32 + r32, cb));
    p0 = __builtin_amdgcn_mfma_f32_32x32x16_bf16(b0, qr[d0], p0, 0, 0, 0);
    p1 = __builtin_amdgcn_mfma_f32_32x32x16_bf16(b1, qr[d0], p1, 0, 0, 0); }
#pragma unroll
  for (int d0 = 0; d0 < 4; ++d0) { const int cb = (d0 * 16 + hi * 8) * 2;
    bf16x8 b0 = *(const LAS bf16x8*)(Rs + RSWZ(r32, cb));
    bf16x8 b1 = *(const LAS bf16x8*)(Rs + RSWZ(32 + r32, cb));
    const bf16x8 qf = *(const LAS bf16x8*)(qrl + d0 * 1024);
    p0 = __builtin_amdgcn_mfma_f32_32x32x16_bf16(b0, qf, p0, 0, 0, 0);
    p1 = __builtin_amdgcn_mfma_f32_32x32x16_bf16(b1, qf, p1, 0, 0, 0); }
}
__device__ __forceinline__ int v_st(int k, int c) { const int kk = (k & ~0xC) | ((k & 4) << 1) | ((k & 8) >> 1); return ((kk >> 3) * 4 + (c >> 5)) * 512 + ((kk & 7) * 32 + (c & 31)) * 2; }
__device__ __forceinline__ int v_rd_base(int lane) { return ((lane & 3) << 3) | (((lane >> 2) & 3) << 6) | (((lane >> 4) & 1) << 5) | (((lane >> 5) & 1) << 8); }
constexpr int v_rd_off(int d0, int ks, int half) { return d0 * 512 + ks * 4096 + half * 2048; }
template <int OFF> __device__ __forceinline__ s16x4 tr_read(int vb) {
  s16x4 r; asm volatile("ds_read_b64_tr_b16 %0, %1 offset:%2" : "=&v"(r) : "v"(vb), "i"(OFF) : "memory"); return r;
}
template <int D0> __device__ __forceinline__ void pv_one(f32x16& od, int vb, bf16x8 pa0, bf16x8 pa1, bf16x8 pa2, bf16x8 pa3) {
  const s16x4 l0 = tr_read<v_rd_off(D0, 0, 0)>(vb), h0 = tr_read<v_rd_off(D0, 0, 1)>(vb), l1 = tr_read<v_rd_off(D0, 1, 0)>(vb), h1 = tr_read<v_rd_off(D0, 1, 1)>(vb);
  const s16x4 l2 = tr_read<v_rd_off(D0, 2, 0)>(vb), h2 = tr_read<v_rd_off(D0, 2, 1)>(vb), l3 = tr_read<v_rd_off(D0, 3, 0)>(vb), h3 = tr_read<v_rd_off(D0, 3, 1)>(vb);
  asm volatile("s_waitcnt lgkmcnt(0)" ::: "memory"); SBAR();
#define PK(L, H) (bf16x8){L[0], L[1], L[2], L[3], H[0], H[1], H[2], H[3]}
  od = __builtin_amdgcn_mfma_f32_32x32x16_bf16(pa0, PK(l0, h0), od, 0, 0, 0);
  od = __builtin_amdgcn_mfma_f32_32x32x16_bf16(pa1, PK(l1, h1), od, 0, 0, 0);
  od = __builtin_amdgcn_mfma_f32_32x32x16_bf16(pa2, PK(l2, h2), od, 0, 0, 0);
  od = __builtin_amdgcn_mfma_f32_32x32x16_bf16(pa3, PK(l3, h3), od, 0, 0, 0);
#undef PK
}
__device__ __forceinline__ void pv_d0(f32x16* o, int vb, bf16x8 pa0, bf16x8 pa1, bf16x8 pa2, bf16x8 pa3) {
  pv_one<0>(o[0], vb, pa0, pa1, pa2, pa3); pv_one<1>(o[1], vb, pa0, pa1, pa2, pa3); pv_one<2>(o[2], vb, pa0, pa1, pa2, pa3); pv_one<3>(o[3], vb, pa0, pa1, pa2, pa3);
  const bf16x8 ones = __builtin_bit_cast(bf16x8, (v4u){0x3f803f80u, 0x3f803f80u, 0x3f803f80u, 0x3f803f80u});
  o[4] = __builtin_amdgcn_mfma_f32_32x32x16_bf16(pa0, ones, o[4], 0, 0, 0); o[4] = __builtin_amdgcn_mfma_f32_32x32x16_bf16(pa1, ones, o[4], 0, 0, 0);
  o[4] = __builtin_amdgcn_mfma_f32_32x32x16_bf16(pa2, ones, o[4], 0, 0, 0); o[4] = __builtin_amdgcn_mfma_f32_32x32x16_bf16(pa3, ones, o[4], 0, 0, 0);
}
__device__ __forceinline__ void attn_body(const bf16* __restrict__ Qb, const bf16* __restrict__ Kh, const bf16* __restrict__ Vh, const bf16* __restrict__ Rh,
                                          bf16* __restrict__ Ob, int seq, const float* rope_tab, LAS char* lds) {
  int tid = threadIdx.x; asm volatile("" : "+v"(tid));
  const int wid = __builtin_amdgcn_readfirstlane(tid >> 6), lane = tid & 63, r32 = lane & 31, hi = lane >> 5;
  LAS char* V_lds = lds + OFF_V; LAS char* K_lds = lds + OFF_K; LAS char* R_lds = lds + OFF_R;
  LAS float* ws = (LAS float*)(lds + OFF_WS) + wid * 64; LAS float* al_l = ws + 32;
  float zf = 0.f; asm volatile("" : "+v"(zf));
  float m_reg = zf; f32x16 o[5]; bf16x8 qr[12];
#pragma unroll
  for (int d = 0; d < 5; ++d)
#pragma unroll
    for (int r = 0; r < 16; ++r) o[d][r] = zf;
  LAS char* qrl = lds + OFF_QR + wid * 4096 + lane * 16;
  const bf16* Qw = Qb + (long)(wid * QBLK + r32) * LDQ + hi * 8;
#pragma unroll
  for (int d0 = 0; d0 < 12; ++d0) qr[d0] = *reinterpret_cast<const bf16x8*>(Qw + d0 * 16);
  if (rope_tab) {
    const float* rt = rope_tab + (long)(wid * QBLK + r32) * 64;
#pragma unroll
    for (int p = 0; p < 2; ++p) {
      const float* cs = rt + p * 16 + hi * 8; const f32x4 c0 = *(const f32x4*)cs, c1 = *(const f32x4*)(cs + 4), s0 = *(const f32x4*)(cs + 32), s1 = *(const f32x4*)(cs + 36);
      const v4u x1 = *reinterpret_cast<v4u*>(&qr[8 + p]), x2 = *reinterpret_cast<v4u*>(&qr[10 + p]); v4u y1, y2;
#pragma unroll
      for (int k = 0; k < 4; ++k) { const float ca = k < 2 ? c0[2 * k] : c1[2 * k - 4], cbv = k < 2 ? c0[2 * k + 1] : c1[2 * k - 3], sa = k < 2 ? s0[2 * k] : s1[2 * k - 4], sb = k < 2 ? s0[2 * k + 1] : s1[2 * k - 3];
        const float a1 = bf_lo(x1[k]), b1 = bf_hi(x1[k]), a2 = bf_lo(x2[k]), b2 = bf_hi(x2[k]);
        y1[k] = cvt_pk_bf16(a1 * ca - a2 * sa, b1 * cbv - b2 * sb); y2[k] = cvt_pk_bf16(a2 * ca + a1 * sa, b2 * cbv + b1 * sb); }
      qr[8 + p] = *reinterpret_cast<bf16x8*>(&y1); qr[10 + p] = *reinterpret_cast<bf16x8*>(&y2); }
  }
#pragma unroll
  for (int d0 = 0; d0 < 4; ++d0) *(LAS bf16x8*)(qrl + d0 * 1024) = qr[8 + d0];
  const int sr = tid >> 4, sc = (tid & 15) * 8, vst0 = v_st(sr, sc), vst1 = v_st(32 + sr, sc);
  const int rr_ = tid >> 3, rc_ = (tid & 7) * 8;
  const int vb0 = (int)(uintptr_t)V_lds + v_rd_base(lane);
  constexpr int SDEPTH = 1;
  struct { bf16x8 vs0, vs1, ks0, ks1, rs; } sr_[SDEPTH];
  const unsigned offk0 = (unsigned)(sr * LDK + sc), offk1 = (unsigned)((32 + sr) * LDK + sc), offr = (unsigned)(rr_ * LDR + rc_);
#define SLOAD(i, k0) do { const bf16* vt_ = Vh + (size_t)(k0) * LDK; const bf16* kt_ = Kh + (size_t)(k0) * LDK; const bf16* rt_ = Rh + (size_t)(k0) * LDR; \
    sr_[i].vs0 = *(const bf16x8*)(vt_ + offk0); sr_[i].vs1 = *(const bf16x8*)(vt_ + offk1); \
    sr_[i].ks0 = *(const bf16x8*)(kt_ + offk0); sr_[i].ks1 = *(const bf16x8*)(kt_ + offk1); \
    sr_[i].rs = *(const bf16x8*)(rt_ + offr); } while (0)
#define SWRITE(b, i) do { *(LAS bf16x8*)(V_lds + (b) * SHM_V + vst0) = sr_[i].vs0;          \
    *(LAS bf16x8*)(V_lds + (b) * SHM_V + vst1) = sr_[i].vs1; int kc = sc * 2;               \
    *(LAS bf16x8*)(K_lds + (b) * SHM_K + KSWZ(sr, kc)) = sr_[i].ks0;                       \
    *(LAS bf16x8*)(K_lds + (b) * SHM_K + KSWZ(32 + sr, kc)) = sr_[i].ks1;                  \
    *(LAS bf16x8*)(R_lds + (b) * SHM_R + RSWZ(rr_, rc_ * 2)) = sr_[i].rs; } while (0)
#define SWAIT() do { if constexpr (SDEPTH == 2) asm volatile("s_waitcnt vmcnt(5)" ::: "memory"); else asm volatile("s_waitcnt vmcnt(0)" ::: "memory"); } while (0)
#define RESC(a) do { if (__any((a) < 1.f)) { if (hi == 0) al_l[r32] = (a); asm volatile("s_waitcnt lgkmcnt(0)" ::: "memory"); \
    for (int d = 0; d < 5; ++d) for (int r = 0; r < 16; ++r) o[d][r] *= al_l[crow(r, hi)]; } } while (0)
  f32x16 pA0, pA1, pB0, pB1; float alA, alB; bf16x8 pa0, pa1, pa2, pa3; const int NT = seq / KVBLK;
  constexpr int SE = 0, SO = SDEPTH - 1;
  SLOAD(SE, 0); asm volatile("s_waitcnt vmcnt(0)" ::: "memory"); SWRITE(0, SE); __syncthreads();
  qkt(pA0, pA1, K_lds, R_lds, qr, qrl, r32, hi, -m_reg); partialSM<true>(pA0, pA1, m_reg, alA);
  SLOAD(SO, KVBLK); if constexpr (SDEPTH == 2) { if (2 < NT) SLOAD(SE, 2 * KVBLK); }
  SWAIT(); SWRITE(1, SO); __syncthreads();
  for (int j = 1; j + 1 < NT; j += 2) {
    SBAR(); qkt(pB0, pB1, K_lds + SHM_K, R_lds + SHM_R, qr, qrl, r32, hi, -m_reg);
    finishSM(pA0, pA1, pa0, pa1, pa2, pa3); SBAR();
    SLOAD(SO, (j + SDEPTH) * KVBLK); SBAR();
    pv_d0(o, vb0, pa0, pa1, pa2, pa3); partialSM<false>(pB0, pB1, m_reg, alB);
    __syncthreads(); SWAIT(); SWRITE(0, SE);
    RESC(alB); __syncthreads();
    SBAR(); qkt(pA0, pA1, K_lds, R_lds, qr, qrl, r32, hi, -m_reg);
    finishSM(pB0, pB1, pa0, pa1, pa2, pa3); SBAR();
    if (SDEPTH == 1 || j + 3 < NT) SLOAD(SE, (j + 1 + SDEPTH) * KVBLK); SBAR();
    pv_d0(o, vb0 + SHM_V, pa0, pa1, pa2, pa3); partialSM<false>(pA0, pA1, m_reg, alA);
    __syncthreads(); SWAIT(); SWRITE(1, SO);
    RESC(alA); __syncthreads();
  }
  SBAR(); qkt(pB0, pB1, K_lds + SHM_K, R_lds + SHM_R, qr, qrl, r32, hi, -m_reg);
  finishSM(pA0, pA1, pa0, pa1, pa2, pa3); SBAR();
  pv_d0(o, vb0, pa0, pa1, pa2, pa3); partialSM<false>(pB0, pB1, m_reg, alB);
  __syncthreads(); RESC(alB);
  finishSM(pB0, pB1, pa0, pa1, pa2, pa3); SBAR();
  pv_d0(o, vb0 + SHM_V, pa0, pa1, pa2, pa3);
  float rli[16];
#pragma unroll
  for (int r = 0; r < 16; ++r) rli[r] = __builtin_amdgcn_rcpf(o[4][r]);
  bf16* Ow = Ob + (long)(wid * QBLK) * LDO;
#pragma unroll
  for (int r = 0; r < 16; ++r) { const int orow = crow(r, hi);
#pragma unroll
    for (int d0 = 0; d0 < 4; ++d0) Ow[(long)orow * LDO + d0 * 32 + r32] = f2bf(o[d0][r] * rli[r]); }
  __syncthreads();
#undef SLOAD
#undef SWRITE
#undef SWAIT
#undef RESC
}
}

__device__ __forceinline__ void attn_phase(Frame& F, bool need_ctx) {
    const bf16* Q = WSP(bf16, WS_Q); const bf16* KV = WSP(bf16, WS_KV); const bf16* KR = WSP(bf16, WS_KR); bf16* O = WSP(bf16, WS_O); const float* ROPE = WSP(float, WS_ROPE);
    const int nunits = 256 + (need_ctx ? 16 : 0);
    for (int u = F.vcu; u < nunits; u += F.G) {
        if (u < 256) { const int b = u >> 7, h = (u >> 4) & 7, qb = u & 15; const size_t kb = (size_t)b * SEGB, row0 = kb + CTXL + qb * 256;
            att::attn_body(Q + row0 * DQ + h * 192, KV + kb * DKV + h * 256, KV + kb * DKV + h * 256 + 128, KR + kb * ROPED, O + row0 * (NH * VD) + h * 128, SEGB, ROPE + (size_t)qb * 256 * 64, (LAS char*)F.lds);
        } else { const int b = (u - 256) >> 3, h = (u - 256) & 7; const size_t kb = (size_t)b * SEGB;
            att::attn_body(Q + kb * DQ + h * 192, KV + kb * DKV + h * 256, KV + kb * DKV + h * 256 + 128, KR + kb * ROPED, O + kb * (NH * VD) + h * 128, CTXL, nullptr, (LAS char*)F.lds);
        }
    }
}


struct LruAB {
    static constexpr bool VARK = false;
    const bf16* XR; const bf16* Bt; int lda, ldb;
    __device__ __forceinline__ static int prow0(int pm) { const int jt = pm % 17; return jt == 0 ? 3 : 265 + (jt - 1) * 256; }
    __device__ __forceinline__ const char* a_base(const pg8::Unit& u) const { const int b = u.pm / 17, dir = u.pn >> 2, blk = u.pn & 3;
        return (const char*)(XR + (((size_t)b * 4 + blk) * XR_ROWS + prow0(u.pm) - (dir ? 0 : 3)) * 128); }
    __device__ __forceinline__ const char* b_base(const pg8::Unit& u) const { return (const char*)(Bt + (size_t)u.pn * 256 * 512); }
};
struct EpiGate {
    static constexpr bool PERM = true;
    const bf16* XR; unsigned* AB; const float* ba; const float* bx; const float* sp; const float* cw;
    __device__ __forceinline__ void operator()(const f32x4 (&acc)[2][2][4][2], const pg8::Unit& u, int wr, int wc, int fr, int fq) const {
        asm volatile("" : "+v"(fr), "+v"(fq));
        const int dir = u.pn >> 2, blk = u.pn & 3, b = u.pm / 17, p0 = LruAB::prow0(u.pm);
        const bf16* xb = XR + ((size_t)b * 4 + blk) * XR_ROWS * 128;
        unsigned* abb = AB + (size_t)dir * MR * LRUC;
#pragma unroll 1
        for (int n = 0; n < 2; ++n) { const int cl = wc * 32 + 8 * fq + 4 * n, ch = blk * 128 + cl;
            const f32x4 ba4 = *(const f32x4*)(ba + dir * LRUC + ch), bx4 = *(const f32x4*)(bx + dir * LRUC + ch), sp4 = *(const f32x4*)(sp + dir * LRUC + ch) * -8.0f;
            f32x4 cw4[4];
#pragma unroll
            for (int j = 0; j < 4; ++j) cw4[j] = *(const f32x4*)(cw + ((size_t)dir * 4 + j) * LRUC + ch);
#pragma unroll
            for (int ai = 0; ai < 2; ++ai) {
                v2u xw[4][4];
#pragma unroll
                for (int m = 0; m < 4; ++m) { const int pr = p0 + ai * 128 + wr * 64 + m * 16 + fr + (dir ? 0 : -3);
#pragma unroll
                    for (int j = 0; j < 4; ++j) xw[m][j] = *(const v2u*)(xb + (unsigned)((pr + j) * 128 + cl)); }
                __builtin_amdgcn_sched_barrier(0);
#pragma unroll
                for (int m = 0; m < 4; ++m) { const int rl = ai * 128 + wr * 64 + m * 16 + fr, row = u.pm * 256 + rl;
                    f32x4 xc = {0.f, 0.f, 0.f, 0.f};
#pragma unroll
                    for (int j = 0; j < 4; ++j) { const v2u w = xw[m][j]; xc[0] += cw4[j][0] * bf_lo(w.x); xc[1] += cw4[j][1] * bf_hi(w.x); xc[2] += cw4[j][2] * bf_lo(w.y); xc[3] += cw4[j][3] * bf_hi(w.y); }
                    const f32x4 rp = (n == 0 ? acc[ai][0][m][0] : acc[ai][0][m][1]) + ba4, ip = (n == 0 ? acc[ai][1][m][0] : acc[ai][1][m][1]) + bx4;
                    v4u o;
#pragma unroll
                    for (int j = 0; j < 4; ++j) { const float rg = sigmoidf_(rp[j]), ig = sigmoidf_(ip[j]); const float la = rg * sp4[j];
                        const float x = 2.0f * la;
                        const float ser = -x * (1.0f + x * (0.5f + x * (0.16666667f + x * (0.041666668f + x * (0.008333334f + x * 0.0013888889f)))));
                        const float om = (x > -0.25f) ? ser : (1.0f - __expf(x));
                        const float bb = __builtin_amdgcn_sqrtf(om) * (ig * xc[j]); o[j] = cvt_pk_bf16(la, bb); }
                    *(v4u*)(abb + (unsigned)(row * LRUC + ch)) = o; }
                asm volatile("" ::: "memory"); }
        }
    }
};
__device__ __forceinline__ void lru_pass1(Frame& F) {
    const unsigned* AB = WSP(unsigned, WS_AB); f32x2* CARRY = WSP(f32x2, WS_CARRY);
    const int gw = ((F.vcu + F.G - 80 % F.G) % F.G) * NWAVES + F.wave, NGW = F.G * NWAVES;
    for (int wi = gw; wi < 2 * NCHUNK * 8; wi += NGW) {
        const int chg = wi & 7, cg = (wi >> 3) % NCHUNK, dir = wi / (8 * NCHUNK), ch = chg * 64 + F.lane;
        const unsigned* base = AB + ((size_t)dir * MR + cg * 64) * LRUC + ch;
        float h = 0.f, S = 0.f;
        unsigned wv[64];
#pragma unroll
        for (int i = 0; i < 64; ++i) { const int rr = dir ? 63 - i : i; wv[i] = base[(size_t)rr * LRUC]; }
        __builtin_amdgcn_sched_barrier(0);
#pragma unroll
        for (int i = 0; i < 64; ++i) { const float la = bf_lo(wv[i]); h = __expf(la) * h + bf_hi(wv[i]); S += la; }
        CARRY[((size_t)dir * NCHUNK + cg) * LRUC + ch] = (f32x2){__expf(S), h};
    }
}
__device__ __forceinline__ void lru_pass2(Frame& F) {
    const unsigned* AB = WSP(unsigned, WS_AB); const f32x2* CARRY = WSP(f32x2, WS_CARRY); const bf16* U = WSP(bf16, WS_U); float* YL = WSP(float, WS_YL);
    const int gw = F.vcu * NWAVES + F.wave, NGW = F.G * NWAVES;
    for (int wi = gw; wi < NCHUNK * 8; wi += NGW) {
        const int chg = wi & 7, cg = wi >> 3, b = cg / 68, jc = cg - b * 68, ch = chg * 64 + F.lane;
        float hf = 0.f, hb = 0.f;
        const f32x2* cf = CARRY + ((size_t)0 * NCHUNK + b * 68) * LRUC + ch; const f32x2* cbk = CARRY + ((size_t)1 * NCHUNK + b * 68) * LRUC + ch;
        for (int k = 0; k < jc; ++k) { const f32x2 c = cf[(size_t)k * LRUC]; hf = c.x * hf + c.y; }
        if (jc < 4) { for (int k = 3; k > jc; --k) { const f32x2 c = cbk[(size_t)k * LRUC]; hb = c.x * hb + c.y; } }
        else { for (int k = 3; k >= 0; --k) { const f32x2 c = cbk[(size_t)k * LRUC]; hb = c.x * hb + c.y; }
               for (int k = 67; k > jc; --k) { const f32x2 c = cbk[(size_t)k * LRUC]; hb = c.x * hb + c.y; } }
        float hfv[64];
        const unsigned* bf_ = AB + ((size_t)0 * MR + cg * 64) * LRUC + ch; const unsigned* bb_ = AB + ((size_t)1 * MR + cg * 64) * LRUC + ch;
#pragma unroll
        for (int i = 0; i < 64; ++i) { const unsigned w = bf_[(size_t)i * LRUC]; hf = __expf(bf_lo(w)) * hf + bf_hi(w); hfv[i] = hf; }
#pragma unroll
        for (int i = 63; i >= 0; --i) { const unsigned w = bb_[(size_t)i * LRUC]; hb = __expf(bf_lo(w)) * hb + bf_hi(w); const size_t row = (size_t)cg * 64 + i;
            const float g = bf2f(U[row * DINP + OFF_LRU_G + ch]); YL[row * LRUC + ch] = gelu_tanh(g) * (hfv[i] + hb); }
    }
}

#if PROBE_TIME >= 0
#define PROBE_SPLIT(ty) do { xcd_barrier(bar); if (blockIdx.x == 0 && F.tid == 0) { const unsigned t_ = (unsigned)__builtin_amdgcn_s_memrealtime(); if ((ty) == PROBE_TIME) MISCP[17] += t_ - MISCP[16]; MISCP[16] = t_; } } while (0)
#else
#define PROBE_SPLIT(ty) do { } while (0)
#endif
__device__ __forceinline__ void mix_heads(Frame& F, int l, int first_wg);
__device__ __forceinline__ void lru2_finalize(Frame& F, int l, const XcdBarrier& bar, volatile LAS unsigned* MISCP) {
    const unsigned* AB = WSP(unsigned, WS_AB); const f32x2* CARRY = WSP(f32x2, WS_CARRY); const bf16* U = WSP(bf16, WS_U); bf16* YM = WSP(bf16, WS_YMIX);
    const float* hg = F.in[25] + (size_t)l * DMIX;
    LAS bf16* yt = (LAS bf16*)F.lds;
    for (int cg = F.vcu; cg < NCHUNK; cg += F.G) {
        const int b = cg / 68, jc = cg - b * 68, ch = F.wave * 64 + F.lane;
        float hf = 0.f, hb = 0.f;
        const f32x2* cf = CARRY + ((size_t)0 * NCHUNK + b * 68) * LRUC + ch; const f32x2* cbk = CARRY + ((size_t)1 * NCHUNK + b * 68) * LRUC + ch;
        { int k = 0;
          for (; k + 8 <= jc; k += 8) { f32x2 c[8];
#pragma unroll
              for (int q = 0; q < 8; ++q) c[q] = cf[(size_t)(k + q) * LRUC];
#pragma unroll
              for (int q = 0; q < 8; ++q) hf = c[q].x * hf + c[q].y; }
          for (; k < jc; ++k) { const f32x2 c = cf[(size_t)k * LRUC]; hf = c.x * hf + c.y; } }
        {
          const int pos = jc < 4 ? 3 - jc : 71 - jc; int p = 0;
          for (; p + 8 <= pos; p += 8) { f32x2 c[8];
#pragma unroll
              for (int q = 0; q < 8; ++q) { const int pp = p + q, kb = pp < 4 ? 3 - pp : 71 - pp; c[q] = cbk[(size_t)kb * LRUC]; }
#pragma unroll
              for (int q = 0; q < 8; ++q) hb = c[q].x * hb + c[q].y; }
          for (; p < pos; ++p) { const int kb = p < 4 ? 3 - p : 71 - p; const f32x2 c = cbk[(size_t)kb * LRUC]; hb = c.x * hb + c.y; } }
        float hfv[64];
        const unsigned* bf_ = AB + ((size_t)0 * MR + cg * 64) * LRUC + ch; const unsigned* bb_ = AB + ((size_t)1 * MR + cg * 64) * LRUC + ch;
        { unsigned wv[64];
#pragma unroll
          for (int i = 0; i < 64; ++i) wv[i] = __builtin_nontemporal_load(bf_ + (size_t)i * LRUC);
          __builtin_amdgcn_sched_barrier(0);
#pragma unroll
          for (int i = 0; i < 64; ++i) { hf = __expf(bf_lo(wv[i])) * hf + bf_hi(wv[i]); hfv[i] = hf; } }
#pragma unroll
        for (int hh = 1; hh >= 0; --hh) { unsigned wb[32]; bf16 gg[32];
#pragma unroll
            for (int i = 0; i < 32; ++i) { const int ii = hh * 32 + i; wb[i] = __builtin_nontemporal_load(bb_ + (size_t)ii * LRUC); gg[i] = U[((size_t)cg * 64 + ii) * DINP + OFF_LRU_G + ch]; }
            __builtin_amdgcn_sched_barrier(0);
#pragma unroll
            for (int i = 31; i >= 0; --i) { const int ii = hh * 32 + i; hb = __expf(bf_lo(wb[i])) * hb + bf_hi(wb[i]);
                yt[ii * 520 + ch] = f2bf(gelu_tanh(bf2f(gg[i])) * (hfv[ii] + hb)); } }
        __syncthreads();
        { const int hd = F.wave & 3, rl = (F.wave >> 2) * 32 + (F.lane >> 1), half = F.lane & 1; const LAS bf16* src = yt + rl * 520 + hd * 128 + half * 64;
          v4u v[8]; float ss = 0.f;
#pragma unroll
          for (int j = 0; j < 8; ++j) { v[j] = *(const LAS v4u*)(src + 8 * j);
#pragma unroll
              for (int k = 0; k < 4; ++k) { const float a = bf_lo(v[j][k]), b2 = bf_hi(v[j][k]); ss += a * a + b2 * b2; } }
          ss += __shfl_xor(ss, 1); const float rs = 1.0f / sqrtf(ss * (1.0f / 128.0f) + EPS);
          const float* g = hg + (4 + hd) * 128 + half * 64; bf16* dst = YM + ((size_t)cg * 64 + rl) * DMIX + (4 + hd) * 128 + half * 64;
#pragma unroll
          for (int j = 0; j < 8; ++j) { const f32x4 g0 = *(const f32x4*)(g + 8 * j), g1 = *(const f32x4*)(g + 8 * j + 4);
              v4u w; w.x = cvt_pk_bf16(bf_lo(v[j][0]) * rs * g0[0], bf_hi(v[j][0]) * rs * g0[1]); w.y = cvt_pk_bf16(bf_lo(v[j][1]) * rs * g0[2], bf_hi(v[j][1]) * rs * g0[3]);
              w.z = cvt_pk_bf16(bf_lo(v[j][2]) * rs * g1[0], bf_hi(v[j][2]) * rs * g1[1]); w.w = cvt_pk_bf16(bf_lo(v[j][3]) * rs * g1[2], bf_hi(v[j][3]) * rs * g1[3]); *(v4u*)(dst + 8 * j) = w; } }
        __syncthreads();
    }
    PROBE_SPLIT(12);
    mix_heads(F, l, NCHUNK);
}

template <int NBLK, int NCH, int WPC>
__device__ __forceinline__ void hyena_item(Frame& F, int l, int item) {
    constexpr int L = 128 * NBLK, GLEN = 2 * L, ZB = NBLK * 136 + 64, ZSZ = 2 * ZB;
    constexpr int CH_BYTES = (GLEN + 2 * ZSZ) * 2 + 64;
    static_assert(CH_BYTES % 16 == 0 && NCH * CH_BYTES <= RING_BYTES && NCH * WPC == NWAVES && (NCH == 2 || NCH == 8), "hyena LDS map");
    constexpr int TT = WPC * 64;
#define HY_G(s)  ((LAS bf16*)(F.lds + (s) * CH_BYTES))
#define HY_ZA(s) (HY_G(s) + GLEN)
#define HY_ZB_(s) (HY_G(s) + GLEN + ZSZ)
#define HY_ZO(t) ((((t) >> 7) * 136) + ((t) & 127))
    const int cs = F.wave / WPC, q = F.wave % WPC, c0 = item * NCH, c = c0 + cs, tl = F.tid % TT;
    LAS bf16* Gs = HY_G(cs); LAS bf16* Zc = HY_ZA(cs); LAS bf16* Zn = HY_ZB_(cs); LAS bf16* zero = Zn + ZSZ;
    const bf16* UH = WSP(bf16, WS_PT); bf16* YT = WSP(bf16, WS_YT);
    const bf16* Gg = (NBLK == 32) ? WSP(bf16, WS_G) + ((size_t)l * 512 + c) * 2 * HYL : WSP(bf16, WS_GC) + ((size_t)l * 512 + c) * 2 * HYLC;
    const int rb0 = (NBLK == 32) ? CTXL : 0;
    const float* cwp = F.in[8] + (size_t)l * 3 * 1536;
    const int sub = (c0 & 7) >> 1;
    constexpr int NG = (2 * L + NTHR - 1) / NTHR;
    { v4u gw_[NG];
#pragma unroll
      for (int k = 0; k < NG; ++k) { const int i = F.tid + k * NTHR; const int ii = i < 2 * L ? i : 0; const int b = ii / L, t = ii - b * L; gw_[k] = *(const v4u*)(UH + ((size_t)(c0 >> 3) * MR + b * SEGB + rb0 + t) * 8); }
      __builtin_amdgcn_sched_barrier(0);
#pragma unroll
      for (int k = 0; k < NG; ++k) { const int i = F.tid + k * NTHR; if (i < 2 * L) { const int b = i / L, t = i - b * L; const int zo = b * ZB + HY_ZO(t); const v4u w = gw_[k];
        if constexpr (NCH == 2) { const unsigned ww = w[sub]; HY_ZB_(0)[zo] = (bf16)(ww & 0xffffu); HY_ZB_(1)[zo] = (bf16)(ww >> 16); }
        else {
#pragma unroll
            for (int s = 0; s < 8; ++s) HY_ZB_(s)[zo] = (bf16)((s & 1) ? (w[s >> 1] >> 16) : (w[s >> 1] & 0xffffu)); } } } }
    if (tl < 16) ((LAS unsigned*)zero)[tl] = 0u;
    __syncthreads();
    for (int i = F.tid; i < NCH * 2 * L / 8; i += NTHR) { const int s = i / (2 * L / 8), rem = i - s * (2 * L / 8), b = rem / (L / 8), t0 = (rem - b * (L / 8)) * 8;
        const LAS bf16* zr = HY_ZB_(s) + b * ZB; const float w0 = cwp[c0 + s], w1 = cwp[1536 + c0 + s], w2 = cwp[2 * 1536 + c0 + s];
        const v4u xw = *(const LAS v4u*)(zr + HY_ZO(t0)); float x[10];
        x[0] = t0 > 0 ? bf2f(zr[HY_ZO(t0 - 1)]) : 0.f; x[9] = (t0 + 8 < L) ? bf2f(zr[HY_ZO(t0 + 8)]) : 0.f;
#pragma unroll
        for (int k = 0; k < 4; ++k) { x[1 + 2 * k] = bf_lo(xw[k]); x[2 + 2 * k] = bf_hi(xw[k]); }
        v4u ow;
#pragma unroll
        for (int k = 0; k < 4; ++k) ow[k] = cvt_pk_bf16(w0 * x[2 * k] + w1 * x[2 * k + 1] + w2 * x[2 * k + 2], w0 * x[2 * k + 1] + w1 * x[2 * k + 2] + w2 * x[2 * k + 3]);
        *(LAS v4u*)(HY_ZA(s) + b * ZB + HY_ZO(t0)) = ow; }
    const int i16 = F.lane & 15, h4 = F.lane >> 4, nb = i16 >> 3, a = 8 * q + (i16 & 7);
    const int mlo = (8 * q - (NBLK - 1)) > -(NBLK - 1) ? (8 * q - (NBLK - 1)) : -(NBLK - 1), mhi = (8 * q + 7) < (NBLK - 1) ? (8 * q + 7) : (NBLK - 1);
    const float* hb = F.in[14] + (size_t)l * 2 * HYC;
    for (int o = 0; o < 2; ++o) {
        { constexpr int NF = (GLEN / 8 + TT - 1) / TT; v4u fw_[NF];
#pragma unroll
          for (int k = 0; k < NF; ++k) { const int i = tl + k * TT; fw_[k] = *(const v4u*)(Gg + (size_t)o * GLEN + 8 * (i < GLEN / 8 ? i : 0)); }
          __builtin_amdgcn_sched_barrier(0);
#pragma unroll
          for (int k = 0; k < NF; ++k) { const int i = tl + k * TT; if (i < GLEN / 8) *(LAS v4u*)(Gs + 8 * i) = fw_[k]; } }
        __syncthreads();
        f32x4 acc[8];
#pragma unroll
        for (int r = 0; r < 8; ++r) acc[r] = (f32x4){0.f, 0.f, 0.f, 0.f};
        for (int m = mlo; m <= mhi; ++m) {
            const int blk_in = a - m; const bool valid = (a < NBLK) && blk_in >= 0 && blk_in < NBLK;
            const LAS bf16* zp = valid ? (Zc + nb * ZB + blk_in * 136 + 8 * h4) : zero;
            const int zk = valid ? 1 : 0;
            const LAS bf16* gp = Gs + (L - 128 * m + 8 * (h4 - i16));
#pragma unroll
            for (int k0 = 0; k0 < 128; k0 += 32) {
                const bf16x8 zf = *(const LAS bf16x8*)(zp + zk * k0);
                const v4u lo = *(const LAS v4u*)(gp + k0 - 8), hi = *(const LAS v4u*)(gp + k0);
                const unsigned c0_ = lo.x, c1 = lo.y, c2 = lo.z, c3 = lo.w, c4 = hi.x, c5 = hi.y, c6 = hi.z, c7 = hi.w;
                const unsigned s0 = __builtin_amdgcn_alignbit(c1, c0_, 16), s1 = __builtin_amdgcn_alignbit(c2, c1, 16), s2 = __builtin_amdgcn_alignbit(c3, c2, 16), s3 = __builtin_amdgcn_alignbit(c4, c3, 16),
                               s4 = __builtin_amdgcn_alignbit(c5, c4, 16), s5 = __builtin_amdgcn_alignbit(c6, c5, 16), s6 = __builtin_amdgcn_alignbit(c7, c6, 16);
#define HYF(x0, x1, x2, x3) __builtin_bit_cast(bf16x8, (v4u){x0, x1, x2, x3})
                acc[0] = __builtin_amdgcn_mfma_f32_16x16x32_bf16(HYF(c4, c5, c6, c7), zf, acc[0], 0, 0, 0);
                acc[1] = __builtin_amdgcn_mfma_f32_16x16x32_bf16(HYF(s3, s4, s5, s6), zf, acc[1], 0, 0, 0);
                acc[2] = __builtin_amdgcn_mfma_f32_16x16x32_bf16(HYF(c3, c4, c5, c6), zf, acc[2], 0, 0, 0);
                acc[3] = __builtin_amdgcn_mfma_f32_16x16x32_bf16(HYF(s2, s3, s4, s5), zf, acc[3], 0, 0, 0);
                acc[4] = __builtin_amdgcn_mfma_f32_16x16x32_bf16(HYF(c2, c3, c4, c5), zf, acc[4], 0, 0, 0);
                acc[5] = __builtin_amdgcn_mfma_f32_16x16x32_bf16(HYF(s1, s2, s3, s4), zf, acc[5], 0, 0, 0);
                acc[6] = __builtin_amdgcn_mfma_f32_16x16x32_bf16(HYF(c1, c2, c3, c4), zf, acc[6], 0, 0, 0);
                acc[7] = __builtin_amdgcn_mfma_f32_16x16x32_bf16(HYF(s0, s1, s2, s3), zf, acc[7], 0, 0, 0);
#undef HYF
            }
        }
        __syncthreads();
        { v4u gw_[NG];
#pragma unroll
          for (int k = 0; k < NG; ++k) { const int i = F.tid + k * NTHR; const int ii = i < 2 * L ? i : 0; gw_[k] = *(const v4u*)(UH + ((size_t)((512 * (o + 1) + c0) >> 3) * MR + (ii / L) * SEGB + rb0 + (ii % L)) * 8); }
          __builtin_amdgcn_sched_barrier(0);
#pragma unroll
          for (int k = 0; k < NG; ++k) { const int i = F.tid + k * NTHR; if (i < 2 * L) { const v4u w = gw_[k];
            if constexpr (NCH == 2) { const unsigned ww = w[sub]; HY_G(0)[i] = (bf16)(ww & 0xffffu); HY_G(1)[i] = (bf16)(ww >> 16); }
            else {
#pragma unroll
                for (int s = 0; s < 8; ++s) HY_G(s)[i] = (bf16)((s & 1) ? (w[s >> 1] >> 16) : (w[s >> 1] & 0xffffu)); } } } }
        __syncthreads();
        if (a < NBLK) {
            const float bias = hb[o * HYC + c];
            float nrm = 0.f; { const float* pb = WSP(float, WS_PART) + ((((size_t)l * 2 + (NBLK == 32 ? 0 : 1)) * 2 + o) * 2) * 8 * 512 + c;
#pragma unroll
                for (int k = 0; k < (NBLK == 32 ? 8 : 1); ++k) nrm += pb[k * 512] + pb[(8 + k) * 512]; }
            const float invn = 1.0f / nrm;
            const int t0 = a * 128 + 32 * h4;
            const float w0 = cwp[512 * (o + 1) + c], w1 = cwp[1536 + 512 * (o + 1) + c], w2 = cwp[2 * 1536 + 512 * (o + 1) + c];
            const LAS bf16* pr = Gs + nb * L + t0;
            const LAS bf16* zz = Zc + nb * ZB + a * 136 + 32 * h4;
            const size_t grow = (size_t)nb * SEGB + rb0 + t0;
            float xprev = t0 > 0 ? bf2f(pr[-1]) : 0.f;
#pragma unroll
            for (int jj = 0; jj < 4; ++jj) { const v4u pw = *(const LAS v4u*)(pr + 8 * jj); const v4u zw = *(const LAS v4u*)(zz + 8 * jj); v4u ow;
                float x[10]; x[0] = xprev;
#pragma unroll
                for (int k = 0; k < 4; ++k) { x[1 + 2 * k] = bf_lo(pw[k]); x[2 + 2 * k] = bf_hi(pw[k]); }
                x[9] = (t0 + 8 * jj + 8 < L) ? bf2f(pr[8 * jj + 8]) : 0.f; xprev = x[8];
#pragma unroll
                for (int k = 0; k < 4; ++k) { const float y0 = acc[2 * k][jj] * invn, y1 = acc[2 * k + 1][jj] * invn;
                    const float p0 = w0 * x[2 * k] + w1 * x[2 * k + 1] + w2 * x[2 * k + 2], p1 = w0 * x[2 * k + 1] + w1 * x[2 * k + 2] + w2 * x[2 * k + 3];
                    const float r0 = p0 * (y0 + bf_lo(zw[k]) * bias), r1 = p1 * (y1 + bf_hi(zw[k]) * bias); ow[k] = cvt_pk_bf16(r0, r1); }
                if (o == 0) *(LAS v4u*)(Zn + nb * ZB + a * 136 + 32 * h4 + 8 * jj) = ow;
                else *(v4u*)(YT + (size_t)c * MR + grow + 8 * jj) = ow; }
        }
        __syncthreads();
        { LAS bf16* t_ = Zc; Zc = Zn; Zn = t_; }
    }
#undef HY_G
#undef HY_ZA
#undef HY_ZB_
#undef HY_ZO
}
__device__ __forceinline__ void hyena_phase(Frame& F, int l, bool need_ctx) {
    for (int item = F.vcu; item < HYC / 2; item += F.G) hyena_item<32, 2, 4>(F, l, item);
    if (need_ctx) for (int item = (F.vcu + F.G - 16 % F.G) % F.G; item < HYC / 8; item += F.G) hyena_item<2, 8, 1>(F, l, item);
}

#ifndef SMALL_BAL
#define SMALL_BAL 1
#endif
struct SmallOrder {
    int G, c;
    __host__ __device__ void init(int G_, int c_) { G = G_; c = c_; }
    __host__ __device__ bool next(int i, pg8::Unit& u) const {
        if (G != 256 || !SMALL_BAL) { const long L = (long)i * G + c; if (L >= 204 + 272 + 272) return false; int li = (int)L;
            if (li < 204) { u.ks = 0; u.pm = li / 6; u.pn = li % 6; } else if (li < 476) { li -= 204; u.ks = 1; u.pm = li >> 3; u.pn = li & 7; } else { li -= 476; u.ks = 2; u.pm = li >> 3; u.pn = li & 7; } return true; }
        int ty, li;
        if (c < 204) { if (i > 2) return false; ty = i; li = i == 0 ? c : (i == 1 ? 52 + c : 36 + c); }
        else if (c < 220) { if (i > 1) return false; ty = 1; li = i == 0 ? c - 204 : 256 + (c - 204); }
        else { if (i > 2) return false; if (i == 0) { ty = 1; li = c - 204; } else { ty = 2; li = (i == 1 ? 0 : 240) + (c - 220); if (li >= 272) return false; } }
        u.ks = ty; if (ty == 0) { u.pm = li / 6; u.pn = li % 6; } else { u.pm = li >> 3; u.pn = li & 7; } return true; }
};
struct SmallAB {
    static constexpr bool VARK = true;
    const bf16* U; const bf16* XR; const bf16* W; int lda, ldb;
    __device__ __forceinline__ int lda_of(const pg8::Unit& u) const { return u.ks == 1 ? 128 : DINP; }
    __device__ __forceinline__ int ktiles(const pg8::Unit& u) const { return u.ks == 2 ? 4 : 8; }
    __device__ __forceinline__ const char* a_base(const pg8::Unit& u) const {
        if (u.ks == 1) { const int b = u.pm / 17, dir = u.pn >> 2, blk = u.pn & 3; return (const char*)(XR + (((size_t)b * 4 + blk) * XR_ROWS + LruAB::prow0(u.pm) - (dir ? 0 : 3)) * 128); }
        return (const char*)(U + (size_t)u.pm * 256 * DINP + (u.ks == 0 ? OFF_Q : OFF_KV)); }
    __device__ __forceinline__ const char* b_base(const pg8::Unit& u) const { const int r0 = (u.ks == 0 ? 0 : (u.ks == 1 ? 1536 : 3584)) + u.pn * 256; return (const char*)(W + (size_t)r0 * 512); }
};
struct EpiSmall {
    static constexpr bool PERM = true;
    pg8::EpiBf16 eq, ekv; EpiGate eg;
    __device__ __forceinline__ void operator()(const f32x4 (&acc)[2][2][4][2], const pg8::Unit& u, int wr, int wc, int fr, int fq) const {
        if (u.ks == 1) eg(acc, u, wr, wc, fr, fq); else if (u.ks == 0) eq(acc, u, wr, wc, fr, fq); else ekv(acc, u, wr, wc, fr, fq); }
};

constexpr int NSTEPS = 2 + 10 * DEPTH;
#define REP(bit) for (int rep_ = 0; rep_ < (int)((PROBE_DUP >> (bit)) & 1) + 1; ++rep_)
#define LAUNDER() do { asm volatile("" : "+v"(F.tid), "+v"(F.lane)); asm volatile("" : "+s"(F.wave), "+s"(F.vcu)); asm volatile("" : "+s"(l)); \
    { unsigned long long w_ = (unsigned long long)F.ws; unsigned wl_ = (unsigned)w_, wh_ = (unsigned)(w_ >> 32); asm volatile("" : "+s"(wl_), "+s"(wh_)); F.ws = (unsigned char*)(((unsigned long long)wh_ << 32) | wl_); } } while (0)
#define IN(k) (lo <= (k) && (k) < hi)
#if PROBE_TIME >= 0
#define SEAM_T(k, ty) do { if (IN(k) && IN((k) + 1)) { if (blockIdx.x == 0 && F.tid == 0 && (k) == NSTEPS - 2) *(volatile unsigned*)(F.ws + WS_CTL + 4 * CW_PROBE) = MISCP[17] + (((ty) == PROBE_TIME) ? (unsigned)__builtin_amdgcn_s_memrealtime() - MISCP[16] : 0u); \
    xcd_barrier(bar); if (blockIdx.x == 0 && F.tid == 0) { const unsigned t_ = (unsigned)__builtin_amdgcn_s_memrealtime(); if ((ty) == PROBE_TIME) MISCP[17] += t_ - MISCP[16]; MISCP[16] = t_; } } } while (0)
#else
#define SEAM_T(k, ty) do { if (IN(k) && IN((k) + 1)) { xcd_barrier(bar); if (PROBE_DUP & (1u << 13)) xcd_barrier(bar); } } while (0)
#endif
#define SEAM(k) SEAM_T(k, (k) < 2 ? 10 + (k) : ((k) - 2) % 10)

template <int LI> __device__ __forceinline__ void layer_steps(Frame& F, const XcdBarrier& bar, const int lo, const int hi, volatile LAS unsigned* MISCP) {
        int l = LI; constexpr int li = LI;
        constexpr int sb = 2 + 10 * li; constexpr bool need_ctx = li < DEPTH - 1;
        if (IN(sb + 0)) REP(2) { LAUNDER(); pg8::PlainAB ab{WSP(bf16, WS_H), WSP(bf16, WS_WIN) + (size_t)l * DINP * DM, DM, DM}; pg8::StaticOrder S; S.init(MR / 256, DINP / 256, F.G, (int)blockIdx.x);
            EpiU E{WSP(bf16, WS_U), WSP(bf16, WS_PT), WSP(bf16, WS_XR), WSP(bf16, WS_KR), WSP(float, WS_ROPE), WSP(float, WS_SSQ)}; xr_pad_zero(F); pg8::gemm_phase<EpiU, pg8::PlainAB>(F.lds, ab, DM, S, E); }
        SEAM(sb + 0);
        if (IN(sb + 1)) REP(4) { LAUNDER();
            SmallAB ab{WSP(bf16, WS_U), WSP(bf16, WS_XR), WSP(bf16, WS_WSM) + (size_t)l * WSM_ROWS * 512, DINP, 512};
            SmallOrder S; S.init(F.G, F.vcu);
            EpiSmall E{pg8::EpiBf16{WSP(bf16, WS_Q), DQ, WSP(float, WS_SSQ), 0, 8, 1.0f / QRANK, att::SCALE * 1.4426950408889634f}, pg8::EpiBf16{WSP(bf16, WS_KV), DKV, WSP(float, WS_SSQ), 8, 4, 1.0f / KVRANK},
                       EpiGate{WSP(bf16, WS_XR), WSP(unsigned, WS_AB), F.in[17] + (size_t)l * 2 * LRUC, F.in[19] + (size_t)l * 2 * LRUC, WSP(float, WS_SP) + (size_t)l * 2 * LRUC, F.in[15] + (size_t)l * 2 * 4 * LRUC}};
            pg8::gemm_phase<EpiSmall, SmallAB, SmallOrder>(F.lds, ab, 512, S, E);
        }
        SEAM(sb + 1);
        if (IN(sb + 2)) { LAUNDER(); REP(5) { attn_phase(F, need_ctx); __syncthreads(); } PROBE_SPLIT(13); REP(6) { hyena_phase(F, l, need_ctx); __syncthreads(); } PROBE_SPLIT(14); REP(7) { lru_pass1(F); } }
        SEAM(sb + 2);
        if (IN(sb + 3)) REP(8) { LAUNDER(); lru2_finalize(F, l, bar, MISCP); __syncthreads(); }
        SEAM(sb + 3);
        if (IN(sb + 4)) REP(9) { LAUNDER();
            { pg8::PlainAB ab{WSP(bf16, WS_YMIX), WSP(bf16, WS_WOUT) + (size_t)l * DM * DMIX, DMIX, DMIX}; pg8::LatentOrder S; S.init(32, DM / 256, F.G, (int)blockIdx.x);
              pg8::EpiBf16 E{WSP(bf16, WS_MO), DM, nullptr, 0, 0, 0.f}; pg8::gemm_phase<pg8::EpiBf16, pg8::PlainAB, pg8::LatentOrder>(F.lds, ab, DMIX, S, E); }
            if (need_ctx) { pg8::PieceAB ab{WSP(bf16, WS_YMIX), WSP(bf16, WS_WOUT) + (size_t)l * DM * DMIX, DMIX, DMIX, 256}; pg8::PieceOrder S; S.init(DM / 256, 8, F.G, (int)blockIdx.x);
              pg8::EpiSlab E{WSP(pg8::slab_t, WS_SLAB)}; pg8::gemm_phase<pg8::EpiSlab, pg8::PieceAB, pg8::PieceOrder>(F.lds, ab, 256, S, E); } }
        SEAM(sb + 4);
        if (IN(sb + 5)) { LAUNDER(); if (PROBE_DUP & (1u << 14)) norm_pass(F, 1, l, true);
#if X_BF16
            norm_pass_pipe(F, 1, l);
#else
            norm_pass(F, 1, l);
#endif
        }
        SEAM(sb + 5);
        if (IN(sb + 6)) REP(10) { LAUNDER(); pg8::PlainAB ab{WSP(bf16, WS_H), WSP(bf16, WS_WUP) + (size_t)l * 2 * DFF * DM, DM, DM}; pg8::StaticOrder S; S.init(MR / 256, 2 * DFF / 256, F.G, (int)blockIdx.x);
            pg8::EpiBf16 E{WSP(bf16, WS_UP), 2 * DFF, nullptr, 0, 0, 0.f}; pg8::gemm_phase<pg8::EpiBf16, pg8::PlainAB>(F.lds, ab, DM, S, E); }
        SEAM(sb + 6);
        if (IN(sb + 7)) REP(11) { LAUNDER(); conv_gelu(F, l); }
        SEAM(sb + 7);
        if (IN(sb + 8)) REP(12) { LAUNDER();
            { pg8::PlainAB ab{WSP(bf16, WS_ACT), WSP(bf16, WS_WDN) + (size_t)l * DM * DFF, DFF, DFF}; pg8::LatentOrder S; S.init(32, DM / 256, F.G, (int)blockIdx.x);
              pg8::EpiBf16 E{WSP(bf16, WS_MO), DM, nullptr, 0, 0, 0.f}; pg8::gemm_phase<pg8::EpiBf16, pg8::PlainAB, pg8::LatentOrder>(F.lds, ab, DFF, S, E); }
            if (need_ctx) { pg8::PieceAB ab{WSP(bf16, WS_ACT), WSP(bf16, WS_WDN) + (size_t)l * DM * DFF, DFF, DFF, 512}; pg8::PieceOrder S; S.init(DM / 256, 11, F.G, (int)blockIdx.x);
              pg8::EpiSlab E{WSP(pg8::slab_t, WS_SLAB)}; pg8::gemm_phase<pg8::EpiSlab, pg8::PieceAB, pg8::PieceOrder>(F.lds, ab, 512, S, E); } }
        SEAM(sb + 8);
        if (IN(sb + 9)) { LAUNDER(); if (PROBE_DUP & (1u << 14)) norm_pass(F, 2, l, true);
#if X_BF16
            norm_pass_pipe(F, 2, l);
#else
            norm_pass(F, 2, l);
#endif
        }
        SEAM(sb + 9);
}

__global__ void __launch_bounds__(NTHR, 2) fwd_kernel(Args args) {
    extern __shared__ __attribute__((aligned(16))) unsigned char lds_raw[];
    Frame F;
    F.lds = (LAS unsigned char*)lds_raw; F.ws = args.ws; F.in = args.in; F.out = args.out;
    F.tid = threadIdx.x; F.lane = F.tid & 63; F.wave = __builtin_amdgcn_readfirstlane(F.tid >> 6);
    F.G = gridDim.x; { const int bx = blockIdx.x; F.vcu = (F.G % 8 == 0) ? (bx % 8) * (F.G / 8) + bx / 8 : bx; }
    volatile LAS unsigned* MISC = (volatile LAS unsigned*)(F.lds + MISC_OFF);
    volatile LAS unsigned* MISCP = MISC;
    for (int u = F.tid; u < (LDS_BYTES - LDSCTL_OFF) / 4; u += NTHR) ((LAS unsigned*)(F.lds + LDSCTL_OFF))[u] = 0u;
    __syncthreads();
#if PROBE_TIME >= 0
    if (blockIdx.x == 0 && F.tid == 0) MISCP[16] = (unsigned)__builtin_amdgcn_s_memrealtime();
#endif
#if MK_MULTI
    const int lo = args.ph_lo, hi = args.ph_hi;
#else
    constexpr int lo = 0, hi = NSTEPS;
#endif
    XcdBarrier bar; bar.bar = (unsigned*)(F.ws + WS_CTL) + CW_BAR; bar.x = 0; bar.st = nullptr;
    if (hi - lo > 1) bar = xcd_barrier_post((unsigned*)(F.ws + WS_CTL) + CW_BAR, MISC + 8);

    if (IN(0)) REP(0) { REP(15) { pro_mod(F); __syncthreads(); } REP(16) { pro_transposes(F); __syncthreads(); } REP(17) { pro_lru_w(F); pro_rope(F); __syncthreads(); } REP(18) { pro_hid(F); __syncthreads(); } }
    SEAM(0);
    if (IN(1)) REP(1) { pro_filter(F); __syncthreads(); norm_pass(F, 0, 0); __syncthreads(); }
    SEAM(1);

    layer_steps<0>(F, bar, lo, hi, MISCP); layer_steps<1>(F, bar, lo, hi, MISCP); layer_steps<2>(F, bar, lo, hi, MISCP); layer_steps<3>(F, bar, lo, hi, MISCP);
#undef IN
#undef SEAM
}

extern "C" void kernel_launch(void* const* d_in, const int* in_sizes, int n_in, void* d_out, int out_size, void* d_ws, size_t ws_size, hipStream_t stream) {
    static int grid = 0;
    if (grid == 0) {
        if (n_in != 30 || ws_size < WS_END) { fprintf(stderr, "kernel_launch: expected 30 inputs and >= %zu bytes of workspace (got %d, %zu)\n", (size_t)WS_END, n_in, ws_size); grid = -1; return; }
        int dev = 0, cus = 0, per_cu = 0;
        if (hipGetDevice(&dev) != hipSuccess || hipDeviceGetAttribute(&cus, hipDeviceAttributeMultiprocessorCount, dev) != hipSuccess) { grid = -1; return; }
        if (hipFuncSetAttribute((const void*)fwd_kernel, hipFuncAttributeMaxDynamicSharedMemorySize, LDS_BYTES) != hipSuccess) { fprintf(stderr, "kernel_launch: hipFuncSetAttribute failed\n"); grid = -1; return; }
        if (hipOccupancyMaxActiveBlocksPerMultiprocessor(&per_cu, (const void*)fwd_kernel, NTHR, LDS_BYTES) != hipSuccess || per_cu < 1) fprintf(stderr, "kernel_launch: occupancy query says %d\n", per_cu);
        (void)hipGetLastError();
        grid = cus;
    }
    if (grid < 0) return;
    (void)hipMemsetAsync((char*)d_ws + WS_CTL, 0, CTL_ZERO_BYTES, stream);
    Args a{};
    for (int i = 0; i < 30; ++i) a.in[i] = (const float*)d_in[i];
    a.out = (float*)d_out; a.ws = (unsigned char*)d_ws;
#if MK_MULTI
    for (int s = 0; s < NSTEPS; ++s) { a.ph_lo = s; a.ph_hi = s + 1; hipLaunchKernelGGL(fwd_kernel, dim3(grid), dim3(NTHR), LDS_BYTES, stream, a); }
#else
    a.ph_lo = 0; a.ph_hi = NSTEPS; hipLaunchKernelGGL(fwd_kernel, dim3(grid), dim3(NTHR), LDS_BYTES, stream, a);
#endif
}
```

```cpp
#include <hip/hip_runtime.h>
#include <cstdio>
#include <cstdint>

#ifndef PROBE_DUP
#define PROBE_DUP 0x0
#endif
#ifndef PROBE_TIME
#define PROBE_TIME -1
#endif
#ifndef PROBE_SCALE
#define PROBE_SCALE 3e-9f
#endif
#ifndef X_BF16
#define X_BF16 1
#endif
#ifndef MK_MULTI
#define MK_MULTI 0
#endif

constexpr int DM = 2048, NBATCH = 2, SEQ = 4096, CTXL = 256, DEPTH = 4;
constexpr int SEGB = CTXL + SEQ;
constexpr int MR = NBATCH * SEGB;
constexpr int DIN = 3392, DINP = 3584;
constexpr int HYC = 512, LRUC = 512, QRANK = 512, KVRANK = 256, NOPE = 128, ROPED = 64, VD = 128, NH = 8;
constexpr int DQ = NH * (NOPE + ROPED);
constexpr int DKV = NH * (NOPE + VD);
constexpr int DFF = 5632, DMIX = 2048;
constexpr int OFF_LRU_G = 1536, OFF_Q = 2048, OFF_LRU_X = 2560, OFF_KV = 3072, OFF_KR = 3328;
constexpr float EPS = 1e-6f;
constexpr int XR_ROWS = 4364;
constexpr int NCHUNK = MR / 64;
constexpr int HYL = 8192, HYLC = 512;

constexpr size_t MiB = 1u << 20;
constexpr size_t WS_CTL = 0, CTL_ZERO_BYTES = 32768;
constexpr size_t WS_MOD = 1 * MiB;
constexpr size_t WS_ROPE = 2 * MiB;
constexpr size_t WS_HID = 3 * MiB;
constexpr size_t WS_PART = 8 * MiB;
constexpr size_t WS_RSTD = 9 * MiB;
constexpr size_t WS_SP = 9 * MiB + 256 * 1024;
constexpr size_t WS_CARRY = 10 * MiB;
constexpr size_t WS_SSQ = 12 * MiB;
constexpr size_t WS_G = 16 * MiB;
constexpr size_t WS_GC = 80 * MiB;
constexpr size_t WS_WIN = 96 * MiB;
constexpr size_t WS_WUQ = 152 * MiB;
constexpr size_t WS_WUKV = 158 * MiB;
constexpr size_t WS_WOUT = 162 * MiB;
constexpr size_t WS_WUP = 194 * MiB;
constexpr size_t WS_WDN = 370 * MiB;
constexpr size_t WS_WLRU = 458 * MiB;
constexpr size_t WS_X = 480 * MiB;
constexpr size_t WS_H = 548 * MiB;
constexpr size_t WS_U = 582 * MiB;
constexpr size_t WS_Q = 642 * MiB;
constexpr size_t WS_KV = 668 * MiB;
constexpr size_t WS_KR = 702 * MiB;
constexpr size_t WS_O = 704 * MiB;
constexpr size_t WS_PT = 722 * MiB;
constexpr size_t WS_YT = 748 * MiB;
constexpr size_t WS_XR = 757 * MiB;
constexpr size_t WS_AB = 766 * MiB;
constexpr size_t WS_HF = 834 * MiB;
constexpr size_t WS_YL = 851 * MiB;
constexpr size_t WS_YMIX = 868 * MiB;
constexpr size_t WS_MO = 902 * MiB;
constexpr size_t WS_UP = 936 * MiB;
constexpr size_t WS_ACT = 1123 * MiB;
constexpr size_t WS_SLAB = 1217 * MiB;
constexpr size_t WS_WUKV2 = 1265 * MiB;
constexpr size_t WS_WSM = 1273 * MiB;
constexpr int WSM_ROWS = 1536 + 2048 + 2048;
constexpr size_t WS_END = 1297 * MiB;

constexpr int CW_BAR = 4096, CW_PROBE = 64;
static_assert((CW_BAR + 3456) * 4 <= (int)CTL_ZERO_BYTES, "barrier words inside the per-call memset");

constexpr int NWAVES = 8, NTHR = 512;
constexpr int RING_BYTES = 131072;
constexpr int LDSCTL_OFF = RING_BYTES, MISC_OFF = LDSCTL_OFF + 320;
constexpr int LDS_BYTES = 147456;

#define GAS __attribute__((address_space(1)))
#define LAS __attribute__((address_space(3)))
#define CAS __attribute__((address_space(4)))
typedef const float CAS cfloat_c;
typedef unsigned short bf16;
typedef unsigned v4u __attribute__((ext_vector_type(4)));
typedef unsigned v2u __attribute__((ext_vector_type(2)));
typedef float f32x4 __attribute__((ext_vector_type(4)));
typedef float f32x2 __attribute__((ext_vector_type(2)));
typedef float f32x16 __attribute__((ext_vector_type(16)));
typedef short bf16x8 __attribute__((ext_vector_type(8)));
typedef short s16x4 __attribute__((ext_vector_type(4)));
typedef GAS unsigned gu32;
#define RLX_AGENT __ATOMIC_RELAXED, __HIP_MEMORY_SCOPE_AGENT
#define LDS_WAIT() asm volatile("s_waitcnt lgkmcnt(0)" ::: "memory")
#define VM_WAIT() asm volatile("s_waitcnt vmcnt(0)" ::: "memory")

__device__ __forceinline__ unsigned cvt_pk_bf16(float lo, float hi) { unsigned r; asm volatile("v_cvt_pk_bf16_f32 %0, %1, %2" : "=v"(r) : "v"(lo), "v"(hi)); return r; }
__device__ __forceinline__ float bf_lo(unsigned w) { return __uint_as_float(w << 16); }
__device__ __forceinline__ float bf_hi(unsigned w) { return __uint_as_float(w & 0xffff0000u); }
__device__ __forceinline__ float bf2f(bf16 v) { return __uint_as_float(((unsigned)v) << 16); }
__device__ __forceinline__ bf16 f2bf(float f) { return (bf16)(cvt_pk_bf16(f, 0.f) & 0xffffu); }
__device__ __forceinline__ float wave_sum(float v) {
#pragma unroll
    for (int o = 1; o < 64; o <<= 1) v += __shfl_xor(v, o);
    return v;
}
__device__ __forceinline__ float sigmoidf_(float x) { return __builtin_amdgcn_rcpf(1.0f + __builtin_amdgcn_exp2f(-1.4426950408889634f * x)); }
__device__ __forceinline__ float gelu_tanh(float x) { const float x2 = x * x; const float t = x * (-2.302208198f - 0.1029432397f * x2);
    return x * __builtin_amdgcn_rcpf(1.0f + __builtin_amdgcn_exp2f(t)); }

#define XB_TMO      128
#define XB_XCNT(j)  (256  + 64 * (j))
#define XB_XSUB(j)  (1280 + 64 * (j))
#define XB_XGEN(j)  (2304 + 64 * (j))
#define XB_TOP      3328
#define XB_TOPGEN   3392
#define XCD_BAR_WORDS 3456
#define XB_SPIN_CAP (1u << 18)
__device__ __forceinline__ unsigned xb_ld(unsigned* p)              { return __hip_atomic_load(p, __ATOMIC_RELAXED, __HIP_MEMORY_SCOPE_AGENT); }
__device__ __forceinline__ unsigned xb_add(unsigned* p, unsigned v) { return __hip_atomic_fetch_add(p, v, __ATOMIC_RELAXED, __HIP_MEMORY_SCOPE_AGENT); }
__device__ __forceinline__ unsigned xb_xcc_id() { return (unsigned)__builtin_amdgcn_s_getreg((3 << 11) | 20) & 0xFu; }
#define XB_SPIN(cond, bar) do { unsigned _sp = 0; while (cond) { __builtin_amdgcn_s_sleep(1); \
    if ((++_sp & 255u) == 0u) { if (xb_ld(&(bar)[XB_TMO])) break; if (_sp > XB_SPIN_CAP) { atomicAdd(&(bar)[XB_TMO], 1u); break; } } } } while (0)
struct XcdBarrier { unsigned* bar; unsigned x; volatile LAS unsigned* st; };
__device__ __forceinline__ XcdBarrier xcd_barrier_post(unsigned* bar, volatile LAS unsigned* st) {
    XcdBarrier b; b.bar = bar; b.x = xb_xcc_id(); b.st = st;
    if (threadIdx.x == 0) (void)xb_add(&bar[XB_XCNT(b.x)], 1u);
    return b;
}
__device__ __forceinline__ void xcd_barrier_complete(unsigned* bar, unsigned x, unsigned& nloc, unsigned& nx) {
    const unsigned G = gridDim.x * gridDim.y * gridDim.z;
    unsigned sum, cnt, mine, sp = 0u;
    for (;;) {
        sum = 0u; cnt = 0u; mine = 0u;
#pragma unroll
        for (unsigned j = 0; j < 16; ++j) { const unsigned c = xb_ld(&bar[XB_XCNT(j)]); sum += c; cnt += (c > 0u) ? 1u : 0u; mine = (j == x) ? c : mine; }
        if (sum == G) break;
        __builtin_amdgcn_s_sleep(1);
        if ((++sp & 255u) == 0u) { if (xb_ld(&bar[XB_TMO])) break; if (sp > XB_SPIN_CAP) { atomicAdd(&bar[XB_TMO], 1u); break; } }
    }
    nloc = mine > 0u ? mine : 1u; nx = cnt > 0u ? cnt : 1u;
}
__device__ __forceinline__ void xcd_barrier(const XcdBarrier& b) {
    asm volatile("s_waitcnt vmcnt(0)" ::: "memory");
    __syncthreads();
    unsigned* bar_l; { unsigned long long w_ = (unsigned long long)b.bar; unsigned wl_ = (unsigned)w_, wh_ = (unsigned)(w_ >> 32); asm volatile("" : "+s"(wl_), "+s"(wh_)); bar_l = (unsigned*)(((unsigned long long)wh_ << 32) | wl_); }
    unsigned x_l = b.x; asm volatile("" : "+s"(x_l));
    if (threadIdx.x == 0) {
        unsigned* bar = bar_l;
        __builtin_amdgcn_s_waitcnt(0);
        unsigned nloc = b.st[0], nx = b.st[1];
        if (nloc == 0u) { xcd_barrier_complete(bar, x_l, nloc, nx); b.st[0] = nloc; b.st[1] = nx; }
        const unsigned old = xb_add(&bar[XB_XSUB(x_l)], 1u);
        const unsigned gen = old / nloc;
        if (old + 1u == (gen + 1u) * nloc) {
            __builtin_amdgcn_fence(__ATOMIC_RELEASE, "agent");
            asm volatile("s_waitcnt vmcnt(0)" ::: "memory");
            const unsigned og = xb_add(&bar[XB_TOP], 1u);
            const unsigned tg = og / nx;
            if (og + 1u == (tg + 1u) * nx) xb_add(&bar[XB_TOPGEN], 1u);
            else XB_SPIN(xb_ld(&bar[XB_TOPGEN]) == tg, bar);
            __builtin_amdgcn_fence(__ATOMIC_ACQUIRE, "agent");
            xb_add(&bar[XB_XGEN(x_l)], 1u);
            asm volatile("s_waitcnt vmcnt(0)" ::: "memory");
        } else {
            XB_SPIN(xb_ld(&bar[XB_XGEN(x_l)]) == gen, bar);
            __builtin_amdgcn_fence(__ATOMIC_ACQUIRE, "agent");
            asm volatile("s_waitcnt vmcnt(0)" ::: "memory");
        }
    }
    __syncthreads();
}

struct Args { const float* in[30]; float* out; unsigned char* ws; int ph_lo, ph_hi; };
struct Frame {
    LAS unsigned char* lds;
    unsigned char* ws;
    const float* const* in;
    float* out;
    int tid, lane, wave, vcu, G;
};
#define WSP(T, off) ((T*)(F.ws + (off)))
__device__ __forceinline__ void row_info(int r, int& b, int& isctx, int& t) { b = r >= SEGB ? 1 : 0; const int j = r - b * SEGB; isctx = j < CTXL ? 1 : 0; t = isctx ? j : j - CTXL; }

namespace pg8 {
constexpr int BM = 256, BK = 64, HALF = 128, HTB = HALF * BK * 2, STAGE_BYTES = 8 * HTB, NXCD = 8, WGM = 8;
__host__ __device__ __forceinline__ int lds_byte(int r, int c) { const int st = (r >> 4) * 2 + (c >> 5), rr = r & 15, cc = c & 31, ob = rr * 64 + cc * 2; return st * 1024 + (ob ^ (((ob >> 9) & 1) << 5)); }
__host__ __device__ __forceinline__ void stage_rc(int b, int& R, int& C) { const int st = b / 1024, sb = b % 1024, swz = sb ^ (((sb >> 9) & 1) << 5); R = (st >> 1) * 16 + swz / 64; C = (st & 1) * 32 + (swz % 64) / 2; }
__host__ __device__ __forceinline__ int perm32(int rho) { const int n = rho >> 4, i = rho & 15; return 8 * (i >> 2) + 4 * n + (i & 3); }
struct Unit { int pm, pn, ks; };
struct StaticOrder {
    int nM, nN, nwg, G, c;
    __host__ __device__ void init(int nM_, int nN_, int G_, int c_) { nM = nM_; nN = nN_; nwg = nM * nN; G = G_; c = c_; }
    __host__ __device__ bool next(int i, Unit& u) const {
        const long L = (long)i * G + c; if (L >= nwg) return false;
        int wgid = (int)L; { const int q = nwg / NXCD, r = nwg % NXCD, xcd = wgid % NXCD, off = wgid / NXCD; wgid = (xcd < r ? xcd * (q + 1) : r * (q + 1) + (xcd - r) * q) + off; }
        const int nig = WGM * nN, gid = wgid / nig, fm = gid * WGM, gsz = (nM - fm) < WGM ? (nM - fm) : WGM;
        u.pm = fm + ((wgid % nig) % gsz); u.pn = (wgid % nig) / gsz; u.ks = 0; return true;
    }
};
struct LatentOrder : StaticOrder {
    __host__ __device__ bool next(int i, Unit& u) const { if (!StaticOrder::next(i, u)) return false; u.pm = u.pm < 16 ? u.pm + 1 : u.pm + 2; return true; }
};
struct PieceOrder {
    int nN, S, n, G, c;
    __host__ __device__ void init(int nN_, int S_, int G_, int c_) { nN = nN_; S = S_; n = 2 * nN_ * S_; G = G_; c = c_; }
    __host__ __device__ bool next(int i, Unit& u) const { const long L = (long)i * G + c; if (L >= n) return false; const int li = (int)L; u.ks = li % S; u.pn = (li / S) % nN; u.pm = (li / (S * nN)) ? 17 : 0; return true; }
};
struct PieceAB {
    static constexpr bool VARK = false;
    const bf16* A; const bf16* Bt; int lda, ldb, Kp;
    __device__ __forceinline__ const char* a_base(const Unit& u) const { return (const char*)(A + (size_t)u.pm * BM * lda + (size_t)u.ks * Kp); }
    __device__ __forceinline__ const char* b_base(const Unit& u) const { return (const char*)(Bt + (size_t)u.pn * BM * ldb + (size_t)u.ks * Kp); }
};
#if X_BF16
typedef bf16 slab_t;
#else
typedef float slab_t;
#endif
struct EpiSlab {
    static constexpr bool PERM = false;
    slab_t* slab;
    __device__ __forceinline__ void operator()(const f32x4 (&acc)[2][2][4][2], const Unit& u, int wr, int wc, int fr, int fq) const {
        const int row0 = (u.pm ? 256 : 0) + wr * 64 + fr, col0 = u.pn * BM + wc * 32 + 4 * fq; slab_t* base = slab + (size_t)u.ks * (512 * 2048);
#pragma unroll
        for (int ai = 0; ai < 2; ++ai)
#pragma unroll
            for (int m = 0; m < 4; ++m) { slab_t* rowp = base + (size_t)(row0 + ai * HALF + m * 16) * 2048 + col0;
#pragma unroll
                for (int bj = 0; bj < 2; ++bj)
#pragma unroll
                    for (int n = 0; n < 2; ++n) {
#if X_BF16
                        const f32x4 a = acc[ai][bj][m][n]; *(v2u*)(rowp + bj * HALF + n * 16) = (v2u){cvt_pk_bf16(a[0], a[1]), cvt_pk_bf16(a[2], a[3])};
#else
                        *(f32x4*)(rowp + bj * HALF + n * 16) = acc[ai][bj][m][n];
#endif
                    } }
    }
};
struct PlainAB {
    static constexpr bool VARK = false;
    const bf16* A; const bf16* Bt; int lda, ldb;
    __device__ __forceinline__ const char* a_base(const Unit& u) const { return (const char*)(A + (size_t)u.pm * BM * lda); }
    __device__ __forceinline__ const char* b_base(const Unit& u) const { return (const char*)(Bt + (size_t)u.pn * BM * ldb); }
};
struct EpiBf16 {
    static constexpr bool PERM = true;
    bf16* O; int ldc; const float* ssq; int s0, ns; float invk; float postmul = 1.0f;
    __device__ __forceinline__ void operator()(const f32x4 (&acc)[2][2][4][2], const Unit& u, int wr, int wc, int fr, int fq) const {
        const int row0 = u.pm * BM + wr * 64 + fr; const int col0 = u.pn * BM + wc * 32 + 8 * fq;
        float scs[2][4];
#pragma unroll
        for (int ai = 0; ai < 2; ++ai)
#pragma unroll
            for (int m = 0; m < 4; ++m) scs[ai][m] = 1.0f;
        if (ssq) {
            f32x4 pa[2][4], pb[2][4];
#pragma unroll
            for (int ai = 0; ai < 2; ++ai)
#pragma unroll
                for (int m = 0; m < 4; ++m) { const float* p = ssq + (size_t)(row0 + ai * HALF + m * 16) * 12 + s0; pa[ai][m] = *(const f32x4*)p; pb[ai][m] = (ns > 4) ? *(const f32x4*)(p + 4) : (f32x4){0.f, 0.f, 0.f, 0.f}; }
#pragma unroll
            for (int ai = 0; ai < 2; ++ai)
#pragma unroll
                for (int m = 0; m < 4; ++m) { const f32x4 t = pa[ai][m] + pb[ai][m]; scs[ai][m] = postmul / sqrtf(((t[0] + t[1]) + (t[2] + t[3])) * invk + 1e-6f); }
        }
#pragma unroll
        for (int ai = 0; ai < 2; ++ai)
#pragma unroll
            for (int m = 0; m < 4; ++m) { const int row = row0 + ai * HALF + m * 16; bf16* rowp = O + (size_t)row * ldc + col0; const float sc = scs[ai][m];
                constexpr size_t bjstep = HALF;
#pragma unroll
                for (int bj = 0; bj < 2; ++bj) { const f32x4 v0 = acc[ai][bj][m][0] * sc, v1 = acc[ai][bj][m][1] * sc;
                    v4u w; w.x = cvt_pk_bf16(v0[0], v0[1]); w.y = cvt_pk_bf16(v0[2], v0[3]); w.z = cvt_pk_bf16(v1[0], v1[1]); w.w = cvt_pk_bf16(v1[2], v1[3]);
                    *(v4u*)(rowp + bj * bjstep) = w; } }
    }
};

#ifndef GEMM_SP2
#define GEMM_SP2 true
#endif
#ifndef GEMM_ALIGN
#define GEMM_ALIGN true
#endif
template <class Epi, class AB, class Sched = StaticOrder, bool ALIGN_EPI = GEMM_ALIGN, bool SP2 = GEMM_SP2>
__device__ __forceinline__ void gemm_phase(LAS unsigned char* lds, const AB ab, const int K, const Sched& S, const Epi& E) {
    int tid = threadIdx.x; asm volatile("" : "+v"(tid));
    const int wid = __builtin_amdgcn_readfirstlane(tid >> 6), lane = tid & 63, wr = wid >> 2, wc = wid & 3, fr = lane & 15, fq = lane >> 4;
    int nt = K / BK;
    unsigned voffA[2], voffB[2], voffAn[2]; int stR[2], stC[2];
#pragma unroll
    for (int i = 0; i < 2; ++i) { int R, C; stage_rc(tid * 16 + i * 8192, R, C); const int Rb = Epi::PERM ? ((R & ~31) + perm32(R & 31)) : R; stR[i] = R; stC[i] = C;
        voffA[i] = (unsigned)(R * ab.lda + C) * 2u; voffB[i] = (unsigned)(Rb * ab.ldb + C) * 2u; voffAn[i] = voffA[i]; }
    const size_t kstep = (size_t)(BK * 2);
    size_t hstepA = (size_t)HALF * ab.lda * 2, hstepAn = hstepA; const size_t hstepB = (size_t)HALF * ab.ldb * 2; int ntn = nt;
    const unsigned ldsw = (unsigned)wid * 1024u;
    const int aoff = lds_byte(wr * 64 + fr, fq * 8), boff = lds_byte(wc * 32 + fr, fq * 8);
#define PG8_SA(b, h) (((b) * 2 + (h)) * HTB)
#define PG8_SB(b, h) ((4 + (b) * 2 + (h)) * HTB)
#define PG8_STAGE(bufoff, gbase, voff) do { _Pragma("unroll") for (int _i = 0; _i < 2; ++_i) \
        __builtin_amdgcn_global_load_lds((const unsigned*)((const char*)(gbase) + (voff)[_i]), (LAS unsigned*)(lds + (bufoff) + ldsw + _i * 8192), 16, 0, 0); } while (0)
#define PG8_LDA(dst, b, h) do { _Pragma("unroll") for (int m = 0; m < 4; ++m) _Pragma("unroll") for (int k = 0; k < 2; ++k) dst[m][k] = *(const LAS bf16x8*)(lds + PG8_SA(b, h) + aoff + m * 2048 + k * 1024); } while (0)
#define PG8_LDB(dst, b, h) do { _Pragma("unroll") for (int n = 0; n < 2; ++n) _Pragma("unroll") for (int k = 0; k < 2; ++k) dst[n][k] = *(const LAS bf16x8*)(lds + PG8_SB(b, h) + boff + n * 2048 + k * 1024); } while (0)
#define PG8_MMA(ai, bj, At, Bt) do { __builtin_amdgcn_s_setprio(1); _Pragma("unroll") for (int m = 0; m < 4; ++m) _Pragma("unroll") for (int n = 0; n < 2; ++n) _Pragma("unroll") for (int k = 0; k < 2; ++k) \
        acc[ai][bj][m][n] = __builtin_amdgcn_mfma_f32_16x16x32_bf16(Bt[n][k], At[m][k], acc[ai][bj][m][n], 0, 0, 0); __builtin_amdgcn_s_setprio(0); } while (0)
#define PG8_WAIT_V(n) asm volatile("s_waitcnt vmcnt(" #n ")" ::: "memory")
#define PG8_WAIT_L(n) asm volatile("s_waitcnt lgkmcnt(" #n ")" ::: "memory")
#define PG8_BAR __builtin_amdgcn_s_barrier()
#define PG8_SCHED __builtin_amdgcn_sched_barrier(0)
    Unit cur, nxt; int ui = 0;
    if (!S.next(0, cur)) return;
    f32x4 acc[2][2][4][2];
#pragma unroll
    for (int a = 0; a < 2; ++a)
#pragma unroll
        for (int b = 0; b < 2; ++b)
#pragma unroll
            for (int m = 0; m < 4; ++m)
#pragma unroll
                for (int n = 0; n < 2; ++n) acc[a][b][m][n] = (f32x4){0.f, 0.f, 0.f, 0.f};
    bf16x8 At[4][2], B0[2][2], B1[2][2];
    const char* cA = ab.a_base(cur); const char* cB = ab.b_base(cur);
    if constexpr (AB::VARK) { const int la_ = ab.lda_of(cur); nt = ab.ktiles(cur); hstepA = (size_t)HALF * la_ * 2;
#pragma unroll
        for (int i = 0; i < 2; ++i) voffA[i] = (unsigned)(stR[i] * la_ + stC[i]) * 2u; }
    if constexpr (SP2) {
    PG8_STAGE(PG8_SB(0, 0), cB, voffB); PG8_STAGE(PG8_SB(0, 1), cB + hstepB, voffB); PG8_STAGE(PG8_SA(0, 0), cA, voffA); PG8_STAGE(PG8_SA(0, 1), cA + hstepA, voffA);
    if (wr == 1) PG8_BAR;
    PG8_WAIT_V(2); PG8_BAR;
    PG8_STAGE(PG8_SB(1, 0), cB + kstep, voffB); PG8_STAGE(PG8_SA(1, 0), cA + kstep, voffA); PG8_STAGE(PG8_SB(1, 1), cB + hstepB + kstep, voffB);
    PG8_WAIT_V(6); PG8_BAR;
    } else {
    PG8_STAGE(PG8_SB(0, 0), cB, voffB); PG8_STAGE(PG8_SA(0, 0), cA, voffA); PG8_STAGE(PG8_SB(0, 1), cB + hstepB, voffB); PG8_STAGE(PG8_SA(0, 1), cA + hstepA, voffA);
    if (wr == 1) PG8_BAR;
    PG8_WAIT_V(4); PG8_BAR;
    PG8_STAGE(PG8_SB(1, 0), cB + kstep, voffB); PG8_STAGE(PG8_SA(1, 0), cA + kstep, voffA); PG8_STAGE(PG8_SB(1, 1), cB + hstepB + kstep, voffB);
    PG8_WAIT_V(6); PG8_BAR;
    }
    for (;;) {
        const bool has_next = S.next(ui + 1, nxt);
        const char* nA = has_next ? ab.a_base(nxt) : cA; const char* nB = has_next ? ab.b_base(nxt) : cB;
        if constexpr (AB::VARK) { if (has_next) { const int la_ = ab.lda_of(nxt); ntn = ab.ktiles(nxt); hstepAn = (size_t)HALF * la_ * 2;
#pragma unroll
                for (int i = 0; i < 2; ++i) voffAn[i] = (unsigned)(stR[i] * la_ + stC[i]) * 2u; } else { ntn = nt; hstepAn = hstepA; voffAn[0] = voffA[0]; voffAn[1] = voffA[1]; } }
        for (int t = 0; t < nt; t += 2) {
            const bool last = (t == nt - 2);
            const char* a1 = cA + (size_t)(t + 1) * kstep;
            const char* a2 = last ? nA : cA + (size_t)(t + 2) * kstep; const char* b2 = last ? nB : cB + (size_t)(t + 2) * kstep;
            const char* a3 = a2 + kstep; const char* b3 = b2 + kstep;
            unsigned voffA2[2]; size_t hstepA2;
            if constexpr (AB::VARK) { voffA2[0] = last ? voffAn[0] : voffA[0]; voffA2[1] = last ? voffAn[1] : voffA[1]; hstepA2 = last ? hstepAn : hstepA; }
            else { voffA2[0] = voffA[0]; voffA2[1] = voffA[1]; hstepA2 = hstepA; }
            if constexpr (SP2) {
            PG8_LDB(B0, 0, 0); PG8_LDB(B1, 0, 1); PG8_SCHED; PG8_LDA(At, 0, 0); PG8_STAGE(PG8_SA(1, 1), a1 + hstepA, voffA);
            PG8_WAIT_V(8); PG8_WAIT_L(0); PG8_BAR; PG8_MMA(0, 0, At, B0); PG8_MMA(0, 1, At, B1); PG8_BAR; PG8_SCHED;
            PG8_LDA(At, 0, 1); PG8_STAGE(PG8_SB(0, 0), b2, voffB); PG8_STAGE(PG8_SB(0, 1), b2 + hstepB, voffB); PG8_STAGE(PG8_SA(0, 0), a2, voffA2);
            PG8_WAIT_V(8); PG8_WAIT_L(0); PG8_BAR; PG8_MMA(1, 0, At, B0); PG8_MMA(1, 1, At, B1); PG8_BAR; PG8_SCHED;
            PG8_LDB(B0, 1, 0); PG8_LDB(B1, 1, 1); PG8_SCHED; PG8_LDA(At, 1, 0); PG8_STAGE(PG8_SA(0, 1), a2 + hstepA2, voffA2);
            PG8_WAIT_V(8); PG8_WAIT_L(0); PG8_BAR; PG8_MMA(0, 0, At, B0); PG8_MMA(0, 1, At, B1); PG8_BAR; PG8_SCHED;
            PG8_LDA(At, 1, 1); PG8_STAGE(PG8_SB(1, 0), b3, voffB); PG8_STAGE(PG8_SB(1, 1), b3 + hstepB, voffB); PG8_STAGE(PG8_SA(1, 0), a3, voffA2);
            PG8_WAIT_V(8); PG8_WAIT_L(0); PG8_BAR; PG8_MMA(1, 0, At, B0); PG8_MMA(1, 1, At, B1); PG8_BAR; PG8_SCHED;
            } else {
            PG8_LDB(B0, 0, 0); PG8_SCHED; PG8_LDA(At, 0, 0); PG8_STAGE(PG8_SA(1, 1), a1 + hstepA, voffA);
            PG8_WAIT_L(8); PG8_BAR; PG8_WAIT_L(0); PG8_MMA(0, 0, At, B0); PG8_BAR; PG8_SCHED;
            PG8_LDB(B1, 0, 1); PG8_STAGE(PG8_SB(0, 0), b2, voffB);
            PG8_BAR; PG8_WAIT_L(0); PG8_MMA(0, 1, At, B1); PG8_BAR;
            PG8_LDA(At, 0, 1); PG8_STAGE(PG8_SA(0, 0), a2, voffA2);
            PG8_BAR; PG8_WAIT_L(0); PG8_MMA(1, 0, At, B0); PG8_BAR; PG8_SCHED;
            PG8_STAGE(PG8_SB(0, 1), b2 + hstepB, voffB);
            PG8_WAIT_V(6); PG8_BAR; PG8_MMA(1, 1, At, B1); PG8_BAR;
            PG8_LDB(B0, 1, 0); PG8_SCHED; PG8_LDA(At, 1, 0); PG8_STAGE(PG8_SA(0, 1), a2 + hstepA2, voffA2);
            PG8_WAIT_L(8); PG8_BAR; PG8_WAIT_L(0); PG8_MMA(0, 0, At, B0); PG8_BAR; PG8_SCHED;
            PG8_LDB(B1, 1, 1); PG8_STAGE(PG8_SB(1, 0), b3, voffB);
            PG8_BAR; PG8_WAIT_L(0); PG8_MMA(0, 1, At, B1); PG8_BAR;
            PG8_LDA(At, 1, 1); PG8_STAGE(PG8_SA(1, 0), a3, voffA2);
            PG8_BAR; PG8_WAIT_L(0); PG8_MMA(1, 0, At, B0); PG8_BAR; PG8_SCHED;
            PG8_STAGE(PG8_SB(1, 1), b3 + hstepB, voffB);
            PG8_WAIT_V(6); PG8_BAR; PG8_MMA(1, 1, At, B1); PG8_BAR;
            }
        }
        if constexpr (ALIGN_EPI) { if (wr == 0) PG8_BAR; }
        E(acc, cur, wr, wc, fr, fq);
        if (!has_next) break;
#pragma unroll
        for (int a = 0; a < 2; ++a)
#pragma unroll
            for (int b = 0; b < 2; ++b)
#pragma unroll
                for (int m = 0; m < 4; ++m)
#pragma unroll
                    for (int n = 0; n < 2; ++n) acc[a][b][m][n] = (f32x4){0.f, 0.f, 0.f, 0.f};
        cur = nxt; cA = nA; cB = nB; ++ui;
        if constexpr (AB::VARK) { nt = ntn; hstepA = hstepAn; voffA[0] = voffAn[0]; voffA[1] = voffAn[1]; }
        if constexpr (ALIGN_EPI) { if (wr == 1) PG8_BAR; }
    }
    PG8_WAIT_V(0);
    if constexpr (!ALIGN_EPI) { if (wr == 0) PG8_BAR; }
    PG8_BAR;
#undef PG8_SA
#undef PG8_SB
#undef PG8_STAGE
#undef PG8_LDA
#undef PG8_LDB
#undef PG8_MMA
#undef PG8_WAIT_V
#undef PG8_WAIT_L
#undef PG8_BAR
#undef PG8_SCHED
}
}

__device__ __forceinline__ void pro_mod(Frame& F) {
    LAS float* sil = (LAS float*)F.lds;
    LAS float* red = (LAS float*)(F.lds + 24576);
    const float* c = F.in[1]; const float* cc = F.in[3];
    for (int i = F.tid; i < 3 * DM; i += NTHR) { const int w = i / DM, k = i - w * DM; const float v = (w < 2) ? c[w * DM + k] : cc[k]; sil[i] = v / (1.0f + expf(-v)); }
    __syncthreads();
    float* MOD = WSP(float, WS_MOD);
    const int k0 = F.wave * 256;
    for (int unit = F.vcu; unit < DEPTH * 192; unit += F.G) {
        const int l = unit / 192, cg = unit - l * 192;
        const float* W = F.in[4] + (size_t)l * DM * (6 * DM) + cg * 64 + F.lane;
        float a0 = 0.f, a1 = 0.f, a2 = 0.f;
#pragma unroll 16
        for (int k = k0; k < k0 + 256; ++k) { const float w = __builtin_nontemporal_load(W + (size_t)k * (6 * DM)); a0 += sil[k] * w; a1 += sil[DM + k] * w; a2 += sil[2 * DM + k] * w; }
        red[(F.wave * 3 + 0) * 64 + F.lane] = a0; red[(F.wave * 3 + 1) * 64 + F.lane] = a1; red[(F.wave * 3 + 2) * 64 + F.lane] = a2;
        __syncthreads();
        if (F.tid < 192) { const int j = F.tid >> 6, ln = F.tid & 63; float s = 0.f;
#pragma unroll
            for (int w = 0; w < 8; ++w) s += red[(w * 3 + j) * 64 + ln];
            MOD[((size_t)l * 3 + j) * (6 * DM) + cg * 64 + ln] = s + F.in[5][(size_t)l * (6 * DM) + cg * 64 + ln]; }
        __syncthreads();
    }
}

__device__ __forceinline__ void tr_tile(const float* __restrict__ W, int K, int N, bf16* __restrict__ WT, const float* kscale, LAS float* scr, int item, int lane, int ldk = 0, int remap_n0 = -1, int remap_add = 0) {
    if (ldk == 0) ldk = K;
    const int nblk = N >> 5, kb = item / nblk, nb = item - kb * nblk, k0 = kb * 64, n0 = nb * 32, nd0 = (n0 == remap_n0) ? n0 + remap_add : n0;
#pragma unroll
    for (int i = 0; i < 8; ++i) { const int kk = 8 * i + (lane >> 3), c4 = (lane & 7) * 4;
        f32x4 v = __builtin_nontemporal_load((const f32x4*)(W + (size_t)(k0 + kk) * N + n0 + c4)); if (kscale) v = v * kscale[k0 + kk];
        scr[kk * 33 + c4 + 0] = v[0]; scr[kk * 33 + c4 + 1] = v[1]; scr[kk * 33 + c4 + 2] = v[2]; scr[kk * 33 + c4 + 3] = v[3]; }
    LDS_WAIT(); asm volatile("" ::: "memory");
    const int c = lane & 7;
#pragma unroll
    for (int j = 0; j < 4; ++j) { const int n = (lane >> 3) + 8 * j; const LAS float* s = scr + (8 * c) * 33 + n;
        v4u o; o.x = cvt_pk_bf16(s[0], s[33]); o.y = cvt_pk_bf16(s[66], s[99]); o.z = cvt_pk_bf16(s[132], s[165]); o.w = cvt_pk_bf16(s[198], s[231]);
        *(v4u*)(WT + (size_t)(nd0 + n) * ldk + k0 + 8 * c) = o; }
    LDS_WAIT(); asm volatile("" ::: "memory");
}
__device__ __forceinline__ void pro_transposes(Frame& F) {
    LAS float* scr = (LAS float*)(F.lds + F.wave * 16384);
    const int gw = F.vcu * NWAVES + F.wave, NGW = F.G * NWAVES;
    constexpr int I0 = 32 * 106, I1 = 8 * 48, I2 = 4 * 64, I3 = 32 * 64, I4 = 32 * 352, I5 = 88 * 64, IL = I0 + I1 + I2 + I3 + I4 + I5;
    for (int it = gw; it < DEPTH * IL; it += NGW) {
        const int l = DEPTH - 1 - it / IL; int r = it - (it / IL) * IL;
        if (r < I0) { tr_tile(F.in[7] + (size_t)l * DM * DIN, DM, DIN, WSP(bf16, WS_WIN) + (size_t)l * DINP * DM, nullptr, scr, r, F.lane, 0, 3360, 96); continue; } r -= I0;
        if (r < I1) { tr_tile(F.in[23] + (size_t)l * QRANK * DQ, QRANK, DQ, WSP(bf16, WS_WSM) + (size_t)l * WSM_ROWS * 512, F.in[21] + l * QRANK, scr, r, F.lane); continue; } r -= I1;
        if (r < I2) { tr_tile(F.in[24] + (size_t)l * KVRANK * DKV, KVRANK, DKV, WSP(bf16, WS_WSM) + ((size_t)l * WSM_ROWS + 3584) * 512, F.in[22] + l * KVRANK, scr, r, F.lane, 512); continue; } r -= I2;
        if (r < I3) { tr_tile(F.in[26] + (size_t)l * DMIX * DM, DMIX, DM, WSP(bf16, WS_WOUT) + (size_t)l * DM * DMIX, nullptr, scr, r, F.lane); continue; } r -= I3;
        if (r < I4) { tr_tile(F.in[27] + (size_t)l * DM * 2 * DFF, DM, 2 * DFF, WSP(bf16, WS_WUP) + (size_t)l * 2 * DFF * DM, nullptr, scr, r, F.lane); continue; } r -= I4;
        tr_tile(F.in[29] + (size_t)l * DFF * DM, DFF, DM, WSP(bf16, WS_WDN) + (size_t)l * DM * DFF, nullptr, scr, r, F.lane);
    }
    { const v4u z = {0u, 0u, 0u, 0u}; constexpr int per = (DINP - DIN) * DM / 8;
      for (int i = F.vcu * NTHR + F.tid; i < DEPTH * per; i += F.G * NTHR) { const int l = i / per, j = i - l * per; const int row = j / (DM / 8), ch = j - row * (DM / 8);
          const int drow = row < 96 ? 3360 + row : 3488 + (row - 96);
          *(v4u*)(WSP(bf16, WS_WIN) + ((size_t)l * DINP + drow) * DM + (size_t)ch * 8) = z; } }
}
__device__ __forceinline__ void pro_lru_w(Frame& F) {
    bf16* WL = WSP(bf16, WS_WLRU);
    constexpr int total = DEPTH * 2 * 4 * 256 * 64;
    for (int i = F.vcu * NTHR + F.tid; i < total; i += F.G * NTHR) {
        const int ch = i & 63, row = (i >> 6) & 255, blk = (i >> 14) & 3, dir = (i >> 16) & 1, l = i >> 17;
        const int g = row >> 7, e = row & 127, j4 = ch >> 4, d0 = (ch & 15) * 8;
        const float* Wsrc = (g ? F.in[18] : F.in[16]) + ((((size_t)l * 2 + dir) * 4 + blk) * 128) * 128;
        const float* cw = F.in[15] + (((size_t)l * 2 + dir) * 4 + j4) * LRUC + blk * 128 + d0;
        float v[8];
#pragma unroll
        for (int j = 0; j < 8; ++j) v[j] = cw[j] * Wsrc[(size_t)(d0 + j) * 128 + e];
        v4u o; o.x = cvt_pk_bf16(v[0], v[1]); o.y = cvt_pk_bf16(v[2], v[3]); o.z = cvt_pk_bf16(v[4], v[5]); o.w = cvt_pk_bf16(v[6], v[7]);
        *(v4u*)(WSP(bf16, WS_WSM) + ((size_t)l * WSM_ROWS + 1536) * 512 + (size_t)(i & ((1 << 17) - 1)) * 8) = o;
    }
}
__device__ __forceinline__ void pro_rope(Frame& F) {
    { float* SP = WSP(float, WS_SP); for (int i = F.vcu * NTHR + F.tid; i < DEPTH * 2 * LRUC; i += F.G * NTHR) SP[i] = log1pf(expf(-F.in[20][i])); }
    float* R = WSP(float, WS_ROPE);
    for (int i = F.vcu * NTHR + F.tid; i < SEQ * 32; i += F.G * NTHR) { const int t = i >> 5, f = i & 31; const float pos = (f < 16) ? (float)(t >> 6) : (float)(t & 63);
        const float inv = powf(10000.0f, -(float)(f & 15) / 16.0f); const float a = pos * inv; R[t * 64 + f] = cosf(a); R[t * 64 + 32 + f] = sinf(a); }
}
__device__ __forceinline__ void pro_hid(Frame& F) {
    LAS float* h1 = (LAS float*)(F.lds + F.wave * 16384);
    float* HID = WSP(float, WS_HID);
    const int gw = F.vcu * NWAVES + F.wave, NGW = F.G * NWAVES;
    const int tl = F.lane & 15, part = F.lane >> 4;
    for (int wi = gw; wi < DEPTH * 272; wi += NGW) {
        const int l = __builtin_amdgcn_readfirstlane(wi / 272), tt = (wi - l * 272) * 16 + tl;
        const int L = tt < 4096 ? 4096 : 256, t = tt < 4096 ? tt : tt - 4096;
        const float tn = (float)t / (float)L;
        float sb[16], cb[16];
#pragma unroll
        for (int b = 0; b < 16; ++b) { const float ang = (6.2831855f * tn) * (float)(b + 1); sb[b] = sinf(ang); cb[b] = cosf(ang); }
        const float* w1p = F.in[9] + (size_t)l * 33 * 64 + part * 16; const float* b1p = F.in[10] + l * 64 + part * 16;
        const float* w2p = F.in[11] + (size_t)l * 64 * 64 + part * 16; const float* b2p = F.in[12] + l * 64 + part * 16;
        for (int dd = 0; dd < 16; ++dd) { float a = b1p[dd] + tn * w1p[dd];
#pragma unroll
            for (int b = 0; b < 16; ++b) a += sb[b] * w1p[(1 + b) * 64 + dd] + cb[b] * w1p[(17 + b) * 64 + dd];
            h1[(part * 16 + dd) * 16 + tl] = sinf(a); }
        LDS_WAIT();
        float* dst = HID + ((size_t)l * 4352 + tt) * 64 + part * 16;
        float acc[16];
#pragma unroll
        for (int ee = 0; ee < 16; ++ee) acc[ee] = b2p[ee];
        for (int d = 0; d < 64; ++d) { const float hv = h1[d * 16 + tl];
#pragma unroll
            for (int ee = 0; ee < 16; ++ee) acc[ee] += hv * w2p[d * 64 + ee]; }
#pragma unroll
        for (int ee = 0; ee < 16; ee += 4) *(f32x4*)(dst + ee) = (f32x4){sinf(acc[ee]), sinf(acc[ee + 1]), sinf(acc[ee + 2]), sinf(acc[ee + 3])};
        LDS_WAIT();
    }
}
__device__ __forceinline__ void split8(const f32x4 x0, const f32x4 x1, bf16x8& h, bf16x8& l) {
    v4u hw, lw;
    hw.x = cvt_pk_bf16(x0[0], x0[1]); hw.y = cvt_pk_bf16(x0[2], x0[3]); hw.z = cvt_pk_bf16(x1[0], x1[1]); hw.w = cvt_pk_bf16(x1[2], x1[3]);
    lw.x = cvt_pk_bf16(x0[0] - bf_lo(hw.x), x0[1] - bf_hi(hw.x)); lw.y = cvt_pk_bf16(x0[2] - bf_lo(hw.y), x0[3] - bf_hi(hw.y));
    lw.z = cvt_pk_bf16(x1[0] - bf_lo(hw.z), x1[1] - bf_hi(hw.z)); lw.w = cvt_pk_bf16(x1[2] - bf_lo(hw.w), x1[3] - bf_hi(hw.w));
    h = __builtin_bit_cast(bf16x8, hw); l = __builtin_bit_cast(bf16x8, lw);
}
__device__ __forceinline__ void pro_filter(Frame& F) {
    const float* HID = WSP(float, WS_HID); float* PART = WSP(float, WS_PART);
    LAS float* wt = (LAS float*)F.lds;
    LAS float* red = (LAS float*)(F.lds + 16384);
    constexpr float dmin = 3.0701134573253945f, dstep = (15.350567286626973f - 3.0701134573253945f) / 511.0f;
    const int r32 = F.lane & 31, hi = F.lane >> 5;
    for (int item = F.vcu; item < DEPTH * 9 * 4 * 8; item += F.G) {
        int r = item; const int cg = r & 7; r >>= 3; const int od = r & 3; r >>= 2; const int tc = r % 9; const int l = r / 9;
        const int kind = tc == 8 ? 1 : 0, L = kind ? 256 : 4096, tb = (kind ? 0 : tc * 512) + F.wave * 64; const bool active = tb < L;
        const int o = od >> 1, dir = od & 1;
        { const int e = F.tid >> 3, c8 = (F.tid & 7) * 8; const float* src = F.in[13] + (size_t)l * 64 * 2048 + (size_t)e * 2048 + o * 1024 + dir * 512 + cg * 64 + c8;
          const f32x4 a = *(const f32x4*)src, b2 = *(const f32x4*)(src + 4); *(LAS f32x4*)(wt + e * 64 + c8) = a; *(LAS f32x4*)(wt + e * 64 + c8 + 4) = b2; }
        __syncthreads();
        f32x16 acc[2][2];
#pragma unroll
        for (int ct = 0; ct < 2; ++ct)
#pragma unroll
            for (int tt = 0; tt < 2; ++tt) acc[ct][tt] = f32x16{};
        if (active) {
            const float* hrow = HID + ((size_t)l * 4352 + (kind ? 4096 : 0) + tb + r32) * 64 + hi * 8;
#pragma unroll
            for (int ks = 0; ks < 4; ++ks) {
                bf16x8 bh[2], bl[2], ah[2], al[2];
#pragma unroll
                for (int tt = 0; tt < 2; ++tt) { const float* hp = hrow + (size_t)tt * 32 * 64 + ks * 16; split8(*(const f32x4*)hp, *(const f32x4*)(hp + 4), bh[tt], bl[tt]); }
#pragma unroll
                for (int ct = 0; ct < 2; ++ct) { const LAS float* wp = wt + (ks * 16 + hi * 8) * 64 + ct * 32 + r32;
                    const f32x4 x0 = {wp[0], wp[64], wp[128], wp[192]}, x1 = {wp[256], wp[320], wp[384], wp[448]}; split8(x0, x1, ah[ct], al[ct]); }
#pragma unroll
                for (int ct = 0; ct < 2; ++ct)
#pragma unroll
                    for (int tt = 0; tt < 2; ++tt) {
                        acc[ct][tt] = __builtin_amdgcn_mfma_f32_32x32x16_bf16(ah[ct], bh[tt], acc[ct][tt], 0, 0, 0);
                        acc[ct][tt] = __builtin_amdgcn_mfma_f32_32x32x16_bf16(ah[ct], bl[tt], acc[ct][tt], 0, 0, 0);
                        acc[ct][tt] = __builtin_amdgcn_mfma_f32_32x32x16_bf16(al[ct], bh[tt], acc[ct][tt], 0, 0, 0); }
            }
            bf16* gout = kind ? WSP(bf16, WS_GC) + (size_t)l * 512 * 2 * HYLC : WSP(bf16, WS_G) + (size_t)l * 512 * 2 * HYL;
            const int glen = kind ? HYLC : HYL;
            float tnv[2], keep[2]; int idx[2];
#pragma unroll
            for (int tt = 0; tt < 2; ++tt) { const int t = tb + tt * 32 + r32; tnv[tt] = (float)t / (float)L; const bool zero0 = (dir == 1 && t == 0); keep[tt] = zero0 ? 0.f : 1.f; idx[tt] = zero0 ? 0 : (dir == 0 ? L - t : L + t); }
#pragma unroll
            for (int ct = 0; ct < 2; ++ct)
#pragma unroll
                for (int rr = 0; rr < 16; ++rr) { const int cl = ct * 32 + (rr & 3) + 8 * (rr >> 2) + 4 * hi, c = cg * 64 + cl; const float delta = dmin + (float)c * dstep;
                    float asum = 0.f;
#pragma unroll
                    for (int tt = 0; tt < 2; ++tt) { const float v = acc[ct][tt][rr] * __expf(-tnv[tt] * delta) * keep[tt]; gout[((size_t)c * 2 + o) * glen + idx[tt]] = f2bf(v); asum += fabsf(v); }
                    asum += __shfl_xor(asum, 1); asum += __shfl_xor(asum, 2); asum += __shfl_xor(asum, 4); asum += __shfl_xor(asum, 8); asum += __shfl_xor(asum, 16);
                    if (r32 == 0) red[F.wave * 64 + cl] = asum; }
        } else red[F.wave * 64 + F.lane] = 0.f;
        __syncthreads();
        if (F.tid < 64) { float s = 0.f;
#pragma unroll
            for (int w = 0; w < 8; ++w) s += red[w * 64 + F.tid];
            PART[((((size_t)l * 2 + kind) * 2 + o) * 2 + dir) * 8 * 512 + (size_t)(kind ? 0 : tc) * 512 + cg * 64 + F.tid] = s; }
        __syncthreads();
    }
}

__device__ __forceinline__ void norm_pass(Frame& F, int mode, int l, bool dry = false) {
    const float* MOD = WSP(float, WS_MOD); float* X = WSP(float, WS_X); bf16* H = dry ? WSP(bf16, WS_UP) : WSP(bf16, WS_H); const bf16* Y = WSP(bf16, WS_MO); float* XO = dry ? WSP(float, WS_ACT) : X;
    const float* ng = F.in[6];
    const int gw = F.vcu * NWAVES + F.wave, NGW = F.G * NWAVES;
    const bool last = (mode == 2 && l == DEPTH - 1);
    const int co = 4 * F.lane;
    const int nfull = MR / NGW, rem = MR - nfull * NGW, spread = rem > 0 ? NGW / rem : 1;
    const int nmine = nfull + ((rem > 0 && gw % spread == 0 && gw / spread < rem) ? 1 : 0);
    for (int it = 0; it < nmine; ++it) { const int r = it < nfull ? gw + it * NGW : nfull * NGW + gw / spread;
        int b, isctx, t; row_info(r, b, isctx, t); const int which = isctx ? 2 : b;
        f32x4 xv[8];
        if (mode == 0) { const float* src = isctx ? F.in[2] + ((size_t)b * CTXL + t) * DM : F.in[0] + ((size_t)b * SEQ + t) * DM;
#pragma unroll
            for (int j = 0; j < 8; ++j) xv[j] = *(const f32x4*)(src + co + 256 * j);
        } else {
            if (isctx && l == DEPTH - 1) continue;
            const float* src = X + (size_t)r * DM; const bf16* yp = Y + (size_t)r * DM;
            const float* gpost = ng + ((size_t)l * 4 + (mode == 1 ? 1 : 3)) * DM; const float* gate = MOD + ((size_t)l * 3 + which) * (6 * DM) + (mode == 1 ? 2 : 5) * DM;
            f32x4 yv[8], gp[8], gt[8];
#pragma unroll
            for (int j = 0; j < 8; ++j) {
#if X_BF16
                { const v2u xw = __builtin_nontemporal_load((const v2u*)((const bf16*)X + (size_t)r * DM + co + 256 * j)); xv[j] = (f32x4){bf_lo(xw.x), bf_hi(xw.x), bf_lo(xw.y), bf_hi(xw.y)}; }
#else
                xv[j] = __builtin_nontemporal_load((const f32x4*)(src + co + 256 * j));
#endif
                gp[j] = *(const f32x4*)(gpost + co + 256 * j); gt[j] = *(const f32x4*)(gate + co + 256 * j); }
            if (!isctx) { v2u yw[8];
#pragma unroll
                for (int j = 0; j < 8; ++j) yw[j] = __builtin_nontemporal_load((const v2u*)(yp + co + 256 * j));
                __builtin_amdgcn_sched_barrier(0);
#pragma unroll
                for (int j = 0; j < 8; ++j) yv[j] = (f32x4){bf_lo(yw[j].x), bf_hi(yw[j].x), bf_lo(yw[j].y), bf_hi(yw[j].y)};
            } else {
                const float* sp_ = WSP(float, WS_SLAB) + (size_t)(b * CTXL + t) * DM; const int ns = (mode == 1) ? 8 : 11;
#pragma unroll
                for (int j = 0; j < 8; ++j) yv[j] = (f32x4){0.f, 0.f, 0.f, 0.f};
                for (int s = 0; s < ns; ++s) { f32x4 tv[8];
#pragma unroll
                    for (int j = 0; j < 8; ++j) tv[j] = __builtin_nontemporal_load((const f32x4*)(sp_ + (size_t)s * (512 * DM) + co + 256 * j));
                    __builtin_amdgcn_sched_barrier(0);
#pragma unroll
                    for (int j = 0; j < 8; ++j) yv[j] += tv[j]; }
            }
            float ss = 0.f;
#pragma unroll
            for (int j = 0; j < 8; ++j) ss += (yv[j][0] * yv[j][0] + yv[j][1] * yv[j][1]) + (yv[j][2] * yv[j][2] + yv[j][3] * yv[j][3]);
            ss = wave_sum(ss); const float rs = 1.0f / sqrtf(ss * (1.0f / DM) + EPS);
#pragma unroll
            for (int j = 0; j < 8; ++j) xv[j] += gt[j] * (yv[j] * rs * gp[j]);
        }
        if (!last) {
            float* dst = XO + (size_t)r * DM;
#pragma unroll
            for (int j = 0; j < 8; ++j) {
#if X_BF16
                { v2u w; w.x = cvt_pk_bf16(xv[j][0], xv[j][1]); w.y = cvt_pk_bf16(xv[j][2], xv[j][3]); __builtin_nontemporal_store(w, (v2u*)((bf16*)XO + (size_t)r * DM + co + 256 * j)); }
#else
                __builtin_nontemporal_store(xv[j], (f32x4*)(dst + co + 256 * j));
#endif
            }
        } else { if (!isctx) { float* dst = (dry ? XO : F.out) + ((size_t)b * SEQ + t) * DM;
#if PROBE_TIME != -1
            { const unsigned ticks = *(const volatile unsigned*)(F.ws + WS_CTL + 4 * CW_PROBE); const float eps = (PROBE_TIME == -2) ? 0.01f : sqrtf(PROBE_SCALE * (float)ticks);
#pragma unroll
              for (int j = 0; j < 8; ++j) xv[j] += (f32x4){eps, -eps, eps, -eps}; }
#endif
#pragma unroll
            for (int j = 0; j < 8; ++j) *(f32x4*)(dst + co + 256 * j) = xv[j]; }
            continue; }
        const int ln = (mode == 2) ? l + 1 : l; const float* gpre = ng + ((size_t)ln * 4 + (mode == 1 ? 2 : 0)) * DM;
        const float* md = MOD + ((size_t)ln * 3 + which) * (6 * DM); const float* sh = md + (mode == 1 ? 3 : 0) * DM; const float* sc = md + (mode == 1 ? 4 : 1) * DM;
        f32x4 gq[8], s4[8], h4[8];
#pragma unroll
        for (int j = 0; j < 8; ++j) { gq[j] = *(const f32x4*)(gpre + co + 256 * j); s4[j] = *(const f32x4*)(sc + co + 256 * j); h4[j] = *(const f32x4*)(sh + co + 256 * j); }
        __builtin_amdgcn_sched_barrier(0);
        float s2 = 0.f;
#pragma unroll
        for (int j = 0; j < 8; ++j) s2 += (xv[j][0] * xv[j][0] + xv[j][1] * xv[j][1]) + (xv[j][2] * xv[j][2] + xv[j][3] * xv[j][3]);
        s2 = wave_sum(s2); const float rs2 = 1.0f / sqrtf(s2 * (1.0f / DM) + EPS);
        bf16* hp = H + (size_t)r * DM;
#pragma unroll
        for (int j = 0; j < 8; ++j) { const f32x4 hv = (xv[j] * rs2 * gq[j]) * (s4[j] + 1.0f) + h4[j]; v2u w; w.x = cvt_pk_bf16(hv[0], hv[1]); w.y = cvt_pk_bf16(hv[2], hv[3]); *(v2u*)(hp + co + 256 * j) = w; }
    }
}


#if X_BF16
__device__ __forceinline__ void norm_pass_pipe(Frame& F, int mode, int l) {
    const float* MOD = WSP(float, WS_MOD); bf16* X = WSP(bf16, WS_X); bf16* H = WSP(bf16, WS_H); const bf16* Y = WSP(bf16, WS_MO);
    const float* ng = F.in[6];
    const bool last = (mode == 2 && l == DEPTH - 1);
    const int ln = (mode == 2) ? l + 1 : l;
    LAS float* P = (LAS float*)F.lds;
    for (int i = F.tid; i < 3 * DM; i += NTHR) { const int w = i / DM, c = i - w * DM;
        const float gpost = ng[((size_t)l * 4 + (mode == 1 ? 1 : 3)) * DM + c], gate = MOD[((size_t)l * 3 + w) * (6 * DM) + (mode == 1 ? 2 : 5) * DM + c];
        P[(w * 3 + 0) * DM + c] = gate * gpost;
        if (!last) { const float gpre = ng[((size_t)ln * 4 + (mode == 1 ? 2 : 0)) * DM + c]; const float* md = MOD + ((size_t)ln * 3 + w) * (6 * DM);
            P[(w * 3 + 1) * DM + c] = gpre * (1.0f + md[(mode == 1 ? 4 : 1) * DM + c]); P[(w * 3 + 2) * DM + c] = md[(mode == 1 ? 3 : 0) * DM + c]; } }
    __syncthreads();
    const int gw = F.vcu * NWAVES + F.wave, NGW = F.G * NWAVES, c8 = 8 * F.lane;
#define NP_COL(j_) (c8 + 512 * ((j_) >> 1) + 4 * ((j_) & 1))
    const int nfull = MR / NGW, rem = MR - nfull * NGW, spread = rem > 0 ? NGW / rem : 1;
    const bool bal = (NGW == 2048), cwv = (gw & 3) == 0; const int kq = gw >> 2, oq = gw - kq - 1;
    const bool lastl = (l == DEPTH - 1);
    const int nmine = bal ? (lastl ? 4 : (cwv ? 2 : 5)) : nfull + ((rem > 0 && gw % spread == 0 && gw / spread < rem) ? 1 : 0);
#define NP_LAT(q_) (((q_) >> 12) * SEGB + CTXL + ((q_) & 4095))
#define NP_ROWOF(it_) (bal ? (lastl ? NP_LAT(gw + (it_) * 2048) : cwv ? ((it_) == 0 ? (kq >> 8) * SEGB + (kq & 255) : NP_LAT(kq)) : NP_LAT(512 + oq + (it_) * 1536)) : ((it_) < nfull ? gw + (it_) * NGW : nfull * NGW + gw / spread))
#define NP_PREFETCH(rn_) do { int b_, c_, t_; row_info((rn_), b_, c_, t_); if (!(c_ && l == DEPTH - 1)) { \
        _Pragma("unroll") for (int j = 0; j < 4; ++j) nx[j] = __builtin_nontemporal_load((const v4u*)(X + (size_t)(rn_) * DM + c8 + 512 * j)); \
        if (!c_) { _Pragma("unroll") for (int j = 0; j < 4; ++j) ny[j] = __builtin_nontemporal_load((const v4u*)(Y + (size_t)(rn_) * DM + c8 + 512 * j)); } } } while (0)
#define NP_UNPK(dst_, src_) do { _Pragma("unroll") for (int j = 0; j < 4; ++j) { dst_[2 * j] = (f32x4){bf_lo(src_[j].x), bf_hi(src_[j].x), bf_lo(src_[j].y), bf_hi(src_[j].y)}; \
        dst_[2 * j + 1] = (f32x4){bf_lo(src_[j].z), bf_hi(src_[j].z), bf_lo(src_[j].w), bf_hi(src_[j].w)}; } } while (0)
    v4u nx[4], ny[4];
#pragma unroll
    for (int j = 0; j < 4; ++j) { nx[j] = (v4u){0u, 0u, 0u, 0u}; ny[j] = (v4u){0u, 0u, 0u, 0u}; }
    if (nmine > 0) NP_PREFETCH(NP_ROWOF(0));
    for (int it = 0; it < nmine; ++it) { const int r = NP_ROWOF(it);
        v4u cx[4], cy[4];
#pragma unroll
        for (int j = 0; j < 4; ++j) { cx[j] = nx[j]; cy[j] = ny[j]; }
        if (it + 1 < nmine) NP_PREFETCH(NP_ROWOF(it + 1));
        __builtin_amdgcn_sched_barrier(0);
        int b, isctx, t; row_info(r, b, isctx, t); const int which = isctx ? 2 : b;
        if (isctx && l == DEPTH - 1) continue;
        f32x4 xv[8], yv[8];
        NP_UNPK(xv, cx);
        if (!isctx) {
            NP_UNPK(yv, cy);
        } else {
            const bf16* sp_ = WSP(bf16, WS_SLAB) + (size_t)(b * CTXL + t) * DM; const int ns = (mode == 1) ? 8 : 11;
#pragma unroll
            for (int j = 0; j < 8; ++j) yv[j] = (f32x4){0.f, 0.f, 0.f, 0.f};
#pragma unroll 1
            for (int s0 = 0; s0 < ns; s0 += 4) { v4u tv[4][4];
#pragma unroll
                for (int q = 0; q < 4; ++q) { const int s = (s0 + q < ns) ? s0 + q : s0;
#pragma unroll
                    for (int j = 0; j < 4; ++j) tv[q][j] = __builtin_nontemporal_load((const v4u*)(sp_ + (size_t)s * (512 * DM) + c8 + 512 * j)); }
                __builtin_amdgcn_sched_barrier(0);
#pragma unroll
                for (int q = 0; q < 4; ++q) if (s0 + q < ns) {
#pragma unroll
                    for (int j = 0; j < 4; ++j) { yv[2 * j] += (f32x4){bf_lo(tv[q][j].x), bf_hi(tv[q][j].x), bf_lo(tv[q][j].y), bf_hi(tv[q][j].y)};
                        yv[2 * j + 1] += (f32x4){bf_lo(tv[q][j].z), bf_hi(tv[q][j].z), bf_lo(tv[q][j].w), bf_hi(tv[q][j].w)}; } } }
        }
        float ss = 0.f;
#pragma unroll
        for (int j = 0; j < 8; ++j) ss += (yv[j][0] * yv[j][0] + yv[j][1] * yv[j][1]) + (yv[j][2] * yv[j][2] + yv[j][3] * yv[j][3]);
        ss = wave_sum(ss); const float rs = 1.0f / sqrtf(ss * (1.0f / DM) + EPS);
        const LAS float* pw = P + (which * 3) * DM;
#pragma unroll
        for (int j = 0; j < 8; ++j) { const f32x4 c1 = *(const LAS f32x4*)(pw + NP_COL(j)); xv[j] += c1 * (yv[j] * rs); }
        if (!last) {
#pragma unroll
            for (int j = 0; j < 4; ++j) { v4u w; w.x = cvt_pk_bf16(xv[2 * j][0], xv[2 * j][1]); w.y = cvt_pk_bf16(xv[2 * j][2], xv[2 * j][3]); w.z = cvt_pk_bf16(xv[2 * j + 1][0], xv[2 * j + 1][1]); w.w = cvt_pk_bf16(xv[2 * j + 1][2], xv[2 * j + 1][3]);
                __builtin_nontemporal_store(w, (v4u*)(X + (size_t)r * DM + c8 + 512 * j)); }
        } else { if (!isctx) { float* dst = F.out + ((size_t)b * SEQ + t) * DM;
#if PROBE_TIME != -1
            { const unsigned ticks = *(const volatile unsigned*)(F.ws + WS_CTL + 4 * CW_PROBE); const float eps = (PROBE_TIME == -2) ? 0.01f : sqrtf(PROBE_SCALE * (float)ticks);
#pragma unroll
              for (int j = 0; j < 8; ++j) xv[j] += (f32x4){eps, -eps, eps, -eps}; }
#endif
#pragma unroll
            for (int j = 0; j < 8; ++j) *(f32x4*)(dst + NP_COL(j)) = xv[j]; }
            continue; }
        float s2 = 0.f;
#pragma unroll
        for (int j = 0; j < 8; ++j) s2 += (xv[j][0] * xv[j][0] + xv[j][1] * xv[j][1]) + (xv[j][2] * xv[j][2] + xv[j][3] * xv[j][3]);
        s2 = wave_sum(s2); const float rs2 = 1.0f / sqrtf(s2 * (1.0f / DM) + EPS);
        bf16* hp = H + (size_t)r * DM;
#pragma unroll
        for (int j = 0; j < 4; ++j) { const f32x4 c2a = *(const LAS f32x4*)(pw + DM + NP_COL(2 * j)), c3a = *(const LAS f32x4*)(pw + 2 * DM + NP_COL(2 * j)), c2b = *(const LAS f32x4*)(pw + DM + NP_COL(2 * j + 1)), c3b = *(const LAS f32x4*)(pw + 2 * DM + NP_COL(2 * j + 1));
            const f32x4 ha = (xv[2 * j] * rs2) * c2a + c3a, hb = (xv[2 * j + 1] * rs2) * c2b + c3b; v4u w; w.x = cvt_pk_bf16(ha[0], ha[1]); w.y = cvt_pk_bf16(ha[2], ha[3]); w.z = cvt_pk_bf16(hb[0], hb[1]); w.w = cvt_pk_bf16(hb[2], hb[3]); *(v4u*)(hp + c8 + 512 * j) = w; }
    }
#undef NP_ROWOF
#undef NP_PREFETCH
#undef NP_UNPK
#undef NP_COL
    __syncthreads();
}
#endif

__device__ __forceinline__ bool seg_start(int r) { const int j = r % SEGB; return j == 0 || j == CTXL; }
__device__ __forceinline__ void xr_pad_zero(Frame& F) {
    bf16* XR = WSP(bf16, WS_XR);
    for (int i = F.vcu * NTHR + F.tid; i < 2 * 4 * 12 * 16; i += F.G * NTHR) { const int ch = i & 15, pi = (i >> 4) % 12, bb = (i >> 4) / 12;
        const int prow = pi < 3 ? pi : (pi < 9 ? 256 + pi : 4352 + pi);
        unsigned zz = 0u; asm volatile("" : "+v"(zz));
        const v4u z = {zz, zz, zz, zz}; *(v4u*)(XR + ((size_t)bb * XR_ROWS + prow) * 128 + ch * 8) = z; }
}
struct EpiU {
    static constexpr bool PERM = true;
    bf16* U; bf16* UH; bf16* XR; bf16* KR; const float* ROPE; float* SSQ;
    __device__ __forceinline__ void operator()(const f32x4 (&acc)[2][2][4][2], const pg8::Unit& u, int wr, int wc, int fr, int fq) const {
        asm volatile("" : "+v"(fr), "+v"(fq));
        const int row0 = u.pm * 256 + wr * 64 + fr, pn = u.pn;
        if (pn == 13) {
            if (wc == 0) {
#pragma unroll
                for (int ai = 0; ai < 2; ++ai)
#pragma unroll
                    for (int m = 0; m < 4; ++m) { const int row = row0 + ai * 128 + m * 16; int b, isctx, t; row_info(row, b, isctx, t);
#pragma unroll
                        for (int n = 0; n < 2; ++n) { const int i0 = 8 * fq + 4 * n; const f32x4 x1 = acc[ai][0][m][n], x2 = acc[ai][1][m][n];
                            f32x4 cs = {1.f, 1.f, 1.f, 1.f}, sn = {0.f, 0.f, 0.f, 0.f};
                            if (!isctx) { cs = *(const f32x4*)(ROPE + (size_t)t * 64 + i0); sn = *(const f32x4*)(ROPE + (size_t)t * 64 + 32 + i0); }
                            const f32x4 o1 = x1 * cs - x2 * sn, o2 = x2 * cs + x1 * sn;
                            v2u w1, w2; w1.x = cvt_pk_bf16(o1[0], o1[1]); w1.y = cvt_pk_bf16(o1[2], o1[3]); w2.x = cvt_pk_bf16(o2[0], o2[1]); w2.y = cvt_pk_bf16(o2[2], o2[3]);
                            *(v2u*)(KR + (size_t)row * 64 + i0) = w1; *(v2u*)(KR + (size_t)row * 64 + 32 + i0) = w2; }
                        asm volatile("" ::: "memory"); }
            }
            return;
        }
        if (pn == 10 || pn == 11) {
#pragma unroll
            for (int ai = 0; ai < 2; ++ai)
#pragma unroll
                for (int m = 0; m < 4; ++m) { const int row = row0 + ai * 128 + m * 16; const int b = row >= SEGB ? 1 : 0, j = row - b * SEGB, prow = j < CTXL ? 3 + j : j + 9;
#pragma unroll
                    for (int bj = 0; bj < 2; ++bj) { const int blk = 2 * (pn - 10) + bj; const f32x4 v0 = acc[ai][bj][m][0], v1 = acc[ai][bj][m][1];
                        v4u w; w.x = cvt_pk_bf16(v0[0], v0[1]); w.y = cvt_pk_bf16(v0[2], v0[3]); w.z = cvt_pk_bf16(v1[0], v1[1]); w.w = cvt_pk_bf16(v1[2], v1[3]);
                        *(v4u*)(XR + (((size_t)b * 4 + blk) * XR_ROWS + prow) * 128 + wc * 32 + 8 * fq) = w; } }
            return;
        }
        const bool grp = pn < 6, doq = (pn == 8 || pn == 9), dokv = (pn == 12);
        const int col0 = pn * 256 + wc * 32 + 8 * fq, slot = doq ? (pn - 8) * 4 + wc : 8 + wc;
#pragma unroll
        for (int ai = 0; ai < 2; ++ai)
#pragma unroll
            for (int m = 0; m < 4; ++m) { const int row = row0 + ai * 128 + m * 16; bf16* rowp = grp ? UH + ((size_t)(col0 >> 3) * MR + row) * 8 : U + (size_t)row * DINP + col0;
                const size_t bjstep = grp ? (size_t)16 * MR * 8 : (size_t)128; float ss = 0.f;
#pragma unroll
                for (int bj = 0; bj < 2; ++bj) { const f32x4 v0 = acc[ai][bj][m][0], v1 = acc[ai][bj][m][1];
                    ss += (v0[0] * v0[0] + v0[1] * v0[1]) + (v0[2] * v0[2] + v0[3] * v0[3]) + (v1[0] * v1[0] + v1[1] * v1[1]) + (v1[2] * v1[2] + v1[3] * v1[3]);
                    v4u w; w.x = cvt_pk_bf16(v0[0], v0[1]); w.y = cvt_pk_bf16(v0[2], v0[3]); w.z = cvt_pk_bf16(v1[0], v1[1]); w.w = cvt_pk_bf16(v1[2], v1[3]);
                    *(v4u*)(rowp + bj * bjstep) = w; }
                if (doq || dokv) { ss += __shfl_xor(ss, 16); ss += __shfl_xor(ss, 32); if (fq == 0) SSQ[(size_t)row * 12 + slot] = ss; } }
    }
};
__device__ __forceinline__ void conv_gelu(Frame& F, int l) {
    const bf16* UP = WSP(bf16, WS_UP); bf16* ACT = WSP(bf16, WS_ACT);
    const float* cw = F.in[28] + (size_t)l * 3 * 2 * DFF;
    const int gw = F.vcu * NWAVES + F.wave, NGW = F.G * NWAVES;
    for (int wi = gw; wi < (MR / 8) * 11; wi += NGW) {
        const int rc = wi / 11, fc = wi - rc * 11, r0 = rc * 8, f0 = fc * 512 + 8 * F.lane;
        const bool has_prev = !seg_start(r0), has_next = !seg_start(r0 + 8) && (r0 + 8 < MR);
        v4u g[10], v[10];
#pragma unroll
        for (int i = 0; i < 10; ++i) { const int r = r0 - 1 + i; const bool ok = (i == 0) ? has_prev : (i == 9 ? has_next : true);
            g[i] = (v4u){0u, 0u, 0u, 0u}; v[i] = (v4u){0u, 0u, 0u, 0u};
            if (ok) { g[i] = __builtin_nontemporal_load((const v4u*)(UP + (size_t)r * (2 * DFF) + f0)); v[i] = __builtin_nontemporal_load((const v4u*)(UP + (size_t)r * (2 * DFF) + DFF + f0)); } }
        float wg[3][8], wv[3][8];
#pragma unroll
        for (int j = 0; j < 3; ++j) { const f32x4 a = *(const f32x4*)(cw + (size_t)j * 2 * DFF + f0), b2 = *(const f32x4*)(cw + (size_t)j * 2 * DFF + f0 + 4);
            const f32x4 c2 = *(const f32x4*)(cw + (size_t)j * 2 * DFF + DFF + f0), d2 = *(const f32x4*)(cw + (size_t)j * 2 * DFF + DFF + f0 + 4);
#pragma unroll
            for (int q = 0; q < 4; ++q) { wg[j][q] = a[q]; wg[j][4 + q] = b2[q]; wv[j][q] = c2[q]; wv[j][4 + q] = d2[q]; } }
#pragma unroll
        for (int i = 0; i < 8; ++i) { float o[8];
#pragma unroll
            for (int q = 0; q < 4; ++q) {
                const float ga = wg[0][2 * q] * bf_lo(g[i][q]) + wg[1][2 * q] * bf_lo(g[i + 1][q]) + wg[2][2 * q] * bf_lo(g[i + 2][q]);
                const float gb = wg[0][2 * q + 1] * bf_hi(g[i][q]) + wg[1][2 * q + 1] * bf_hi(g[i + 1][q]) + wg[2][2 * q + 1] * bf_hi(g[i + 2][q]);
                const float va = wv[0][2 * q] * bf_lo(v[i][q]) + wv[1][2 * q] * bf_lo(v[i + 1][q]) + wv[2][2 * q] * bf_lo(v[i + 2][q]);
                const float vb = wv[0][2 * q + 1] * bf_hi(v[i][q]) + wv[1][2 * q + 1] * bf_hi(v[i + 1][q]) + wv[2][2 * q + 1] * bf_hi(v[i + 2][q]);
                o[2 * q] = gelu_tanh(ga) * va; o[2 * q + 1] = gelu_tanh(gb) * vb; }
            v4u w; w.x = cvt_pk_bf16(o[0], o[1]); w.y = cvt_pk_bf16(o[2], o[3]); w.z = cvt_pk_bf16(o[4], o[5]); w.w = cvt_pk_bf16(o[6], o[7]);
            *(v4u*)(ACT + (size_t)(r0 + i) * DFF + f0) = w; }
    }
}

__device__ __forceinline__ void mix_heads(Frame& F, int l, int first_wg) {
    const bf16* YT = WSP(bf16, WS_YT); const bf16* O = WSP(bf16, WS_O); bf16* YM = WSP(bf16, WS_YMIX);
    const float* hg = F.in[25] + (size_t)l * DMIX;
    const bool only_free = (first_wg > 0 && F.G - first_wg >= 64);
    if (only_free && F.vcu < first_wg) return;
    const int gw = only_free ? (F.vcu - first_wg) * NWAVES + F.wave : ((F.vcu + F.G - first_wg % F.G) % F.G) * NWAVES + F.wave, NGW = only_free ? (F.G - first_wg) * NWAVES : F.G * NWAVES;
    LAS bf16* st = (LAS bf16*)(F.lds + F.wave * 16384);
    constexpr int NHY = (MR / 32) * 4, NLR = 0, NAT = (MR / 64) * 8;
    for (int wi = gw; wi < NHY + NLR + NAT; wi += NGW) {
        if (wi < NHY) {
            const int rt = wi >> 2, hd = wi & 3, r0 = rt * 32, cs = F.lane >> 2, rc = F.lane & 3;
            const bf16* src = YT + (size_t)(hd * 128 + cs) * MR + r0 + 8 * rc;
            v4u v[8]; float ss[8], gv[8];
#pragma unroll
            for (int k = 0; k < 8; ++k) ss[k] = 0.f;
#pragma unroll
            for (int i = 0; i < 8; ++i) { v[i] = *(const v4u*)(src + (size_t)(16 * i) * MR); gv[i] = hg[hd * 128 + 16 * i + cs]; }
            __builtin_amdgcn_sched_barrier(0);
#pragma unroll
            for (int i = 0; i < 8; ++i) {
#pragma unroll
                for (int k = 0; k < 4; ++k) { const float a = bf_lo(v[i][k]), b2 = bf_hi(v[i][k]); ss[2 * k] += a * a; ss[2 * k + 1] += b2 * b2; } }
#pragma unroll
            for (int k = 0; k < 8; ++k) { float s = ss[k]; s += __shfl_xor(s, 4); s += __shfl_xor(s, 8); s += __shfl_xor(s, 16); s += __shfl_xor(s, 32); ss[k] = 1.0f / sqrtf(s * (1.0f / 128.0f) + EPS); }
#pragma unroll
            for (int i = 0; i < 8; ++i) { const int c = 16 * i + cs; const float g = gv[i];
#pragma unroll
                for (int k = 0; k < 4; ++k) { st[(8 * rc + 2 * k) * 130 + c] = f2bf(bf_lo(v[i][k]) * ss[2 * k] * g); st[(8 * rc + 2 * k + 1) * 130 + c] = f2bf(bf_hi(v[i][k]) * ss[2 * k + 1] * g); } }
            LDS_WAIT();
#pragma unroll 8
            for (int row = 0; row < 32; ++row) { const unsigned w = *(const LAS unsigned*)(st + row * 130 + 2 * F.lane);
                *(unsigned*)(YM + (size_t)(r0 + row) * DMIX + hd * 128 + 2 * F.lane) = w; }
            LDS_WAIT();
        } else {
            const int w2 = wi - NHY - NLR, rt = w2 >> 3, hd = w2 & 7, r0 = rt * 64, q = F.lane & 3;
            const float* g = hg + (8 + hd) * 128 + q * 32;
            v4u v[4][4]; f32x4 g0[4], g1[4];
#pragma unroll
            for (int ps = 0; ps < 4; ++ps) { const int row = r0 + ps * 16 + (F.lane >> 2); const bf16* src = O + (size_t)row * (NH * VD) + hd * 128 + q * 32;
#pragma unroll
                for (int j = 0; j < 4; ++j) v[ps][j] = *(const v4u*)(src + 8 * j); }
#pragma unroll
            for (int j = 0; j < 4; ++j) { g0[j] = *(const f32x4*)(g + 8 * j); g1[j] = *(const f32x4*)(g + 8 * j + 4); }
            __builtin_amdgcn_sched_barrier(0);
#pragma unroll
            for (int ps = 0; ps < 4; ++ps) { const int row = r0 + ps * 16 + (F.lane >> 2); float ss = 0.f;
#pragma unroll
                for (int j = 0; j < 4; ++j)
#pragma unroll
                    for (int k = 0; k < 4; ++k) { const float a = bf_lo(v[ps][j][k]), b2 = bf_hi(v[ps][j][k]); ss += a * a + b2 * b2; }
                ss += __shfl_xor(ss, 1); ss += __shfl_xor(ss, 2); const float rs = 1.0f / sqrtf(ss * (1.0f / 128.0f) + EPS);
                bf16* dst = YM + (size_t)row * DMIX + (8 + hd) * 128 + q * 32;
#pragma unroll
                for (int j = 0; j < 4; ++j) {
                    v4u w; w.x = cvt_pk_bf16(bf_lo(v[ps][j][0]) * rs * g0[j][0], bf_hi(v[ps][j][0]) * rs * g0[j][1]); w.y = cvt_pk_bf16(bf_lo(v[ps][j][1]) * rs * g0[j][2], bf_hi(v[ps][j][1]) * rs * g0[j][3]);
                    w.z = cvt_pk_bf16(bf_lo(v[ps][j][2]) * rs * g1[j][0], bf_hi(v[ps][j][2]) * rs * g1[j][1]); w.w = cvt_pk_bf16(bf_lo(v[ps][j][3]) * rs * g1[j][2], bf_hi(v[ps][j][3]) * rs * g1[j][3]); *(v4u*)(dst + 8 * j) = w; } }
        }
    }
}

namespace att {
constexpr int NW = 8, QBLK = 32, KVBLK = 64;
constexpr float SCALE = 0.07216878364870323f;
constexpr float THR = 8.f;
constexpr int LDQ = DQ, LDK = DKV, LDR = ROPED, LDO = NH * VD;
constexpr int SHM_V = KVBLK * 128 * 2, SHM_K = KVBLK * 128 * 2, SHM_R = KVBLK * 64 * 2;
constexpr int OFF_V = 0, OFF_K = 2 * SHM_V, OFF_R = OFF_K + 2 * SHM_K, OFF_WS = OFF_R + 2 * SHM_R, OFF_QR = OFF_WS + NW * 64 * 4, SHM_ATTN = OFF_QR + NW * 4096;
#define KSWZ(row, colB) ((row) * 256 + ((colB) ^ (((row) & 15) << 4)))
#define RSWZ(row, colB) ((row) * 128 + ((colB) ^ ((((row) >> 1) & 7) << 4)))
#define SBAR() __builtin_amdgcn_sched_barrier(0)
__device__ __forceinline__ int crow(int r, int hi) { return (r & 3) + 8 * (r >> 2) + 4 * hi; }
template <bool FIRST> __device__ __forceinline__ void partialSM(f32x16& p0, f32x16& p1, float& m_reg, float& alpha) {
  constexpr float THRL = THR * 1.4426950408889634f;
  float pmax = p0[0]; for (int r = 1; r < 16; ++r) pmax = fmaxf(pmax, p0[r]); for (int r = 0; r < 16; ++r) pmax = fmaxf(pmax, p1[r]);
  { auto rr = __builtin_amdgcn_permlane32_swap(__float_as_uint(pmax), __float_as_uint(pmax), false, false);
    pmax = fmaxf(__uint_as_float(rr[0]), __uint_as_float(rr[1])); }
  if (!FIRST && __builtin_expect(__all(pmax <= THRL), 1)) { alpha = 1.f; }
  else { const float d = FIRST ? pmax : fmaxf(pmax, 0.f); alpha = FIRST ? 1.f : __builtin_amdgcn_exp2f(-d); m_reg += d;
    for (int r = 0; r < 16; ++r) p0[r] -= d; for (int r = 0; r < 16; ++r) p1[r] -= d; }
  for (int r = 0; r < 16; ++r) p0[r] = __builtin_amdgcn_exp2f(p0[r]);
}
__device__ __forceinline__ void finishSM(f32x16& p0, f32x16& p1, bf16x8& pa0, bf16x8& pa1, bf16x8& pa2, bf16x8& pa3) {
  for (int r = 0; r < 16; ++r) p1[r] = __builtin_amdgcn_exp2f(p1[r]);
#define PK4(P, BASE, OUT) do { unsigned a0 = cvt_pk_bf16(P[BASE + 0], P[BASE + 1]), a1 = cvt_pk_bf16(P[BASE + 2], P[BASE + 3]);   \
    unsigned b0 = cvt_pk_bf16(P[BASE + 4], P[BASE + 5]), b1 = cvt_pk_bf16(P[BASE + 6], P[BASE + 7]);                              \
    auto r0 = __builtin_amdgcn_permlane32_swap(a0, b0, false, false); auto r1 = __builtin_amdgcn_permlane32_swap(a1, b1, false, false); \
    v4u w = {r0[0], r1[0], r0[1], r1[1]}; OUT = *reinterpret_cast<bf16x8*>(&w); } while (0)
  PK4(p0, 0, pa0); PK4(p0, 8, pa1); PK4(p1, 0, pa2); PK4(p1, 8, pa3);
#undef PK4
}
__device__ __forceinline__ void qkt(f32x16& p0, f32x16& p1, const LAS char* Ks, const LAS char* Rs, const bf16x8* qr, const LAS char* qrl, int r32, int hi, float negm) {
  for (int r = 0; r < 16; ++r) { p0[r] = negm; p1[r] = negm; }
#pragma unroll
  for (int d0 = 0; d0 < 8; ++d0) { const int cb = (d0 * 16 + hi * 8) * 2;
    bf16x8 b0 = *(const LAS bf16x8*)(Ks + KSWZ(r32, cb));
    bf16x8 b1 = *(const LAS bf16x8*)(Ks + KSWZ(32 + r32, cb));
    p0 = __builtin_amdgcn_mfma_f32_32x32x16_bf16(b0, qr[d0], p0, 0, 0, 0);
    p1 = __builtin_amdgcn_mfma_f32_32x32x16_bf16(b1, qr[d0], p1, 0, 0, 0); }
#pragma unroll
  for (int d0 = 0; d0 < 4; ++d0) { const int cb = (d0 * 16 + hi * 8) * 2;
    bf16x8 b0 = *(const LAS bf16x8*)(Rs + RSWZ(r32, cb));
    bf16x8 b1 = *(const LAS bf16x8*)(Rs + RSWZ(32 + r32, cb));
    const bf16x8 qf = *(const LAS bf16x8*)(qrl + d0 * 1024);
    p0 = __builtin_amdgcn_mfma_f32_32x32x16_bf16(b0, qf, p0, 0, 0, 0);
    p1 = __builtin_amdgcn_mfma_f32_32x32x16_bf16(b1, qf, p1, 0, 0, 0); }
}
__device__ __forceinline__ int v_st(int k, int c) { const int kk = (k & ~0xC) | ((k & 4) << 1) | ((k & 8) >> 1); return ((kk >> 3) * 4 + (c >> 5)) * 512 + ((kk & 7) * 32 + (c & 31)) * 2; }
__device__ __forceinline__ int v_rd_base(int lane) { return ((lane & 3) << 3) | (((lane >> 2) & 3) << 6) | (((lane >> 4) & 1) << 5) | (((lane >> 5) & 1) << 8); }
constexpr int v_rd_off(int d0, int ks, int half) { return d0 * 512 + ks * 4096 + half * 2048; }
template <int OFF> __device__ __forceinline__ s16x4 tr_read(int vb) {
  s16x4 r; asm volatile("ds_read_b64_tr_b16 %0, %1 offset:%2" : "=&v"(r) : "v"(vb), "i"(OFF) : "memory"); return r;
}
template <int D0> __device__ __forceinline__ void pv_one(f32x16& od, int vb, bf16x8 pa0, bf16x8 pa1, bf16x8 pa2, bf16x8 pa3) {
  const s16x4 l0 = tr_read<v_rd_off(D0, 0, 0)>(vb), h0 = tr_read<v_rd_off(D0, 0, 1)>(vb), l1 = tr_read<v_rd_off(D0, 1, 0)>(vb), h1 = tr_read<v_rd_off(D0, 1, 1)>(vb);
  const s16x4 l2 = tr_read<v_rd_off(D0, 2, 0)>(vb), h2 = tr_read<v_rd_off(D0, 2, 1)>(vb), l3 = tr_read<v_rd_off(D0, 3, 0)>(vb), h3 = tr_read<v_rd_off(D0, 3, 1)>(vb);
  asm volatile("s_waitcnt lgkmcnt(0)" ::: "memory"); SBAR();
#define PK(L, H) (bf16x8){L[0], L[1], L[2], L[3], H[0], H[1], H[2], H[3]}
  od = __builtin_amdgcn_mfma_f32_32x32x16_bf16(pa0, PK(l0, h0), od, 0, 0, 0);
  od = __builtin_amdgcn_mfma_f32_32x32x16_bf16(pa1, PK(l1, h1), od, 0, 0, 0);
  od = __builtin_amdgcn_mfma_f32_32x32x16_bf16(pa2, PK(l2, h2), od, 0, 0, 0);
  od = __builtin_amdgcn_mfma_f32_32x32x16_bf16(pa3, PK(l3, h3), od, 0, 0, 0);
#undef PK
}
__device__ __forceinline__ void pv_d0(f32x16* o, int vb, bf16x8 pa0, bf16x8 pa1, bf16x8 pa2, bf16x8 pa3) {
  pv_one<0>(o[0], vb, pa0, pa1, pa2, pa3); pv_one<1>(o[1], vb, pa0, pa1, pa2, pa3); pv_one<2>(o[2], vb, pa0, pa1, pa2, pa3); pv_one<3>(o[3], vb, pa0, pa1, pa2, pa3);
  const bf16x8 ones = __builtin_bit_cast(bf16x8, (v4u){0x3f803f80u, 0x3f803f80u, 0x3f803f80u, 0x3f803f80u});
  o[4] = __builtin_amdgcn_mfma_f32_32x32x16_bf16(pa0, ones, o[4], 0, 0, 0); o[4] = __builtin_amdgcn_mfma_f32_32x32x16_bf16(pa1, ones, o[4], 0, 0, 0);
  o[4] = __builtin_amdgcn_mfma_f32_32x32x16_bf16(pa2, ones, o[4], 0, 0, 0); o[4] = __builtin_amdgcn_mfma_f32_32x32x16_bf16(pa3, ones, o[4], 0, 0, 0);
}
__device__ __forceinline__ void attn_body(const bf16* __restrict__ Qb, const bf16* __restrict__ Kh, const bf16* __restrict__ Vh, const bf16* __restrict__ Rh,
                                          bf16* __restrict__ Ob, int seq, const float* rope_tab, LAS char* lds) {
  int tid = threadIdx.x; asm volatile("" : "+v"(tid));
  const int wid = __builtin_amdgcn_readfirstlane(tid >> 6), lane = tid & 63, r32 = lane & 31, hi = lane >> 5;
  LAS char* V_lds = lds + OFF_V; LAS char* K_lds = lds + OFF_K; LAS char* R_lds = lds + OFF_R;
  LAS float* ws = (LAS float*)(lds + OFF_WS) + wid * 64; LAS float* al_l = ws + 32;
  float zf = 0.f; asm volatile("" : "+v"(zf));
  float m_reg = zf; f32x16 o[5]; bf16x8 qr[12];
#pragma unroll
  for (int d = 0; d < 5; ++d)
#pragma unroll
    for (int r = 0; r < 16; ++r) o[d][r] = zf;
  LAS char* qrl = lds + OFF_QR + wid * 4096 + lane * 16;
  const bf16* Qw = Qb + (long)(wid * QBLK + r32) * LDQ + hi * 8;
#pragma unroll
  for (int d0 = 0; d0 < 12; ++d0) qr[d0] = *reinterpret_cast<const bf16x8*>(Qw + d0 * 16);
  if (rope_tab) {
    const float* rt = rope_tab + (long)(wid * QBLK + r32) * 64;
#pragma unroll
    for (int p = 0; p < 2; ++p) {
      const float* cs = rt + p * 16 + hi * 8; const f32x4 c0 = *(const f32x4*)cs, c1 = *(const f32x4*)(cs + 4), s0 = *(const f32x4*)(cs + 32), s1 = *(const f32x4*)(cs + 36);
      const v4u x1 = *reinterpret_cast<v4u*>(&qr[8 + p]), x2 = *reinterpret_cast<v4u*>(&qr[10 + p]); v4u y1, y2;
#pragma unroll
      for (int k = 0; k < 4; ++k) { const float ca = k < 2 ? c0[2 * k] : c1[2 * k - 4], cbv = k < 2 ? c0[2 * k + 1] : c1[2 * k - 3], sa = k < 2 ? s0[2 * k] : s1[2 * k - 4], sb = k < 2 ? s0[2 * k + 1] : s1[2 * k - 3];
        const float a1 = bf_lo(x1[k]), b1 = bf_hi(x1[k]), a2 = bf_lo(x2[k]), b2 = bf_hi(x2[k]);
        y1[k] = cvt_pk_bf16(a1 * ca - a2 * sa, b1 * cbv - b2 * sb); y2[k] = cvt_pk_bf16(a2 * ca + a1 * sa, b2 * cbv + b1 * sb); }
      qr[8 + p] = *reinterpret_cast<bf16x8*>(&y1); qr[10 + p] = *reinterpret_cast<bf16x8*>(&y2); }
  }
#pragma unroll
  for (int d0 = 0; d0 < 4; ++d0) *(LAS bf16x8*)(qrl + d0 * 1024) = qr[8 + d0];
  const int sr = tid >> 4, sc = (tid & 15) * 8, vst0 = v_st(sr, sc), vst1 = v_st(32 + sr, sc);
  const int rr_ = tid >> 3, rc_ = (tid & 7) * 8;
  const int vb0 = (int)(uintptr_t)V_lds + v_rd_base(lane);
  constexpr int SDEPTH = 1;
  struct { bf16x8 vs0, vs1, ks0, ks1, rs; } sr_[SDEPTH];
  const unsigned offk0 = (unsigned)(sr * LDK + sc), offk1 = (unsigned)((32 + sr) * LDK + sc), offr = (unsigned)(rr_ * LDR + rc_);
#define SLOAD(i, k0) do { const bf16* vt_ = Vh + (size_t)(k0) * LDK; const bf16* kt_ = Kh + (size_t)(k0) * LDK; const bf16* rt_ = Rh + (size_t)(k0) * LDR; \
    sr_[i].vs0 = *(const bf16x8*)(vt_ + offk0); sr_[i].vs1 = *(const bf16x8*)(vt_ + offk1); \
    sr_[i].ks0 = *(const bf16x8*)(kt_ + offk0); sr_[i].ks1 = *(const bf16x8*)(kt_ + offk1); \
    sr_[i].rs = *(const bf16x8*)(rt_ + offr); } while (0)
#define SWRITE(b, i) do { *(LAS bf16x8*)(V_lds + (b) * SHM_V + vst0) = sr_[i].vs0;          \
    *(LAS bf16x8*)(V_lds + (b) * SHM_V + vst1) = sr_[i].vs1; int kc = sc * 2;               \
    *(LAS bf16x8*)(K_lds + (b) * SHM_K + KSWZ(sr, kc)) = sr_[i].ks0;                       \
    *(LAS bf16x8*)(K_lds + (b) * SHM_K + KSWZ(32 + sr, kc)) = sr_[i].ks1;                  \
    *(LAS bf16x8*)(R_lds + (b) * SHM_R + RSWZ(rr_, rc_ * 2)) = sr_[i].rs; } while (0)
#define SWAIT() do { if constexpr (SDEPTH == 2) asm volatile("s_waitcnt vmcnt(5)" ::: "memory"); else asm volatile("s_waitcnt vmcnt(0)" ::: "memory"); } while (0)
#define RESC(a) do { if (__any((a) < 1.f)) { if (hi == 0) al_l[r32] = (a); asm volatile("s_waitcnt lgkmcnt(0)" ::: "memory"); \
    for (int d = 0; d < 5; ++d) for (int r = 0; r < 16; ++r) o[d][r] *= al_l[crow(r, hi)]; } } while (0)
  f32x16 pA0, pA1, pB0, pB1; float alA, alB; bf16x8 pa0, pa1, pa2, pa3; const int NT = seq / KVBLK;
  constexpr int SE = 0, SO = SDEPTH - 1;
  SLOAD(SE, 0); asm volatile("s_waitcnt vmcnt(0)" ::: "memory"); SWRITE(0, SE); __syncthreads();
  qkt(pA0, pA1, K_lds, R_lds, qr, qrl, r32, hi, -m_reg); partialSM<true>(pA0, pA1, m_reg, alA);
  SLOAD(SO, KVBLK); if constexpr (SDEPTH == 2) { if (2 < NT) SLOAD(SE, 2 * KVBLK); }
  SWAIT(); SWRITE(1, SO); __syncthreads();
  for (int j = 1; j + 1 < NT; j += 2) {
    SBAR(); qkt(pB0, pB1, K_lds + SHM_K, R_lds + SHM_R, qr, qrl, r32, hi, -m_reg);
    finishSM(pA0, pA1, pa0, pa1, pa2, pa3); SBAR();
    SLOAD(SO, (j + SDEPTH) * KVBLK); SBAR();
    pv_d0(o, vb0, pa0, pa1, pa2, pa3); partialSM<false>(pB0, pB1, m_reg, alB);
    __syncthreads(); SWAIT(); SWRITE(0, SE);
    RESC(alB); __syncthreads();
    SBAR(); qkt(pA0, pA1, K_lds, R_lds, qr, qrl, r32, hi, -m_reg);
    finishSM(pB0, pB1, pa0, pa1, pa2, pa3); SBAR();
    if (SDEPTH == 1 || j + 3 < NT) SLOAD(SE, (j + 1 + SDEPTH) * KVBLK); SBAR();
    pv_d0(o, vb0 + SHM_V, pa0, pa1, pa2, pa3); partialSM<false>(pA0, pA1, m_reg, alA);
    __syncthreads(); SWAIT(); SWRITE(1, SO);
    RESC(alA); __syncthreads();
  }
  SBAR(); qkt(pB0, pB1, K_lds + SHM_K, R_lds + SHM_R, qr, qrl, r32, hi, -m_reg);
  finishSM(pA0, pA1, pa0, pa1, pa2, pa3); SBAR();
  pv_d0(o, vb0, pa0, pa1, pa2, pa3); partialSM<false>(pB0, pB1, m_reg, alB);
  __syncthreads(); RESC(alB);
  finishSM(pB0, pB1, pa0, pa1, pa2, pa3); SBAR();
  pv_d0(o, vb0 + SHM_V, pa0, pa1, pa2, pa3);
  float rli[16];
#pragma unroll
  for (int r = 0; r < 16; ++r) rli[r] = __builtin_amdgcn_rcpf(o[4][r]);
  bf16* Ow = Ob + (long)(wid * QBLK) * LDO;
#pragma unroll
  for (int r = 0; r < 16; ++r) { const int orow = crow(r, hi);
#pragma unroll
    for (int d0 = 0; d0 < 4; ++d0) Ow[(long)orow * LDO + d0 * 32 + r32] = f2bf(o[d0][r] * rli[r]); }
  __syncthreads();
#undef SLOAD
#undef SWRITE
#undef SWAIT
#undef RESC
}
}

__device__ __forceinline__ void attn_phase(Frame& F, bool need_ctx) {
    const bf16* Q = WSP(bf16, WS_Q); const bf16* KV = WSP(bf16, WS_KV); const bf16* KR = WSP(bf16, WS_KR); bf16* O = WSP(bf16, WS_O); const float* ROPE = WSP(float, WS_ROPE);
    const int nunits = 256 + (need_ctx ? 16 : 0);
    for (int u = F.vcu; u < nunits; u += F.G) {
        if (u < 256) { const int b = u >> 7, h = (u >> 4) & 7, qb = u & 15; const size_t kb = (size_t)b * SEGB, row0 = kb + CTXL + qb * 256;
            att::attn_body(Q + row0 * DQ + h * 192, KV + kb * DKV + h * 256, KV + kb * DKV + h * 256 + 128, KR + kb * ROPED, O + row0 * (NH * VD) + h * 128, SEGB, ROPE + (size_t)qb * 256 * 64, (LAS char*)F.lds);
        } else { const int b = (u - 256) >> 3, h = (u - 256) & 7; const size_t kb = (size_t)b * SEGB;
            att::attn_body(Q + kb * DQ + h * 192, KV + kb * DKV + h * 256, KV + kb * DKV + h * 256 + 128, KR + kb * ROPED, O + kb * (NH * VD) + h * 128, CTXL, nullptr, (LAS char*)F.lds);
        }
    }
}


struct LruAB {
    static constexpr bool VARK = false;
    const bf16* XR; const bf16* Bt; int lda, ldb;
    __device__ __forceinline__ static int prow0(int pm) { const int jt = pm % 17; return jt == 0 ? 3 : 265 + (jt - 1) * 256; }
    __device__ __forceinline__ const char* a_base(const pg8::Unit& u) const { const int b = u.pm / 17, dir = u.pn >> 2, blk = u.pn & 3;
        return (const char*)(XR + (((size_t)b * 4 + blk) * XR_ROWS + prow0(u.pm) - (dir ? 0 : 3)) * 128); }
    __device__ __forceinline__ const char* b_base(const pg8::Unit& u) const { return (const char*)(Bt + (size_t)u.pn * 256 * 512); }
};
struct EpiGate {
    static constexpr bool PERM = true;
    const bf16* XR; unsigned* AB; const float* ba; const float* bx; const float* sp; const float* cw;
    __device__ __forceinline__ void operator()(const f32x4 (&acc)[2][2][4][2], const pg8::Unit& u, int wr, int wc, int fr, int fq) const {
        asm volatile("" : "+v"(fr), "+v"(fq));
        const int dir = u.pn >> 2, blk = u.pn & 3, b = u.pm / 17, p0 = LruAB::prow0(u.pm);
        const bf16* xb = XR + ((size_t)b * 4 + blk) * XR_ROWS * 128;
        unsigned* abb = AB + (size_t)dir * MR * LRUC;
#pragma unroll 1
        for (int n = 0; n < 2; ++n) { const int cl = wc * 32 + 8 * fq + 4 * n, ch = blk * 128 + cl;
            const f32x4 ba4 = *(const f32x4*)(ba + dir * LRUC + ch), bx4 = *(const f32x4*)(bx + dir * LRUC + ch), sp4 = *(const f32x4*)(sp + dir * LRUC + ch) * -8.0f;
            f32x4 cw4[4];
#pragma unroll
            for (int j = 0; j < 4; ++j) cw4[j] = *(const f32x4*)(cw + ((size_t)dir * 4 + j) * LRUC + ch);
#pragma unroll
            for (int ai = 0; ai < 2; ++ai) {
                v2u xw[4][4];
#pragma unroll
                for (int m = 0; m < 4; ++m) { const int pr = p0 + ai * 128 + wr * 64 + m * 16 + fr + (dir ? 0 : -3);
#pragma unroll
                    for (int j = 0; j < 4; ++j) xw[m][j] = *(const v2u*)(xb + (unsigned)((pr + j) * 128 + cl)); }
                __builtin_amdgcn_sched_barrier(0);
#pragma unroll
                for (int m = 0; m < 4; ++m) { const int rl = ai * 128 + wr * 64 + m * 16 + fr, row = u.pm * 256 + rl;
                    f32x4 xc = {0.f, 0.f, 0.f, 0.f};
#pragma unroll
                    for (int j = 0; j < 4; ++j) { const v2u w = xw[m][j]; xc[0] += cw4[j][0] * bf_lo(w.x); xc[1] += cw4[j][1] * bf_hi(w.x); xc[2] += cw4[j][2] * bf_lo(w.y); xc[3] += cw4[j][3] * bf_hi(w.y); }
                    const f32x4 rp = (n == 0 ? acc[ai][0][m][0] : acc[ai][0][m][1]) + ba4, ip = (n == 0 ? acc[ai][1][m][0] : acc[ai][1][m][1]) + bx4;
                    v4u o;
#pragma unroll
                    for (int j = 0; j < 4; ++j) { const float rg = sigmoidf_(rp[j]), ig = sigmoidf_(ip[j]); const float la = rg * sp4[j];
                        const float x = 2.0f * la;
                        const float ser = -x * (1.0f + x * (0.5f + x * (0.16666667f + x * (0.041666668f + x * (0.008333334f + x * 0.0013888889f)))));
                        const float om = (x > -0.25f) ? ser : (1.0f - __expf(x));
                        const float bb = __builtin_amdgcn_sqrtf(om) * (ig * xc[j]); o[j] = cvt_pk_bf16(la, bb); }
                    *(v4u*)(abb + (unsigned)(row * LRUC + ch)) = o; }
                asm volatile("" ::: "memory"); }
        }
    }
};
__device__ __forceinline__ void lru_pass1(Frame& F) {
    const unsigned* AB = WSP(unsigned, WS_AB); f32x2* CARRY = WSP(f32x2, WS_CARRY);
    const int gw = ((F.vcu + F.G - 80 % F.G) % F.G) * NWAVES + F.wave, NGW = F.G * NWAVES;
    for (int wi = gw; wi < 2 * NCHUNK * 8; wi += NGW) {
        const int chg = wi & 7, cg = (wi >> 3) % NCHUNK, dir = wi / (8 * NCHUNK), ch = chg * 64 + F.lane;
        const unsigned* base = AB + ((size_t)dir * MR + cg * 64) * LRUC + ch;
        float h = 0.f, S = 0.f;
        unsigned wv[64];
#pragma unroll
        for (int i = 0; i < 64; ++i) { const int rr = dir ? 63 - i : i; wv[i] = base[(size_t)rr * LRUC]; }
        __builtin_amdgcn_sched_barrier(0);
#pragma unroll
        for (int i = 0; i < 64; ++i) { const float la = bf_lo(wv[i]); h = __expf(la) * h + bf_hi(wv[i]); S += la; }
        CARRY[((size_t)dir * NCHUNK + cg) * LRUC + ch] = (f32x2){__expf(S), h};
    }
}
__device__ __forceinline__ void lru_pass2(Frame& F) {
    const unsigned* AB = WSP(unsigned, WS_AB); const f32x2* CARRY = WSP(f32x2, WS_CARRY); const bf16* U = WSP(bf16, WS_U); float* YL = WSP(float, WS_YL);
    const int gw = F.vcu * NWAVES + F.wave, NGW = F.G * NWAVES;
    for (int wi = gw; wi < NCHUNK * 8; wi += NGW) {
        const int chg = wi & 7, cg = wi >> 3, b = cg / 68, jc = cg - b * 68, ch = chg * 64 + F.lane;
        float hf = 0.f, hb = 0.f;
        const f32x2* cf = CARRY + ((size_t)0 * NCHUNK + b * 68) * LRUC + ch; const f32x2* cbk = CARRY + ((size_t)1 * NCHUNK + b * 68) * LRUC + ch;
        for (int k = 0; k < jc; ++k) { const f32x2 c = cf[(size_t)k * LRUC]; hf = c.x * hf + c.y; }
        if (jc < 4) { for (int k = 3; k > jc; --k) { const f32x2 c = cbk[(size_t)k * LRUC]; hb = c.x * hb + c.y; } }
        else { for (int k = 3; k >= 0; --k) { const f32x2 c = cbk[(size_t)k * LRUC]; hb = c.x * hb + c.y; }
               for (int k = 67; k > jc; --k) { const f32x2 c = cbk[(size_t)k * LRUC]; hb = c.x * hb + c.y; } }
        float hfv[64];
        const unsigned* bf_ = AB + ((size_t)0 * MR + cg * 64) * LRUC + ch; const unsigned* bb_ = AB + ((size_t)1 * MR + cg * 64) * LRUC + ch;
#pragma unroll
        for (int i = 0; i < 64; ++i) { const unsigned w = bf_[(size_t)i * LRUC]; hf = __expf(bf_lo(w)) * hf + bf_hi(w); hfv[i] = hf; }
#pragma unroll
        for (int i = 63; i >= 0; --i) { const unsigned w = bb_[(size_t)i * LRUC]; hb = __expf(bf_lo(w)) * hb + bf_hi(w); const size_t row = (size_t)cg * 64 + i;
            const float g = bf2f(U[row * DINP + OFF_LRU_G + ch]); YL[row * LRUC + ch] = gelu_tanh(g) * (hfv[i] + hb); }
    }
}

#if PROBE_TIME >= 0
#define PROBE_SPLIT(ty) do { xcd_barrier(bar); if (blockIdx.x == 0 && F.tid == 0) { const unsigned t_ = (unsigned)__builtin_amdgcn_s_memrealtime(); if ((ty) == PROBE_TIME) MISCP[17] += t_ - MISCP[16]; MISCP[16] = t_; } } while (0)
#else
#define PROBE_SPLIT(ty) do { } while (0)
#endif
__device__ __forceinline__ void mix_heads(Frame& F, int l, int first_wg);
__device__ __forceinline__ void lru2_finalize(Frame& F, int l, const XcdBarrier& bar, volatile LAS unsigned* MISCP) {
    const unsigned* AB = WSP(unsigned, WS_AB); const f32x2* CARRY = WSP(f32x2, WS_CARRY); const bf16* U = WSP(bf16, WS_U); bf16* YM = WSP(bf16, WS_YMIX);
    const float* hg = F.in[25] + (size_t)l * DMIX;
    LAS bf16* yt = (LAS bf16*)F.lds;
    for (int cg = F.vcu; cg < NCHUNK; cg += F.G) {
        const int b = cg / 68, jc = cg - b * 68, ch = F.wave * 64 + F.lane;
        float hf = 0.f, hb = 0.f;
        const f32x2* cf = CARRY + ((size_t)0 * NCHUNK + b * 68) * LRUC + ch; const f32x2* cbk = CARRY + ((size_t)1 * NCHUNK + b * 68) * LRUC + ch;
        { int k = 0;
          for (; k + 8 <= jc; k += 8) { f32x2 c[8];
#pragma unroll
              for (int q = 0; q < 8; ++q) c[q] = cf[(size_t)(k + q) * LRUC];
#pragma unroll
              for (int q = 0; q < 8; ++q) hf = c[q].x * hf + c[q].y; }
          for (; k < jc; ++k) { const f32x2 c = cf[(size_t)k * LRUC]; hf = c.x * hf + c.y; } }
        {
          const int pos = jc < 4 ? 3 - jc : 71 - jc; int p = 0;
          for (; p + 8 <= pos; p += 8) { f32x2 c[8];
#pragma unroll
              for (int q = 0; q < 8; ++q) { const int pp = p + q, kb = pp < 4 ? 3 - pp : 71 - pp; c[q] = cbk[(size_t)kb * LRUC]; }
#pragma unroll
              for (int q = 0; q < 8; ++q) hb = c[q].x * hb + c[q].y; }
          for (; p < pos; ++p) { const int kb = p < 4 ? 3 - p : 71 - p; const f32x2 c = cbk[(size_t)kb * LRUC]; hb = c.x * hb + c.y; } }
        float hfv[64];
        const unsigned* bf_ = AB + ((size_t)0 * MR + cg * 64) * LRUC + ch; const unsigned* bb_ = AB + ((size_t)1 * MR + cg * 64) * LRUC + ch;
        { unsigned wv[64];
#pragma unroll
          for (int i = 0; i < 64; ++i) wv[i] = __builtin_nontemporal_load(bf_ + (size_t)i * LRUC);
          __builtin_amdgcn_sched_barrier(0);
#pragma unroll
          for (int i = 0; i < 64; ++i) { hf = __expf(bf_lo(wv[i])) * hf + bf_hi(wv[i]); hfv[i] = hf; } }
#pragma unroll
        for (int hh = 1; hh >= 0; --hh) { unsigned wb[32]; bf16 gg[32];
#pragma unroll
            for (int i = 0; i < 32; ++i) { const int ii = hh * 32 + i; wb[i] = __builtin_nontemporal_load(bb_ + (size_t)ii * LRUC); gg[i] = U[((size_t)cg * 64 + ii) * DINP + OFF_LRU_G + ch]; }
            __builtin_amdgcn_sched_barrier(0);
#pragma unroll
            for (int i = 31; i >= 0; --i) { const int ii = hh * 32 + i; hb = __expf(bf_lo(wb[i])) * hb + bf_hi(wb[i]);
                yt[ii * 520 + ch] = f2bf(gelu_tanh(bf2f(gg[i])) * (hfv[ii] + hb)); } }
        __syncthreads();
        { const int hd = F.wave & 3, rl = (F.wave >> 2) * 32 + (F.lane >> 1), half = F.lane & 1; const LAS bf16* src = yt + rl * 520 + hd * 128 + half * 64;
          v4u v[8]; float ss = 0.f;
#pragma unroll
          for (int j = 0; j < 8; ++j) { v[j] = *(const LAS v4u*)(src + 8 * j);
#pragma unroll
              for (int k = 0; k < 4; ++k) { const float a = bf_lo(v[j][k]), b2 = bf_hi(v[j][k]); ss += a * a + b2 * b2; } }
          ss += __shfl_xor(ss, 1); const float rs = 1.0f / sqrtf(ss * (1.0f / 128.0f) + EPS);
          const float* g = hg + (4 + hd) * 128 + half * 64; bf16* dst = YM + ((size_t)cg * 64 + rl) * DMIX + (4 + hd) * 128 + half * 64;
#pragma unroll
          for (int j = 0; j < 8; ++j) { const f32x4 g0 = *(const f32x4*)(g + 8 * j), g1 = *(const f32x4*)(g + 8 * j + 4);
              v4u w; w.x = cvt_pk_bf16(bf_lo(v[j][0]) * rs * g0[0], bf_hi(v[j][0]) * rs * g0[1]); w.y = cvt_pk_bf16(bf_lo(v[j][1]) * rs * g0[2], bf_hi(v[j][1]) * rs * g0[3]);
              w.z = cvt_pk_bf16(bf_lo(v[j][2]) * rs * g1[0], bf_hi(v[j][2]) * rs * g1[1]); w.w = cvt_pk_bf16(bf_lo(v[j][3]) * rs * g1[2], bf_hi(v[j][3]) * rs * g1[3]); *(v4u*)(dst + 8 * j) = w; } }
        __syncthreads();
    }
    PROBE_SPLIT(12);
    mix_heads(F, l, NCHUNK);
}

template <int NBLK, int NCH, int WPC>
__device__ __forceinline__ void hyena_item(Frame& F, int l, int item) {
    constexpr int L = 128 * NBLK, GLEN = 2 * L, ZB = NBLK * 136 + 64, ZSZ = 2 * ZB;
    constexpr int CH_BYTES = (GLEN + 2 * ZSZ) * 2 + 64;
    static_assert(CH_BYTES % 16 == 0 && NCH * CH_BYTES <= RING_BYTES && NCH * WPC == NWAVES && (NCH == 2 || NCH == 8), "hyena LDS map");
    constexpr int TT = WPC * 64;
#define HY_G(s)  ((LAS bf16*)(F.lds + (s) * CH_BYTES))
#define HY_ZA(s) (HY_G(s) + GLEN)
#define HY_ZB_(s) (HY_G(s) + GLEN + ZSZ)
#define HY_ZO(t) ((((t) >> 7) * 136) + ((t) & 127))
    const int cs = F.wave / WPC, q = F.wave % WPC, c0 = item * NCH, c = c0 + cs, tl = F.tid % TT;
    LAS bf16* Gs = HY_G(cs); LAS bf16* Zc = HY_ZA(cs); LAS bf16* Zn = HY_ZB_(cs); LAS bf16* zero = Zn + ZSZ;
    const bf16* UH = WSP(bf16, WS_PT); bf16* YT = WSP(bf16, WS_YT);
    const bf16* Gg = (NBLK == 32) ? WSP(bf16, WS_G) + ((size_t)l * 512 + c) * 2 * HYL : WSP(bf16, WS_GC) + ((size_t)l * 512 + c) * 2 * HYLC;
    const int rb0 = (NBLK == 32) ? CTXL : 0;
    const float* cwp = F.in[8] + (size_t)l * 3 * 1536;
    const int sub = (c0 & 7) >> 1;
    constexpr int NG = (2 * L + NTHR - 1) / NTHR;
    { v4u gw_[NG];
#pragma unroll
      for (int k = 0; k < NG; ++k) { const int i = F.tid + k * NTHR; const int ii = i < 2 * L ? i : 0; const int b = ii / L, t = ii - b * L; gw_[k] = *(const v4u*)(UH + ((size_t)(c0 >> 3) * MR + b * SEGB + rb0 + t) * 8); }
      __builtin_amdgcn_sched_barrier(0);
#pragma unroll
      for (int k = 0; k < NG; ++k) { const int i = F.tid + k * NTHR; if (i < 2 * L) { const int b = i / L, t = i - b * L; const int zo = b * ZB + HY_ZO(t); const v4u w = gw_[k];
        if constexpr (NCH == 2) { const unsigned ww = w[sub]; HY_ZB_(0)[zo] = (bf16)(ww & 0xffffu); HY_ZB_(1)[zo] = (bf16)(ww >> 16); }
        else {
#pragma unroll
            for (int s = 0; s < 8; ++s) HY_ZB_(s)[zo] = (bf16)((s & 1) ? (w[s >> 1] >> 16) : (w[s >> 1] & 0xffffu)); } } } }
    if (tl < 16) ((LAS unsigned*)zero)[tl] = 0u;
    __syncthreads();
    for (int i = F.tid; i < NCH * 2 * L / 8; i += NTHR) { const int s = i / (2 * L / 8), rem = i - s * (2 * L / 8), b = rem / (L / 8), t0 = (rem - b * (L / 8)) * 8;
        const LAS bf16* zr = HY_ZB_(s) + b * ZB; const float w0 = cwp[c0 + s], w1 = cwp[1536 + c0 + s], w2 = cwp[2 * 1536 + c0 + s];
        const v4u xw = *(const LAS v4u*)(zr + HY_ZO(t0)); float x[10];
        x[0] = t0 > 0 ? bf2f(zr[HY_ZO(t0 - 1)]) : 0.f; x[9] = (t0 + 8 < L) ? bf2f(zr[HY_ZO(t0 + 8)]) : 0.f;
#pragma unroll
        for (int k = 0; k < 4; ++k) { x[1 + 2 * k] = bf_lo(xw[k]); x[2 + 2 * k] = bf_hi(xw[k]); }
        v4u ow;
#pragma unroll
        for (int k = 0; k < 4; ++k) ow[k] = cvt_pk_bf16(w0 * x[2 * k] + w1 * x[2 * k + 1] + w2 * x[2 * k + 2], w0 * x[2 * k + 1] + w1 * x[2 * k + 2] + w2 * x[2 * k + 3]);
        *(LAS v4u*)(HY_ZA(s) + b * ZB + HY_ZO(t0)) = ow; }
    const int i16 = F.lane & 15, h4 = F.lane >> 4, nb = i16 >> 3, a = 8 * q + (i16 & 7);
    const int mlo = (8 * q - (NBLK - 1)) > -(NBLK - 1) ? (8 * q - (NBLK - 1)) : -(NBLK - 1), mhi = (8 * q + 7) < (NBLK - 1) ? (8 * q + 7) : (NBLK - 1);
    const float* hb = F.in[14] + (size_t)l * 2 * HYC;
    for (int o = 0; o < 2; ++o) {
        { constexpr int NF = (GLEN / 8 + TT - 1) / TT; v4u fw_[NF];
#pragma unroll
          for (int k = 0; k < NF; ++k) { const int i = tl + k * TT; fw_[k] = *(const v4u*)(Gg + (size_t)o * GLEN + 8 * (i < GLEN / 8 ? i : 0)); }
          __builtin_amdgcn_sched_barrier(0);
#pragma unroll
          for (int k = 0; k < NF; ++k) { const int i = tl + k * TT; if (i < GLEN / 8) *(LAS v4u*)(Gs + 8 * i) = fw_[k]; } }
        __syncthreads();
        f32x4 acc[8];
#pragma unroll
        for (int r = 0; r < 8; ++r) acc[r] = (f32x4){0.f, 0.f, 0.f, 0.f};
        for (int m = mlo; m <= mhi; ++m) {
            const int blk_in = a - m; const bool valid = (a < NBLK) && blk_in >= 0 && blk_in < NBLK;
            const LAS bf16* zp = valid ? (Zc + nb * ZB + blk_in * 136 + 8 * h4) : zero;
            const int zk = valid ? 1 : 0;
            const LAS bf16* gp = Gs + (L - 128 * m + 8 * (h4 - i16));
#pragma unroll
            for (int k0 = 0; k0 < 128; k0 += 32) {
                const bf16x8 zf = *(const LAS bf16x8*)(zp + zk * k0);
                const v4u lo = *(const LAS v4u*)(gp + k0 - 8), hi = *(const LAS v4u*)(gp + k0);
                const unsigned c0_ = lo.x, c1 = lo.y, c2 = lo.z, c3 = lo.w, c4 = hi.x, c5 = hi.y, c6 = hi.z, c7 = hi.w;
                const unsigned s0 = __builtin_amdgcn_alignbit(c1, c0_, 16), s1 = __builtin_amdgcn_alignbit(c2, c1, 16), s2 = __builtin_amdgcn_alignbit(c3, c2, 16), s3 = __builtin_amdgcn_alignbit(c4, c3, 16),
                               s4 = __builtin_amdgcn_alignbit(c5, c4, 16), s5 = __builtin_amdgcn_alignbit(c6, c5, 16), s6 = __builtin_amdgcn_alignbit(c7, c6, 16);
#define HYF(x0, x1, x2, x3) __builtin_bit_cast(bf16x8, (v4u){x0, x1, x2, x3})
                acc[0] = __builtin_amdgcn_mfma_f32_16x16x32_bf16(HYF(c4, c5, c6, c7), zf, acc[0], 0, 0, 0);
                acc[1] = __builtin_amdgcn_mfma_f32_16x16x32_bf16(HYF(s3, s4, s5, s6), zf, acc[1], 0, 0, 0);
                acc[2] = __builtin_amdgcn_mfma_f32_16x16x32_bf16(HYF(c3, c4, c5, c6), zf, acc[2], 0, 0, 0);
                acc[3] = __builtin_amdgcn_mfma_f32_16x16x32_bf16(HYF(s2, s3, s4, s5), zf, acc[3], 0, 0, 0);
                acc[4] = __builtin_amdgcn_mfma_f32_16x16x32_bf16(HYF(c2, c3, c4, c5), zf, acc[4], 0, 0, 0);
                acc[5] = __builtin_amdgcn_mfma_f32_16x16x32_bf16(HYF(s1, s2, s3, s4), zf, acc[5], 0, 0, 0);
                acc[6] = __builtin_amdgcn_mfma_f32_16x16x32_bf16(HYF(c1, c2, c3, c4), zf, acc[6], 0, 0, 0);
                acc[7] = __builtin_amdgcn_mfma_f32_16x16x32_bf16(HYF(s0, s1, s2, s3), zf, acc[7], 0, 0, 0);
#undef HYF
            }
        }
        __syncthreads();
        { v4u gw_[NG];
#pragma unroll
          for (int k = 0; k < NG; ++k) { const int i = F.tid + k * NTHR; const int ii = i < 2 * L ? i : 0; gw_[k] = *(const v4u*)(UH + ((size_t)((512 * (o + 1) + c0) >> 3) * MR + (ii / L) * SEGB + rb0 + (ii % L)) * 8); }
          __builtin_amdgcn_sched_barrier(0);
#pragma unroll
          for (int k = 0; k < NG; ++k) { const int i = F.tid + k * NTHR; if (i < 2 * L) { const v4u w = gw_[k];
            if constexpr (NCH == 2) { const unsigned ww = w[sub]; HY_G(0)[i] = (bf16)(ww & 0xffffu); HY_G(1)[i] = (bf16)(ww >> 16); }
            else {
#pragma unroll
                for (int s = 0; s < 8; ++s) HY_G(s)[i] = (bf16)((s & 1) ? (w[s >> 1] >> 16) : (w[s >> 1] & 0xffffu)); } } } }
        __syncthreads();
        if (a < NBLK) {
            const float bias = hb[o * HYC + c];
            float nrm = 0.f; { const float* pb = WSP(float, WS_PART) + ((((size_t)l * 2 + (NBLK == 32 ? 0 : 1)) * 2 + o) * 2) * 8 * 512 + c;
#pragma unroll
                for (int k = 0; k < (NBLK == 32 ? 8 : 1); ++k) nrm += pb[k * 512] + pb[(8 + k) * 512]; }
            const float invn = 1.0f / nrm;
            const int t0 = a * 128 + 32 * h4;
            const float w0 = cwp[512 * (o + 1) + c], w1 = cwp[1536 + 512 * (o + 1) + c], w2 = cwp[2 * 1536 + 512 * (o + 1) + c];
            const LAS bf16* pr = Gs + nb * L + t0;
            const LAS bf16* zz = Zc + nb * ZB + a * 136 + 32 * h4;
            const size_t grow = (size_t)nb * SEGB + rb0 + t0;
            float xprev = t0 > 0 ? bf2f(pr[-1]) : 0.f;
#pragma unroll
            for (int jj = 0; jj < 4; ++jj) { const v4u pw = *(const LAS v4u*)(pr + 8 * jj); const v4u zw = *(const LAS v4u*)(zz + 8 * jj); v4u ow;
                float x[10]; x[0] = xprev;
#pragma unroll
                for (int k = 0; k < 4; ++k) { x[1 + 2 * k] = bf_lo(pw[k]); x[2 + 2 * k] = bf_hi(pw[k]); }
                x[9] = (t0 + 8 * jj + 8 < L) ? bf2f(pr[8 * jj + 8]) : 0.f; xprev = x[8];
#pragma unroll
                for (int k = 0; k < 4; ++k) { const float y0 = acc[2 * k][jj] * invn, y1 = acc[2 * k + 1][jj] * invn;
                    const float p0 = w0 * x[2 * k] + w1 * x[2 * k + 1] + w2 * x[2 * k + 2], p1 = w0 * x[2 * k + 1] + w1 * x[2 * k + 2] + w2 * x[2 * k + 3];
                    const float r0 = p0 * (y0 + bf_lo(zw[k]) * bias), r1 = p1 * (y1 + bf_hi(zw[k]) * bias); ow[k] = cvt_pk_bf16(r0, r1); }
                if (o == 0) *(LAS v4u*)(Zn + nb * ZB + a * 136 + 32 * h4 + 8 * jj) = ow;
                else *(v4u*)(YT + (size_t)c * MR + grow + 8 * jj) = ow; }
        }
        __syncthreads();
        { LAS bf16* t_ = Zc; Zc = Zn; Zn = t_; }
    }
#undef HY_G
#undef HY_ZA
#undef HY_ZB_
#undef HY_ZO
}
__device__ __forceinline__ void hyena_phase(Frame& F, int l, bool need_ctx) {
    for (int item = F.vcu; item < HYC / 2; item += F.G) hyena_item<32, 2, 4>(F, l, item);
    if (need_ctx) for (int item = (F.vcu + F.G - 16 % F.G) % F.G; item < HYC / 8; item += F.G) hyena_item<2, 8, 1>(F, l, item);
}

#ifndef SMALL_BAL
#define SMALL_BAL 1
#endif
struct SmallOrder {
    int G, c;
    __host__ __device__ void init(int G_, int c_) { G = G_; c = c_; }
    __host__ __device__ bool next(int i, pg8::Unit& u) const {
        if (G != 256 || !SMALL_BAL) { const long L = (long)i * G + c; if (L >= 204 + 272 + 272) return false; int li = (int)L;
            if (li < 204) { u.ks = 0; u.pm = li / 6; u.pn = li % 6; } else if (li < 476) { li -= 204; u.ks = 1; u.pm = li >> 3; u.pn = li & 7; } else { li -= 476; u.ks = 2; u.pm = li >> 3; u.pn = li & 7; } return true; }
        int ty, li;
        if (c < 204) { if (i > 2) return false; ty = i; li = i == 0 ? c : (i == 1 ? 52 + c : 36 + c); }
        else if (c < 220) { if (i > 1) return false; ty = 1; li = i == 0 ? c - 204 : 256 + (c - 204); }
        else { if (i > 2) return false; if (i == 0) { ty = 1; li = c - 204; } else { ty = 2; li = (i == 1 ? 0 : 240) + (c - 220); if (li >= 272) return false; } }
        u.ks = ty; if (ty == 0) { u.pm = li / 6; u.pn = li % 6; } else { u.pm = li >> 3; u.pn = li & 7; } return true; }
};
struct SmallAB {
    static constexpr bool VARK = true;
    const bf16* U; const bf16* XR; const bf16* W; int lda, ldb;
    __device__ __forceinline__ int lda_of(const pg8::Unit& u) const { return u.ks == 1 ? 128 : DINP; }
    __device__ __forceinline__ int ktiles(const pg8::Unit& u) const { return u.ks == 2 ? 4 : 8; }
    __device__ __forceinline__ const char* a_base(const pg8::Unit& u) const {
        if (u.ks == 1) { const int b = u.pm / 17, dir = u.pn >> 2, blk = u.pn & 3; return (const char*)(XR + (((size_t)b * 4 + blk) * XR_ROWS + LruAB::prow0(u.pm) - (dir ? 0 : 3)) * 128); }
        return (const char*)(U + (size_t)u.pm * 256 * DINP + (u.ks == 0 ? OFF_Q : OFF_KV)); }
    __device__ __forceinline__ const char* b_base(const pg8::Unit& u) const { const int r0 = (u.ks == 0 ? 0 : (u.ks == 1 ? 1536 : 3584)) + u.pn * 256; return (const char*)(W + (size_t)r0 * 512); }
};
struct EpiSmall {
    static constexpr bool PERM = true;
    pg8::EpiBf16 eq, ekv; EpiGate eg;
    __device__ __forceinline__ void operator()(const f32x4 (&acc)[2][2][4][2], const pg8::Unit& u, int wr, int wc, int fr, int fq) const {
        if (u.ks == 1) eg(acc, u, wr, wc, fr, fq); else if (u.ks == 0) eq(acc, u, wr, wc, fr, fq); else ekv(acc, u, wr, wc, fr, fq); }
};

constexpr int NSTEPS = 2 + 10 * DEPTH;
#define REP(bit) for (int rep_ = 0; rep_ < (int)((PROBE_DUP >> (bit)) & 1) + 1; ++rep_)
#define LAUNDER() do { asm volatile("" : "+v"(F.tid), "+v"(F.lane)); asm volatile("" : "+s"(F.wave), "+s"(F.vcu)); asm volatile("" : "+s"(l)); \
    { unsigned long long w_ = (unsigned long long)F.ws; unsigned wl_ = (unsigned)w_, wh_ = (unsigned)(w_ >> 32); asm volatile("" : "+s"(wl_), "+s"(wh_)); F.ws = (unsigned char*)(((unsigned long long)wh_ << 32) | wl_); } } while (0)
#define IN(k) (lo <= (k) && (k) < hi)
#if PROBE_TIME >= 0
#define SEAM_T(k, ty) do { if (IN(k) && IN((k) + 1)) { if (blockIdx.x == 0 && F.tid == 0 && (k) == NSTEPS - 2) *(volatile unsigned*)(F.ws + WS_CTL + 4 * CW_PROBE) = MISCP[17] + (((ty) == PROBE_TIME) ? (unsigned)__builtin_amdgcn_s_memrealtime() - MISCP[16] : 0u); \
    xcd_barrier(bar); if (blockIdx.x == 0 && F.tid == 0) { const unsigned t_ = (unsigned)__builtin_amdgcn_s_memrealtime(); if ((ty) == PROBE_TIME) MISCP[17] += t_ - MISCP[16]; MISCP[16] = t_; } } } while (0)
#else
#define SEAM_T(k, ty) do { if (IN(k) && IN((k) + 1)) { xcd_barrier(bar); if (PROBE_DUP & (1u << 13)) xcd_barrier(bar); } } while (0)
#endif
#define SEAM(k) SEAM_T(k, (k) < 2 ? 10 + (k) : ((k) - 2) % 10)

template <int LI> __device__ __forceinline__ void layer_steps(Frame& F, const XcdBarrier& bar, const int lo, const int hi, volatile LAS unsigned* MISCP) {
        int l = LI; constexpr int li = LI;
        constexpr int sb = 2 + 10 * li; constexpr bool need_ctx = li < DEPTH - 1;
        if (IN(sb + 0)) REP(2) { LAUNDER(); pg8::PlainAB ab{WSP(bf16, WS_H), WSP(bf16, WS_WIN) + (size_t)l * DINP * DM, DM, DM}; pg8::StaticOrder S; S.init(MR / 256, DINP / 256, F.G, (int)blockIdx.x);
            EpiU E{WSP(bf16, WS_U), WSP(bf16, WS_PT), WSP(bf16, WS_XR), WSP(bf16, WS_KR), WSP(float, WS_ROPE), WSP(float, WS_SSQ)}; xr_pad_zero(F); pg8::gemm_phase<EpiU, pg8::PlainAB>(F.lds, ab, DM, S, E); }
        SEAM(sb + 0);
        if (IN(sb + 1)) REP(4) { LAUNDER();
            SmallAB ab{WSP(bf16, WS_U), WSP(bf16, WS_XR), WSP(bf16, WS_WSM) + (size_t)l * WSM_ROWS * 512, DINP, 512};
            SmallOrder S; S.init(F.G, F.vcu);
            EpiSmall E{pg8::EpiBf16{WSP(bf16, WS_Q), DQ, WSP(float, WS_SSQ), 0, 8, 1.0f / QRANK, att::SCALE * 1.4426950408889634f}, pg8::EpiBf16{WSP(bf16, WS_KV), DKV, WSP(float, WS_SSQ), 8, 4, 1.0f / KVRANK},
                       EpiGate{WSP(bf16, WS_XR), WSP(unsigned, WS_AB), F.in[17] + (size_t)l * 2 * LRUC, F.in[19] + (size_t)l * 2 * LRUC, WSP(float, WS_SP) + (size_t)l * 2 * LRUC, F.in[15] + (size_t)l * 2 * 4 * LRUC}};
            pg8::gemm_phase<EpiSmall, SmallAB, SmallOrder>(F.lds, ab, 512, S, E);
        }
        SEAM(sb + 1);
        if (IN(sb + 2)) { LAUNDER(); REP(5) { attn_phase(F, need_ctx); __syncthreads(); } PROBE_SPLIT(13); REP(6) { hyena_phase(F, l, need_ctx); __syncthreads(); } PROBE_SPLIT(14); REP(7) { lru_pass1(F); } }
        SEAM(sb + 2);
        if (IN(sb + 3)) REP(8) { LAUNDER(); lru2_finalize(F, l, bar, MISCP); __syncthreads(); }
        SEAM(sb + 3);
        if (IN(sb + 4)) REP(9) { LAUNDER();
            { pg8::PlainAB ab{WSP(bf16, WS_YMIX), WSP(bf16, WS_WOUT) + (size_t)l * DM * DMIX, DMIX, DMIX}; pg8::LatentOrder S; S.init(32, DM / 256, F.G, (int)blockIdx.x);
              pg8::EpiBf16 E{WSP(bf16, WS_MO), DM, nullptr, 0, 0, 0.f}; pg8::gemm_phase<pg8::EpiBf16, pg8::PlainAB, pg8::LatentOrder>(F.lds, ab, DMIX, S, E); }
            if (need_ctx) { pg8::PieceAB ab{WSP(bf16, WS_YMIX), WSP(bf16, WS_WOUT) + (size_t)l * DM * DMIX, DMIX, DMIX, 256}; pg8::PieceOrder S; S.init(DM / 256, 8, F.G, (int)blockIdx.x);
              pg8::EpiSlab E{WSP(pg8::slab_t, WS_SLAB)}; pg8::gemm_phase<pg8::EpiSlab, pg8::PieceAB, pg8::PieceOrder>(F.lds, ab, 256, S, E); } }
        SEAM(sb + 4);
        if (IN(sb + 5)) { LAUNDER(); if (PROBE_DUP & (1u << 14)) norm_pass(F, 1, l, true);
#if X_BF16
            norm_pass_pipe(F, 1, l);
#else
            norm_pass(F, 1, l);
#endif
        }
        SEAM(sb + 5);
        if (IN(sb + 6)) REP(10) { LAUNDER(); pg8::PlainAB ab{WSP(bf16, WS_H), WSP(bf16, WS_WUP) + (size_t)l * 2 * DFF * DM, DM, DM}; pg8::StaticOrder S; S.init(MR / 256, 2 * DFF / 256, F.G, (int)blockIdx.x);
            pg8::EpiBf16 E{WSP(bf16, WS_UP), 2 * DFF, nullptr, 0, 0, 0.f}; pg8::gemm_phase<pg8::EpiBf16, pg8::PlainAB>(F.lds, ab, DM, S, E); }
        SEAM(sb + 6);
        if (IN(sb + 7)) REP(11) { LAUNDER(); conv_gelu(F, l); }
        SEAM(sb + 7);
        if (IN(sb + 8)) REP(12) { LAUNDER();
            { pg8::PlainAB ab{WSP(bf16, WS_ACT), WSP(bf16, WS_WDN) + (size_t)l * DM * DFF, DFF, DFF}; pg8::LatentOrder S; S.init(32, DM / 256, F.G, (int)blockIdx.x);
              pg8::EpiBf16 E{WSP(bf16, WS_MO), DM, nullptr, 0, 0, 0.f}; pg8::gemm_phase<pg8::EpiBf16, pg8::PlainAB, pg8::LatentOrder>(F.lds, ab, DFF, S, E); }
            if (need_ctx) { pg8::PieceAB ab{WSP(bf16, WS_ACT), WSP(bf16, WS_WDN) + (size_t)l * DM * DFF, DFF, DFF, 512}; pg8::PieceOrder S; S.init(DM / 256, 11, F.G, (int)blockIdx.x);
              pg8::EpiSlab E{WSP(pg8::slab_t, WS_SLAB)}; pg8::gemm_phase<pg8::EpiSlab, pg8::PieceAB, pg8::PieceOrder>(F.lds, ab, 512, S, E); } }
        SEAM(sb + 8);
        if (IN(sb + 9)) { LAUNDER(); if (PROBE_DUP & (1u << 14)) norm_pass(F, 2, l, true);
#if X_BF16
            norm_pass_pipe(F, 2, l);
#else
            norm_pass(F, 2, l);
#endif
        }
        SEAM(sb + 9);
}

__global__ void __launch_bounds__(NTHR, 2) fwd_kernel(Args args) {
    extern __shared__ __attribute__((aligned(16))) unsigned char lds_raw[];
    Frame F;
    F.lds = (LAS unsigned char*)lds_raw; F.ws = args.ws; F.in = args.in; F.out = args.out;
    F.tid = threadIdx.x; F.lane = F.tid & 63; F.wave = __builtin_amdgcn_readfirstlane(F.tid >> 6);
    F.G = gridDim.x; { const int bx = blockIdx.x; F.vcu = (F.G % 8 == 0) ? (bx % 8) * (F.G / 8) + bx / 8 : bx; }
    volatile LAS unsigned* MISC = (volatile LAS unsigned*)(F.lds + MISC_OFF);
    volatile LAS unsigned* MISCP = MISC;
    for (int u = F.tid; u < (LDS_BYTES - LDSCTL_OFF) / 4; u += NTHR) ((LAS unsigned*)(F.lds + LDSCTL_OFF))[u] = 0u;
    __syncthreads();
#if PROBE_TIME >= 0
    if (blockIdx.x == 0 && F.tid == 0) MISCP[16] = (unsigned)__builtin_amdgcn_s_memrealtime();
#endif
#if MK_MULTI
    const int lo = args.ph_lo, hi = args.ph_hi;
#else
    constexpr int lo = 0, hi = NSTEPS;
#endif
    XcdBarrier bar; bar.bar = (unsigned*)(F.ws + WS_CTL) + CW_BAR; bar.x = 0; bar.st = nullptr;
    if (hi - lo > 1) bar = xcd_barrier_post((unsigned*)(F.ws + WS_CTL) + CW_BAR, MISC + 8);

    if (IN(0)) REP(0) { REP(15) { pro_mod(F); __syncthreads(); } REP(16) { pro_transposes(F); __syncthreads(); } REP(17) { pro_lru_w(F); pro_rope(F); __syncthreads(); } REP(18) { pro_hid(F); __syncthreads(); } }
    SEAM(0);
    if (IN(1)) REP(1) { pro_filter(F); __syncthreads(); norm_pass(F, 0, 0); __syncthreads(); }
    SEAM(1);

    layer_steps<0>(F, bar, lo, hi, MISCP); layer_steps<1>(F, bar, lo, hi, MISCP); layer_steps<2>(F, bar, lo, hi, MISCP); layer_steps<3>(F, bar, lo, hi, MISCP);
#undef IN
#undef SEAM
}

extern "C" void kernel_launch(void* const* d_in, const int* in_sizes, int n_in, void* d_out, int out_size, void* d_ws, size_t ws_size, hipStream_t stream) {
    static int grid = 0;
    if (grid == 0) {
        if (n_in != 30 || ws_size < WS_END) { fprintf(stderr, "kernel_launch: expected 30 inputs and >= %zu bytes of workspace (got %d, %zu)\n", (size_t)WS_END, n_in, ws_size); grid = -1; return; }
        int dev = 0, cus = 0, per_cu = 0;
        if (hipGetDevice(&dev) != hipSuccess || hipDeviceGetAttribute(&cus, hipDeviceAttributeMultiprocessorCount, dev) != hipSuccess) { grid = -1; return; }
        if (hipFuncSetAttribute((const void*)fwd_kernel, hipFuncAttributeMaxDynamicSharedMemorySize, LDS_BYTES) != hipSuccess) { fprintf(stderr, "kernel_launch: hipFuncSetAttribute failed\n"); grid = -1; return; }
        if (hipOccupancyMaxActiveBlocksPerMultiprocessor(&per_cu, (const void*)fwd_kernel, NTHR, LDS_BYTES) != hipSuccess || per_cu < 1) fprintf(stderr, "kernel_launch: occupancy query says %d\n", per_cu);
        (void)hipGetLastError();
        grid = cus;
    }
    if (grid < 0) return;
    (void)hipMemsetAsync((char*)d_ws + WS_CTL, 0, CTL_ZERO_BYTES, stream);
    Args a{};
    for (int i = 0; i < 30; ++i) a.in[i] = (const float*)d_in[i];
    a.out = (float*)d_out; a.ws = (unsigned char*)d_ws;
#if MK_MULTI
    for (int s = 0; s < NSTEPS; ++s) { a.ph_lo = s; a.ph_hi = s + 1; hipLaunchKernelGGL(fwd_kernel, dim3(grid), dim3(NTHR), LDS_BYTES, stream, a); }
#else
    a.ph_lo = 0; a.ph_hi = NSTEPS; hipLaunchKernelGGL(fwd_kernel, dim3(grid), dim3(NTHR), LDS_BYTES, stream, a);
#endif
}
```
